# Optimizing an MI355X kernel written in HIP

```python
import math
import jax
import jax.numpy as jnp
from jax import lax
import numpy as np

D_MODEL = 2048
BATCH = 2
SEQ = 16384
DEPTH = 2

GRID_W = 64
CTX_LEN = 256
ROPE_THETA = 10000.0
Q_BLOCK = 128
NORM_EPS = 1e-6
NEG_INF = -1e30

N_BRANCHES = 4
BRANCH_WIDTH = D_MODEL // 4
MLSTM_HEADS = 4
MLSTM_DV = BRANCH_WIDTH // MLSTM_HEADS
MLSTM_DK = MLSTM_DV // 2
MLSTM_CHUNK = 128
DIFF_HEADS = 4
DIFF_D = BRANCH_WIDTH // (2 * DIFF_HEADS)
SWA_HEADS = 8
SWA_KV_HEADS = 2
SWA_D = BRANCH_WIDTH // SWA_HEADS
SWA_WINDOW = 128
GQA_HEADS = 4
GQA_KV_HEADS = 2
GQA_D = BRANCH_WIDTH // GQA_HEADS
FFN_HIDDEN = -(-8 * D_MODEL // (3 * 256)) * 256

IN_SPLITS = (
    MLSTM_HEADS * MLSTM_DK,
    MLSTM_HEADS * MLSTM_DK,
    MLSTM_HEADS * MLSTM_DV,
    MLSTM_HEADS * MLSTM_DV,
    4 * MLSTM_HEADS,
    DIFF_HEADS * 2 * DIFF_D,
    DIFF_HEADS * 2 * DIFF_D,
    DIFF_HEADS * 2 * DIFF_D,
    SWA_HEADS * SWA_D,
    SWA_KV_HEADS * SWA_D,
    SWA_KV_HEADS * SWA_D,
    GQA_HEADS * GQA_D,
    GQA_KV_HEADS * GQA_D,
    GQA_KV_HEADS * GQA_D,
    N_BRANCHES * D_MODEL,
)
D_IN = sum(IN_SPLITS)

kernel_name = "hybrid_mlstm_diffattn_swa_gqa_dit_block"


def rms_norm(x, g):
    xf = x.astype(jnp.float32)
    y = xf * lax.rsqrt(jnp.mean(xf * xf, axis=-1, keepdims=True) + NORM_EPS)
    return (y * g.astype(jnp.float32)).astype(x.dtype)


def modulate(h, shift, scale):
    return h * (1 + scale) + shift


def split_cols(p):
    offsets = []
    acc = 0
    for s in IN_SPLITS[:-1]:
        acc += s
        offsets.append(acc)
    return jnp.split(p, offsets, axis=-1)


def axial_rope_tables(rows, head_dim):
    row = jnp.repeat(jnp.arange(rows, dtype=jnp.float32), GRID_W)
    col = jnp.tile(jnp.arange(GRID_W, dtype=jnp.float32), rows)
    n_freq = head_dim // 4
    inv = ROPE_THETA ** (-jnp.arange(n_freq, dtype=jnp.float32) / n_freq)
    ang = jnp.stack([row[:, None] * inv, col[:, None] * inv], axis=1)
    return jnp.cos(ang), jnp.sin(ang)


def apply_rope(x, cos, sin):
    b, n, h, d = x.shape
    xr = x.reshape(b, n, h, 2, 2, d // 4)
    x1, x2 = xr[..., 0, :], xr[..., 1, :]
    c = cos[None, :, None].astype(x.dtype)
    s = sin[None, :, None].astype(x.dtype)
    return jnp.stack([x1 * c - x2 * s, x2 * c + x1 * s], axis=-2).reshape(b, n, h, d)


def dense_gqa(q, k, v, sink=None):
    b, nq, hq, d = q.shape
    hkv, dv = k.shape[2], v.shape[-1]
    g = hq // hkv
    nb = nq // Q_BLOCK
    qb = q.reshape(b, nb, Q_BLOCK, hkv, g, d).transpose(1, 0, 2, 3, 4, 5)
    scale = d ** -0.5

    def block(qblk):
        s = jnp.einsum("bqhgd,bkhd->bhgqk", qblk, k).astype(jnp.float32) * scale
        if sink is not None:
            sk = jnp.broadcast_to(sink.astype(jnp.float32).reshape(1, hkv, g, 1, 1), s.shape[:-1] + (1,))
            p = jax.nn.softmax(jnp.concatenate([s, sk], axis=-1), axis=-1)[..., :-1]
        else:
            p = jax.nn.softmax(s, axis=-1)
        return jnp.einsum("bhgqk,bkhd->bqhgd", p.astype(v.dtype), v)

    o = lax.map(block, qb)
    return o.transpose(1, 0, 2, 3, 4, 5).reshape(b, nq, hq, dv)


def window_attention(q, k, v, k_ctx, v_ctx, sink):
    b, n, hq, d = q.shape
    hkv = k.shape[2]
    g = hq // hkv
    nb = n // Q_BLOCK
    nc = k_ctx.shape[1]
    span = Q_BLOCK + 2 * SWA_WINDOW
    pad = ((0, 0), (SWA_WINDOW, SWA_WINDOW), (0, 0), (0, 0))
    k_pad = jnp.pad(k, pad)
    v_pad = jnp.pad(v, pad)
    qb = q.reshape(b, nb, Q_BLOCK, hkv, g, d).transpose(1, 0, 2, 3, 4, 5)
    scale = d ** -0.5
    sink_l = sink.astype(jnp.float32).reshape(1, hkv, g, 1, 1)

    def block(args):
        j, qblk = args
        start = j * Q_BLOCK
        kb = lax.dynamic_slice_in_dim(k_pad, start, span, axis=1)
        vb = lax.dynamic_slice_in_dim(v_pad, start, span, axis=1)
        qpos = start + jnp.arange(Q_BLOCK)
        kpos = start - SWA_WINDOW + jnp.arange(span)
        valid = (jnp.abs(qpos[:, None] - kpos[None, :]) <= SWA_WINDOW) & (kpos[None, :] >= 0) & (kpos[None, :] < n)
        s_band = jnp.einsum("bqhgd,bkhd->bhgqk", qblk, kb).astype(jnp.float32) * scale
        s_band = jnp.where(valid, s_band, NEG_INF)
        s_ctx = jnp.einsum("bqhgd,bkhd->bhgqk", qblk, k_ctx).astype(jnp.float32) * scale
        s_sink = jnp.broadcast_to(sink_l, s_ctx.shape[:-1] + (1,))
        p = jax.nn.softmax(jnp.concatenate([s_ctx, s_band, s_sink], axis=-1), axis=-1).astype(v.dtype)
        return (jnp.einsum("bhgqk,bkhd->bqhgd", p[..., :nc], v_ctx)
                + jnp.einsum("bhgqk,bkhd->bqhgd", p[..., nc:nc + span], vb))

    o = lax.map(block, (jnp.arange(nb), qb))
    return o.transpose(1, 0, 2, 3, 4, 5).reshape(b, n, hq, v.shape[-1])


def diff_attention(q, k, v, lam):
    b, nq, h, _, d = q.shape
    nb = nq // Q_BLOCK
    qb = q.reshape(b, nb, Q_BLOCK, h, 2, d).transpose(1, 0, 2, 3, 4, 5)
    scale = d ** -0.5
    lam_f = lam.astype(jnp.float32)[None, :, None, None]

    def block(qblk):
        s = jnp.einsum("bqhmd,bkhmd->bhmqk", qblk, k).astype(jnp.float32) * scale
        p = jax.nn.softmax(s, axis=-1)
        a = p[:, :, 0] - lam_f * p[:, :, 1]
        return jnp.einsum("bhqk,bkhe->bqhe", a.astype(v.dtype), v)

    o = lax.map(block, qb)
    return o.transpose(1, 0, 2, 3, 4).reshape(b, nq, h, v.shape[-1])


def mlstm_chunked(q, k, v, ig, lf, state):
    b, n, h, dk = q.shape
    dv = v.shape[-1]
    L = MLSTM_CHUNK
    nc = n // L

    def to_chunks(a):
        a = a.astype(jnp.float32).reshape((b, nc, L, h) + a.shape[3:])
        return jnp.moveaxis(a, 2, 3).swapaxes(0, 1)

    xs = (to_chunks(q), to_chunks(k) * (dk ** -0.5), to_chunks(v), to_chunks(ig), to_chunks(lf))
    tril = jnp.tril(jnp.ones((L, L), dtype=bool))

    def step(carry, inp):
        C, nv, m = carry
        qc, kc, vc, ic, fc = inp
        bcum = jnp.cumsum(fc, axis=-1)
        dmat = bcum[..., :, None] - bcum[..., None, :] + ic[..., None, :]
        dmat = jnp.where(tril, dmat, NEG_INF)
        inter = bcum + m[..., None]
        m_t = jnp.maximum(inter, jnp.max(dmat, axis=-1))
        w_intra = jnp.exp(dmat - m_t[..., None])
        w_inter = jnp.exp(inter - m_t)
        s = jnp.einsum("bhtd,bhsd->bhts", qc, kc) * w_intra
        num = (w_inter[..., None] * jnp.einsum("bhvd,bhtd->bhtv", C, qc)
               + jnp.einsum("bhts,bhsv->bhtv", s, vc))
        den = w_inter * jnp.einsum("bhd,bhtd->bht", nv, qc) + jnp.sum(s, axis=-1)
        hout = num / jnp.maximum(jnp.abs(den), jnp.exp(-m_t))[..., None]
        b_last = bcum[..., -1]
        log_w = b_last[..., None] - bcum + ic
        m_new = jnp.maximum(b_last + m, jnp.max(log_w, axis=-1))
        decay = jnp.exp(b_last + m - m_new)
        w_s = jnp.exp(log_w - m_new[..., None])
        C_new = decay[..., None, None] * C + jnp.einsum("bhs,bhsv,bhsd->bhvd", w_s, vc, kc)
        n_new = decay[..., None] * nv + jnp.einsum("bhs,bhsd->bhd", w_s, kc)
        return (C_new, n_new, m_new), hout

    state, hs = lax.scan(step, state, xs)
    hs = jnp.moveaxis(hs.swapaxes(0, 1), 2, 3).reshape(b, n, h, dv)
    return hs.astype(v.dtype), state


def mlstm_mixer(pc, pl, gate_b, norm_g, ctx_out):
    def prep(p):
        q, k, v, o, gt = p
        b, n = q.shape[:2]
        q = q.reshape(b, n, MLSTM_HEADS, MLSTM_DK)
        k = k.reshape(b, n, MLSTM_HEADS, MLSTM_DK)
        v = v.reshape(b, n, MLSTM_HEADS, MLSTM_DV)
        gt = gt.astype(jnp.float32).reshape(b, n, 4, MLSTM_HEADS) + gate_b.astype(jnp.float32)
        fwd = (q, k, v, gt[:, :, 0], jax.nn.log_sigmoid(gt[:, :, 1]))
        bwd = tuple(jnp.flip(a, axis=1) for a in (q, k, v, gt[:, :, 2], jax.nn.log_sigmoid(gt[:, :, 3])))
        return fwd, bwd, o

    fc, bc, oc = prep(pc)
    fl, bl, ol = prep(pl)
    b = ol.shape[0]
    zero = (jnp.zeros((b, MLSTM_HEADS, MLSTM_DV, MLSTM_DK), jnp.float32),
            jnp.zeros((b, MLSTM_HEADS, MLSTM_DK), jnp.float32),
            jnp.zeros((b, MLSTM_HEADS), jnp.float32))
    hc_f, st_f = mlstm_chunked(*fc, zero)
    hl_f, _ = mlstm_chunked(*fl, st_f)
    hc_b, st_b = mlstm_chunked(*bc, zero)
    hl_b, _ = mlstm_chunked(*bl, st_b)
    g = norm_g.reshape(MLSTM_HEADS, MLSTM_DV)

    def finish(h, o):
        bb, n = h.shape[:2]
        h = rms_norm(h, g).reshape(bb, n, MLSTM_HEADS * MLSTM_DV)
        return h * jax.nn.sigmoid(o)

    yl = finish(hl_f + jnp.flip(hl_b, axis=1), ol)
    yc = finish(hc_f + jnp.flip(hc_b, axis=1), oc) if ctx_out else None
    return yc, yl


def diff_mixer(pc, pl, lam_params, norm_g, lam_init, rope, ctx_out):
    def heads(p):
        q, k, v = p
        b, n = q.shape[:2]
        return (q.reshape(b, n, 2 * DIFF_HEADS, DIFF_D),
                k.reshape(b, n, 2 * DIFF_HEADS, DIFF_D),
                v.reshape(b, n, DIFF_HEADS, 2 * DIFF_D))

    qc, kc, vc = heads(pc)
    ql, kl, vl = heads(pl)
    ql = apply_rope(ql, *rope)
    kl = apply_rope(kl, *rope)

    def pair(a):
        return a.reshape(a.shape[0], a.shape[1], DIFF_HEADS, 2, DIFF_D)

    lp = lam_params.astype(jnp.float32)
    lam = jnp.exp(jnp.sum(lp[0] * lp[1], axis=-1)) - jnp.exp(jnp.sum(lp[2] * lp[3], axis=-1)) + lam_init
    g = norm_g.reshape(DIFF_HEADS, 2 * DIFF_D)

    def finish(o):
        b, n = o.shape[:2]
        return (rms_norm(o, g) * (1.0 - lam_init)).reshape(b, n, DIFF_HEADS * 2 * DIFF_D)

    k_all = jnp.concatenate([pair(kc), pair(kl)], axis=1)
    v_all = jnp.concatenate([vc, vl], axis=1)
    yl = finish(diff_attention(pair(ql), k_all, v_all, lam))
    yc = finish(diff_attention(pair(qc), pair(kc), vc, lam)) if ctx_out else None
    return yc, yl


def swa_mixer(pc, pl, sink, rope, ctx_out):
    def heads(p):
        q, k, v = p
        b, n = q.shape[:2]
        return (q.reshape(b, n, SWA_HEADS, SWA_D),
                k.reshape(b, n, SWA_KV_HEADS, SWA_D),
                v.reshape(b, n, SWA_KV_HEADS, SWA_D))

    qc, kc, vc = heads(pc)
    ql, kl, vl = heads(pl)
    ql = apply_rope(ql, *rope)
    kl = apply_rope(kl, *rope)

    def flat(o):
        return o.reshape(o.shape[0], o.shape[1], SWA_HEADS * SWA_D)

    yl = flat(window_attention(ql, kl, vl, kc, vc, sink))
    yc = flat(dense_gqa(qc, kc, vc, sink)) if ctx_out else None
    return yc, yl


def gqa_mixer(pc, pl, q_norm_g, k_norm_g, rope, ctx_out):
    def heads(p):
        q, k, v = p
        b, n = q.shape[:2]
        q = rms_norm(q.reshape(b, n, GQA_HEADS, GQA_D), q_norm_g)
        k = rms_norm(k.reshape(b, n, GQA_KV_HEADS, GQA_D), k_norm_g)
        return q, k, v.reshape(b, n, GQA_KV_HEADS, GQA_D)

    qc, kc, vc = heads(pc)
    ql, kl, vl = heads(pl)
    ql = apply_rope(ql, *rope)
    kl = apply_rope(kl, *rope)

    def flat(o):
        return o.reshape(o.shape[0], o.shape[1], GQA_HEADS * GQA_D)

    yl = flat(dense_gqa(ql, jnp.concatenate([kc, kl], axis=1), jnp.concatenate([vc, vl], axis=1)))
    yc = flat(dense_gqa(qc, kc, vc)) if ctx_out else None
    return yc, yl


def merge_branches(ys, gate_pre, w_branch, w_out):
    b, n = gate_pre.shape[:2]
    gates = jax.nn.sigmoid(gate_pre.astype(jnp.float32)).astype(ys[0].dtype).reshape(b, n, N_BRANCHES, D_MODEL)
    acc = gates[:, :, 0] * (ys[0] @ w_branch[0])
    for i in range(1, N_BRANCHES):
        acc = acc + gates[:, :, i] * (ys[i] @ w_branch[i])
    return acc @ w_out


def hybrid_mixer(hc, hl, w_in, mlstm_gate_b, mlstm_norm_g, diff_lambda, diff_norm_g, lam_init,
                 swa_sink, gqa_q_norm_g, gqa_k_norm_g, w_branch, w_out, rope64, rope128, ctx_out):
    pc = split_cols(hc @ w_in)
    pl = split_cols(hl @ w_in)
    ya_c, ya_l = mlstm_mixer(pc[0:5], pl[0:5], mlstm_gate_b, mlstm_norm_g, ctx_out)
    yb_c, yb_l = diff_mixer(pc[5:8], pl[5:8], diff_lambda, diff_norm_g, lam_init, rope64, ctx_out)
    yc_c, yc_l = swa_mixer(pc[8:11], pl[8:11], swa_sink, rope64, ctx_out)
    yd_c, yd_l = gqa_mixer(pc[11:14], pl[11:14], gqa_q_norm_g, gqa_k_norm_g, rope128, ctx_out)
    out_l = merge_branches((ya_l, yb_l, yc_l, yd_l), pl[14], w_branch, w_out)
    out_c = merge_branches((ya_c, yb_c, yc_c, yd_c), pc[14], w_branch, w_out) if ctx_out else None
    return out_c, out_l


def swiglu(h, w_up, w_down):
    gate, up = jnp.split(h @ w_up, 2, axis=-1)
    return (jax.nn.silu(gate) * up) @ w_down


def setup_inputs(seed: int = 0) -> dict:
    key = jax.random.key(seed)
    ks = jax.random.split(key, 24)
    f32 = jnp.float32

    def nrm(k, shape, s):
        return s * jax.random.normal(k, shape, f32)

    zeros_h = jnp.zeros((MLSTM_HEADS,), f32)
    forget_base = jnp.linspace(3.0, 6.0, MLSTM_HEADS, dtype=f32)
    gate_base = jnp.stack([zeros_h, forget_base, zeros_h, forget_base])
    return {
        "x": nrm(ks[0], (BATCH, SEQ, D_MODEL), 1.0),
        "c": nrm(ks[1], (BATCH, D_MODEL), 1.0),
        "ctx": nrm(ks[2], (BATCH, CTX_LEN, D_MODEL), 1.0),
        "c_ctx": nrm(ks[3], (D_MODEL,), 1.0),
        "ada_w": nrm(ks[4], (DEPTH, D_MODEL, 6 * D_MODEL), 0.5 * D_MODEL ** -0.5),
        "ada_b": nrm(ks[5], (DEPTH, 6 * D_MODEL), 0.01),
        "norm1_g": 1.0 + nrm(ks[6], (DEPTH, D_MODEL), 0.01),
        "w_in": nrm(ks[7], (DEPTH, D_MODEL, D_IN), D_MODEL ** -0.5),
        "mlstm_gate_b": gate_base + nrm(ks[8], (DEPTH, 4, MLSTM_HEADS), 0.1),
        "mlstm_norm_g": 1.0 + nrm(ks[9], (DEPTH, MLSTM_HEADS * MLSTM_DV), 0.01),
        "diff_lambda": nrm(ks[10], (DEPTH, 4, DIFF_HEADS, DIFF_D), 0.1),
        "diff_norm_g": 1.0 + nrm(ks[11], (DEPTH, DIFF_HEADS * 2 * DIFF_D), 0.01),
        "swa_sink": nrm(ks[12], (DEPTH, SWA_HEADS), 0.5),
        "gqa_q_norm_g": 1.0 + nrm(ks[13], (DEPTH, GQA_D), 0.01),
        "gqa_k_norm_g": 1.0 + nrm(ks[14], (DEPTH, GQA_D), 0.01),
        "w_branch": nrm(ks[15], (DEPTH, N_BRANCHES, BRANCH_WIDTH, D_MODEL), BRANCH_WIDTH ** -0.5),
        "w_out": nrm(ks[16], (DEPTH, D_MODEL, D_MODEL), D_MODEL ** -0.5),
        "norm2_g": 1.0 + nrm(ks[17], (DEPTH, D_MODEL), 0.01),
        "w_up": nrm(ks[18], (DEPTH, D_MODEL, 2 * FFN_HIDDEN), D_MODEL ** -0.5),
        "w_down": nrm(ks[19], (DEPTH, FFN_HIDDEN, D_MODEL), FFN_HIDDEN ** -0.5),
        "final_norm_g": 1.0 + nrm(ks[20], (D_MODEL,), 0.01),
    }


def reference(x, c, ctx, c_ctx, ada_w, ada_b, norm1_g, w_in, mlstm_gate_b, mlstm_norm_g,
              diff_lambda, diff_norm_g, swa_sink, gqa_q_norm_g, gqa_k_norm_g, w_branch, w_out,
              norm2_g, w_up, w_down, final_norm_g):
    n_lat = x.shape[1]
    rows = n_lat // GRID_W
    rope64 = axial_rope_tables(rows, DIFF_D)
    rope128 = axial_rope_tables(rows, GQA_D)
    s_lat = jax.nn.silu(c.astype(jnp.float32))
    s_ctx = jax.nn.silu(c_ctx.astype(jnp.float32))
    xc = ctx
    for l in range(DEPTH):
        last = l == DEPTH - 1
        mod_l = (s_lat @ ada_w[l] + ada_b[l]).astype(x.dtype)[:, None, :]
        mod_c = (s_ctx @ ada_w[l] + ada_b[l]).astype(x.dtype)[None, None, :]
        sh1_l, sc1_l, g1_l, sh2_l, sc2_l, g2_l = jnp.split(mod_l, 6, axis=-1)
        sh1_c, sc1_c, g1_c, sh2_c, sc2_c, g2_c = jnp.split(mod_c, 6, axis=-1)
        lam_init = 0.8 - 0.6 * math.exp(-0.3 * l)

        hl = modulate(rms_norm(x, norm1_g[l]), sh1_l, sc1_l)
        hc = modulate(rms_norm(xc, norm1_g[l]), sh1_c, sc1_c)
        out_c, out_l = hybrid_mixer(hc, hl, w_in[l], mlstm_gate_b[l], mlstm_norm_g[l], diff_lambda[l],
                                    diff_norm_g[l], lam_init, swa_sink[l], gqa_q_norm_g[l], gqa_k_norm_g[l],
                                    w_branch[l], w_out[l], rope64, rope128, not last)
        x = x + g1_l * out_l
        hl = modulate(rms_norm(x, norm2_g[l]), sh2_l, sc2_l)
        x = x + g2_l * swiglu(hl, w_up[l], w_down[l])
        if not last:
            xc = xc + g1_c * out_c
            hc = modulate(rms_norm(xc, norm2_g[l]), sh2_c, sc2_c)
            xc = xc + g2_c * swiglu(hc, w_up[l], w_down[l])
    return rms_norm(x, final_norm_g)
```

```cpp
#include <hip/hip_runtime.h>
#include <hip/hip_bf16.h>
#include <hip/hip_cooperative_groups.h>
#include <cstdio>
#include <cstdint>
namespace cg = cooperative_groups;

constexpr int DM = 2048, NBATCH = 2, SEQ = 16384, CTX = 256, DEPTH = 2;
constexpr int TPB = SEQ + CTX;
constexpr int MROWS = NBATCH * TPB;
constexpr int DIN = 13072, NMIX = 4880, PP = 5120;
constexpr int FF = 5632;
constexpr int C_MQ = 0, C_MK = 256, C_MV = 512, C_MO = 1024, C_MG = 1536, C_DQ = 1552, C_DK = 2064, C_DV = 2576, C_SQ = 3088, C_SK = 3600, C_SV = 3728,
              C_GQ = 3856, C_GK = 4368, C_GV = 4624;
constexpr int NCHUNK = TPB / 128;
constexpr float NORM_EPS = 1e-6f;

constexpr size_t MiB = 1u << 20;
constexpr size_t WS_MODP = 0;
constexpr size_t WS_MOD = 5 * MiB;
constexpr size_t WS_ROPE = 5 * MiB + 512 * 1024;
constexpr size_t WS_LAM = 5 * MiB + 768 * 1024;
constexpr size_t WS_MSC = 6 * MiB;
constexpr size_t WS_NST = 6 * MiB + 512 * 1024;
constexpr size_t WS_W = 8 * MiB;
constexpr size_t WS_WIN = WS_W, WS_WG = WS_WIN + 20 * MiB, WS_WB = WS_WG + 32 * MiB, WS_WOUT = WS_WB + 8 * MiB, WS_WUP = WS_WOUT + 8 * MiB, WS_WDN = WS_WUP + 44 * MiB;
constexpr size_t WS_H = WS_WDN + 22 * MiB;
constexpr size_t WS_Y = WS_H + 130 * MiB;
constexpr size_t WS_XC = WS_Y + 130 * MiB;
constexpr size_t WS_BIG = WS_XC + 4 * MiB;
constexpr size_t WS_P = WS_BIG, WS_DTMP = WS_BIG + 325 * MiB, WS_CST = WS_BIG + 390 * MiB;
constexpr size_t WS_END = WS_BIG + 520 * MiB;
static_assert(WS_H == 142 * MiB && WS_END == 926 * MiB, "ws map");
static_assert((size_t)MROWS * PP * 2 <= 325 * MiB && (size_t)MROWS * 1024 * 2 <= 65 * MiB && (size_t)16 * NCHUNK * 8192 * 4 <= 65 * MiB, "big map");
static_assert((size_t)4 * MROWS * DM * 2 <= 520 * MiB && (size_t)MROWS * FF * 2 <= 520 * MiB, "big map 2");

constexpr int LDS_BYTES = 147456;

typedef unsigned short bf16raw;
typedef float f32x4_t __attribute__((ext_vector_type(4)));
typedef float f32x2_t __attribute__((ext_vector_type(2)));
typedef unsigned u32x4_t __attribute__((ext_vector_type(4)));
typedef unsigned u32x2_t __attribute__((ext_vector_type(2)));
typedef __bf16 bf16x2_t __attribute__((ext_vector_type(2)));

__device__ __forceinline__ unsigned pk2(float lo, float hi) { f32x2_t v = {lo, hi}; bf16x2_t b = __builtin_convertvector(v, bf16x2_t); return __builtin_bit_cast(unsigned, b); }
__device__ __forceinline__ float bflo(unsigned u) { return __uint_as_float(u << 16); }
__device__ __forceinline__ float bfhi(unsigned u) { return __uint_as_float(u & 0xffff0000u); }
__device__ __forceinline__ float bf1(bf16raw u) { return __uint_as_float(((unsigned)u) << 16); }
__device__ __forceinline__ void unpack8(const u32x4_t w, float* f) { f[0] = bflo(w.x); f[1] = bfhi(w.x); f[2] = bflo(w.y); f[3] = bfhi(w.y); f[4] = bflo(w.z); f[5] = bfhi(w.z); f[6] = bflo(w.w); f[7] = bfhi(w.w); }
__device__ __forceinline__ u32x4_t pack8(const float* f) { u32x4_t w; w.x = pk2(f[0], f[1]); w.y = pk2(f[2], f[3]); w.z = pk2(f[4], f[5]); w.w = pk2(f[6], f[7]); return w; }
__device__ __forceinline__ float wave_sum(float v) {
#pragma unroll
    for (int o = 1; o < 64; o <<= 1) v += __shfl_xor(v, o);
    return v;
}
__device__ __forceinline__ float wave_max(float v) {
#pragma unroll
    for (int o = 1; o < 64; o <<= 1) v = fmaxf(v, __shfl_xor(v, o));
    return v;
}
__device__ __forceinline__ float sigmoid_f(float x) { return __builtin_amdgcn_rcpf(1.f + __expf(-x)); }

struct XPtr { const float* lat; const float* ctx;
    __device__ __forceinline__ const float* row(int r) const { const int b = r / TPB, t = r - b * TPB; return t < CTX ? ctx + ((size_t)b * CTX + t) * DM : lat + ((size_t)b * SEQ + (t - CTX)) * DM; } };
struct XOut { float* lat; float* ctx;
    __device__ __forceinline__ float* row(int r) const { const int b = r / TPB, t = r - b * TPB; return t < CTX ? ctx + ((size_t)b * CTX + t) * DM : lat + ((size_t)b * SEQ + (t - CTX)) * DM; } };

namespace pg8 {
#define PG8_LAS __attribute__((address_space(3)))
typedef unsigned short bf16_t;
typedef short bf16x8 __attribute__((ext_vector_type(8)));
typedef float f32x4 __attribute__((ext_vector_type(4)));
typedef unsigned u32x4 __attribute__((ext_vector_type(4)));
constexpr int BM = 256, BK = 64, HALF = 128, HTB = HALF * BK * 2  , STAGE_BYTES = 8 * HTB, NXCD = 8, WGM = 8;

__host__ __device__ __forceinline__ int lds_byte(int r, int c) { const int st = (r >> 4) * 2 + (c >> 5), rr = r & 15, cc = c & 31, ob = rr * 64 + cc * 2; return st * 1024 + (ob ^ (((ob >> 9) & 1) << 5)); }
__host__ __device__ __forceinline__ void stage_rc(int b, int& R, int& C) { const int st = b / 1024, sb = b % 1024, swz = sb ^ (((sb >> 9) & 1) << 5); R = (st >> 1) * 16 + swz / 64; C = (st & 1) * 32 + (swz % 64) / 2; }
__host__ __device__ __forceinline__ int perm32(int rho) { const int n = rho >> 4, i = rho & 15; return 8 * (i >> 2) + 4 * n + (i & 3); }

struct Unit { int pm, pn; };
struct Gemm { const bf16_t* A; const bf16_t* Bt; int M, N, K; int lda; int agrp; int agstride; };

struct StaticOrder {
    int nM, nN, nwg, G, c;
    __host__ __device__ void init(int M, int N, int G_, int c_) { nM = M / BM; nN = N / BM; nwg = nM * nN; G = G_; c = c_; }
    __host__ __device__ bool next(int i, Unit& u) const {
        const long L = (long)i * G + c; if (L >= nwg) return false;
        int wgid = (int)L; { const int q = nwg / NXCD, r = nwg % NXCD, xcd = wgid % NXCD, off = wgid / NXCD; wgid = (xcd < r ? xcd * (q + 1) : r * (q + 1) + (xcd - r) * q) + off; }
        const int nig = WGM * nN, gid = wgid / nig, fm = gid * WGM, gsz = (nM - fm) < WGM ? (nM - fm) : WGM;
        u.pm = fm + ((wgid % nig) % gsz); u.pn = (wgid % nig) / gsz; return true;
    }
    __device__ __forceinline__ void a_ready(const Unit&) const {}
    __device__ __forceinline__ void done(const Unit&) const {}
};

__device__ __forceinline__ unsigned cvt_pk_bf16(float lo, float hi) { unsigned r; asm volatile("v_cvt_pk_bf16_f32 %0, %1, %2" : "=v"(r) : "v"(lo), "v"(hi)); return r; }
typedef float f32x2 __attribute__((ext_vector_type(2)));
__device__ __forceinline__ f32x2 gelu_pk(f32x2 v) {
    const f32x2 av = __builtin_elementwise_abs(v), d = av * 0.2316418882f + 1.0f;
    f32x2 t; t.x = __builtin_amdgcn_rcpf(d.x); t.y = __builtin_amdgcn_rcpf(d.y);
    f32x2 q = t * 0.5307027145f + (-0.7265760135f); q = q * t + 0.7107068705f; q = q * t + (-0.142248368f); q = q * t + 0.127414796f; q = q * t;
    const f32x2 s = (v * v) * (-0.72134752044f);
    f32x2 e; e.x = __builtin_amdgcn_exp2f(s.x); e.y = __builtin_amdgcn_exp2f(s.y);
    const f32x2 m = v * (q * e), r = v - m;
    f32x2 o; o.x = v.x < 0.f ? m.x : r.x; o.y = v.y < 0.f ? m.y : r.y; return o;
}

template <int ACT  > struct EpiBf16 {
    static constexpr bool PERM = true, AFTER_DRAIN = false; static_assert(ACT == 0 || ACT == 1, "EpiBf16: ACT is 0 (none) or 1 (gelu_pk)");
    bf16_t* O; int ldc; const float* bias; int split_cols; size_t split_stride; float scale0;
    __device__ __forceinline__ void operator()(const f32x4 (&acc)[2][2][4][2], const Unit& u, int wr, int wc, int fr, int fq) const {
        asm volatile("" : "+v"(fr), "+v"(fq));
        const int row0 = u.pm * BM + wr * 64 + fr; int colt = u.pn * BM; bf16_t* base = O;
        float sc = 1.f; if (split_cols) { const int t = colt / split_cols; base += (size_t)t * split_stride; colt -= t * split_cols; if (t == 0) sc = scale0; }
        const int col0 = colt + wc * 32 + 8 * fq, bcol0 = u.pn * BM + wc * 32 + 8 * fq;
        f32x4 bv[2][2];
#pragma unroll
        for (int bj = 0; bj < 2; ++bj)
#pragma unroll
            for (int n = 0; n < 2; ++n) bv[bj][n] = bias ? *(const f32x4*)(bias + bcol0 + bj * HALF + 4 * n) : (f32x4){0.f, 0.f, 0.f, 0.f};
#pragma unroll
        for (int ai = 0; ai < 2; ++ai)
#pragma unroll
            for (int m = 0; m < 4; ++m) { bf16_t* rowp = base + (size_t)(row0 + ai * HALF + m * 16) * ldc + col0;
#pragma unroll
                for (int bj = 0; bj < 2; ++bj) { f32x4 v0 = acc[ai][bj][m][0] + bv[bj][0], v1 = acc[ai][bj][m][1] + bv[bj][1];
                    if (ACT == 1) { f32x2 a = gelu_pk((f32x2){v0[0], v0[1]}), b = gelu_pk((f32x2){v0[2], v0[3]}), c = gelu_pk((f32x2){v1[0], v1[1]}), d = gelu_pk((f32x2){v1[2], v1[3]});
                        v0 = (f32x4){a.x, a.y, b.x, b.y}; v1 = (f32x4){c.x, c.y, d.x, d.y}; }
                    v0 = v0 * sc; v1 = v1 * sc; u32x4 w; w.x = cvt_pk_bf16(v0[0], v0[1]); w.y = cvt_pk_bf16(v0[2], v0[3]); w.z = cvt_pk_bf16(v1[0], v1[1]); w.w = cvt_pk_bf16(v1[2], v1[3]);
                    *(u32x4*)(rowp + bj * HALF) = w; } }
    }
};

__device__ __forceinline__ float sigm(float x) { return __builtin_amdgcn_rcpf(1.f + __expf(-x)); }
struct EpiGate {
    static constexpr bool PERM = false, AFTER_DRAIN = false;
    const bf16_t* Bq; bf16_t* out; size_t bstride;
    __device__ __forceinline__ void operator()(const f32x4 (&acc)[2][2][4][2], const Unit& u, int wr, int wc, int fr, int fq) const {
        asm volatile("" : "+v"(fr), "+v"(fq));
        typedef unsigned u32x2 __attribute__((ext_vector_type(2)));
        const int oc = u.pn * 64 + wc * 16 + fq * 4;
#pragma unroll
        for (int ai = 0; ai < 2; ++ai) {
            u32x2 bv[4][4];
#pragma unroll
            for (int m = 0; m < 4; ++m) { const size_t off = (size_t)(u.pm * BM + ai * HALF + wr * 64 + m * 16 + fr) * 2048 + oc;
#pragma unroll
                for (int i = 0; i < 4; ++i) bv[m][i] = *(const u32x2*)(Bq + (size_t)i * bstride + off); }
#pragma unroll
            for (int m = 0; m < 4; ++m) {
                const size_t off = (size_t)(u.pm * BM + ai * HALF + wr * 64 + m * 16 + fr) * 2048 + oc;
                f32x4 s = (f32x4){0.f, 0.f, 0.f, 0.f};
#pragma unroll
                for (int bj = 0; bj < 2; ++bj)
#pragma unroll
                    for (int n = 0; n < 2; ++n) { const f32x4 g = acc[ai][bj][m][n]; const u32x2 b = bv[m][2 * bj + n];
                        s[0] += sigm(g[0]) * __uint_as_float(b.x << 16); s[1] += sigm(g[1]) * __uint_as_float(b.x & 0xffff0000u);
                        s[2] += sigm(g[2]) * __uint_as_float(b.y << 16); s[3] += sigm(g[3]) * __uint_as_float(b.y & 0xffff0000u); }
                u32x2 w; w.x = cvt_pk_bf16(s[0], s[1]); w.y = cvt_pk_bf16(s[2], s[3]);
                *(u32x2*)(out + off) = w; }
            asm volatile("" ::: "memory"); }
    }
};
struct EpiResid {
    static constexpr bool PERM = false, AFTER_DRAIN = false;
    const float* in_lat; const float* in_ctx; float* out_lat; float* out_ctx; const float* modl; int gidx;
    __device__ __forceinline__ void operator()(const f32x4 (&acc)[2][2][4][2], const Unit& u, int wr, int wc, int fr, int fq) const {
        asm volatile("" : "+v"(fr), "+v"(fq));
        const int b = u.pm / 65, tb = u.pm - b * 65; const bool isctx = (tb == 0);
        const float* gv = modl + (size_t)(isctx ? 2 : b) * 12288 + gidx * 2048;
        const float* xi = isctx ? in_ctx + (size_t)b * 256 * 2048 : in_lat + ((size_t)b * 16384 + (size_t)(tb - 1) * 256) * 2048;
        float* xo = isctx ? out_ctx + (size_t)b * 256 * 2048 : out_lat + ((size_t)b * 16384 + (size_t)(tb - 1) * 256) * 2048;
        const int col0 = u.pn * BM + wc * 32 + 4 * fq;
#pragma unroll
        for (int bj = 0; bj < 2; ++bj)
#pragma unroll
            for (int n = 0; n < 2; ++n) { const f32x4 gg = *(const f32x4*)(gv + col0 + bj * HALF + n * 16);
                f32x4 xv[2][4];
#pragma unroll
                for (int ai = 0; ai < 2; ++ai)
#pragma unroll
                    for (int m = 0; m < 4; ++m) xv[ai][m] = *(const f32x4*)(xi + (size_t)(ai * HALF + wr * 64 + m * 16 + fr) * 2048 + col0 + bj * HALF + n * 16);
#pragma unroll
                for (int ai = 0; ai < 2; ++ai)
#pragma unroll
                    for (int m = 0; m < 4; ++m) *(f32x4*)(xo + (size_t)(ai * HALF + wr * 64 + m * 16 + fr) * 2048 + col0 + bj * HALF + n * 16) = xv[ai][m] + gg * acc[ai][bj][m][n];
                asm volatile("" ::: "memory"); }
    }
};
struct EpiSwiGLU {
    static constexpr bool PERM = true, AFTER_DRAIN = false;
    bf16_t* hid; int ldh;
    __device__ __forceinline__ void operator()(const f32x4 (&acc)[2][2][4][2], const Unit& u, int wr, int wc, int fr, int fq) const {
        asm volatile("" : "+v"(fr), "+v"(fq));
        const int hc = u.pn * 128 + wc * 32 + 8 * fq;
#pragma unroll
        for (int ai = 0; ai < 2; ++ai)
#pragma unroll
            for (int m = 0; m < 4; ++m) { bf16_t* p = hid + (size_t)(u.pm * BM + ai * HALF + wr * 64 + m * 16 + fr) * ldh + hc;
                f32x4 v[2];
#pragma unroll
                for (int n = 0; n < 2; ++n) { const f32x4 g = acc[ai][0][m][n], up = acc[ai][1][m][n];
#pragma unroll
                    for (int e = 0; e < 4; ++e) v[n][e] = g[e] * sigm(g[e]) * up[e]; }
                u32x4 w; w.x = cvt_pk_bf16(v[0][0], v[0][1]); w.y = cvt_pk_bf16(v[0][2], v[0][3]); w.z = cvt_pk_bf16(v[1][0], v[1][1]); w.w = cvt_pk_bf16(v[1][2], v[1][3]);
                *(u32x4*)p = w; }
    }
};

template <class Epi, class Sched, bool ALIGN_EPI = false, bool SP2 = false>
__device__ __forceinline__ void gemm_phase(PG8_LAS unsigned char* lds, const Gemm g, const Sched& S, const Epi& E) {
    int tid_ = threadIdx.x; asm volatile("" : "+v"(tid_)); const int tid = tid_, wid = __builtin_amdgcn_readfirstlane(tid >> 6), lane = tid & 63, wr = wid >> 2, wc = wid & 3, fr = lane & 15, fq = lane >> 4;
    const int K = g.K, nt = K / BK;
    unsigned voffA[2], voffB[2];
#pragma unroll
    for (int i = 0; i < 2; ++i) { int R, C; stage_rc(tid * 16 + i * 8192, R, C); const int Rb = Epi::PERM ? ((R & ~31) + perm32(R & 31)) : R;
        voffA[i] = (unsigned)(R * g.lda + C) * 2u; voffB[i] = (unsigned)(Rb * K + C) * 2u; }
    const size_t kstep = (size_t)(BK * 2);
    const size_t hstepB = (size_t)HALF * K * 2, hstepA = (size_t)HALF * g.lda * 2;
    const size_t tstepA = 2 * hstepA, tstepB = 2 * hstepB;
    const unsigned ldsw = (unsigned)wid * 1024u;
    const int aoff = lds_byte(wr * 64 + fr, fq * 8), boff = lds_byte(wc * 32 + fr, fq * 8);
#define PG8_SA(b, h) (((b) * 2 + (h)) * HTB)
#define PG8_SB(b, h) ((4 + (b) * 2 + (h)) * HTB)
#define PG8_STAGE(bufoff, gbase, voff) do { _Pragma("unroll") for (int _i = 0; _i < 2; ++_i) \
        __builtin_amdgcn_global_load_lds((const unsigned*)((const char*)(gbase) + (voff)[_i]), (PG8_LAS unsigned*)(lds + (bufoff) + ldsw + _i * 8192), 16, 0, 0); } while (0)
#define PG8_LDA(dst, b, h) do { _Pragma("unroll") for (int m = 0; m < 4; ++m) _Pragma("unroll") for (int k = 0; k < 2; ++k) dst[m][k] = *(const PG8_LAS bf16x8*)(lds + PG8_SA(b, h) + aoff + m * 2048 + k * 1024); } while (0)
#define PG8_LDB(dst, b, h) do { _Pragma("unroll") for (int n = 0; n < 2; ++n) _Pragma("unroll") for (int k = 0; k < 2; ++k) dst[n][k] = *(const PG8_LAS bf16x8*)(lds + PG8_SB(b, h) + boff + n * 2048 + k * 1024); } while (0)
#define PG8_MMA(ai, bj, At, Bt) do { __builtin_amdgcn_s_setprio(1); _Pragma("unroll") for (int m = 0; m < 4; ++m) _Pragma("unroll") for (int n = 0; n < 2; ++n) _Pragma("unroll") for (int k = 0; k < 2; ++k) \
        acc[ai][bj][m][n] = __builtin_amdgcn_mfma_f32_16x16x32_bf16(Bt[n][k], At[m][k], acc[ai][bj][m][n], 0, 0, 0); __builtin_amdgcn_s_setprio(0); } while (0)
#define PG8_WAIT_V(n) asm volatile("s_waitcnt vmcnt(" #n ")" ::: "memory")
#define PG8_WAIT_L(n) asm volatile("s_waitcnt lgkmcnt(" #n ")" ::: "memory")
#define PG8_BAR __builtin_amdgcn_s_barrier()
#define PG8_SCHED __builtin_amdgcn_sched_barrier(0)
    Unit cur, nxt; int ui = 0;
    if (!S.next(0, cur)) return;
    f32x4 acc[2][2][4][2];
#pragma unroll
    for (int a = 0; a < 2; ++a)
#pragma unroll
        for (int b = 0; b < 2; ++b)
#pragma unroll
            for (int m = 0; m < 4; ++m)
#pragma unroll
                for (int n = 0; n < 2; ++n) acc[a][b][m][n] = (f32x4){0.f, 0.f, 0.f, 0.f};
    bf16x8 At[4][2], B0[2][2], B1[2][2];
    const char* cA = (const char*)g.A + (size_t)cur.pm * tstepA + (g.agrp ? (size_t)(cur.pn / g.agrp) * g.agstride * 2 : 0); const char* cB = (const char*)g.Bt + (size_t)cur.pn * tstepB;
    S.a_ready(cur);
    if constexpr (SP2) {
        PG8_STAGE(PG8_SB(0, 0), cB, voffB); PG8_STAGE(PG8_SB(0, 1), cB + hstepB, voffB); PG8_STAGE(PG8_SA(0, 0), cA, voffA); PG8_STAGE(PG8_SA(0, 1), cA + hstepA, voffA);
        if (wr == 1) PG8_BAR;
        PG8_WAIT_V(2); PG8_BAR;
        PG8_STAGE(PG8_SB(1, 0), cB + kstep, voffB); PG8_STAGE(PG8_SA(1, 0), cA + kstep, voffA); PG8_STAGE(PG8_SB(1, 1), cB + hstepB + kstep, voffB);
        PG8_WAIT_V(6); PG8_BAR;
    } else {
        PG8_STAGE(PG8_SB(0, 0), cB, voffB); PG8_STAGE(PG8_SA(0, 0), cA, voffA); PG8_STAGE(PG8_SB(0, 1), cB + hstepB, voffB); PG8_STAGE(PG8_SA(0, 1), cA + hstepA, voffA);
        if (wr == 1) PG8_BAR;
        PG8_WAIT_V(4); PG8_BAR;
        PG8_STAGE(PG8_SB(1, 0), cB + kstep, voffB); PG8_STAGE(PG8_SA(1, 0), cA + kstep, voffA); PG8_STAGE(PG8_SB(1, 1), cB + hstepB + kstep, voffB);
        PG8_WAIT_V(6); PG8_BAR;
    }
    for (;;) {
        const bool has_next = S.next(ui + 1, nxt);
        const char* nA = has_next ? (const char*)g.A + (size_t)nxt.pm * tstepA + (g.agrp ? (size_t)(nxt.pn / g.agrp) * g.agstride * 2 : 0) : cA; const char* nB = has_next ? (const char*)g.Bt + (size_t)nxt.pn * tstepB : cB;
        for (int t = 0; t < nt; t += 2) {
            const bool last = (t == nt - 2);
            const char* a1 = cA + (size_t)(t + 1) * kstep;
            const char* a2 = last ? nA : cA + (size_t)(t + 2) * kstep; const char* b2 = last ? nB : cB + (size_t)(t + 2) * kstep;
            const char* a3 = a2 + kstep; const char* b3 = b2 + kstep;
            if (last && has_next) S.a_ready(nxt);
            if constexpr (SP2) {
            PG8_LDB(B0, 0, 0); PG8_LDB(B1, 0, 1); PG8_SCHED; PG8_LDA(At, 0, 0); PG8_STAGE(PG8_SA(1, 1), a1 + hstepA, voffA);
            PG8_WAIT_V(8); PG8_WAIT_L(0); PG8_BAR; PG8_MMA(0, 0, At, B0); PG8_MMA(0, 1, At, B1); PG8_BAR; PG8_SCHED;
            PG8_LDA(At, 0, 1); PG8_STAGE(PG8_SB(0, 0), b2, voffB); PG8_STAGE(PG8_SB(0, 1), b2 + hstepB, voffB); PG8_STAGE(PG8_SA(0, 0), a2, voffA);
            PG8_WAIT_V(8); PG8_WAIT_L(0); PG8_BAR; PG8_MMA(1, 0, At, B0); PG8_MMA(1, 1, At, B1); PG8_BAR; PG8_SCHED;
            PG8_LDB(B0, 1, 0); PG8_LDB(B1, 1, 1); PG8_SCHED; PG8_LDA(At, 1, 0); PG8_STAGE(PG8_SA(0, 1), a2 + hstepA, voffA);
            PG8_WAIT_V(8); PG8_WAIT_L(0); PG8_BAR; PG8_MMA(0, 0, At, B0); PG8_MMA(0, 1, At, B1); PG8_BAR; PG8_SCHED;
            PG8_LDA(At, 1, 1); PG8_STAGE(PG8_SB(1, 0), b3, voffB); PG8_STAGE(PG8_SB(1, 1), b3 + hstepB, voffB); PG8_STAGE(PG8_SA(1, 0), a3, voffA);
            PG8_WAIT_V(8); PG8_WAIT_L(0); PG8_BAR; PG8_MMA(1, 0, At, B0); PG8_MMA(1, 1, At, B1); PG8_BAR; PG8_SCHED;
            } else {
            PG8_LDB(B0, 0, 0); PG8_SCHED; PG8_LDA(At, 0, 0); PG8_STAGE(PG8_SA(1, 1), a1 + hstepA, voffA);
            PG8_WAIT_L(8); PG8_BAR; PG8_WAIT_L(0); PG8_MMA(0, 0, At, B0); PG8_BAR; PG8_SCHED;
            PG8_LDB(B1, 0, 1); PG8_STAGE(PG8_SB(0, 0), b2, voffB);
            PG8_BAR; PG8_WAIT_L(0); PG8_MMA(0, 1, At, B1); PG8_BAR;
            PG8_LDA(At, 0, 1); PG8_STAGE(PG8_SA(0, 0), a2, voffA);
            PG8_BAR; PG8_WAIT_L(0); PG8_MMA(1, 0, At, B0); PG8_BAR; PG8_SCHED;
            PG8_STAGE(PG8_SB(0, 1), b2 + hstepB, voffB);
            PG8_WAIT_V(6); PG8_BAR; PG8_MMA(1, 1, At, B1); PG8_BAR;
            PG8_LDB(B0, 1, 0); PG8_SCHED; PG8_LDA(At, 1, 0); PG8_STAGE(PG8_SA(0, 1), a2 + hstepA, voffA);
            PG8_WAIT_L(8); PG8_BAR; PG8_WAIT_L(0); PG8_MMA(0, 0, At, B0); PG8_BAR; PG8_SCHED;
            PG8_LDB(B1, 1, 1); PG8_STAGE(PG8_SB(1, 0), b3, voffB);
            PG8_BAR; PG8_WAIT_L(0); PG8_MMA(0, 1, At, B1); PG8_BAR;
            PG8_LDA(At, 1, 1); PG8_STAGE(PG8_SA(1, 0), a3, voffA);
            PG8_BAR; PG8_WAIT_L(0); PG8_MMA(1, 0, At, B0); PG8_BAR; PG8_SCHED;
            PG8_STAGE(PG8_SB(1, 1), b3 + hstepB, voffB);
            PG8_WAIT_V(6); PG8_BAR; PG8_MMA(1, 1, At, B1); PG8_BAR;
            }
        }
        if constexpr (ALIGN_EPI) { if (wr == 0) PG8_BAR; }
        if constexpr (!Epi::AFTER_DRAIN) { E(acc, cur, wr, wc, fr, fq); S.done(cur); }
        if (!has_next) break;
#pragma unroll
        for (int a = 0; a < 2; ++a)
#pragma unroll
            for (int b = 0; b < 2; ++b)
#pragma unroll
                for (int m = 0; m < 4; ++m)
#pragma unroll
                    for (int n = 0; n < 2; ++n) acc[a][b][m][n] = (f32x4){0.f, 0.f, 0.f, 0.f};
        cur = nxt; cA = nA; cB = nB; ++ui;
        if constexpr (ALIGN_EPI) { if (wr == 1) PG8_BAR; }
    }
    PG8_WAIT_V(0);
    if constexpr (!ALIGN_EPI) { if (wr == 0) PG8_BAR; }
    PG8_BAR;
    if constexpr (Epi::AFTER_DRAIN) { E.fused(acc, cur, wr, wc, fr, fq, lds, wid, lane); S.done(cur); }
#undef PG8_SA
#undef PG8_SB
#undef PG8_STAGE
#undef PG8_LDA
#undef PG8_LDB
#undef PG8_MMA
#undef PG8_WAIT_V
#undef PG8_WAIT_L
#undef PG8_BAR
#undef PG8_SCHED
}
}
#ifndef ATT_SDEPTH
#define ATT_SDEPTH 1
#endif
namespace att {
using bf16 = __hip_bfloat16;
constexpr int NW = 8, QBLK = 32, KVBLK = 64, SDEPTH = ATT_SDEPTH;
constexpr float THR = 8.f;
constexpr size_t SHM_V = KVBLK * 128 * 2, SHM_K = KVBLK * 128 * 2, SHM_ATTN = 2 * SHM_V + 2 * SHM_K + NW * 64 * 4;
using bf16x8 = __attribute__((ext_vector_type(8))) short;
using s16x4  = __attribute__((ext_vector_type(4))) short;
using f32x16 = __attribute__((ext_vector_type(16))) float;
using f32x8  = __attribute__((ext_vector_type(8))) float;
using u32x4  = __attribute__((ext_vector_type(4))) unsigned;
#define KSWZ(row, colB) ((row) * 256 + ((colB) ^ (((row) & 7) << 4)))
#define SBAR() __builtin_amdgcn_sched_barrier(0)
__device__ __forceinline__ int crow(int r, int hi) { return (r & 3) + 8 * (r >> 2) + 4 * hi; }
__device__ __forceinline__ unsigned cvtpk(float lo, float hi) {
  unsigned r; asm volatile("v_cvt_pk_bf16_f32 %0, %1, %2" : "=v"(r) : "v"(lo), "v"(hi)); return r;
}
template <int DQK> __device__ __forceinline__ void partialSM(f32x16& p0, f32x16& p1, float& m_reg, float& mn, float& alpha) {
  constexpr float SCALE = (DQK == 64) ? 0.125f : 0.088388347648318440f; constexpr float C = SCALE * 1.4426950408889634f;
  float pmax = p0[0]; for (int r = 1; r < 16; ++r) pmax = fmaxf(pmax, p0[r]); for (int r = 0; r < 16; ++r) pmax = fmaxf(pmax, p1[r]);
  { auto rr = __builtin_amdgcn_permlane32_swap(__float_as_uint(pmax), __float_as_uint(pmax), false, false);
    pmax = fmaxf(__uint_as_float(rr[0]), __uint_as_float(rr[1])); }
  if (__builtin_expect(__all(pmax - m_reg <= THR / SCALE), 1)) { mn = m_reg; alpha = 1.f; }
  else { mn = fmaxf(m_reg, pmax); alpha = __builtin_amdgcn_exp2f((m_reg - mn) * C); m_reg = mn; }
  float mnC = -mn * C;
  for (int r = 0; r < 16; ++r) p0[r] = fmaf(p0[r], C, mnC); for (int r = 0; r < 16; ++r) p1[r] = fmaf(p1[r], C, mnC);
  for (int r = 0; r < 16; ++r) p0[r] = __builtin_amdgcn_exp2f(p0[r]);
}
__device__ __forceinline__ void finishSM(f32x16& p0, f32x16& p1, float alpha, float& l_reg, bf16x8& pa0, bf16x8& pa1, bf16x8& pa2, bf16x8& pa3) {
  for (int r = 0; r < 16; ++r) p1[r] = __builtin_amdgcn_exp2f(p1[r]);
  float ps = 0; for (int r = 0; r < 16; ++r) ps += p0[r]; for (int r = 0; r < 16; ++r) ps += p1[r];
  { auto rr = __builtin_amdgcn_permlane32_swap(__float_as_uint(ps), __float_as_uint(ps), false, false);
    ps = __uint_as_float(rr[0]) + __uint_as_float(rr[1]); }
  l_reg = l_reg * alpha + ps;
#define PK4(P, BASE, OUT) do { unsigned a0 = cvtpk(P[BASE + 0], P[BASE + 1]), a1 = cvtpk(P[BASE + 2], P[BASE + 3]);   \
    unsigned b0 = cvtpk(P[BASE + 4], P[BASE + 5]), b1 = cvtpk(P[BASE + 6], P[BASE + 7]);                              \
    auto r0 = __builtin_amdgcn_permlane32_swap(a0, b0, false, false); auto r1 = __builtin_amdgcn_permlane32_swap(a1, b1, false, false); \
    u32x4 w = {r0[0], r1[0], r0[1], r1[1]}; OUT = *reinterpret_cast<bf16x8*>(&w); } while (0)
  PK4(p0, 0, pa0); PK4(p0, 8, pa1); PK4(p1, 0, pa2); PK4(p1, 8, pa3);
#undef PK4
}
template <int DQK> __device__ __forceinline__ void qkt(f32x16& p0, f32x16& p1, const bf16* Ks, const bf16x8* qr, int r32, int hi, int kcol0) {
  p0 = f32x16{}; p1 = f32x16{};
#pragma unroll
  for (int d0 = 0; d0 < DQK / 16; ++d0) { int cb = (kcol0 + d0 * 16 + hi * 8) * 2;
    bf16x8 b0 = *reinterpret_cast<const bf16x8*>((const char*)Ks + KSWZ(r32, cb));
    bf16x8 b1 = *reinterpret_cast<const bf16x8*>((const char*)Ks + KSWZ(32 + r32, cb));
    p0 = __builtin_amdgcn_mfma_f32_32x32x16_bf16(b0, qr[d0], p0, 0, 0, 0);
    p1 = __builtin_amdgcn_mfma_f32_32x32x16_bf16(b1, qr[d0], p1, 0, 0, 0); }
}
__device__ __forceinline__ int v_st(int k, int c) { const int kk = (k & ~0xC) | ((k & 4) << 1) | ((k & 8) >> 1); return ((kk >> 3) * 4 + (c >> 5)) * 512 + ((kk & 7) * 32 + (c & 31)) * 2; }
__device__ __forceinline__ int v_rd_base(int lane) { return ((lane & 3) << 3) | (((lane >> 2) & 3) << 6) | (((lane >> 4) & 1) << 5) | (((lane >> 5) & 1) << 8); }
constexpr int v_rd_off(int d0, int ks, int half) { return d0 * 512 + ks * 4096 + half * 2048; }
template <int OFF> __device__ __forceinline__ s16x4 tr_read(int vb) {
  s16x4 r; asm volatile("ds_read_b64_tr_b16 %0, %1 offset:%2" : "=&v"(r) : "v"(vb), "i"(OFF) : "memory"); return r;
}
template <int D0> __device__ __forceinline__ void pv_one(f32x16& od, int vb, bf16x8 pa0, bf16x8 pa1, bf16x8 pa2, bf16x8 pa3) {
  const s16x4 l0 = tr_read<v_rd_off(D0, 0, 0)>(vb), h0 = tr_read<v_rd_off(D0, 0, 1)>(vb), l1 = tr_read<v_rd_off(D0, 1, 0)>(vb), h1 = tr_read<v_rd_off(D0, 1, 1)>(vb);
  const s16x4 l2 = tr_read<v_rd_off(D0, 2, 0)>(vb), h2 = tr_read<v_rd_off(D0, 2, 1)>(vb), l3 = tr_read<v_rd_off(D0, 3, 0)>(vb), h3 = tr_read<v_rd_off(D0, 3, 1)>(vb);
  asm volatile("s_waitcnt lgkmcnt(0)" ::: "memory"); SBAR();
#define PK(L, H) (bf16x8){L[0], L[1], L[2], L[3], H[0], H[1], H[2], H[3]}
  od = __builtin_amdgcn_mfma_f32_32x32x16_bf16(pa0, PK(l0, h0), od, 0, 0, 0);
  od = __builtin_amdgcn_mfma_f32_32x32x16_bf16(pa1, PK(l1, h1), od, 0, 0, 0);
  od = __builtin_amdgcn_mfma_f32_32x32x16_bf16(pa2, PK(l2, h2), od, 0, 0, 0);
  od = __builtin_amdgcn_mfma_f32_32x32x16_bf16(pa3, PK(l3, h3), od, 0, 0, 0);
#undef PK
}
__device__ __forceinline__ void pv_d0(f32x16* o, int vb, bf16x8 pa0, bf16x8 pa1, bf16x8 pa2, bf16x8 pa3) {
  pv_one<0>(o[0], vb, pa0, pa1, pa2, pa3); pv_one<1>(o[1], vb, pa0, pa1, pa2, pa3); pv_one<2>(o[2], vb, pa0, pa1, pa2, pa3); pv_one<3>(o[3], vb, pa0, pa1, pa2, pa3);
}

template <int DQK, int LDO>
__device__ __forceinline__ void attn_dense_body(const bf16* __restrict__ Qb, const bf16* __restrict__ Kh, const bf16* __restrict__ Vh,
                                                bf16* __restrict__ Ob, int seq, int kcol0, char* lds) {
  constexpr int LDQ = PP, LDK = PP;
  constexpr float SCALE = (DQK == 64) ? 0.125f : 0.088388347648318440f;
  int tid = threadIdx.x; asm volatile("" : "+v"(tid)); const int wid = tid >> 6, lane = tid & 63, r32 = lane & 31, hi = lane >> 5;
  bf16* V_lds = (bf16*)lds; bf16* K_lds = (bf16*)(lds + 2 * SHM_V);
  float* ws = (float*)(lds + 2 * SHM_V + 2 * SHM_K) + wid * 64; float* li_l = ws; float* al_l = ws + 32;
  float m_reg = -1e30f, l_reg = 0; f32x16 o[4] = {}; bf16x8 qr[DQK / 16];
  const bf16* Qw = Qb + (long)(wid * QBLK + r32) * LDQ + hi * 8;
#pragma unroll
  for (int d0 = 0; d0 < DQK / 16; ++d0) qr[d0] = *reinterpret_cast<const bf16x8*>(Qw + d0 * 16);
  const int sr = tid >> 4, sc = (tid & 15) * 8, vst0 = v_st(sr, sc), vst1 = v_st(32 + sr, sc);
  const int vb0 = (int)(uintptr_t)V_lds + v_rd_base(lane);
  struct { bf16x8 vs0, vs1, ks0, ks1; } sr_[SDEPTH];
#define SLOAD(i, k0) do { sr_[i].vs0 = *reinterpret_cast<const bf16x8*>(&Vh[(long)((k0) + sr) * LDK + sc]); sr_[i].vs1 = *reinterpret_cast<const bf16x8*>(&Vh[(long)((k0) + 32 + sr) * LDK + sc]); \
    sr_[i].ks0 = *reinterpret_cast<const bf16x8*>(&Kh[(long)((k0) + sr) * LDK + sc]); sr_[i].ks1 = *reinterpret_cast<const bf16x8*>(&Kh[(long)((k0) + 32 + sr) * LDK + sc]); } while (0)
#define SWRITE(b, i) do { *(bf16x8*)((char*)V_lds + (b) * SHM_V + vst0) = sr_[i].vs0;          \
    *(bf16x8*)((char*)V_lds + (b) * SHM_V + vst1) = sr_[i].vs1; int kc = sc * 2;               \
    *(bf16x8*)((char*)K_lds + (b) * SHM_K + KSWZ(sr, kc)) = sr_[i].ks0;                       \
    *(bf16x8*)((char*)K_lds + (b) * SHM_K + KSWZ(32 + sr, kc)) = sr_[i].ks1; } while (0)
#define SWAIT() do { if constexpr (SDEPTH == 2) asm volatile("s_waitcnt vmcnt(4)" ::: "memory"); else asm volatile("s_waitcnt vmcnt(0)" ::: "memory"); } while (0)
#define RESC(a) do { if (__any((a) < 1.f)) { if (hi == 0) al_l[r32] = (a); asm volatile("s_waitcnt lgkmcnt(0)" ::: "memory"); \
    for (int d = 0; d < 4; ++d) for (int r = 0; r < 16; ++r) o[d][r] *= al_l[crow(r, hi)]; } } while (0)
  f32x16 pA0, pA1, pB0, pB1; float mnA, mnB, alA, alB; bf16x8 pa0, pa1, pa2, pa3; const int NT = seq / KVBLK;
  constexpr int SE = 0, SO = SDEPTH - 1;
  SLOAD(SE, 0); asm volatile("s_waitcnt vmcnt(0)" ::: "memory"); SWRITE(0, SE); __syncthreads();
  qkt<DQK>(pA0, pA1, K_lds, qr, r32, hi, kcol0); partialSM<DQK>(pA0, pA1, m_reg, mnA, alA);
  SLOAD(SO, KVBLK); if constexpr (SDEPTH == 2) { if (2 < NT) SLOAD(SE, 2 * KVBLK); }
  SWAIT(); SWRITE(1, SO); __syncthreads();
  for (int j = 1; j + 1 < NT; j += 2) {
    SBAR(); qkt<DQK>(pB0, pB1, (bf16*)((char*)K_lds + SHM_K), qr, r32, hi, kcol0);
    finishSM(pA0, pA1, alA, l_reg, pa0, pa1, pa2, pa3); SBAR();
    SLOAD(SO, (j + SDEPTH) * KVBLK); SBAR();
    pv_d0(o, vb0, pa0, pa1, pa2, pa3); partialSM<DQK>(pB0, pB1, m_reg, mnB, alB);
    __syncthreads(); SWAIT(); SWRITE(0, SE);
    RESC(alB); __syncthreads();
    SBAR(); qkt<DQK>(pA0, pA1, K_lds, qr, r32, hi, kcol0);
    finishSM(pB0, pB1, alB, l_reg, pa0, pa1, pa2, pa3); SBAR();
    if (SDEPTH == 1 || j + 3 < NT) SLOAD(SE, (j + 1 + SDEPTH) * KVBLK); SBAR();
    pv_d0(o, vb0 + (int)SHM_V, pa0, pa1, pa2, pa3); partialSM<DQK>(pA0, pA1, m_reg, mnA, alA);
    __syncthreads(); SWAIT(); SWRITE(1, SO);
    RESC(alA); __syncthreads();
  }
  SBAR(); qkt<DQK>(pB0, pB1, (bf16*)((char*)K_lds + SHM_K), qr, r32, hi, kcol0);
  finishSM(pA0, pA1, alA, l_reg, pa0, pa1, pa2, pa3); SBAR();
  pv_d0(o, vb0, pa0, pa1, pa2, pa3); partialSM<DQK>(pB0, pB1, m_reg, mnB, alB);
  __syncthreads(); RESC(alB);
  finishSM(pB0, pB1, alB, l_reg, pa0, pa1, pa2, pa3); SBAR();
  pv_d0(o, vb0 + (int)SHM_V, pa0, pa1, pa2, pa3);
  if (hi == 0) li_l[r32] = l_reg; asm volatile("s_waitcnt lgkmcnt(0)" ::: "memory");
  float rli[16];
#pragma unroll
  for (int r = 0; r < 16; ++r) rli[r] = __builtin_amdgcn_rcpf(li_l[crow(r, hi)]);
  bf16* Ow = Ob + (long)(wid * QBLK) * LDO;
#pragma unroll
  for (int r = 0; r < 16; ++r) { int orow = crow(r, hi);
    for (int d0 = 0; d0 < 4; ++d0) Ow[(long)orow * LDO + d0 * 32 + r32] = __float2bfloat16(o[d0][r] * rli[r]); }
#undef SLOAD
#undef SWRITE
#undef SWAIT
#undef RESC
}

__device__ __forceinline__ void swa_unit(const bf16* __restrict__ P, bf16* __restrict__ Y, int bb, int kvh, int qblk, bool isctx, const float* __restrict__ sinkl, char* lds) {
  constexpr float SCALE = 0.125f;
  int tid = threadIdx.x; asm volatile("" : "+v"(tid)); const int wid = tid >> 6, lane = tid & 63, r32 = lane & 31, hi = lane >> 5;
  const int head = kvh * 4 + (wid & 3), half = wid >> 2;
  bf16* V_lds = (bf16*)lds; bf16* K_lds = (bf16*)(lds + 2 * SHM_V);
  float* ws = (float*)(lds + 2 * SHM_V + 2 * SHM_K) + wid * 64; float* li_l = ws; float* al_l = ws + 32;
  const long rowq0 = (long)bb * TPB + (isctx ? 0 : CTX) + qblk * 64 + half * 32;
  const bf16* Qw = P + (rowq0 + r32) * PP + C_SQ + head * 64 + hi * 8;
  bf16x8 qr[4];
#pragma unroll
  for (int d0 = 0; d0 < 4; ++d0) qr[d0] = *reinterpret_cast<const bf16x8*>(Qw + d0 * 16);
  float m_reg = sinkl[head] * (1.f / SCALE), l_reg = 1.f; f32x16 o[2] = {};
  const int sr = tid >> 3, sc = (tid & 7) * 8, vst = v_st(sr, sc);
  const int vb0 = (int)(uintptr_t)V_lds + v_rd_base(lane);
  const int qpos = qblk * 64 + half * 32 + r32;
  int jlo = 0, nband = 0;
  if (!isctx) { const int q0 = qblk * 64; jlo = (q0 >= 128) ? 0 : (128 - q0) / 64; int jhi = (SEQ - 64 - q0 + 128) / 64; if (jhi > 4) jhi = 4; nband = jhi - jlo + 1; }
  const int ntile = 4 + nband;
  const long kbase = (long)bb * TPB;
#define SWA_KROW(tt) ((tt) < 4 ? kbase + (tt) * 64 : kbase + CTX + (qblk * 64 - 128 + ((tt) - 4 + jlo) * 64))
  bf16x8 kreg, vreg;
  { const long kr = SWA_KROW(0); kreg = *reinterpret_cast<const bf16x8*>(P + (kr + sr) * PP + C_SK + kvh * 64 + sc); vreg = *reinterpret_cast<const bf16x8*>(P + (kr + sr) * PP + C_SV + kvh * 64 + sc); }
  __syncthreads();
  for (int t = 0; t < ntile; ++t) {
    const int buf = t & 1; const bool band = (t >= 4); const int kpos0 = qblk * 64 - 128 + (t - 4 + jlo) * 64;
    *(bf16x8*)((char*)K_lds + buf * SHM_K + KSWZ(sr, sc * 2)) = kreg; *(bf16x8*)((char*)V_lds + buf * SHM_V + vst) = vreg;
    if (t + 1 < ntile) { const long kr = SWA_KROW(t + 1); kreg = *reinterpret_cast<const bf16x8*>(P + (kr + sr) * PP + C_SK + kvh * 64 + sc); vreg = *reinterpret_cast<const bf16x8*>(P + (kr + sr) * PP + C_SV + kvh * 64 + sc); }
    __syncthreads();
    f32x16 p0, p1; float mn, alpha; bf16x8 pa0, pa1, pa2, pa3;
    qkt<64>(p0, p1, (const bf16*)((const char*)K_lds + buf * SHM_K), qr, r32, hi, 0);
    if (band) {
#pragma unroll
      for (int r = 0; r < 16; ++r) { const int d0_ = qpos - (kpos0 + crow(r, hi)); if (d0_ > 128 || d0_ < -128) p0[r] = -1e30f; const int d1_ = d0_ - 32; if (d1_ > 128 || d1_ < -128) p1[r] = -1e30f; }
    }
    partialSM<64>(p0, p1, m_reg, mn, alpha);
    if (__any(alpha < 1.f)) { if (hi == 0) al_l[r32] = alpha; asm volatile("s_waitcnt lgkmcnt(0)" ::: "memory");
#pragma unroll
      for (int d = 0; d < 2; ++d)
#pragma unroll
        for (int r = 0; r < 16; ++r) o[d][r] *= al_l[crow(r, hi)]; }
    finishSM(p0, p1, alpha, l_reg, pa0, pa1, pa2, pa3); SBAR();
    pv_one<0>(o[0], vb0 + buf * (int)SHM_V, pa0, pa1, pa2, pa3); pv_one<1>(o[1], vb0 + buf * (int)SHM_V, pa0, pa1, pa2, pa3);
  }
#undef SWA_KROW
  if (hi == 0) li_l[r32] = l_reg; asm volatile("s_waitcnt lgkmcnt(0)" ::: "memory");
  float rli[16];
#pragma unroll
  for (int r = 0; r < 16; ++r) rli[r] = __builtin_amdgcn_rcpf(li_l[crow(r, hi)]);
  bf16* Ow = Y + rowq0 * DM + 1024 + head * 64;
#pragma unroll
  for (int r = 0; r < 16; ++r) { const int orow = crow(r, hi);
#pragma unroll
    for (int d0 = 0; d0 < 2; ++d0) Ow[(long)orow * DM + d0 * 32 + r32] = __float2bfloat16(o[d0][r] * rli[r]); }
  __syncthreads();
}
#undef KSWZ
#undef SBAR
}

#define LAS __attribute__((address_space(3)))
#ifndef PH_MASK
#define PH_MASK 0xFFFFF
#endif
#ifndef MX_MASK
#define MX_MASK 15
#endif
#ifndef P_ALIGN
#define P_ALIGN true
#endif
#ifndef BR_ALIGN
#define BR_ALIGN true
#endif
#ifndef UP_ALIGN
#define UP_ALIGN true
#endif
#ifndef GATE_ALIGN
#define GATE_ALIGN false
#endif
#ifndef RESID_ALIGN
#define RESID_ALIGN false
#endif
#ifndef DBL_MASK
#define DBL_MASK 0
#endif
#ifndef DBL_MX
#define DBL_MX 0
#endif
#ifdef DBL_RESID
#define RESID_LOOP for (int rr_ = 0; rr_ < 2; ++rr_)
#else
#define RESID_LOOP for (int rr_ = 1; rr_ < 2; ++rr_)
#endif
#define REP(bit) for (int rep_ = 0; rep_ < ((DBL_MASK & (bit)) ? 2 : 1); ++rep_)
#define REPX(bit) for (int rep_ = 0; rep_ < ((DBL_MX & (bit)) ? 2 : 1); ++rep_)
typedef __hip_bfloat16 hbf16;
constexpr size_t WS_ZT = 7 * MiB + 256 * 1024;
struct Args { const float* in[21]; float* out; unsigned char* ws; int pad0, pad1; };
struct Frame { int tid, lane, wave, G, vcu, gw, NGW; unsigned char* ws; char* lds; };

#define XB_TMO      128
#define XB_XCNT(j)  (256  + 64 * (j))
#define XB_XSUB(j)  (1280 + 64 * (j))
#define XB_XGEN(j)  (2304 + 64 * (j))
#define XB_TOP      3328
#define XB_TOPGEN   3392
#define XCD_BAR_WORDS 3456
#define XB_SPIN_CAP (1u << 18)

__device__ __forceinline__ unsigned xb_ld(unsigned* p)              { return __hip_atomic_load(p, __ATOMIC_RELAXED, __HIP_MEMORY_SCOPE_AGENT); }
__device__ __forceinline__ unsigned xb_add(unsigned* p, unsigned v) { return __hip_atomic_fetch_add(p, v, __ATOMIC_RELAXED, __HIP_MEMORY_SCOPE_AGENT); }
__device__ __forceinline__ unsigned xb_xcc_id() { return (unsigned)__builtin_amdgcn_s_getreg((3 << 11) | 20) & 0xFu; }
#define XB_SPIN(cond, bar) do { unsigned _sp = 0; while (cond) { __builtin_amdgcn_s_sleep(1); \
    if ((++_sp & 255u) == 0u) { if (xb_ld(&(bar)[XB_TMO])) break; if (_sp > XB_SPIN_CAP) { atomicAdd(&(bar)[XB_TMO], 1u); break; } } } } while (0)

struct XcdBarrier {
    unsigned* bar; unsigned x;
    volatile LAS unsigned* st;
};

__device__ __forceinline__ XcdBarrier xcd_barrier_post(unsigned* bar, volatile LAS unsigned* st) {
    XcdBarrier b; b.bar = bar; b.x = xb_xcc_id(); b.st = st;
    if (threadIdx.x == 0) (void)xb_add(&bar[XB_XCNT(b.x)], 1u);
    return b;
}
__device__ __forceinline__ void xcd_barrier_complete(unsigned* bar, unsigned x, unsigned& nloc, unsigned& nx) {
    const unsigned G = gridDim.x * gridDim.y * gridDim.z;
    unsigned sum, cnt, mine, sp = 0u;
    for (;;) {
        sum = 0u; cnt = 0u; mine = 0u;
#pragma unroll
        for (unsigned j = 0; j < 16; ++j) { const unsigned c = xb_ld(&bar[XB_XCNT(j)]); sum += c; cnt += (c > 0u) ? 1u : 0u; mine = (j == x) ? c : mine; }
        if (sum == G) break;
        __builtin_amdgcn_s_sleep(1);
        if ((++sp & 255u) == 0u) { if (xb_ld(&bar[XB_TMO])) break; if (sp > XB_SPIN_CAP) { atomicAdd(&bar[XB_TMO], 1u); break; } }
    }
    nloc = mine > 0u ? mine : 1u; nx = cnt > 0u ? cnt : 1u;
}

__device__ __forceinline__ void xcd_barrier(const XcdBarrier& b) {
    asm volatile("s_waitcnt vmcnt(0)" ::: "memory");
    __syncthreads();
    if (threadIdx.x == 0) {
        unsigned* bar = b.bar;
        __builtin_amdgcn_s_waitcnt(0);
        unsigned nloc = b.st[0], nx = b.st[1];
        if (nloc == 0u) { xcd_barrier_complete(bar, b.x, nloc, nx); b.st[0] = nloc; b.st[1] = nx; }
        const unsigned old = xb_add(&bar[XB_XSUB(b.x)], 1u);
        const unsigned gen = old / nloc;
        if (old + 1u == (gen + 1u) * nloc) {
            __builtin_amdgcn_fence(__ATOMIC_RELEASE, "agent");
            asm volatile("s_waitcnt vmcnt(0)" ::: "memory");
            const unsigned og = xb_add(&bar[XB_TOP], 1u);
            const unsigned tg = og / nx;
            if (og + 1u == (tg + 1u) * nx) xb_add(&bar[XB_TOPGEN], 1u);
            else XB_SPIN(xb_ld(&bar[XB_TOPGEN]) == tg, bar);
            __builtin_amdgcn_fence(__ATOMIC_ACQUIRE, "agent");
            xb_add(&bar[XB_XGEN(b.x)], 1u);
            asm volatile("s_waitcnt vmcnt(0)" ::: "memory");
        } else {
            XB_SPIN(xb_ld(&bar[XB_XGEN(b.x)]) == gen, bar);
            __builtin_amdgcn_fence(__ATOMIC_ACQUIRE, "agent");
            asm volatile("s_waitcnt vmcnt(0)" ::: "memory");
        }
    }
    __syncthreads();
}

constexpr size_t WS_BAR = 7 * MiB + 512 * 1024;
constexpr int LDS_BARST = LDS_BYTES - 64;
__device__ __forceinline__ Frame make_frame(unsigned char* ws, char* lds) {
    Frame F; int t = threadIdx.x; asm volatile("" : "+v"(t)); F.tid = t; F.lane = t & 63; F.wave = __builtin_amdgcn_readfirstlane(t >> 6); F.G = gridDim.x;
    { const int bx = blockIdx.x; F.vcu = (F.G % 8 == 0) ? (bx % 8) * (F.G / 8) + bx / 8 : bx; }
    F.gw = F.vcu * 8 + F.wave; F.NGW = F.G * 8; F.ws = ws; F.lds = lds; return F;
}
typedef const __attribute__((address_space(4))) Args* CArgsP0;
__device__ __forceinline__ void s0_phase(const Frame& F, CArgsP0 a) {
    float* sv = (float*)F.lds;
    float* modp = (float*)(F.ws + WS_MODP);
    const float* c = a->in[1]; const float* cctx = a->in[3]; const float* adaw = a->in[4];
    for (int i = blockIdx.x * 512 + F.tid; i < 3 * 12288; i += F.G * 512) ((float*)(F.ws + WS_ZT))[i] = 0.f;
    for (int it = blockIdx.x; it < 793; it += F.G) {
        if (it < 768) {
            const int l = it / 384, r = it % 384, ks = r / 24, ch = r % 24;
            __syncthreads();
            if (F.tid < 384) { const int w = F.tid >> 7, dd = F.tid & 127, d = ks * 128 + dd; const float cv = (w < 2) ? c[w * DM + d] : cctx[d]; sv[F.tid] = cv / (1.f + expf(-cv)); }
            __syncthreads();
            const int j = ch * 512 + F.tid;
            const float* W = adaw + (size_t)l * DM * 12288 + (size_t)(ks * 128) * 12288 + j;
            float a0 = 0.f, a1 = 0.f, a2 = 0.f;
#pragma unroll 8
            for (int dd = 0; dd < 128; ++dd) { const float wv = W[(size_t)dd * 12288]; a0 += sv[dd] * wv; a1 += sv[128 + dd] * wv; a2 += sv[256 + dd] * wv; }
            float* o = modp + (size_t)((l * 16 + ks) * 3) * 12288 + j;
            o[0] = a0; o[12288] = a1; o[2 * 12288] = a2;
        } else if (it < 792) {
            const int idx = (it - 768) * 512 + F.tid;
            float* tab = (float*)(F.ws + WS_ROPE);
            int pos, f, nf; float* cdst; float* sdst;
            if (idx < 4096) { pos = idx >> 4; f = idx & 15; nf = 16; cdst = tab + idx; sdst = tab + 4096 + idx; }
            else { const int i2 = idx - 4096; pos = i2 >> 5; f = i2 & 31; nf = 32; cdst = tab + 8192 + i2; sdst = tab + 16384 + i2; }
            const float inv = exp2f(-(float)f / (float)nf * 13.287712379549449f);
            const float ang = (float)pos * inv;
            double rev = (double)ang * 0.15915494309189535; rev -= floor(rev);
            const float fr = (float)rev;
            *cdst = __builtin_amdgcn_cosf(fr); *sdst = __builtin_amdgcn_sinf(fr);
        } else {
            const int l = F.wave >> 2, h = F.wave & 3; const float* lp = a->in[10] + (size_t)l * 4 * 4 * 64;
            float pa = lp[(0 * 4 + h) * 64 + F.lane] * lp[(1 * 4 + h) * 64 + F.lane], pb = lp[(2 * 4 + h) * 64 + F.lane] * lp[(3 * 4 + h) * 64 + F.lane];
            pa = wave_sum(pa); pb = wave_sum(pb);
            const float lam_init = (l == 0) ? 0.2f : 0.35550906759f;
            if (F.lane == 0) ((float*)(F.ws + WS_LAM))[l * 4 + h] = expf(pa) - expf(pb) + lam_init;
        }
    }
}

__device__ __forceinline__ int map_win(int j) { return j < NMIX ? j : -1; }
__device__ __forceinline__ int map_gate(int R) { const int pn = R >> 8, c = R & 255; const int i = 2 * (c >> 7) + ((c & 31) >> 4), oc = 64 * pn + 16 * ((c & 127) >> 5) + (c & 15); return NMIX + i * DM + oc; }
__device__ __forceinline__ int map_up(int R) { const int pn = R >> 8, c = R & 255; return (c >> 7) * FF + 128 * pn + (c & 127); }
template <int MAP> __device__ __forceinline__ void transpose_item(const float* __restrict__ W, int Nsrc, int K, bf16raw* __restrict__ WT, int kb, int nb, float* scr, int lane) {
    const int k0 = 64 * kb, n0 = 32 * nb; const int jr = n0 + (lane & 31);
    const int col = (MAP == 0) ? jr : (MAP == 1) ? map_win(jr) : (MAP == 2) ? map_gate(jr) : map_up(jr);
#pragma unroll 8
    for (int i = 0; i < 32; ++i) { const int kk = 2 * i + (lane >> 5); scr[kk * 33 + (lane & 31)] = (col >= 0) ? W[(size_t)(k0 + kk) * Nsrc + col] : 0.f; }
    asm volatile("s_waitcnt lgkmcnt(0)" ::: "memory");
    const int cch = lane & 7;
#pragma unroll
    for (int j = 0; j < 4; ++j) { const int n = (lane >> 3) + 8 * j; const float* s = scr + (8 * cch) * 33 + n;
        u32x4_t o; o.x = pk2(s[0 * 33], s[1 * 33]); o.y = pk2(s[2 * 33], s[3 * 33]); o.z = pk2(s[4 * 33], s[5 * 33]); o.w = pk2(s[6 * 33], s[7 * 33]);
        *(u32x4_t*)(WT + (size_t)(n0 + n) * K + k0 + 8 * cch) = o; }
    asm volatile("s_waitcnt lgkmcnt(0)" ::: "memory");
}
__device__ __forceinline__ void s1_phase(const Frame& F, CArgsP0 a, int l) {
    if (l == 0) {
        const float* modp = (const float*)(F.ws + WS_MODP); float* mod = (float*)(F.ws + WS_MOD); const float* adab = a->in[5];
        for (int idx = blockIdx.x * 512 + F.tid; idx < 2 * 3 * 12288; idx += F.G * 512) {
            const int l2 = idx / (3 * 12288), rem = idx - l2 * 3 * 12288, w = rem / 12288, j = rem - w * 12288;
            float s = adab[l2 * 12288 + j];
#pragma unroll
            for (int ks = 0; ks < 16; ++ks) s += modp[(size_t)((l2 * 16 + ks) * 3 + w) * 12288 + j];
            mod[idx] = s;
        }
    }
    float* scr = (float*)F.lds + F.wave * (64 * 33);
    const float* w_in = a->in[7] + (size_t)l * DM * DIN; const float* w_br = a->in[15] + (size_t)l * 4 * 512 * DM; const float* w_out = a->in[16] + (size_t)l * DM * DM;
    const float* w_up = a->in[18] + (size_t)l * DM * 2 * FF; const float* w_dn = a->in[19] + (size_t)l * FF * DM;
    constexpr int I_IN = 32 * (PP / 32), I_G = 32 * (8192 / 32), I_B = 4 * 8 * 64, I_O = 32 * 64, I_U = 32 * (2 * FF / 32), I_D = (FF / 64) * 64;
    constexpr int NITEMS = I_IN + I_G + I_B + I_O + I_U + I_D;
    for (int it = F.gw; it < NITEMS; it += F.NGW) {
        int r = it;
        if (r < I_IN) { const int nblk = PP / 32; transpose_item<1>(w_in, DIN, DM, (bf16raw*)(F.ws + WS_WIN), r / nblk, r % nblk, scr, F.lane); continue; } r -= I_IN;
        if (r < I_G) { const int nblk = 8192 / 32; transpose_item<2>(w_in, DIN, DM, (bf16raw*)(F.ws + WS_WG), r / nblk, r % nblk, scr, F.lane); continue; } r -= I_G;
        if (r < I_B) { const int i = r / 512, rr = r % 512; transpose_item<0>(w_br + (size_t)i * 512 * DM, DM, 512, (bf16raw*)(F.ws + WS_WB) + (size_t)i * DM * 512, rr / 64, rr % 64, scr, F.lane); continue; } r -= I_B;
        if (r < I_O) { transpose_item<0>(w_out, DM, DM, (bf16raw*)(F.ws + WS_WOUT), r / 64, r % 64, scr, F.lane); continue; } r -= I_O;
        if (r < I_U) { const int nblk = 2 * FF / 32; transpose_item<3>(w_up, 2 * FF, DM, (bf16raw*)(F.ws + WS_WUP), r / nblk, r % nblk, scr, F.lane); continue; } r -= I_U;
        transpose_item<0>(w_dn, DM, FF, (bf16raw*)(F.ws + WS_WDN), r / 64, r % 64, scr, F.lane);
    }
}

__device__ __forceinline__ void norm_mod_phase(const Frame& F, const XPtr xin, const float* __restrict__ gam, const float* __restrict__ modl, int shi, int sci, bf16raw* __restrict__ out) {
    constexpr int RPW = 17;
    int curw = -1; f32x4_t ca[8], cb[8];
    const int rbeg = F.gw * RPW, rend = (rbeg + RPW < MROWS) ? rbeg + RPW : MROWS;
    for (int r = rbeg; r < rend; ++r) {
        const int b = r / TPB, t = r - b * TPB, w = (t < CTX) ? 2 : b;
        if (w != curw) { curw = w;
#pragma unroll
            for (int j = 0; j < 8; ++j) { const int col = 4 * F.lane + 256 * j; const f32x4_t g = *(const f32x4_t*)(gam + col), sc = *(const f32x4_t*)(modl + (size_t)w * 12288 + sci * 2048 + col);
                ca[j] = g * (sc + 1.0f); cb[j] = *(const f32x4_t*)(modl + (size_t)w * 12288 + shi * 2048 + col); } }
        const f32x4_t* xr = (const f32x4_t*)xin.row(r) + F.lane;
        f32x4_t v[8]; float s = 0.f;
#pragma unroll
        for (int j = 0; j < 8; ++j) { v[j] = xr[64 * j]; s += (v[j].x * v[j].x + v[j].y * v[j].y) + (v[j].z * v[j].z + v[j].w * v[j].w); }
        const float rstd = 1.0f / sqrtf(wave_sum(s) * (1.f / DM) + NORM_EPS);
        u32x2_t* o8 = (u32x2_t*)(out + (size_t)r * DM) + F.lane;
#pragma unroll
        for (int j = 0; j < 8; ++j) { const f32x4_t y = v[j] * rstd * ca[j] + cb[j]; u32x2_t w2; w2.x = pk2(y.x, y.y); w2.y = pk2(y.z, y.w); o8[64 * j] = w2; }
    }
}
__device__ __forceinline__ void final_norm_phase(const Frame& F, float* x, const float* __restrict__ gam) {
    for (int r = F.gw; r < NBATCH * SEQ; r += F.NGW) {
        f32x4_t* xr = (f32x4_t*)(x + (size_t)r * DM) + F.lane; f32x4_t v[8]; float s = 0.f;
#pragma unroll
        for (int j = 0; j < 8; ++j) { v[j] = xr[64 * j]; s += (v[j].x * v[j].x + v[j].y * v[j].y) + (v[j].z * v[j].z + v[j].w * v[j].w); }
        const float rstd = 1.0f / sqrtf(wave_sum(s) * (1.f / DM) + NORM_EPS);
#pragma unroll
        for (int j = 0; j < 8; ++j) xr[64 * j] = v[j] * rstd * *(const f32x4_t*)(gam + 4 * F.lane + 256 * j);
    }
}

__device__ __forceinline__ void rope_decode(int vp, int& x1c, int& x2c, int& f0, int& axis, int& hcol, bool& d128, bool& isq) {
    x1c = 0; x2c = 0; f0 = 0; axis = 0; hcol = 0; d128 = false; isq = true;
    if (vp < 48) { d128 = true; isq = vp < 32; const int v2 = isq ? vp : vp - 32; const int head = v2 >> 3, i = v2 & 7; axis = i >> 2; const int j = i & 3; f0 = 8 * j;
        const int base = (isq ? C_GQ : C_GK) + head * 128 + axis * 64; x1c = base + 8 * j; x2c = x1c + 32; hcol = axis * 64 + 8 * j; }
    else if (vp < 152) { const int v3 = vp - 48, seg = v3 >> 5, w = v3 & 31, head = w >> 2, i = w & 3; axis = i >> 1; const int j = i & 1; f0 = 8 * j;
        const int sb = (seg == 0) ? C_DQ : (seg == 1) ? C_DK : (seg == 2) ? C_SQ : C_SK; const int base = sb + head * 64 + axis * 32; x1c = base + 8 * j; x2c = x1c + 16; }
}
__device__ __forceinline__ void rope_phase(const Frame& F, bf16raw* P, const float* __restrict__ qg, const float* __restrict__ kg) {
    const float* tab = (const float*)(F.ws + WS_ROPE);
    int x1c[3], x2c[3], f0[3], axis[3], hcol[3]; bool d128[3], isq[3], act[3];
#pragma unroll
    for (int pass = 0; pass < 3; ++pass) { const int vp = pass * 64 + F.lane; act[pass] = vp < 152; rope_decode(vp, x1c[pass], x2c[pass], f0[pass], axis[pass], hcol[pass], d128[pass], isq[pass]); }
    for (int r = F.gw; r < MROWS; r += F.NGW) {
        const int b = r / TPB, t = r - b * TPB; const bool latent = t >= CTX; const int pos = t - CTX, prow = pos >> 6, pcol = pos & 63;
        bf16raw* Pr = P + (size_t)r * PP;
        u32x4_t w1[3], w2[3];
#pragma unroll
        for (int pass = 0; pass < 3; ++pass) { const bool ld = act[pass] && (d128[pass] || latent);
            if (ld) { w1[pass] = *(const u32x4_t*)(Pr + x1c[pass]); w2[pass] = *(const u32x4_t*)(Pr + x2c[pass]); } else { w1[pass] = (u32x4_t){0u, 0u, 0u, 0u}; w2[pass] = w1[pass]; } }
#pragma unroll
        for (int pass = 0; pass < 3; ++pass) {
            float x1[8], x2[8]; unpack8(w1[pass], x1); unpack8(w2[pass], x2);
            if (pass == 0) {
                float ss = 0.f;
#pragma unroll
                for (int e = 0; e < 8; ++e) ss += x1[e] * x1[e] + x2[e] * x2[e];
                ss += __shfl_xor(ss, 1); ss += __shfl_xor(ss, 2); ss += __shfl_xor(ss, 4);
                if (d128[0]) { const float rstd = 1.0f / sqrtf(ss * (1.f / 128.f) + NORM_EPS); const float* gn = isq[0] ? qg : kg;
#pragma unroll
                    for (int e = 0; e < 8; ++e) { x1[e] = x1[e] * rstd * gn[hcol[0] + e]; x2[e] = x2[e] * rstd * gn[hcol[0] + 32 + e]; } }
            }
            if (act[pass] && latent) {
                const int p = axis[pass] ? pcol : prow;
                const float* ct = d128[pass] ? tab + 8192 + p * 32 + f0[pass] : tab + p * 16 + f0[pass]; const float* st = d128[pass] ? tab + 16384 + p * 32 + f0[pass] : tab + 4096 + p * 16 + f0[pass];
#pragma unroll
                for (int e = 0; e < 8; ++e) { const float cc = ct[e], sn = st[e], a1 = x1[e], a2 = x2[e]; x1[e] = a1 * cc - a2 * sn; x2[e] = a2 * cc + a1 * sn; }
            }
            if (act[pass] && (d128[pass] || latent)) { *(u32x4_t*)(Pr + x1c[pass]) = pack8(x1); *(u32x4_t*)(Pr + x2c[pass]) = pack8(x2); }
        }
    }
}

__device__ __forceinline__ int tbmap(int dir, int j) { return dir == 0 ? j : (j == 0 ? 1 : (j == 1 ? 0 : 131 - j)); }
__device__ __forceinline__ float log_sigmoid_f(float x) { return fminf(x, 0.f) - log1pf(expf(-fabsf(x))); }
__device__ __forceinline__ void gate_scan(const bf16raw* __restrict__ P, const float* __restrict__ gb, int r0, int head, int dir, int lane, float (&ig)[2], float (&bc)[2], float& blast) {
    float lf[2];
#pragma unroll
    for (int k = 0; k < 2; ++k) { const int s = 2 * lane + k, tok = dir ? 127 - s : s; const bf16raw* pr = P + (size_t)(r0 + tok) * PP + C_MG;
        ig[k] = bf1(pr[(2 * dir) * 4 + head]) + gb[(2 * dir) * 4 + head]; lf[k] = log_sigmoid_f(bf1(pr[(2 * dir + 1) * 4 + head]) + gb[(2 * dir + 1) * 4 + head]); }
    const float c1 = lf[0] + lf[1]; float v = c1;
#pragma unroll
    for (int o = 1; o < 64; o <<= 1) { const float tt = __shfl_up(v, o); if (lane >= o) v += tt; }
    const float excl = v - c1; bc[0] = excl + lf[0]; bc[1] = excl + c1; blast = __shfl(v, 63);
}
__device__ __forceinline__ void mlstm_a_phase(const Frame& F, const bf16raw* __restrict__ P, const float* __restrict__ gb) {
    float* ks = (float*)F.lds;
    float* vs = ks + 128 * 64;
    float* wts = vs + 128 * 128;
    float* CST = (float*)(F.ws + WS_CST); float* NST = (float*)(F.ws + WS_NST); float* MSC = (float*)(F.ws + WS_MSC);
    for (int u = blockIdx.x; u < 16 * NCHUNK; u += F.G) {
        const int chain = u / NCHUNK, tb = u - chain * NCHUNK, bb = chain >> 3, head = (chain >> 1) & 3, dir = chain & 1;
        const int r0 = bb * TPB + tb * 128;
        __syncthreads();
        if (F.wave == 0) {
            float ig[2], bc[2], bl; gate_scan(P, gb, r0, head, dir, F.lane, ig, bc, bl);
            const float lw0 = bl - bc[0] + ig[0], lw1 = bl - bc[1] + ig[1]; const float ml = wave_max(fmaxf(lw0, lw1));
            const int s0 = 2 * F.lane; wts[dir ? 127 - s0 : s0] = expf(lw0 - ml); wts[dir ? 126 - s0 : s0 + 1] = expf(lw1 - ml);
            if (F.lane == 0) { MSC[chain * NCHUNK + tb] = bl; MSC[16 * NCHUNK + chain * NCHUNK + tb] = ml; }
        }
        __syncthreads();
#pragma unroll
        for (int i = 0; i < 2; ++i) { const int vi = F.tid + 512 * i, tok = vi >> 3, c8 = (vi & 7) * 8; float f[8]; unpack8(*(const u32x4_t*)(P + (size_t)(r0 + tok) * PP + C_MK + head * 64 + c8), f);
            const float w = wts[tok] * 0.125f;
#pragma unroll
            for (int e = 0; e < 8; ++e) ks[tok * 64 + c8 + e] = f[e] * w; }
#pragma unroll
        for (int i = 0; i < 4; ++i) { const int vi = F.tid + 512 * i, tok = vi >> 4, c8 = (vi & 15) * 8; float f[8]; unpack8(*(const u32x4_t*)(P + (size_t)(r0 + tok) * PP + C_MV + head * 128 + c8), f);
#pragma unroll
            for (int e = 0; e < 8; ++e) vs[tok * 128 + c8 + e] = f[e]; }
        __syncthreads();
        const int vg = F.tid & 31, dg = F.tid >> 5;
        f32x4_t acc[4];
#pragma unroll
        for (int i = 0; i < 4; ++i) acc[i] = (f32x4_t){0.f, 0.f, 0.f, 0.f};
#pragma unroll 4
        for (int tok = 0; tok < 128; ++tok) { const f32x4_t vv = *(const f32x4_t*)(vs + tok * 128 + 4 * vg), kv = *(const f32x4_t*)(ks + tok * 64 + 4 * dg);
            acc[0] += kv * vv.x; acc[1] += kv * vv.y; acc[2] += kv * vv.z; acc[3] += kv * vv.w; }
        float* Co = CST + (size_t)(chain * NCHUNK + tb) * 8192;
#pragma unroll
        for (int i = 0; i < 4; ++i) *(f32x4_t*)(Co + (4 * vg + i) * 64 + 4 * dg) = acc[i];
        if (F.tid < 64) { float s = 0.f;
#pragma unroll 8
            for (int tok = 0; tok < 128; ++tok) s += ks[tok * 64 + F.tid];
            NST[(size_t)(chain * NCHUNK + tb) * 64 + F.tid] = s; }
    }
}
__device__ __forceinline__ void mlstm_b_phase(const Frame& F) {
    float* CST = (float*)(F.ws + WS_CST); float* NST = (float*)(F.ws + WS_NST); float* MSC = (float*)(F.ws + WS_MSC);
    const float* BL = MSC; const float* ML = MSC + 16 * NCHUNK; float* MS = MSC + 32 * NCHUNK;
    for (int e = blockIdx.x * 512 + F.tid; e < 16 * 8192; e += F.G * 512) {
        const int chain = e >> 13, idx = e & 8191, dir = chain & 1; const bool hn = idx < 64;
        float C = 0.f, nv = 0.f, m = 0.f;
        for (int j0 = 0; j0 < NCHUNK; j0 += 10) {
            float cl[10], nl[10], bl[10], ml[10];
#pragma unroll
            for (int i = 0; i < 10; ++i) { const int tb = tbmap(dir, j0 + i), ci = chain * NCHUNK + tb; cl[i] = CST[(size_t)ci * 8192 + idx]; nl[i] = hn ? NST[(size_t)ci * 64 + idx] : 0.f; bl[i] = BL[ci]; ml[i] = ML[ci]; }
#pragma unroll
            for (int i = 0; i < 10; ++i) { const int tb = tbmap(dir, j0 + i), ci = chain * NCHUNK + tb;
                CST[(size_t)ci * 8192 + idx] = C; if (hn) NST[(size_t)ci * 64 + idx] = nv; if (idx == 0) MS[ci] = m;
                const float mnew = fmaxf(bl[i] + m, ml[i]); const float dec = expf(bl[i] + m - mnew), wg = expf(ml[i] - mnew);
                C = dec * C + wg * cl[i]; nv = dec * nv + wg * nl[i]; m = mnew; }
        }
    }
}
__device__ __forceinline__ void mlstm_c_unit(const Frame& F, const bf16raw* __restrict__ P, const float* __restrict__ gb, const float* __restrict__ ng, bf16raw* __restrict__ Y, int bb, int head, int tb) {
    constexpr int KP = 72, SP = 132;
    bf16raw* qs = (bf16raw*)F.lds;
    bf16raw* kc = qs + 128 * 64;
    bf16raw* vs = kc + 128 * KP;
    float* Ss = (float*)(vs + 128 * 128);
    float* sm = Ss + 128 * SP;
    float* a_tok = sm, *M_tok = sm + 128, *bc_tok = sm + 256, *nst = sm + 384, *misc = sm + 448;
    const float* CST = (const float*)(F.ws + WS_CST); const float* NST = (const float*)(F.ws + WS_NST); const float* MS = (const float*)(F.ws + WS_MSC) + 32 * NCHUNK;
    const int r0 = bb * TPB + tb * 128;
    int tidl = F.tid; asm volatile("" : "+v"(tidl));
    const int vg = tidl & 15, tg = tidl >> 4;
    float hsum[4][8];
#pragma unroll
    for (int a = 0; a < 4; ++a)
#pragma unroll
        for (int e = 0; e < 8; ++e) hsum[a][e] = 0.f;
    for (int dir = 0; dir < 2; ++dir) {
        const int chain = bb * 8 + head * 2 + dir, ci = chain * NCHUNK + tb;
        __syncthreads();
        int tA = F.tid; asm volatile("" : "+v"(tA));
#pragma unroll
        for (int i = 0; i < 2; ++i) { const int vi = tA + 512 * i, tok = vi >> 3, c8 = (vi & 7) * 8; const bf16raw* pr = P + (size_t)(r0 + tok) * PP + head * 64 + c8;
            *(u32x4_t*)(qs + tok * 64 + c8) = *(const u32x4_t*)(pr + C_MQ); *(u32x4_t*)(kc + tok * KP + c8) = *(const u32x4_t*)(pr + C_MK); }
#pragma unroll
        for (int i = 0; i < 4; ++i) { const int vi = tA + 512 * i, tok = vi >> 4, c8 = (vi & 15) * 8; *(u32x4_t*)(vs + tok * 128 + c8) = *(const u32x4_t*)(P + (size_t)(r0 + tok) * PP + C_MV + head * 128 + c8); }
        const float m_prev = MS[ci];
        if (F.wave == 0) {
            float ig[2], bc[2], bl; gate_scan(P, gb, r0, head, dir, F.lane, ig, bc, bl);
            const float a0 = ig[0] - bc[0], a1 = ig[1] - bc[1];
            const float pm = fmaxf(a0, a1); float v = pm;
#pragma unroll
            for (int o = 1; o < 64; o <<= 1) { const float tt = __shfl_up(v, o); if (F.lane >= o) v = fmaxf(v, tt); }
            float ex = __shfl_up(v, 1); if (F.lane == 0) ex = -3.0e38f;
            const float M0 = fmaxf(m_prev, fmaxf(ex, a0)), M1 = fmaxf(m_prev, fmaxf(ex, pm));
            const int s0 = 2 * F.lane, t0 = dir ? 127 - s0 : s0, t1 = dir ? 126 - s0 : s0 + 1;
            a_tok[t0] = a0; a_tok[t1] = a1; M_tok[t0] = M0; M_tok[t1] = M1; bc_tok[t0] = bc[0]; bc_tok[t1] = bc[1];
        } else if (F.wave == 1) { nst[F.lane] = NST[(size_t)ci * 64 + F.lane]; }
        __syncthreads();
        {
            float sacc[4][8];
#pragma unroll
            for (int a = 0; a < 4; ++a)
#pragma unroll
                for (int i = 0; i < 8; ++i) sacc[a][i] = 0.f;
#pragma unroll 1
            for (int d0 = 0; d0 < 64; d0 += 8) {
                float qf[4][8];
#pragma unroll
                for (int a = 0; a < 4; ++a) unpack8(*(const u32x4_t*)(qs + (4 * tg + a) * 64 + d0), qf[a]);
#pragma unroll
                for (int i = 0; i < 8; ++i) { float kf[8]; unpack8(*(const u32x4_t*)(kc + (vg + 16 * i) * KP + d0), kf);
#pragma unroll
                    for (int a = 0; a < 4; ++a)
#pragma unroll
                        for (int e = 0; e < 8; ++e) sacc[a][i] += qf[a][e] * kf[e]; }
            }
#pragma unroll
            for (int a = 0; a < 4; ++a) { const int t = 4 * tg + a; const float Mt = M_tok[t];
#pragma unroll
                for (int i = 0; i < 8; ++i) { const int s = vg + 16 * i; const bool ok = dir ? (s >= t) : (s <= t);
                    Ss[t * SP + s] = ok ? sacc[a][i] * 0.125f * expf(a_tok[s] - Mt) : 0.f; } }
        }
        __syncthreads();
        {
            const float* Cg = CST + (size_t)ci * 8192;
#pragma unroll
            for (int i = 0; i < 4; ++i) { const int vi = tA + 512 * i, vrow = vi >> 4, c4 = (vi & 15) * 4; const f32x4_t cv = *(const f32x4_t*)(Cg + vrow * 64 + c4);
                u32x2_t w; w.x = pk2(cv.x, cv.y); w.y = pk2(cv.z, cv.w); *(u32x2_t*)(kc + vrow * KP + c4) = w; }
        }
        float num[4][8], rs[4];
#pragma unroll
        for (int a = 0; a < 4; ++a) { rs[a] = 0.f;
#pragma unroll
            for (int e = 0; e < 8; ++e) num[a][e] = 0.f; }
        {
            const int wv16 = 16 * F.wave;
            const int sbeg = dir ? wv16 : 0, send = dir ? 128 : wv16 + 16;
#pragma unroll 1
            for (int s0 = sbeg; s0 < send; s0 += 4) {
                f32x4_t S4[4];
#pragma unroll
                for (int a = 0; a < 4; ++a) S4[a] = *(const f32x4_t*)(Ss + (4 * tg + a) * SP + s0);
#pragma unroll
                for (int ss = 0; ss < 4; ++ss) { float vf[8]; unpack8(*(const u32x4_t*)(vs + (s0 + ss) * 128 + 8 * vg), vf);
#pragma unroll
                    for (int a = 0; a < 4; ++a) { const float sv = S4[a][ss]; rs[a] += sv;
#pragma unroll
                        for (int e = 0; e < 8; ++e) num[a][e] += sv * vf[e]; } }
            }
        }
        __syncthreads();
        {
            float qc[4][8], nq[4];
#pragma unroll
            for (int a = 0; a < 4; ++a) { nq[a] = 0.f;
#pragma unroll
                for (int e = 0; e < 8; ++e) qc[a][e] = 0.f; }
#pragma unroll 1
            for (int d0 = 0; d0 < 64; d0 += 8) {
                float qf[4][8];
#pragma unroll
                for (int a = 0; a < 4; ++a) { unpack8(*(const u32x4_t*)(qs + (4 * tg + a) * 64 + d0), qf[a]);
#pragma unroll
                    for (int e = 0; e < 8; ++e) nq[a] += nst[d0 + e] * qf[a][e]; }
#pragma unroll
                for (int e = 0; e < 8; ++e) { float cf[8]; unpack8(*(const u32x4_t*)(kc + (8 * vg + e) * KP + d0), cf);
#pragma unroll
                    for (int a = 0; a < 4; ++a)
#pragma unroll
                        for (int k = 0; k < 8; ++k) qc[a][e] += cf[k] * qf[a][k]; }
            }
#pragma unroll
            for (int a = 0; a < 4; ++a) { const int t = 4 * tg + a; const float Mt = M_tok[t], winter = expf(m_prev - Mt);
                const float den = winter * nq[a] + rs[a]; const float dn = fmaxf(fabsf(den), expf(-(bc_tok[t] + Mt))); const float inv = 1.0f / dn;
#pragma unroll
                for (int e = 0; e < 8; ++e) hsum[a][e] += (winter * qc[a][e] + num[a][e]) * inv; }
        }
    }
    float gmm[8];
#pragma unroll
    for (int e = 0; e < 8; ++e) gmm[e] = ng[head * 128 + 8 * vg + e];
#pragma unroll
    for (int a = 0; a < 4; ++a) { float ss = 0.f;
#pragma unroll
        for (int e = 0; e < 8; ++e) ss += hsum[a][e] * hsum[a][e];
        ss += __shfl_xor(ss, 1); ss += __shfl_xor(ss, 2); ss += __shfl_xor(ss, 4); ss += __shfl_xor(ss, 8);
        const float rstd = 1.0f / sqrtf(ss * (1.f / 128.f) + NORM_EPS);
        const int row = r0 + 4 * tg + a; float of[8]; unpack8(*(const u32x4_t*)(P + (size_t)row * PP + C_MO + head * 128 + 8 * vg), of);
        float yv[8];
#pragma unroll
        for (int e = 0; e < 8; ++e) yv[e] = hsum[a][e] * rstd * gmm[e] * sigmoid_f(of[e]);
        *(u32x4_t*)(Y + (size_t)row * DM + head * 128 + 8 * vg) = pack8(yv); }
    (void)misc;
}

#define KSWZ64(row, colB) ((row) * 128 + ((colB) ^ (((row) & 7) << 4)))
__device__ __forceinline__ void mlstm_c_unit_mfma(const Frame& F, const bf16raw* __restrict__ P, const float* __restrict__ gb, const float* __restrict__ ng, bf16raw* __restrict__ Y, int bb, int head, int tb) {
    using att::bf16x8; using att::f32x16; using att::crow;
    constexpr int CP = 72;
    constexpr int L_K = 0, L_V = 16384, L_C = 49152, L_SM = 86016, L_WS = 90112, L_HB = 0, HP = 132;
    char* lds = F.lds;
    int tid = F.tid; asm volatile("" : "+v"(tid));
    const int wid = F.wave, lane = tid & 63, r32 = lane & 31, hi = lane >> 5, dir = wid >> 2, rg = wid & 3;
    const float* CST = (const float*)(F.ws + WS_CST); const float* NST = (const float*)(F.ws + WS_NST); const float* MS = (const float*)(F.ws + WS_MSC) + 32 * NCHUNK;
    const int r0 = bb * TPB + tb * 128;
    float* sm = (float*)(lds + L_SM);
    float* wsc = (float*)(lds + L_WS) + wid * 64;
    __syncthreads();
#pragma unroll
    for (int i = 0; i < 2; ++i) { const int vi = tid + 512 * i, key = vi >> 3, c8 = (vi & 7) * 8;
        *(u32x4_t*)(lds + L_K + (key >> 6) * 8192 + KSWZ64(key & 63, c8 * 2)) = *(const u32x4_t*)(P + (size_t)(r0 + key) * PP + C_MK + head * 64 + c8); }
#pragma unroll
    for (int i = 0; i < 4; ++i) { const int vi = tid + 512 * i, key = vi >> 4, c8 = (vi & 15) * 8;
        *(u32x4_t*)(lds + L_V + (key >> 6) * 16384 + att::v_st(key & 63, c8)) = *(const u32x4_t*)(P + (size_t)(r0 + key) * PP + C_MV + head * 128 + c8); }
#pragma unroll
    for (int i = 0; i < 8; ++i) { const int vi = tid + 512 * i, d2 = vi >> 11, rem = vi & 2047, vrow = rem >> 4, c4 = (rem & 15) * 4;
        const int ci2 = (bb * 8 + head * 2 + d2) * NCHUNK + tb; const f32x4_t cv = *(const f32x4_t*)(CST + (size_t)ci2 * 8192 + vrow * 64 + c4);
        u32x2_t w; w.x = pk2(cv.x, cv.y); w.y = pk2(cv.z, cv.w); *(u32x2_t*)(lds + L_C + d2 * 18432 + (vrow * CP + c4) * 2) = w; }
    const int chain = bb * 8 + head * 2 + dir, ci = chain * NCHUNK + tb;
    const float m_prev = MS[ci];
    float* smd = sm + dir * 448;
    if (rg == 0) {
        float ig[2], bc[2], bl; gate_scan(P, gb, r0, head, dir, lane, ig, bc, bl);
        const float a0 = ig[0] - bc[0], a1 = ig[1] - bc[1]; const float pm = fmaxf(a0, a1); float v = pm;
#pragma unroll
        for (int o = 1; o < 64; o <<= 1) { const float tt = __shfl_up(v, o); if (lane >= o) v = fmaxf(v, tt); }
        float ex = __shfl_up(v, 1); if (lane == 0) ex = -3.0e38f;
        const float M0 = fmaxf(m_prev, fmaxf(ex, a0)), M1 = fmaxf(m_prev, fmaxf(ex, pm));
        const int s0 = 2 * lane, t0 = dir ? 127 - s0 : s0, t1 = dir ? 126 - s0 : s0 + 1;
        smd[t0] = a0; smd[t1] = a1; smd[128 + t0] = M0; smd[128 + t1] = M1; smd[256 + t0] = bc[0]; smd[256 + t1] = bc[1];
    } else if (rg == 1) { smd[384 + lane] = NST[(size_t)ci * 64 + lane]; }
    const int tq = 32 * rg + r32;
    bf16x8 qr[4];
#pragma unroll
    for (int d0 = 0; d0 < 4; ++d0) qr[d0] = *reinterpret_cast<const bf16x8*>(P + (size_t)(r0 + tq) * PP + C_MQ + head * 64 + d0 * 16 + hi * 8);
    __syncthreads();
    const float Mt = smd[128 + tq], winter = __expf(m_prev - Mt);
    float nq = 0.f; bf16x8 qs[4];
#pragma unroll
    for (int d0 = 0; d0 < 4; ++d0) { float qf[8]; unpack8(__builtin_bit_cast(u32x4_t, qr[d0]), qf); float qw[8];
#pragma unroll
        for (int e = 0; e < 8; ++e) { nq += smd[384 + d0 * 16 + hi * 8 + e] * qf[e]; qw[e] = qf[e] * winter; }
        qs[d0] = __builtin_bit_cast(bf16x8, pack8(qw)); }
    { auto rr = __builtin_amdgcn_permlane32_swap(__float_as_uint(nq), __float_as_uint(nq), false, false); nq = __uint_as_float(rr[0]) + __uint_as_float(rr[1]); }
    f32x16 o[4] = {};
    { const char* cb = lds + L_C + dir * 18432;
#pragma unroll
      for (int blk = 0; blk < 4; ++blk)
#pragma unroll
        for (int ks = 0; ks < 4; ++ks) { const bf16x8 cf = *reinterpret_cast<const bf16x8*>(cb + ((32 * blk + r32) * CP + 16 * ks + 8 * hi) * 2);
            o[blk] = __builtin_amdgcn_mfma_f32_32x32x16_bf16(qs[ks], cf, o[blk], 0, 0, 0); } }
    float rs = 0.f;
    const int vb0 = (int)(uintptr_t)(lds + L_V) + att::v_rd_base(lane);
    const int kt_lo = dir ? (rg >= 2 ? 1 : 0) : 0, kt_hi = dir ? 1 : (rg >= 2 ? 1 : 0);
    for (int kt = kt_lo; kt <= kt_hi; ++kt) {
        f32x16 p0 = {}, p1 = {};
        const char* Ks = lds + L_K + kt * 8192;
#pragma unroll
        for (int d0 = 0; d0 < 4; ++d0) { const int cbb = (d0 * 16 + hi * 8) * 2;
            const bf16x8 b0 = *reinterpret_cast<const bf16x8*>(Ks + KSWZ64(r32, cbb)), b1 = *reinterpret_cast<const bf16x8*>(Ks + KSWZ64(32 + r32, cbb));
            p0 = __builtin_amdgcn_mfma_f32_32x32x16_bf16(b0, qr[d0], p0, 0, 0, 0); p1 = __builtin_amdgcn_mfma_f32_32x32x16_bf16(b1, qr[d0], p1, 0, 0, 0); }
#pragma unroll
        for (int r = 0; r < 16; ++r) { const int s0_ = 64 * kt + crow(r, hi), s1_ = s0_ + 32;
            const bool ok0 = dir ? (s0_ >= tq) : (s0_ <= tq), ok1 = dir ? (s1_ >= tq) : (s1_ <= tq);
            const float w0 = ok0 ? 0.125f * __expf(smd[s0_] - Mt) : 0.f, w1 = ok1 ? 0.125f * __expf(smd[s1_] - Mt) : 0.f;
            p0[r] *= w0; p1[r] *= w1; rs += p0[r] + p1[r]; }
        bf16x8 pa0, pa1, pa2, pa3;
#define PK4M(Pv, BASE, OUT) do { unsigned a0 = att::cvtpk(Pv[BASE + 0], Pv[BASE + 1]), a1 = att::cvtpk(Pv[BASE + 2], Pv[BASE + 3]);   \
    unsigned b0 = att::cvtpk(Pv[BASE + 4], Pv[BASE + 5]), b1 = att::cvtpk(Pv[BASE + 6], Pv[BASE + 7]);                              \
    auto r0_ = __builtin_amdgcn_permlane32_swap(a0, b0, false, false); auto r1_ = __builtin_amdgcn_permlane32_swap(a1, b1, false, false); \
    u32x4_t w_ = {r0_[0], r1_[0], r0_[1], r1_[1]}; OUT = __builtin_bit_cast(bf16x8, w_); } while (0)
        PK4M(p0, 0, pa0); PK4M(p0, 8, pa1); PK4M(p1, 0, pa2); PK4M(p1, 8, pa3);
#undef PK4M
        __builtin_amdgcn_sched_barrier(0);
        const int vb = vb0 + kt * 16384;
        att::pv_one<0>(o[0], vb, pa0, pa1, pa2, pa3); att::pv_one<1>(o[1], vb, pa0, pa1, pa2, pa3); att::pv_one<2>(o[2], vb, pa0, pa1, pa2, pa3); att::pv_one<3>(o[3], vb, pa0, pa1, pa2, pa3);
    }
    { auto rr = __builtin_amdgcn_permlane32_swap(__float_as_uint(rs), __float_as_uint(rs), false, false); rs = __uint_as_float(rr[0]) + __uint_as_float(rr[1]); }
    const float den = winter * nq + rs; const float dn = fmaxf(fabsf(den), __expf(-(smd[256 + tq] + Mt)));
    if (hi == 0) wsc[r32] = 1.0f / dn;
    asm volatile("s_waitcnt lgkmcnt(0)" ::: "memory");
    float inv[16];
#pragma unroll
    for (int r = 0; r < 16; ++r) inv[r] = wsc[crow(r, hi)];
    __syncthreads();
    float* hb = (float*)(lds + L_HB);
    if (dir == 1) {
#pragma unroll
        for (int blk = 0; blk < 4; ++blk)
#pragma unroll
            for (int r = 0; r < 16; ++r) hb[(32 * rg + crow(r, hi)) * HP + 32 * blk + r32] = o[blk][r] * inv[r];
    }
    __syncthreads();
    if (dir == 0) {
        float ss[16];
#pragma unroll
        for (int r = 0; r < 16; ++r) ss[r] = 0.f;
#pragma unroll
        for (int blk = 0; blk < 4; ++blk)
#pragma unroll
            for (int r = 0; r < 16; ++r) { const float h = o[blk][r] * inv[r] + hb[(32 * rg + crow(r, hi)) * HP + 32 * blk + r32]; o[blk][r] = h; ss[r] += h * h; }
#pragma unroll
        for (int r = 0; r < 16; ++r) { float s = ss[r]; s += __shfl_xor(s, 1); s += __shfl_xor(s, 2); s += __shfl_xor(s, 4); s += __shfl_xor(s, 8); s += __shfl_xor(s, 16); ss[r] = 1.0f / sqrtf(s * (1.f / 128.f) + NORM_EPS); }
#pragma unroll
        for (int blk = 0; blk < 4; ++blk) { const float gm = ng[head * 128 + 32 * blk + r32];
#pragma unroll
            for (int r = 0; r < 16; ++r) { const size_t row = (size_t)(r0 + 32 * rg + crow(r, hi));
                const float og = bf1(P[row * PP + C_MO + head * 128 + 32 * blk + r32]);
                const float yv = o[blk][r] * ss[r] * gm * sigmoid_f(og);
                Y[row * DM + head * 128 + 32 * blk + r32] = (bf16raw)(pk2(yv, 0.f) & 0xffffu); } }
    }
}

__device__ __forceinline__ void diff_post_phase(const Frame& F, const bf16raw* __restrict__ T, const float* __restrict__ lam, const float* __restrict__ g, float one_minus, bf16raw* __restrict__ Y) {
    const int h = F.lane >> 4, c8 = (F.lane & 15) * 8; const float lm = lam[h]; float gm[8];
#pragma unroll
    for (int e = 0; e < 8; ++e) gm[e] = g[h * 128 + c8 + e] * one_minus;
    for (int r = F.gw; r < MROWS; r += 2 * F.NGW) {
        const int r2 = r + F.NGW; const bool has2 = r2 < MROWS; const int rb = has2 ? r2 : r;
        const u32x4_t wa1 = *(const u32x4_t*)(T + (size_t)r * 1024 + (2 * h) * 128 + c8), wa2 = *(const u32x4_t*)(T + (size_t)r * 1024 + (2 * h + 1) * 128 + c8);
        const u32x4_t wb1 = *(const u32x4_t*)(T + (size_t)rb * 1024 + (2 * h) * 128 + c8), wb2 = *(const u32x4_t*)(T + (size_t)rb * 1024 + (2 * h + 1) * 128 + c8);
#pragma unroll
        for (int q = 0; q < 2; ++q) {
            float o1[8], o2[8]; unpack8(q ? wb1 : wa1, o1); unpack8(q ? wb2 : wa2, o2);
            float ss = 0.f;
#pragma unroll
            for (int e = 0; e < 8; ++e) { o1[e] -= lm * o2[e]; ss += o1[e] * o1[e]; }
            ss += __shfl_xor(ss, 1); ss += __shfl_xor(ss, 2); ss += __shfl_xor(ss, 4); ss += __shfl_xor(ss, 8);
            const float rstd = 1.0f / sqrtf(ss * (1.f / 128.f) + NORM_EPS);
#pragma unroll
            for (int e = 0; e < 8; ++e) o1[e] *= rstd * gm[e];
            if (q == 0 || has2) *(u32x4_t*)(Y + (size_t)(q ? r2 : r) * DM + 512 + h * 128 + c8) = pack8(o1);
        }
    }
}

__device__ __forceinline__ void mixer_phase(const Frame& F, CArgsP0 a, int l) {
    const hbf16* P = (const hbf16*)(F.ws + WS_P); hbf16* Yb = (hbf16*)(F.ws + WS_Y); hbf16* DT = (hbf16*)(F.ws + WS_DTMP);
    REPX(1) if (MX_MASK & 1) for (int k = F.vcu; k < 1536; k += F.G) {
        const int i = k >> 8, rem = k & 255, xcd = rem >> 5, idx = rem & 31;
        __syncthreads();
        if (i < 4) { const int id = xcd * 4 + i, combo = id >> 1, qb = (id & 1) * 32 + idx, bb = combo >> 3, sh = combo & 7, h = sh >> 1, m = sh & 1;
            const long rq = (long)bb * TPB + CTX + qb * 256, rk = (long)bb * TPB;
            att::attn_dense_body<64, 1024>(P + rq * PP + C_DQ + h * 128 + m * 64, P + rk * PP + C_DK + h * 128, P + rk * PP + C_DV + h * 128, DT + rq * 1024 + sh * 128, TPB, m * 64, F.lds);
        } else { const int id = xcd * 2 + (i - 4), combo = id >> 1, qb = (id & 1) * 32 + idx, bb = combo >> 2, h = combo & 3;
            const long rq = (long)bb * TPB + CTX + qb * 256, rk = (long)bb * TPB;
            att::attn_dense_body<128, DM>(P + rq * PP + C_GQ + h * 128, P + rk * PP + C_GK + (h >> 1) * 128, P + rk * PP + C_GV + (h >> 1) * 128, Yb + rq * DM + 1536 + h * 128, TPB, 0, F.lds);
        }
    }
    const bool lastl = (l == DEPTH - 1);
    if (!lastl && (MX_MASK & 1)) for (int k = F.vcu; k < 24; k += F.G) {
        __syncthreads();
        if (k < 16) { const int bb = k >> 3, sh = k & 7, h = sh >> 1, m = sh & 1; const long rq = (long)bb * TPB;
            att::attn_dense_body<64, 1024>(P + rq * PP + C_DQ + h * 128 + m * 64, P + rq * PP + C_DK + h * 128, P + rq * PP + C_DV + h * 128, DT + rq * 1024 + sh * 128, CTX, m * 64, F.lds);
        } else { const int k2 = k - 16, bb = k2 >> 2, h = k2 & 3; const long rq = (long)bb * TPB;
            att::attn_dense_body<128, DM>(P + rq * PP + C_GQ + h * 128, P + rq * PP + C_GK + (h >> 1) * 128, P + rq * PP + C_GV + (h >> 1) * 128, Yb + rq * DM + 1536 + h * 128, CTX, 0, F.lds);
        }
    }
    __syncthreads();
    const float* sinkl = a->in[12] + l * 8;
    REPX(2) if (MX_MASK & 2) for (int k = F.vcu; k < (lastl ? 1024 : 1040); k += F.G) {
        if (k < 1024) att::swa_unit(P, Yb, k >> 9, (k >> 8) & 1, k & 255, false, sinkl, F.lds);
        else { const int k2 = k - 1024; att::swa_unit(P, Yb, k2 >> 3, (k2 >> 2) & 1, k2 & 3, true, sinkl, F.lds); }
    }
    const float* gb = a->in[8] + l * 16; const float* ng = a->in[9] + l * 512;
    REPX(4) if (MX_MASK & 4) for (int k = F.vcu; k < (lastl ? 8 * (NCHUNK - 2) : 8 * NCHUNK); k += F.G) { int bb, head, tb;
        if (lastl) { bb = k / (4 * (NCHUNK - 2)); const int rem = k - bb * 4 * (NCHUNK - 2); head = rem / (NCHUNK - 2); tb = 2 + rem - head * (NCHUNK - 2); }
        else { bb = k / (4 * NCHUNK); const int rem = k - bb * 4 * NCHUNK; head = rem / NCHUNK; tb = rem - head * NCHUNK; }
#ifdef MLSTM_VALU
        mlstm_c_unit(F, (const bf16raw*)P, gb, ng, (bf16raw*)Yb, bb, head, tb);
#else
        mlstm_c_unit_mfma(F, (const bf16raw*)P, gb, ng, (bf16raw*)Yb, bb, head, tb);
#endif
    }
    __syncthreads();
}

struct RowOrder { pg8::StaticOrder S; int skip;
    __device__ void init(int N, int G, int c, int skip_) { skip = skip_; S.init(skip_ ? NBATCH * SEQ : MROWS, N, G, c); }
    __device__ bool next(int i, pg8::Unit& u) const { if (!S.next(i, u)) return false; if (skip) u.pm += 1 + (u.pm >= 64 ? 1 : 0); return true; }
    __device__ __forceinline__ void a_ready(const pg8::Unit&) const {}
    __device__ __forceinline__ void done(const pg8::Unit&) const {}
};
typedef const __attribute__((address_space(4))) Args* CArgsP;
__device__ __forceinline__ CArgsP get_args() { CArgsP p = (CArgsP)__builtin_amdgcn_kernarg_segment_ptr(); asm volatile("" : "+s"(p)); return p; }
#define PHASE_BEGIN CArgsP ap = get_args(); unsigned char* ws = ap->ws; const Frame F = make_frame(ws, (char*)lds); (void)F;
__global__ void __launch_bounds__(512, 2) fwd_megakernel(Args a_unused) {
    extern __shared__ __attribute__((aligned(16))) unsigned char lds[];
    cg::grid_group grid = cg::this_grid();
    PG8_LAS unsigned char* glds = (PG8_LAS unsigned char*)lds;
    if (threadIdx.x < 16) ((LAS unsigned*)((LAS unsigned char*)lds + LDS_BARST))[threadIdx.x] = 0u;
    __syncthreads();
    { CArgsP ap0 = get_args(); (void)xcd_barrier_post((unsigned*)(ap0->ws + WS_BAR), (volatile LAS unsigned*)((LAS unsigned char*)lds + LDS_BARST)); }
#define GBAR() do { CArgsP apb = get_args(); XcdBarrier xb_; xb_.bar = (unsigned*)(apb->ws + WS_BAR); xb_.x = xb_xcc_id(); xb_.st = (volatile LAS unsigned*)((LAS unsigned char*)lds + LDS_BARST); xcd_barrier(xb_); } while (0)
    REP(1) if (PH_MASK & 1) { PHASE_BEGIN s0_phase(F, ap); }
    grid.sync();
#ifdef EXTRA_SYNCS
    for (int es = 0; es < EXTRA_SYNCS; ++es) GBAR();
#endif
#pragma unroll 1
    for (int l = 0; l < DEPTH; ++l) {
        REP(2) if (PH_MASK & 2) { PHASE_BEGIN s1_phase(F, ap, l); }
        GBAR();
        REP(4) if (PH_MASK & 4) { PHASE_BEGIN const float* modl = (const float*)(ws + WS_MOD) + (size_t)l * 3 * 12288;
            const XPtr xin = (l == 0) ? XPtr{ap->in[0], ap->in[2]} : XPtr{ap->out, (const float*)(ws + WS_XC)};
            norm_mod_phase(F, xin, ap->in[6] + l * DM, modl, 0, 1, (bf16raw*)(ws + WS_H)); }
        GBAR();
        REP(8) if (PH_MASK & 8) { PHASE_BEGIN
            pg8::Gemm g{(const pg8::bf16_t*)(ws + WS_H), (const pg8::bf16_t*)(ws + WS_WIN), MROWS, PP, DM, DM, 0, 0}; pg8::StaticOrder S; S.init(MROWS, PP, F.G, (int)blockIdx.x);
            pg8::EpiBf16<0> E{(pg8::bf16_t*)(ws + WS_P), PP, nullptr, 0, 0, 1.f};
            pg8::gemm_phase<pg8::EpiBf16<0>, pg8::StaticOrder, P_ALIGN, true>(glds, g, S, E);
        }
        GBAR();
        if (PH_MASK & 16) { PHASE_BEGIN rope_phase(F, (bf16raw*)(ws + WS_P), ap->in[13] + l * 128, ap->in[14] + l * 128); }
#ifdef DBL_SCAN
        for (int rs_ = 0; rs_ < 2; ++rs_) {
#endif
        REP(32) if (PH_MASK & 32) { PHASE_BEGIN mlstm_a_phase(F, (const bf16raw*)(ws + WS_P), ap->in[8] + l * 16); }
        GBAR();
        if (PH_MASK & 64) { PHASE_BEGIN mlstm_b_phase(F); }
        GBAR();
#ifdef DBL_SCAN
        }
#endif
        if (PH_MASK & 128) { PHASE_BEGIN mixer_phase(F, ap, l); }
        GBAR();
        REP(256) if (PH_MASK & 256) { PHASE_BEGIN diff_post_phase(F, (const bf16raw*)(ws + WS_DTMP), (const float*)(ws + WS_LAM) + l * 4, ap->in[11] + l * 512, (l == 0) ? 0.8f : 0.64449093241f, (bf16raw*)(ws + WS_Y)); }
        GBAR();
        REP(512) if (PH_MASK & 512) { PHASE_BEGIN
            pg8::Gemm g{(const pg8::bf16_t*)(ws + WS_Y), (const pg8::bf16_t*)(ws + WS_WB), MROWS, 8192, 512, DM, 8, 512}; RowOrder S; S.init(8192, F.G, (int)blockIdx.x, l == DEPTH - 1);
            pg8::EpiBf16<0> E{(pg8::bf16_t*)(ws + WS_BIG), DM, nullptr, DM, (size_t)MROWS * DM, 1.f};
            pg8::gemm_phase<pg8::EpiBf16<0>, RowOrder, BR_ALIGN, true>(glds, g, S, E);
        }
        GBAR();
        REP(1024) if (PH_MASK & 1024) { PHASE_BEGIN
            pg8::Gemm g{(const pg8::bf16_t*)(ws + WS_H), (const pg8::bf16_t*)(ws + WS_WG), MROWS, 8192, DM, DM, 0, 0}; RowOrder S; S.init(8192, F.G, (int)blockIdx.x, l == DEPTH - 1);
            pg8::EpiGate E{(const pg8::bf16_t*)(ws + WS_BIG), (pg8::bf16_t*)(ws + WS_Y), (size_t)MROWS * DM};
            pg8::gemm_phase<pg8::EpiGate, RowOrder, GATE_ALIGN, true>(glds, g, S, E);
        }
        GBAR();
        RESID_LOOP
        if (PH_MASK & 2048) { PHASE_BEGIN
            const float* modl = rr_ ? (const float*)(ws + WS_MOD) + (size_t)l * 3 * 12288 : (const float*)(ws + WS_ZT) - 2 * 2048; float* xc = (float*)(ws + WS_XC);
            pg8::Gemm g{(const pg8::bf16_t*)(ws + WS_Y), (const pg8::bf16_t*)(ws + WS_WOUT), MROWS, DM, DM, DM, 0, 0}; RowOrder S; S.init(DM, F.G, (int)blockIdx.x, l == DEPTH - 1);
            pg8::EpiResid E{(l == 0) ? ap->in[0] : (const float*)ap->out, (l == 0) ? ap->in[2] : (const float*)xc, ap->out, xc, modl, 2};
            pg8::gemm_phase<pg8::EpiResid, RowOrder, RESID_ALIGN, true>(glds, g, S, E);
        }
        GBAR();
        REP(4) if (PH_MASK & 4) { PHASE_BEGIN const float* modl = (const float*)(ws + WS_MOD) + (size_t)l * 3 * 12288;
            norm_mod_phase(F, XPtr{ap->out, (const float*)(ws + WS_XC)}, ap->in[17] + l * DM, modl, 3, 4, (bf16raw*)(ws + WS_H)); }
        GBAR();
        REP(4096) if (PH_MASK & 4096) { PHASE_BEGIN
            pg8::Gemm g{(const pg8::bf16_t*)(ws + WS_H), (const pg8::bf16_t*)(ws + WS_WUP), MROWS, 2 * FF, DM, DM, 0, 0}; RowOrder S; S.init(2 * FF, F.G, (int)blockIdx.x, l == DEPTH - 1);
            pg8::EpiSwiGLU E{(pg8::bf16_t*)(ws + WS_BIG), FF};
            pg8::gemm_phase<pg8::EpiSwiGLU, RowOrder, UP_ALIGN, true>(glds, g, S, E);
        }
        GBAR();
        RESID_LOOP
        if (PH_MASK & 8192) { PHASE_BEGIN
            const float* modl = rr_ ? (const float*)(ws + WS_MOD) + (size_t)l * 3 * 12288 : (const float*)(ws + WS_ZT) - 5 * 2048; float* xc = (float*)(ws + WS_XC);
            pg8::Gemm g{(const pg8::bf16_t*)(ws + WS_BIG), (const pg8::bf16_t*)(ws + WS_WDN), MROWS, DM, FF, FF, 0, 0}; RowOrder S; S.init(DM, F.G, (int)blockIdx.x, l == DEPTH - 1);
            pg8::EpiResid E{ap->out, xc, ap->out, xc, modl, 5};
            pg8::gemm_phase<pg8::EpiResid, RowOrder, RESID_ALIGN, true>(glds, g, S, E);
        }
        GBAR();
    }
    if (PH_MASK & 16384) { PHASE_BEGIN final_norm_phase(F, ap->out, ap->in[20]); }
}

extern "C" void kernel_launch(void* const* d_in, const int* in_sizes, int n_in, void* d_out, int out_size, void* d_ws, size_t ws_size, hipStream_t stream) {
    static int grid = 0;
    if (grid == 0) {
        if (n_in != 21 || out_size != NBATCH * SEQ * DM || ws_size < WS_END) { fprintf(stderr, "kernel_launch: unexpected shapes: n_in %d out %d ws %zu (need %zu)\n", n_in, out_size, ws_size, (size_t)WS_END); grid = -1; return; }
        int dev = 0, cus = 0, per_cu = 0;
        if (hipGetDevice(&dev) != hipSuccess || hipDeviceGetAttribute(&cus, hipDeviceAttributeMultiprocessorCount, dev) != hipSuccess) { grid = -1; return; }
        if (hipFuncSetAttribute((const void*)fwd_megakernel, hipFuncAttributeMaxDynamicSharedMemorySize, LDS_BYTES) != hipSuccess) { fprintf(stderr, "kernel_launch: hipFuncSetAttribute failed\n"); grid = -1; return; }
        if (hipOccupancyMaxActiveBlocksPerMultiprocessor(&per_cu, (const void*)fwd_megakernel, 512, LDS_BYTES) != hipSuccess || per_cu < 1) per_cu = 1;
        (void)hipGetLastError();
        grid = cus;
        fprintf(stderr, "kernel_launch: cus %d per_cu %d grid %d ws %zu\n", cus, per_cu, grid, ws_size);
    }
    if (grid < 0) return;
    Args a{};
    for (int i = 0; i < 21; ++i) a.in[i] = (const float*)d_in[i];
    a.out = (float*)d_out; a.ws = (unsigned char*)d_ws;
    (void)hipMemsetAsync((char*)d_ws + WS_BAR, 0, XCD_BAR_WORDS * 4, stream);
    void* args[] = {&a};
    const hipError_t e = hipLaunchCooperativeKernel((const void*)fwd_megakernel, dim3(grid), dim3(512), args, LDS_BYTES, stream);
    if (e != hipSuccess) fprintf(stderr, "kernel_launch: cooperative launch failed: %s (grid %d)\n", hipGetErrorString(e), grid);
}
```

```cpp
#include <hip/hip_runtime.h>
#include <hip/hip_bf16.h>
#include <hip/hip_cooperative_groups.h>
#include <cstdio>
#include <cstdint>
namespace cg = cooperative_groups;

constexpr int DM = 2048, NBATCH = 2, SEQ = 16384, CTX = 256, DEPTH = 2;
constexpr int TPB = SEQ + CTX;
constexpr int MROWS = NBATCH * TPB;
constexpr int DIN = 13072, NMIX = 4880, PP = 5120;
constexpr int FF = 5632;
constexpr int C_MQ = 0, C_MK = 256, C_MV = 512, C_MO = 1024, C_MG = 1536, C_DQ = 1552, C_DK = 2064, C_DV = 2576, C_SQ = 3088, C_SK = 3600, C_SV = 3728,
              C_GQ = 3856, C_GK = 4368, C_GV = 4624;
constexpr int NCHUNK = TPB / 128;
constexpr float NORM_EPS = 1e-6f;

constexpr size_t MiB = 1u << 20;
constexpr size_t WS_MODP = 0;
constexpr size_t WS_MOD = 5 * MiB;
constexpr size_t WS_ROPE = 5 * MiB + 512 * 1024;
constexpr size_t WS_LAM = 5 * MiB + 768 * 1024;
constexpr size_t WS_MSC = 6 * MiB;
constexpr size_t WS_NST = 6 * MiB + 512 * 1024;
constexpr size_t WS_W = 8 * MiB;
constexpr size_t WS_WIN = WS_W, WS_WG = WS_WIN + 20 * MiB, WS_WB = WS_WG + 32 * MiB, WS_WOUT = WS_WB + 8 * MiB, WS_WUP = WS_WOUT + 8 * MiB, WS_WDN = WS_WUP + 44 * MiB;
constexpr size_t WS_H = WS_WDN + 22 * MiB;
constexpr size_t WS_Y = WS_H + 130 * MiB;
constexpr size_t WS_XC = WS_Y + 130 * MiB;
constexpr size_t WS_BIG = WS_XC + 4 * MiB;
constexpr size_t WS_P = WS_BIG, WS_DTMP = WS_BIG + 325 * MiB, WS_CST = WS_BIG + 390 * MiB;
constexpr size_t WS_END = WS_BIG + 520 * MiB;
static_assert(WS_H == 142 * MiB && WS_END == 926 * MiB, "ws map");
static_assert((size_t)MROWS * PP * 2 <= 325 * MiB && (size_t)MROWS * 1024 * 2 <= 65 * MiB && (size_t)16 * NCHUNK * 8192 * 4 <= 65 * MiB, "big map");
static_assert((size_t)4 * MROWS * DM * 2 <= 520 * MiB && (size_t)MROWS * FF * 2 <= 520 * MiB, "big map 2");

constexpr int LDS_BYTES = 147456;

typedef unsigned short bf16raw;
typedef float f32x4_t __attribute__((ext_vector_type(4)));
typedef float f32x2_t __attribute__((ext_vector_type(2)));
typedef unsigned u32x4_t __attribute__((ext_vector_type(4)));
typedef unsigned u32x2_t __attribute__((ext_vector_type(2)));
typedef __bf16 bf16x2_t __attribute__((ext_vector_type(2)));

__device__ __forceinline__ unsigned pk2(float lo, float hi) { f32x2_t v = {lo, hi}; bf16x2_t b = __builtin_convertvector(v, bf16x2_t); return __builtin_bit_cast(unsigned, b); }
__device__ __forceinline__ float bflo(unsigned u) { return __uint_as_float(u << 16); }
__device__ __forceinline__ float bfhi(unsigned u) { return __uint_as_float(u & 0xffff0000u); }
__device__ __forceinline__ float bf1(bf16raw u) { return __uint_as_float(((unsigned)u) << 16); }
__device__ __forceinline__ void unpack8(const u32x4_t w, float* f) { f[0] = bflo(w.x); f[1] = bfhi(w.x); f[2] = bflo(w.y); f[3] = bfhi(w.y); f[4] = bflo(w.z); f[5] = bfhi(w.z); f[6] = bflo(w.w); f[7] = bfhi(w.w); }
__device__ __forceinline__ u32x4_t pack8(const float* f) { u32x4_t w; w.x = pk2(f[0], f[1]); w.y = pk2(f[2], f[3]); w.z = pk2(f[4], f[5]); w.w = pk2(f[6], f[7]); return w; }
__device__ __forceinline__ float wave_sum(float v) {
#pragma unroll
    for (int o = 1; o < 64; o <<= 1) v += __shfl_xor(v, o);
    return v;
}
__device__ __forceinline__ float wave_max(float v) {
#pragma unroll
    for (int o = 1; o < 64; o <<= 1) v = fmaxf(v, __shfl_xor(v, o));
    return v;
}
__device__ __forceinline__ float sigmoid_f(float x) { return __builtin_amdgcn_rcpf(1.f + __expf(-x)); }

struct XPtr { const float* lat; const float* ctx;
    __device__ __forceinline__ const float* row(int r) const { const int b = r / TPB, t = r - b * TPB; return t < CTX ? ctx + ((size_t)b * CTX + t) * DM : lat + ((size_t)b * SEQ + (t - CTX)) * DM; } };
struct XOut { float* lat; float* ctx;
    __device__ __forceinline__ float* row(int r) const { const int b = r / TPB, t = r - b * TPB; return t < CTX ? ctx + ((size_t)b * CTX + t) * DM : lat + ((size_t)b * SEQ + (t - CTX)) * DM; } };

namespace pg8 {
#define PG8_LAS __attribute__((address_space(3)))
typedef unsigned short bf16_t;
typedef short bf16x8 __attribute__((ext_vector_type(8)));
typedef float f32x4 __attribute__((ext_vector_type(4)));
typedef unsigned u32x4 __attribute__((ext_vector_type(4)));
constexpr int BM = 256, BK = 64, HALF = 128, HTB = HALF * BK * 2  , STAGE_BYTES = 8 * HTB, NXCD = 8, WGM = 8;

__host__ __device__ __forceinline__ int lds_byte(int r, int c) { const int st = (r >> 4) * 2 + (c >> 5), rr = r & 15, cc = c & 31, ob = rr * 64 + cc * 2; return st * 1024 + (ob ^ (((ob >> 9) & 1) << 5)); }
__host__ __device__ __forceinline__ void stage_rc(int b, int& R, int& C) { const int st = b / 1024, sb = b % 1024, swz = sb ^ (((sb >> 9) & 1) << 5); R = (st >> 1) * 16 + swz / 64; C = (st & 1) * 32 + (swz % 64) / 2; }
__host__ __device__ __forceinline__ int perm32(int rho) { const int n = rho >> 4, i = rho & 15; return 8 * (i >> 2) + 4 * n + (i & 3); }

struct Unit { int pm, pn; };
struct Gemm { const bf16_t* A; const bf16_t* Bt; int M, N, K; int lda; int agrp; int agstride; };

struct StaticOrder {
    int nM, nN, nwg, G, c;
    __host__ __device__ void init(int M, int N, int G_, int c_) { nM = M / BM; nN = N / BM; nwg = nM * nN; G = G_; c = c_; }
    __host__ __device__ bool next(int i, Unit& u) const {
        const long L = (long)i * G + c; if (L >= nwg) return false;
        int wgid = (int)L; { const int q = nwg / NXCD, r = nwg % NXCD, xcd = wgid % NXCD, off = wgid / NXCD; wgid = (xcd < r ? xcd * (q + 1) : r * (q + 1) + (xcd - r) * q) + off; }
        const int nig = WGM * nN, gid = wgid / nig, fm = gid * WGM, gsz = (nM - fm) < WGM ? (nM - fm) : WGM;
        u.pm = fm + ((wgid % nig) % gsz); u.pn = (wgid % nig) / gsz; return true;
    }
    __device__ __forceinline__ void a_ready(const Unit&) const {}
    __device__ __forceinline__ void done(const Unit&) const {}
};

__device__ __forceinline__ unsigned cvt_pk_bf16(float lo, float hi) { unsigned r; asm volatile("v_cvt_pk_bf16_f32 %0, %1, %2" : "=v"(r) : "v"(lo), "v"(hi)); return r; }
typedef float f32x2 __attribute__((ext_vector_type(2)));
__device__ __forceinline__ f32x2 gelu_pk(f32x2 v) {
    const f32x2 av = __builtin_elementwise_abs(v), d = av * 0.2316418882f + 1.0f;
    f32x2 t; t.x = __builtin_amdgcn_rcpf(d.x); t.y = __builtin_amdgcn_rcpf(d.y);
    f32x2 q = t * 0.5307027145f + (-0.7265760135f); q = q * t + 0.7107068705f; q = q * t + (-0.142248368f); q = q * t + 0.127414796f; q = q * t;
    const f32x2 s = (v * v) * (-0.72134752044f);
    f32x2 e; e.x = __builtin_amdgcn_exp2f(s.x); e.y = __builtin_amdgcn_exp2f(s.y);
    const f32x2 m = v * (q * e), r = v - m;
    f32x2 o; o.x = v.x < 0.f ? m.x : r.x; o.y = v.y < 0.f ? m.y : r.y; return o;
}

template <int ACT  > struct EpiBf16 {
    static constexpr bool PERM = true, AFTER_DRAIN = false; static_assert(ACT == 0 || ACT == 1, "EpiBf16: ACT is 0 (none) or 1 (gelu_pk)");
    bf16_t* O; int ldc; const float* bias; int split_cols; size_t split_stride; float scale0;
    __device__ __forceinline__ void operator()(const f32x4 (&acc)[2][2][4][2], const Unit& u, int wr, int wc, int fr, int fq) const {
        asm volatile("" : "+v"(fr), "+v"(fq));
        const int row0 = u.pm * BM + wr * 64 + fr; int colt = u.pn * BM; bf16_t* base = O;
        float sc = 1.f; if (split_cols) { const int t = colt / split_cols; base += (size_t)t * split_stride; colt -= t * split_cols; if (t == 0) sc = scale0; }
        const int col0 = colt + wc * 32 + 8 * fq, bcol0 = u.pn * BM + wc * 32 + 8 * fq;
        f32x4 bv[2][2];
#pragma unroll
        for (int bj = 0; bj < 2; ++bj)
#pragma unroll
            for (int n = 0; n < 2; ++n) bv[bj][n] = bias ? *(const f32x4*)(bias + bcol0 + bj * HALF + 4 * n) : (f32x4){0.f, 0.f, 0.f, 0.f};
#pragma unroll
        for (int ai = 0; ai < 2; ++ai)
#pragma unroll
            for (int m = 0; m < 4; ++m) { bf16_t* rowp = base + (size_t)(row0 + ai * HALF + m * 16) * ldc + col0;
#pragma unroll
                for (int bj = 0; bj < 2; ++bj) { f32x4 v0 = acc[ai][bj][m][0] + bv[bj][0], v1 = acc[ai][bj][m][1] + bv[bj][1];
                    if (ACT == 1) { f32x2 a = gelu_pk((f32x2){v0[0], v0[1]}), b = gelu_pk((f32x2){v0[2], v0[3]}), c = gelu_pk((f32x2){v1[0], v1[1]}), d = gelu_pk((f32x2){v1[2], v1[3]});
                        v0 = (f32x4){a.x, a.y, b.x, b.y}; v1 = (f32x4){c.x, c.y, d.x, d.y}; }
                    v0 = v0 * sc; v1 = v1 * sc; u32x4 w; w.x = cvt_pk_bf16(v0[0], v0[1]); w.y = cvt_pk_bf16(v0[2], v0[3]); w.z = cvt_pk_bf16(v1[0], v1[1]); w.w = cvt_pk_bf16(v1[2], v1[3]);
                    *(u32x4*)(rowp + bj * HALF) = w; } }
    }
};

__device__ __forceinline__ float sigm(float x) { return __builtin_amdgcn_rcpf(1.f + __expf(-x)); }
struct EpiGate {
    static constexpr bool PERM = false, AFTER_DRAIN = false;
    const bf16_t* Bq; bf16_t* out; size_t bstride;
    __device__ __forceinline__ void operator()(const f32x4 (&acc)[2][2][4][2], const Unit& u, int wr, int wc, int fr, int fq) const {
        asm volatile("" : "+v"(fr), "+v"(fq));
        typedef unsigned u32x2 __attribute__((ext_vector_type(2)));
        const int oc = u.pn * 64 + wc * 16 + fq * 4;
        u32x2 bv[2][4][4];
#pragma unroll
        for (int ai = 0; ai < 2; ++ai)
#pragma unroll
            for (int m = 0; m < 4; ++m) { const size_t off = (size_t)(u.pm * BM + ai * HALF + wr * 64 + m * 16 + fr) * 2048 + oc;
#pragma unroll
                for (int i = 0; i < 4; ++i) bv[ai][m][i] = *(const u32x2*)(Bq + (size_t)i * bstride + off); }
#pragma unroll
        for (int ai = 0; ai < 2; ++ai)
#pragma unroll
            for (int m = 0; m < 4; ++m) {
                const size_t off = (size_t)(u.pm * BM + ai * HALF + wr * 64 + m * 16 + fr) * 2048 + oc;
                f32x4 s = (f32x4){0.f, 0.f, 0.f, 0.f};
#pragma unroll
                for (int bj = 0; bj < 2; ++bj)
#pragma unroll
                    for (int n = 0; n < 2; ++n) { const f32x4 g = acc[ai][bj][m][n]; const u32x2 b = bv[ai][m][2 * bj + n];
                        s[0] += sigm(g[0]) * __uint_as_float(b.x << 16); s[1] += sigm(g[1]) * __uint_as_float(b.x & 0xffff0000u);
                        s[2] += sigm(g[2]) * __uint_as_float(b.y << 16); s[3] += sigm(g[3]) * __uint_as_float(b.y & 0xffff0000u); }
                u32x2 w; w.x = cvt_pk_bf16(s[0], s[1]); w.y = cvt_pk_bf16(s[2], s[3]);
                *(u32x2*)(out + off) = w; }
    }
};
struct EpiBranchTiled {
    static constexpr bool PERM = true, AFTER_DRAIN = false;
    bf16_t* Bq;
    __device__ __forceinline__ void operator()(const f32x4 (&acc)[2][2][4][2], const Unit& u, int wr, int wc, int fr, int fq) const {
        asm volatile("" : "+v"(fr), "+v"(fq));
        const int t = u.pn >> 3, ct = u.pn & 7;
#pragma unroll
        for (int bj = 0; bj < 2; ++bj) { const int c0 = ct * 256 + bj * HALF + wc * 32 + 8 * fq, png = c0 >> 6, cc = c0 & 63;
            bf16_t* ub = Bq + (size_t)(u.pm * 32 + png) * 65536 + t * 64 + cc;
#pragma unroll
            for (int ai = 0; ai < 2; ++ai)
#pragma unroll
                for (int m = 0; m < 4; ++m) { const int rr = ai * HALF + wr * 64 + m * 16 + fr; const f32x4 v0 = acc[ai][bj][m][0], v1 = acc[ai][bj][m][1];
                    u32x4 w; w.x = cvt_pk_bf16(v0[0], v0[1]); w.y = cvt_pk_bf16(v0[2], v0[3]); w.z = cvt_pk_bf16(v1[0], v1[1]); w.w = cvt_pk_bf16(v1[2], v1[3]);
                    *(u32x4*)(ub + rr * 256) = w; } }
    }
};
struct EpiResid {
    static constexpr bool PERM = false, AFTER_DRAIN = false;
    const float* in_lat; const float* in_ctx; float* out_lat; float* out_ctx; const float* modl; int gidx;
    __device__ __forceinline__ void operator()(const f32x4 (&acc)[2][2][4][2], const Unit& u, int wr, int wc, int fr, int fq) const {
        asm volatile("" : "+v"(fr), "+v"(fq));
        const int b = u.pm / 65, tb = u.pm - b * 65; const bool isctx = (tb == 0);
        const float* gv = modl + (size_t)(isctx ? 2 : b) * 12288 + gidx * 2048;
        const float* xi = isctx ? in_ctx + (size_t)b * 256 * 2048 : in_lat + ((size_t)b * 16384 + (size_t)(tb - 1) * 256) * 2048;
        float* xo = isctx ? out_ctx + (size_t)b * 256 * 2048 : out_lat + ((size_t)b * 16384 + (size_t)(tb - 1) * 256) * 2048;
        const int col0 = u.pn * BM + wc * 32 + 4 * fq;
#pragma unroll
        for (int bj = 0; bj < 2; ++bj)
#pragma unroll
            for (int n = 0; n < 2; ++n) { const f32x4 gg = *(const f32x4*)(gv + col0 + bj * HALF + n * 16);
                f32x4 xv[2][4];
#pragma unroll
                for (int ai = 0; ai < 2; ++ai)
#pragma unroll
                    for (int m = 0; m < 4; ++m) xv[ai][m] = *(const f32x4*)(xi + (size_t)(ai * HALF + wr * 64 + m * 16 + fr) * 2048 + col0 + bj * HALF + n * 16);
#pragma unroll
                for (int ai = 0; ai < 2; ++ai)
#pragma unroll
                    for (int m = 0; m < 4; ++m) *(f32x4*)(xo + (size_t)(ai * HALF + wr * 64 + m * 16 + fr) * 2048 + col0 + bj * HALF + n * 16) = xv[ai][m] + gg * acc[ai][bj][m][n];
                asm volatile("" ::: "memory"); }
    }
};
struct EpiDelta {
    static constexpr bool PERM = true, AFTER_DRAIN = false;
    bf16_t* D; const float* modl; int gidx;
    __device__ __forceinline__ void operator()(const f32x4 (&acc)[2][2][4][2], const Unit& u, int wr, int wc, int fr, int fq) const {
        asm volatile("" : "+v"(fr), "+v"(fq));
        const int b = u.pm / 65, tb = u.pm - b * 65; const bool isctx = (tb == 0);
        const float* gv = modl + (size_t)(isctx ? 2 : b) * 12288 + gidx * 2048;
        const int col0 = u.pn * BM + wc * 32 + 8 * fq;
#pragma unroll
        for (int bj = 0; bj < 2; ++bj) { const f32x4 g0 = *(const f32x4*)(gv + col0 + bj * HALF), g1 = *(const f32x4*)(gv + col0 + bj * HALF + 4);
#pragma unroll
            for (int ai = 0; ai < 2; ++ai)
#pragma unroll
                for (int m = 0; m < 4; ++m) { const f32x4 v0 = acc[ai][bj][m][0] * g0, v1 = acc[ai][bj][m][1] * g1;
                    u32x4 w; w.x = cvt_pk_bf16(v0[0], v0[1]); w.y = cvt_pk_bf16(v0[2], v0[3]); w.z = cvt_pk_bf16(v1[0], v1[1]); w.w = cvt_pk_bf16(v1[2], v1[3]);
                    *(u32x4*)(D + (size_t)(u.pm * BM + ai * HALF + wr * 64 + m * 16 + fr) * 2048 + col0 + bj * HALF) = w; } }
    }
};
struct EpiSwiGLU {
    static constexpr bool PERM = true, AFTER_DRAIN = false;
    bf16_t* hid; int ldh;
    __device__ __forceinline__ void operator()(const f32x4 (&acc)[2][2][4][2], const Unit& u, int wr, int wc, int fr, int fq) const {
        asm volatile("" : "+v"(fr), "+v"(fq));
        const int hc = u.pn * 128 + wc * 32 + 8 * fq;
#pragma unroll
        for (int ai = 0; ai < 2; ++ai)
#pragma unroll
            for (int m = 0; m < 4; ++m) { bf16_t* p = hid + (size_t)(u.pm * BM + ai * HALF + wr * 64 + m * 16 + fr) * ldh + hc;
                f32x4 v[2];
#pragma unroll
                for (int n = 0; n < 2; ++n) { const f32x4 g = acc[ai][0][m][n], up = acc[ai][1][m][n];
#pragma unroll
                    for (int e = 0; e < 4; ++e) v[n][e] = g[e] * sigm(g[e]) * up[e]; }
                u32x4 w; w.x = cvt_pk_bf16(v[0][0], v[0][1]); w.y = cvt_pk_bf16(v[0][2], v[0][3]); w.z = cvt_pk_bf16(v[1][0], v[1][1]); w.w = cvt_pk_bf16(v[1][2], v[1][3]);
                *(u32x4*)p = w; }
    }
};


struct EpiNone {
    static constexpr bool PERM = false, AFTER_DRAIN = false;
    float* sink;
    __device__ __forceinline__ void operator()(const f32x4 (&acc)[2][2][4][2], const Unit& u, int wr, int wc, int fr, int fq) const {
        asm volatile("" : "+v"(fr), "+v"(fq));
        if (u.pm < 0) {
#pragma unroll
            for (int ai = 0; ai < 2; ++ai)
#pragma unroll
                for (int bj = 0; bj < 2; ++bj)
#pragma unroll
                    for (int m = 0; m < 4; ++m)
#pragma unroll
                        for (int n = 0; n < 2; ++n) *(f32x4*)(sink + ((((ai * 2 + bj) * 4 + m) * 2 + n) * 64 + fr + 16 * fq) * 4) = acc[ai][bj][m][n];
        }
    }
};
template <class Epi, class Sched, bool ALIGN_EPI = false, bool SP2 = false>
__device__ __forceinline__ void gemm_phase(PG8_LAS unsigned char* lds, const Gemm g, const Sched& S, const Epi& E) {
    int tid_ = threadIdx.x; asm volatile("" : "+v"(tid_)); const int tid = tid_, wid = __builtin_amdgcn_readfirstlane(tid >> 6), lane = tid & 63, wr = wid >> 2, wc = wid & 3, fr = lane & 15, fq = lane >> 4;
    const int K = g.K, nt = K / BK;
    unsigned voffA[2], voffB[2];
#pragma unroll
    for (int i = 0; i < 2; ++i) { int R, C; stage_rc(tid * 16 + i * 8192, R, C); const int Rb = Epi::PERM ? ((R & ~31) + perm32(R & 31)) : R;
        voffA[i] = (unsigned)(R * g.lda + C) * 2u; voffB[i] = (unsigned)(Rb * K + C) * 2u; }
    const size_t kstep = (size_t)(BK * 2);
    const size_t hstepB = (size_t)HALF * K * 2, hstepA = (size_t)HALF * g.lda * 2;
    const size_t tstepA = 2 * hstepA, tstepB = 2 * hstepB;
    const unsigned ldsw = (unsigned)wid * 1024u;
    const int aoff = lds_byte(wr * 64 + fr, fq * 8), boff = lds_byte(wc * 32 + fr, fq * 8);
#define PG8_SA(b, h) (((b) * 2 + (h)) * HTB)
#define PG8_SB(b, h) ((4 + (b) * 2 + (h)) * HTB)
#define PG8_STAGE(bufoff, gbase, voff) do { _Pragma("unroll") for (int _i = 0; _i < 2; ++_i) \
        __builtin_amdgcn_global_load_lds((const unsigned*)((const char*)(gbase) + (voff)[_i]), (PG8_LAS unsigned*)(lds + (bufoff) + ldsw + _i * 8192), 16, 0, 0); } while (0)
#define PG8_LDA(dst, b, h) do { _Pragma("unroll") for (int m = 0; m < 4; ++m) _Pragma("unroll") for (int k = 0; k < 2; ++k) dst[m][k] = *(const PG8_LAS bf16x8*)(lds + PG8_SA(b, h) + aoff + m * 2048 + k * 1024); } while (0)
#define PG8_LDB(dst, b, h) do { _Pragma("unroll") for (int n = 0; n < 2; ++n) _Pragma("unroll") for (int k = 0; k < 2; ++k) dst[n][k] = *(const PG8_LAS bf16x8*)(lds + PG8_SB(b, h) + boff + n * 2048 + k * 1024); } while (0)
#define PG8_MMA(ai, bj, At, Bt) do { __builtin_amdgcn_s_setprio(1); _Pragma("unroll") for (int m = 0; m < 4; ++m) _Pragma("unroll") for (int n = 0; n < 2; ++n) _Pragma("unroll") for (int k = 0; k < 2; ++k) \
        acc[ai][bj][m][n] = __builtin_amdgcn_mfma_f32_16x16x32_bf16(Bt[n][k], At[m][k], acc[ai][bj][m][n], 0, 0, 0); __builtin_amdgcn_s_setprio(0); } while (0)
#define PG8_WAIT_V(n) asm volatile("s_waitcnt vmcnt(" #n ")" ::: "memory")
#define PG8_WAIT_L(n) asm volatile("s_waitcnt lgkmcnt(" #n ")" ::: "memory")
#define PG8_BAR __builtin_amdgcn_s_barrier()
#define PG8_SCHED __builtin_amdgcn_sched_barrier(0)
    Unit cur, nxt; int ui = 0;
    if (!S.next(0, cur)) return;
    f32x4 acc[2][2][4][2];
#pragma unroll
    for (int a = 0; a < 2; ++a)
#pragma unroll
        for (int b = 0; b < 2; ++b)
#pragma unroll
            for (int m = 0; m < 4; ++m)
#pragma unroll
                for (int n = 0; n < 2; ++n) acc[a][b][m][n] = (f32x4){0.f, 0.f, 0.f, 0.f};
    bf16x8 At[4][2], B0[2][2], B1[2][2];
    const char* cA = (const char*)g.A + (size_t)cur.pm * tstepA + (g.agrp ? (size_t)(cur.pn / g.agrp) * g.agstride * 2 : 0); const char* cB = (const char*)g.Bt + (size_t)cur.pn * tstepB;
    S.a_ready(cur);
    if constexpr (SP2) {
        PG8_STAGE(PG8_SB(0, 0), cB, voffB); PG8_STAGE(PG8_SB(0, 1), cB + hstepB, voffB); PG8_STAGE(PG8_SA(0, 0), cA, voffA); PG8_STAGE(PG8_SA(0, 1), cA + hstepA, voffA);
        if (wr == 1) PG8_BAR;
        PG8_WAIT_V(2); PG8_BAR;
        PG8_STAGE(PG8_SB(1, 0), cB + kstep, voffB); PG8_STAGE(PG8_SA(1, 0), cA + kstep, voffA); PG8_STAGE(PG8_SB(1, 1), cB + hstepB + kstep, voffB);
        PG8_WAIT_V(6); PG8_BAR;
    } else {
        PG8_STAGE(PG8_SB(0, 0), cB, voffB); PG8_STAGE(PG8_SA(0, 0), cA, voffA); PG8_STAGE(PG8_SB(0, 1), cB + hstepB, voffB); PG8_STAGE(PG8_SA(0, 1), cA + hstepA, voffA);
        if (wr == 1) PG8_BAR;
        PG8_WAIT_V(4); PG8_BAR;
        PG8_STAGE(PG8_SB(1, 0), cB + kstep, voffB); PG8_STAGE(PG8_SA(1, 0), cA + kstep, voffA); PG8_STAGE(PG8_SB(1, 1), cB + hstepB + kstep, voffB);
        PG8_WAIT_V(6); PG8_BAR;
    }
    for (;;) {
        const bool has_next = S.next(ui + 1, nxt);
        const char* nA = has_next ? (const char*)g.A + (size_t)nxt.pm * tstepA + (g.agrp ? (size_t)(nxt.pn / g.agrp) * g.agstride * 2 : 0) : cA; const char* nB = has_next ? (const char*)g.Bt + (size_t)nxt.pn * tstepB : cB;
        for (int t = 0; t < nt; t += 2) {
            const bool last = (t == nt - 2);
            const char* a1 = cA + (size_t)(t + 1) * kstep;
            const char* a2 = last ? nA : cA + (size_t)(t + 2) * kstep; const char* b2 = last ? nB : cB + (size_t)(t + 2) * kstep;
            const char* a3 = a2 + kstep; const char* b3 = b2 + kstep;
            if (last && has_next) S.a_ready(nxt);
            if constexpr (SP2) {
            PG8_LDB(B0, 0, 0); PG8_LDB(B1, 0, 1); PG8_SCHED; PG8_LDA(At, 0, 0); PG8_STAGE(PG8_SA(1, 1), a1 + hstepA, voffA);
            PG8_WAIT_V(8); PG8_WAIT_L(0); PG8_BAR; PG8_MMA(0, 0, At, B0); PG8_MMA(0, 1, At, B1); PG8_BAR; PG8_SCHED;
            PG8_LDA(At, 0, 1); PG8_STAGE(PG8_SB(0, 0), b2, voffB); PG8_STAGE(PG8_SB(0, 1), b2 + hstepB, voffB); PG8_STAGE(PG8_SA(0, 0), a2, voffA);
            PG8_WAIT_V(8); PG8_WAIT_L(0); PG8_BAR; PG8_MMA(1, 0, At, B0); PG8_MMA(1, 1, At, B1); PG8_BAR; PG8_SCHED;
            PG8_LDB(B0, 1, 0); PG8_LDB(B1, 1, 1); PG8_SCHED; PG8_LDA(At, 1, 0); PG8_STAGE(PG8_SA(0, 1), a2 + hstepA, voffA);
            PG8_WAIT_V(8); PG8_WAIT_L(0); PG8_BAR; PG8_MMA(0, 0, At, B0); PG8_MMA(0, 1, At, B1); PG8_BAR; PG8_SCHED;
            PG8_LDA(At, 1, 1); PG8_STAGE(PG8_SB(1, 0), b3, voffB); PG8_STAGE(PG8_SB(1, 1), b3 + hstepB, voffB); PG8_STAGE(PG8_SA(1, 0), a3, voffA);
            PG8_WAIT_V(8); PG8_WAIT_L(0); PG8_BAR; PG8_MMA(1, 0, At, B0); PG8_MMA(1, 1, At, B1); PG8_BAR; PG8_SCHED;
            } else {
            PG8_LDB(B0, 0, 0); PG8_SCHED; PG8_LDA(At, 0, 0); PG8_STAGE(PG8_SA(1, 1), a1 + hstepA, voffA);
            PG8_WAIT_L(8); PG8_BAR; PG8_WAIT_L(0); PG8_MMA(0, 0, At, B0); PG8_BAR; PG8_SCHED;
            PG8_LDB(B1, 0, 1); PG8_STAGE(PG8_SB(0, 0), b2, voffB);
            PG8_BAR; PG8_WAIT_L(0); PG8_MMA(0, 1, At, B1); PG8_BAR;
            PG8_LDA(At, 0, 1); PG8_STAGE(PG8_SA(0, 0), a2, voffA);
            PG8_BAR; PG8_WAIT_L(0); PG8_MMA(1, 0, At, B0); PG8_BAR; PG8_SCHED;
            PG8_STAGE(PG8_SB(0, 1), b2 + hstepB, voffB);
            PG8_WAIT_V(6); PG8_BAR; PG8_MMA(1, 1, At, B1); PG8_BAR;
            PG8_LDB(B0, 1, 0); PG8_SCHED; PG8_LDA(At, 1, 0); PG8_STAGE(PG8_SA(0, 1), a2 + hstepA, voffA);
            PG8_WAIT_L(8); PG8_BAR; PG8_WAIT_L(0); PG8_MMA(0, 0, At, B0); PG8_BAR; PG8_SCHED;
            PG8_LDB(B1, 1, 1); PG8_STAGE(PG8_SB(1, 0), b3, voffB);
            PG8_BAR; PG8_WAIT_L(0); PG8_MMA(0, 1, At, B1); PG8_BAR;
            PG8_LDA(At, 1, 1); PG8_STAGE(PG8_SA(1, 0), a3, voffA);
            PG8_BAR; PG8_WAIT_L(0); PG8_MMA(1, 0, At, B0); PG8_BAR; PG8_SCHED;
            PG8_STAGE(PG8_SB(1, 1), b3 + hstepB, voffB);
            PG8_WAIT_V(6); PG8_BAR; PG8_MMA(1, 1, At, B1); PG8_BAR;
            }
        }
        if constexpr (ALIGN_EPI) { if (wr == 0) PG8_BAR; }
        if constexpr (!Epi::AFTER_DRAIN) { E(acc, cur, wr, wc, fr, fq); S.done(cur); }
        if (!has_next) break;
#pragma unroll
        for (int a = 0; a < 2; ++a)
#pragma unroll
            for (int b = 0; b < 2; ++b)
#pragma unroll
                for (int m = 0; m < 4; ++m)
#pragma unroll
                    for (int n = 0; n < 2; ++n) acc[a][b][m][n] = (f32x4){0.f, 0.f, 0.f, 0.f};
        cur = nxt; cA = nA; cB = nB; ++ui;
        if constexpr (ALIGN_EPI) { if (wr == 1) PG8_BAR; }
    }
    PG8_WAIT_V(0);
    if constexpr (!ALIGN_EPI) { if (wr == 0) PG8_BAR; }
    PG8_BAR;
    if constexpr (Epi::AFTER_DRAIN) { E.fused(acc, cur, wr, wc, fr, fq, lds, wid, lane); S.done(cur); }
#undef PG8_SA
#undef PG8_SB
#undef PG8_STAGE
#undef PG8_LDA
#undef PG8_LDB
#undef PG8_MMA
#undef PG8_WAIT_V
#undef PG8_WAIT_L
#undef PG8_BAR
#undef PG8_SCHED
}
}
#ifndef ATT_SDEPTH
#define ATT_SDEPTH 1
#endif
namespace att {
using bf16 = __hip_bfloat16;
constexpr int NW = 8, QBLK = 32, KVBLK = 64, SDEPTH = ATT_SDEPTH;
constexpr float THR = 8.f;
constexpr size_t SHM_V = KVBLK * 128 * 2, SHM_K = KVBLK * 128 * 2, SHM_ATTN = 2 * SHM_V + 2 * SHM_K + NW * 64 * 4;
using bf16x8 = __attribute__((ext_vector_type(8))) short;
using s16x4  = __attribute__((ext_vector_type(4))) short;
using f32x16 = __attribute__((ext_vector_type(16))) float;
using f32x8  = __attribute__((ext_vector_type(8))) float;
using u32x4  = __attribute__((ext_vector_type(4))) unsigned;
#define KSWZ(row, colB) ((row) * 256 + ((colB) ^ (((row) & 7) << 4)))
#define SBAR() __builtin_amdgcn_sched_barrier(0)
__device__ __forceinline__ int crow(int r, int hi) { return (r & 3) + 8 * (r >> 2) + 4 * hi; }
__device__ __forceinline__ unsigned cvtpk(float lo, float hi) {
  unsigned r; asm volatile("v_cvt_pk_bf16_f32 %0, %1, %2" : "=v"(r) : "v"(lo), "v"(hi)); return r;
}
template <int DQK> __device__ __forceinline__ void partialSM(f32x16& p0, f32x16& p1, float& m_reg, float& mn, float& alpha) {
  constexpr float SCALE = (DQK == 64) ? 0.125f : 0.088388347648318440f; constexpr float C = SCALE * 1.4426950408889634f;
  float pmax = p0[0]; for (int r = 1; r < 16; ++r) pmax = fmaxf(pmax, p0[r]); for (int r = 0; r < 16; ++r) pmax = fmaxf(pmax, p1[r]);
  { auto rr = __builtin_amdgcn_permlane32_swap(__float_as_uint(pmax), __float_as_uint(pmax), false, false);
    pmax = fmaxf(__uint_as_float(rr[0]), __uint_as_float(rr[1])); }
  if (__builtin_expect(__all(pmax - m_reg <= THR / SCALE), 1)) { mn = m_reg; alpha = 1.f; }
  else { mn = fmaxf(m_reg, pmax); alpha = __builtin_amdgcn_exp2f((m_reg - mn) * C); m_reg = mn; }
  float mnC = -mn * C;
  for (int r = 0; r < 16; ++r) p0[r] = fmaf(p0[r], C, mnC); for (int r = 0; r < 16; ++r) p1[r] = fmaf(p1[r], C, mnC);
  for (int r = 0; r < 16; ++r) p0[r] = __builtin_amdgcn_exp2f(p0[r]);
}
__device__ __forceinline__ void finishSM(f32x16& p0, f32x16& p1, float alpha, float& l_reg, bf16x8& pa0, bf16x8& pa1, bf16x8& pa2, bf16x8& pa3) {
  for (int r = 0; r < 16; ++r) p1[r] = __builtin_amdgcn_exp2f(p1[r]);
  float ps = 0; for (int r = 0; r < 16; ++r) ps += p0[r]; for (int r = 0; r < 16; ++r) ps += p1[r];
  { auto rr = __builtin_amdgcn_permlane32_swap(__float_as_uint(ps), __float_as_uint(ps), false, false);
    ps = __uint_as_float(rr[0]) + __uint_as_float(rr[1]); }
  l_reg = l_reg * alpha + ps;
#define PK4(P, BASE, OUT) do { unsigned a0 = cvtpk(P[BASE + 0], P[BASE + 1]), a1 = cvtpk(P[BASE + 2], P[BASE + 3]);   \
    unsigned b0 = cvtpk(P[BASE + 4], P[BASE + 5]), b1 = cvtpk(P[BASE + 6], P[BASE + 7]);                              \
    auto r0 = __builtin_amdgcn_permlane32_swap(a0, b0, false, false); auto r1 = __builtin_amdgcn_permlane32_swap(a1, b1, false, false); \
    u32x4 w = {r0[0], r1[0], r0[1], r1[1]}; OUT = *reinterpret_cast<bf16x8*>(&w); } while (0)
  PK4(p0, 0, pa0); PK4(p0, 8, pa1); PK4(p1, 0, pa2); PK4(p1, 8, pa3);
#undef PK4
}
template <int DQK> __device__ __forceinline__ void qkt(f32x16& p0, f32x16& p1, const bf16* Ks, const bf16x8* qr, int r32, int hi, int kcol0) {
  p0 = f32x16{}; p1 = f32x16{};
#pragma unroll
  for (int d0 = 0; d0 < DQK / 16; ++d0) { int cb = (kcol0 + d0 * 16 + hi * 8) * 2;
    bf16x8 b0 = *reinterpret_cast<const bf16x8*>((const char*)Ks + KSWZ(r32, cb));
    bf16x8 b1 = *reinterpret_cast<const bf16x8*>((const char*)Ks + KSWZ(32 + r32, cb));
    p0 = __builtin_amdgcn_mfma_f32_32x32x16_bf16(b0, qr[d0], p0, 0, 0, 0);
    p1 = __builtin_amdgcn_mfma_f32_32x32x16_bf16(b1, qr[d0], p1, 0, 0, 0); }
}
__device__ __forceinline__ int v_st(int k, int c) { const int kk = (k & ~0xC) | ((k & 4) << 1) | ((k & 8) >> 1); return ((kk >> 3) * 4 + (c >> 5)) * 512 + ((kk & 7) * 32 + (c & 31)) * 2; }
__device__ __forceinline__ int v_rd_base(int lane) { return ((lane & 3) << 3) | (((lane >> 2) & 3) << 6) | (((lane >> 4) & 1) << 5) | (((lane >> 5) & 1) << 8); }
constexpr int v_rd_off(int d0, int ks, int half) { return d0 * 512 + ks * 4096 + half * 2048; }
template <int OFF> __device__ __forceinline__ s16x4 tr_read(int vb) {
  s16x4 r; asm volatile("ds_read_b64_tr_b16 %0, %1 offset:%2" : "=&v"(r) : "v"(vb), "i"(OFF) : "memory"); return r;
}
template <int D0> __device__ __forceinline__ void pv_one(f32x16& od, int vb, bf16x8 pa0, bf16x8 pa1, bf16x8 pa2, bf16x8 pa3) {
  const s16x4 l0 = tr_read<v_rd_off(D0, 0, 0)>(vb), h0 = tr_read<v_rd_off(D0, 0, 1)>(vb), l1 = tr_read<v_rd_off(D0, 1, 0)>(vb), h1 = tr_read<v_rd_off(D0, 1, 1)>(vb);
  const s16x4 l2 = tr_read<v_rd_off(D0, 2, 0)>(vb), h2 = tr_read<v_rd_off(D0, 2, 1)>(vb), l3 = tr_read<v_rd_off(D0, 3, 0)>(vb), h3 = tr_read<v_rd_off(D0, 3, 1)>(vb);
  asm volatile("s_waitcnt lgkmcnt(0)" ::: "memory"); SBAR();
#define PK(L, H) (bf16x8){L[0], L[1], L[2], L[3], H[0], H[1], H[2], H[3]}
  od = __builtin_amdgcn_mfma_f32_32x32x16_bf16(pa0, PK(l0, h0), od, 0, 0, 0);
  od = __builtin_amdgcn_mfma_f32_32x32x16_bf16(pa1, PK(l1, h1), od, 0, 0, 0);
  od = __builtin_amdgcn_mfma_f32_32x32x16_bf16(pa2, PK(l2, h2), od, 0, 0, 0);
  od = __builtin_amdgcn_mfma_f32_32x32x16_bf16(pa3, PK(l3, h3), od, 0, 0, 0);
#undef PK
}
template <int KS> __device__ __forceinline__ void pv_ks(f32x16* o, int vb, bf16x8 pa) {
  const s16x4 l0 = tr_read<v_rd_off(0, KS, 0)>(vb), h0 = tr_read<v_rd_off(0, KS, 1)>(vb), l1 = tr_read<v_rd_off(1, KS, 0)>(vb), h1 = tr_read<v_rd_off(1, KS, 1)>(vb);
  const s16x4 l2 = tr_read<v_rd_off(2, KS, 0)>(vb), h2 = tr_read<v_rd_off(2, KS, 1)>(vb), l3 = tr_read<v_rd_off(3, KS, 0)>(vb), h3 = tr_read<v_rd_off(3, KS, 1)>(vb);
  asm volatile("s_waitcnt lgkmcnt(0)" ::: "memory"); SBAR();
#define PK(L, H) (bf16x8){L[0], L[1], L[2], L[3], H[0], H[1], H[2], H[3]}
  o[0] = __builtin_amdgcn_mfma_f32_32x32x16_bf16(pa, PK(l0, h0), o[0], 0, 0, 0);
  o[1] = __builtin_amdgcn_mfma_f32_32x32x16_bf16(pa, PK(l1, h1), o[1], 0, 0, 0);
  o[2] = __builtin_amdgcn_mfma_f32_32x32x16_bf16(pa, PK(l2, h2), o[2], 0, 0, 0);
  o[3] = __builtin_amdgcn_mfma_f32_32x32x16_bf16(pa, PK(l3, h3), o[3], 0, 0, 0);
#undef PK
}
#define PVR(D0, l0, h0, l1, h1, l2, h2, l3, h3) const s16x4 l0 = tr_read<v_rd_off(D0, 0, 0)>(vb), h0 = tr_read<v_rd_off(D0, 0, 1)>(vb), l1 = tr_read<v_rd_off(D0, 1, 0)>(vb), h1 = tr_read<v_rd_off(D0, 1, 1)>(vb), \
    l2 = tr_read<v_rd_off(D0, 2, 0)>(vb), h2 = tr_read<v_rd_off(D0, 2, 1)>(vb), l3 = tr_read<v_rd_off(D0, 3, 0)>(vb), h3 = tr_read<v_rd_off(D0, 3, 1)>(vb)
#define PK(L, H) (bf16x8){L[0], L[1], L[2], L[3], H[0], H[1], H[2], H[3]}
#define PVM(od, l0, h0, l1, h1, l2, h2, l3, h3) do { od = __builtin_amdgcn_mfma_f32_32x32x16_bf16(pa0, PK(l0, h0), od, 0, 0, 0); od = __builtin_amdgcn_mfma_f32_32x32x16_bf16(pa1, PK(l1, h1), od, 0, 0, 0); \
    od = __builtin_amdgcn_mfma_f32_32x32x16_bf16(pa2, PK(l2, h2), od, 0, 0, 0); od = __builtin_amdgcn_mfma_f32_32x32x16_bf16(pa3, PK(l3, h3), od, 0, 0, 0); } while (0)
__device__ __forceinline__ void pv_d0(f32x16* o, int vb, bf16x8 pa0, bf16x8 pa1, bf16x8 pa2, bf16x8 pa3) {
#ifndef PV_PIPE
  pv_one<0>(o[0], vb, pa0, pa1, pa2, pa3); pv_one<1>(o[1], vb, pa0, pa1, pa2, pa3); pv_one<2>(o[2], vb, pa0, pa1, pa2, pa3); pv_one<3>(o[3], vb, pa0, pa1, pa2, pa3);
#else
  PVR(0, a0, a1, a2, a3, a4, a5, a6, a7);
  PVR(1, b0, b1, b2, b3, b4, b5, b6, b7);
  asm volatile("s_waitcnt lgkmcnt(8)" ::: "memory"); SBAR();
  PVM(o[0], a0, a1, a2, a3, a4, a5, a6, a7); SBAR();
  PVR(2, c0, c1, c2, c3, c4, c5, c6, c7);
  asm volatile("s_waitcnt lgkmcnt(8)" ::: "memory"); SBAR();
  PVM(o[1], b0, b1, b2, b3, b4, b5, b6, b7); SBAR();
  PVR(3, d0, d1, d2, d3, d4, d5, d6, d7);
  asm volatile("s_waitcnt lgkmcnt(8)" ::: "memory"); SBAR();
  PVM(o[2], c0, c1, c2, c3, c4, c5, c6, c7); SBAR();
  asm volatile("s_waitcnt lgkmcnt(0)" ::: "memory"); SBAR();
  PVM(o[3], d0, d1, d2, d3, d4, d5, d6, d7);
#endif
}
#undef PVR
#undef PVM
#undef PK
constexpr int STASH_OFF = 67584;
template <int DQK, int LDO, int MODE = 0>
__device__ __forceinline__ void attn_dense_body(const bf16* __restrict__ Qb, const bf16* __restrict__ Kh, const bf16* __restrict__ Vh,
                                                bf16* __restrict__ Ob, int seq, int kcol0, char* lds, float lam = 0.f, const float* __restrict__ gvec = nullptr, float gmul = 1.f) {
  constexpr int LDQ = PP, LDK = PP;
  constexpr float SCALE = (DQK == 64) ? 0.125f : 0.088388347648318440f;
  int tid = threadIdx.x; asm volatile("" : "+v"(tid)); const int wid = tid >> 6, lane = tid & 63, r32 = lane & 31, hi = lane >> 5;
  if (__builtin_amdgcn_readfirstlane(tid) >= 256) __builtin_amdgcn_s_setprio(1);
  bf16* V_lds = (bf16*)lds; bf16* K_lds = (bf16*)(lds + 2 * SHM_V);
  float* ws = (float*)(lds + 2 * SHM_V + 2 * SHM_K) + wid * 64; float* li_l = ws; float* al_l = ws + 32;
  float m_reg = -1e30f, l_reg = 0; f32x16 o[4] = {}; bf16x8 qr[DQK / 16];
  const bf16* Qw = Qb + (long)(wid * QBLK + r32) * LDQ + hi * 8;
#pragma unroll
  for (int d0 = 0; d0 < DQK / 16; ++d0) qr[d0] = *reinterpret_cast<const bf16x8*>(Qw + d0 * 16);
  const int sr = tid >> 4, sc = (tid & 15) * 8, vst0 = v_st(sr, sc), vst1 = v_st(32 + sr, sc);
  const int vb0 = (int)(uintptr_t)V_lds + v_rd_base(lane);
  struct { bf16x8 vs0, vs1, ks0, ks1; } sr_[SDEPTH];
#define SLOAD(i, k0) do { sr_[i].vs0 = *reinterpret_cast<const bf16x8*>(&Vh[(long)((k0) + sr) * LDK + sc]); sr_[i].vs1 = *reinterpret_cast<const bf16x8*>(&Vh[(long)((k0) + 32 + sr) * LDK + sc]); \
    sr_[i].ks0 = *reinterpret_cast<const bf16x8*>(&Kh[(long)((k0) + sr) * LDK + sc]); sr_[i].ks1 = *reinterpret_cast<const bf16x8*>(&Kh[(long)((k0) + 32 + sr) * LDK + sc]); } while (0)
#define SWRITE(b, i) do { *(bf16x8*)((char*)V_lds + (b) * SHM_V + vst0) = sr_[i].vs0;          \
    *(bf16x8*)((char*)V_lds + (b) * SHM_V + vst1) = sr_[i].vs1; int kc = sc * 2;               \
    *(bf16x8*)((char*)K_lds + (b) * SHM_K + KSWZ(sr, kc)) = sr_[i].ks0;                       \
    *(bf16x8*)((char*)K_lds + (b) * SHM_K + KSWZ(32 + sr, kc)) = sr_[i].ks1; } while (0)
#define SWAIT() do { if constexpr (SDEPTH == 2) asm volatile("s_waitcnt vmcnt(4)" ::: "memory"); else asm volatile("s_waitcnt vmcnt(0)" ::: "memory"); } while (0)
#define RESC(a) do { if (__any((a) < 1.f)) { if (hi == 0) al_l[r32] = (a); asm volatile("s_waitcnt lgkmcnt(0)" ::: "memory"); \
    for (int d = 0; d < 4; ++d) for (int r = 0; r < 16; ++r) o[d][r] *= al_l[crow(r, hi)]; } } while (0)
  f32x16 pA0, pA1, pB0, pB1; float mnA, mnB, alA, alB; bf16x8 pa0, pa1, pa2, pa3; const int NT = seq / KVBLK;
  constexpr int SE = 0, SO = SDEPTH - 1;
  SLOAD(SE, 0); asm volatile("s_waitcnt vmcnt(0)" ::: "memory"); SWRITE(0, SE); __syncthreads();
  qkt<DQK>(pA0, pA1, K_lds, qr, r32, hi, kcol0); partialSM<DQK>(pA0, pA1, m_reg, mnA, alA);
  SLOAD(SO, KVBLK); if constexpr (SDEPTH == 2) { if (2 < NT) SLOAD(SE, 2 * KVBLK); }
  SWAIT(); SWRITE(1, SO); __syncthreads();
  for (int j = 1; j + 1 < NT; j += 2) {
    SBAR(); qkt<DQK>(pB0, pB1, (bf16*)((char*)K_lds + SHM_K), qr, r32, hi, kcol0);
    finishSM(pA0, pA1, alA, l_reg, pa0, pa1, pa2, pa3); SBAR();
    SLOAD(SO, (j + SDEPTH) * KVBLK); SBAR();
    pv_d0(o, vb0, pa0, pa1, pa2, pa3); partialSM<DQK>(pB0, pB1, m_reg, mnB, alB);
    __syncthreads(); SWAIT(); SWRITE(0, SE);
    RESC(alB); __syncthreads();
    SBAR(); qkt<DQK>(pA0, pA1, K_lds, qr, r32, hi, kcol0);
    finishSM(pB0, pB1, alB, l_reg, pa0, pa1, pa2, pa3); SBAR();
    if (SDEPTH == 1 || j + 3 < NT) SLOAD(SE, (j + 1 + SDEPTH) * KVBLK); SBAR();
    pv_d0(o, vb0 + (int)SHM_V, pa0, pa1, pa2, pa3); partialSM<DQK>(pA0, pA1, m_reg, mnA, alA);
    __syncthreads(); SWAIT(); SWRITE(1, SO);
    RESC(alA); __syncthreads();
  }
  SBAR(); qkt<DQK>(pB0, pB1, (bf16*)((char*)K_lds + SHM_K), qr, r32, hi, kcol0);
  finishSM(pA0, pA1, alA, l_reg, pa0, pa1, pa2, pa3); SBAR();
  pv_d0(o, vb0, pa0, pa1, pa2, pa3); partialSM<DQK>(pB0, pB1, m_reg, mnB, alB);
  __syncthreads(); RESC(alB);
  finishSM(pB0, pB1, alB, l_reg, pa0, pa1, pa2, pa3); SBAR();
  pv_d0(o, vb0 + (int)SHM_V, pa0, pa1, pa2, pa3);
  if (hi == 0) li_l[r32] = l_reg; asm volatile("s_waitcnt lgkmcnt(0)" ::: "memory");
  float rli[16];
#pragma unroll
  for (int r = 0; r < 16; ++r) rli[r] = __builtin_amdgcn_rcpf(li_l[crow(r, hi)]);
  if constexpr (MODE == 0) {
  bf16* Ow = Ob + (long)(wid * QBLK) * LDO;
#pragma unroll
  for (int r = 0; r < 16; ++r) { int orow = crow(r, hi);
    for (int d0 = 0; d0 < 4; ++d0) Ow[(long)orow * LDO + d0 * 32 + r32] = __float2bfloat16(o[d0][r] * rli[r]); }
  } else if constexpr (MODE == 1) {
  bf16* st = (bf16*)(lds + STASH_OFF) + (wid * QBLK) * 128;
#pragma unroll
  for (int r = 0; r < 16; ++r) { int orow = crow(r, hi);
    for (int d0 = 0; d0 < 4; ++d0) st[orow * 128 + d0 * 32 + r32] = __float2bfloat16(o[d0][r] * rli[r]); }
  } else {
  const bf16* st = (const bf16*)(lds + STASH_OFF) + (wid * QBLK) * 128;
  float ssq[16];
#pragma unroll
  for (int r = 0; r < 16; ++r) { int orow = crow(r, hi); float s = 0.f;
    for (int d0 = 0; d0 < 4; ++d0) { const float v = __bfloat162float(st[orow * 128 + d0 * 32 + r32]) - lam * (o[d0][r] * rli[r]); o[d0][r] = v; s += v * v; }
    s += __shfl_xor(s, 1); s += __shfl_xor(s, 2); s += __shfl_xor(s, 4); s += __shfl_xor(s, 8); s += __shfl_xor(s, 16);
    ssq[r] = 1.0f / sqrtf(s * (1.f / 128.f) + NORM_EPS); }
  bf16* Ow = Ob + (long)(wid * QBLK) * LDO;
#pragma unroll
  for (int d0 = 0; d0 < 4; ++d0) { const float gm = gvec[d0 * 32 + r32] * gmul;
#pragma unroll
    for (int r = 0; r < 16; ++r) Ow[(long)crow(r, hi) * LDO + d0 * 32 + r32] = __float2bfloat16(o[d0][r] * ssq[r] * gm); }
  }
  __builtin_amdgcn_s_setprio(0);
#undef SLOAD
#undef SWRITE
#undef SWAIT
#undef RESC
}

__device__ __forceinline__ void swa_unit(const bf16* __restrict__ P, bf16* __restrict__ Y, int bb, int kvh, int qblk, bool isctx, const float* __restrict__ sinkl, char* lds) {
  constexpr float SCALE = 0.125f;
  int tid = threadIdx.x; asm volatile("" : "+v"(tid)); const int wid = tid >> 6, lane = tid & 63, r32 = lane & 31, hi = lane >> 5;
  if (__builtin_amdgcn_readfirstlane(tid) >= 256) __builtin_amdgcn_s_setprio(1);
  const int head = kvh * 4 + (wid & 3), half = wid >> 2;
  bf16* V_lds = (bf16*)lds; bf16* K_lds = (bf16*)(lds + 2 * SHM_V);
  float* ws = (float*)(lds + 2 * SHM_V + 2 * SHM_K) + wid * 64; float* li_l = ws; float* al_l = ws + 32;
  const long rowq0 = (long)bb * TPB + (isctx ? 0 : CTX) + qblk * 64 + half * 32;
  const bf16* Qw = P + (rowq0 + r32) * PP + C_SQ + head * 64 + hi * 8;
  bf16x8 qr[4];
#pragma unroll
  for (int d0 = 0; d0 < 4; ++d0) qr[d0] = *reinterpret_cast<const bf16x8*>(Qw + d0 * 16);
  float m_reg = sinkl[head] * (1.f / SCALE), l_reg = 1.f; f32x16 o[2] = {};
  const int sr = tid >> 3, sc = (tid & 7) * 8, vst = v_st(sr, sc);
  const int vb0 = (int)(uintptr_t)V_lds + v_rd_base(lane);
  const int qpos = qblk * 64 + half * 32 + r32;
  int jlo = 0, nband = 0;
  if (!isctx) { const int q0 = qblk * 64; jlo = (q0 >= 128) ? 0 : (128 - q0) / 64; int jhi = (SEQ - 64 - q0 + 128) / 64; if (jhi > 4) jhi = 4; nband = jhi - jlo + 1; }
  const int ntile = 4 + nband;
  const long kbase = (long)bb * TPB;
#define SWA_KROW(tt) ((tt) < 4 ? kbase + (tt) * 64 : kbase + CTX + (qblk * 64 - 128 + ((tt) - 4 + jlo) * 64))
  bf16x8 kreg, vreg;
  { const long kr = SWA_KROW(0); kreg = *reinterpret_cast<const bf16x8*>(P + (kr + sr) * PP + C_SK + kvh * 64 + sc); vreg = *reinterpret_cast<const bf16x8*>(P + (kr + sr) * PP + C_SV + kvh * 64 + sc); }
  __syncthreads();
  for (int t = 0; t < ntile; ++t) {
    const int buf = t & 1; const bool band = (t >= 4); const int kpos0 = qblk * 64 - 128 + (t - 4 + jlo) * 64;
    *(bf16x8*)((char*)K_lds + buf * SHM_K + KSWZ(sr, sc * 2)) = kreg; *(bf16x8*)((char*)V_lds + buf * SHM_V + vst) = vreg;
    if (t + 1 < ntile) { const long kr = SWA_KROW(t + 1); kreg = *reinterpret_cast<const bf16x8*>(P + (kr + sr) * PP + C_SK + kvh * 64 + sc); vreg = *reinterpret_cast<const bf16x8*>(P + (kr + sr) * PP + C_SV + kvh * 64 + sc); }
    __syncthreads();
    f32x16 p0, p1; float mn, alpha; bf16x8 pa0, pa1, pa2, pa3;
    qkt<64>(p0, p1, (const bf16*)((const char*)K_lds + buf * SHM_K), qr, r32, hi, 0);
    if (band) {
#pragma unroll
      for (int r = 0; r < 16; ++r) { const int d0_ = qpos - (kpos0 + crow(r, hi)); if (d0_ > 128 || d0_ < -128) p0[r] = -1e30f; const int d1_ = d0_ - 32; if (d1_ > 128 || d1_ < -128) p1[r] = -1e30f; }
    }
    partialSM<64>(p0, p1, m_reg, mn, alpha);
    if (__any(alpha < 1.f)) { if (hi == 0) al_l[r32] = alpha; asm volatile("s_waitcnt lgkmcnt(0)" ::: "memory");
#pragma unroll
      for (int d = 0; d < 2; ++d)
#pragma unroll
        for (int r = 0; r < 16; ++r) o[d][r] *= al_l[crow(r, hi)]; }
    finishSM(p0, p1, alpha, l_reg, pa0, pa1, pa2, pa3); SBAR();
    pv_one<0>(o[0], vb0 + buf * (int)SHM_V, pa0, pa1, pa2, pa3); pv_one<1>(o[1], vb0 + buf * (int)SHM_V, pa0, pa1, pa2, pa3);
  }
#undef SWA_KROW
  if (hi == 0) li_l[r32] = l_reg; asm volatile("s_waitcnt lgkmcnt(0)" ::: "memory");
  float rli[16];
#pragma unroll
  for (int r = 0; r < 16; ++r) rli[r] = __builtin_amdgcn_rcpf(li_l[crow(r, hi)]);
  bf16* Ow = Y + rowq0 * DM + 1024 + head * 64;
#pragma unroll
  for (int r = 0; r < 16; ++r) { const int orow = crow(r, hi);
#pragma unroll
    for (int d0 = 0; d0 < 2; ++d0) Ow[(long)orow * DM + d0 * 32 + r32] = __float2bfloat16(o[d0][r] * rli[r]); }
  __builtin_amdgcn_s_setprio(0);
  __syncthreads();
}
#undef KSWZ
#undef SBAR
}

#define LAS __attribute__((address_space(3)))
#ifndef PH_MASK
#define PH_MASK 0xFFFFF
#endif
#ifndef MX_MASK
#define MX_MASK 15
#endif
#ifndef P_ALIGN
#define P_ALIGN true
#endif
#ifndef BR_ALIGN
#define BR_ALIGN true
#endif
#ifndef UP_ALIGN
#define UP_ALIGN true
#endif
#ifndef GATE_ALIGN
#define GATE_ALIGN false
#endif
#ifndef RESID_ALIGN
#define RESID_ALIGN false
#endif
#ifndef DBL_MASK
#define DBL_MASK 0
#endif
#ifndef DBL_MX
#define DBL_MX 0
#endif
#ifdef DBL_RESID
#define RESID_LOOP for (int rr_ = 0; rr_ < 2; ++rr_)
#else
#define RESID_LOOP for (int rr_ = 1; rr_ < 2; ++rr_)
#endif
#define REP(bit) for (int rep_ = 0; rep_ < ((DBL_MASK & (bit)) ? 2 : 1); ++rep_)
#define REPX(bit) for (int rep_ = 0; rep_ < ((DBL_MX & (bit)) ? 2 : 1); ++rep_)
typedef __hip_bfloat16 hbf16;
constexpr size_t WS_ZT = 7 * MiB + 256 * 1024;
struct Args { const float* in[21]; float* out; unsigned char* ws; int pad0, pad1; };
struct Frame { int tid, lane, wave, G, vcu, gw, NGW; unsigned char* ws; char* lds; };

#define XB_TMO      128
#define XB_XCNT(j)  (256  + 64 * (j))
#define XB_XSUB(j)  (1280 + 64 * (j))
#define XB_XGEN(j)  (2304 + 64 * (j))
#define XB_TOP      3328
#define XB_TOPGEN   3392
#define XCD_BAR_WORDS 3456
#define XB_SPIN_CAP (1u << 18)

__device__ __forceinline__ unsigned xb_ld(unsigned* p)              { return __hip_atomic_load(p, __ATOMIC_RELAXED, __HIP_MEMORY_SCOPE_AGENT); }
__device__ __forceinline__ unsigned xb_add(unsigned* p, unsigned v) { return __hip_atomic_fetch_add(p, v, __ATOMIC_RELAXED, __HIP_MEMORY_SCOPE_AGENT); }
__device__ __forceinline__ unsigned xb_xcc_id() { return (unsigned)__builtin_amdgcn_s_getreg((3 << 11) | 20) & 0xFu; }
#define XB_SPIN(cond, bar) do { unsigned _sp = 0; while (cond) { __builtin_amdgcn_s_sleep(1); \
    if ((++_sp & 255u) == 0u) { if (xb_ld(&(bar)[XB_TMO])) break; if (_sp > XB_SPIN_CAP) { atomicAdd(&(bar)[XB_TMO], 1u); break; } } } } while (0)

struct XcdBarrier {
    unsigned* bar; unsigned x;
    volatile LAS unsigned* st;
};

__device__ __forceinline__ XcdBarrier xcd_barrier_post(unsigned* bar, volatile LAS unsigned* st) {
    XcdBarrier b; b.bar = bar; b.x = xb_xcc_id(); b.st = st;
    if (threadIdx.x == 0) (void)xb_add(&bar[XB_XCNT(b.x)], 1u);
    return b;
}
__device__ __forceinline__ void xcd_barrier_complete(unsigned* bar, unsigned x, unsigned& nloc, unsigned& nx) {
    const unsigned G = gridDim.x * gridDim.y * gridDim.z;
    unsigned sum, cnt, mine, sp = 0u;
    for (;;) {
        sum = 0u; cnt = 0u; mine = 0u;
#pragma unroll
        for (unsigned j = 0; j < 16; ++j) { const unsigned c = xb_ld(&bar[XB_XCNT(j)]); sum += c; cnt += (c > 0u) ? 1u : 0u; mine = (j == x) ? c : mine; }
        if (sum == G) break;
        __builtin_amdgcn_s_sleep(1);
        if ((++sp & 255u) == 0u) { if (xb_ld(&bar[XB_TMO])) break; if (sp > XB_SPIN_CAP) { atomicAdd(&bar[XB_TMO], 1u); break; } }
    }
    nloc = mine > 0u ? mine : 1u; nx = cnt > 0u ? cnt : 1u;
}

__device__ __forceinline__ void xcd_barrier(const XcdBarrier& b) {
    asm volatile("s_waitcnt vmcnt(0)" ::: "memory");
    __syncthreads();
    if (threadIdx.x == 0) {
        unsigned* bar = b.bar;
        __builtin_amdgcn_s_waitcnt(0);
        unsigned nloc = b.st[0], nx = b.st[1];
        if (nloc == 0u) { xcd_barrier_complete(bar, b.x, nloc, nx); b.st[0] = nloc; b.st[1] = nx; }
        const unsigned old = xb_add(&bar[XB_XSUB(b.x)], 1u);
        const unsigned gen = old / nloc;
        if (old + 1u == (gen + 1u) * nloc) {
            __builtin_amdgcn_fence(__ATOMIC_RELEASE, "agent");
            asm volatile("s_waitcnt vmcnt(0)" ::: "memory");
            const unsigned og = xb_add(&bar[XB_TOP], 1u);
            const unsigned tg = og / nx;
            if (og + 1u == (tg + 1u) * nx) xb_add(&bar[XB_TOPGEN], 1u);
            else XB_SPIN(xb_ld(&bar[XB_TOPGEN]) == tg, bar);
            __builtin_amdgcn_fence(__ATOMIC_ACQUIRE, "agent");
            xb_add(&bar[XB_XGEN(b.x)], 1u);
            asm volatile("s_waitcnt vmcnt(0)" ::: "memory");
        } else {
            XB_SPIN(xb_ld(&bar[XB_XGEN(b.x)]) == gen, bar);
            __builtin_amdgcn_fence(__ATOMIC_ACQUIRE, "agent");
            asm volatile("s_waitcnt vmcnt(0)" ::: "memory");
        }
    }
    __syncthreads();
}

constexpr size_t WS_BAR = 7 * MiB + 512 * 1024;
constexpr int LDS_BARST = LDS_BYTES - 64;
__device__ __forceinline__ Frame make_frame(unsigned char* ws, char* lds) {
    Frame F; int t = threadIdx.x; asm volatile("" : "+v"(t)); F.tid = t; F.lane = t & 63; F.wave = __builtin_amdgcn_readfirstlane(t >> 6); F.G = gridDim.x;
    { const int bx = blockIdx.x; F.vcu = (F.G % 8 == 0) ? (bx % 8) * (F.G / 8) + bx / 8 : bx; }
    F.gw = F.vcu * 8 + F.wave; F.NGW = F.G * 8; F.ws = ws; F.lds = lds; return F;
}
typedef const __attribute__((address_space(4))) Args* CArgsP0;
__device__ __forceinline__ void s0_phase(const Frame& F, CArgsP0 a) {
    float* sv = (float*)F.lds;
    float* modp = (float*)(F.ws + WS_MODP);
    const float* c = a->in[1]; const float* cctx = a->in[3]; const float* adaw = a->in[4];
    for (int i = blockIdx.x * 512 + F.tid; i < 3 * 12288; i += F.G * 512) ((float*)(F.ws + WS_ZT))[i] = 0.f;
    for (int it = blockIdx.x; it < 793; it += F.G) {
        if (it < 768) {
            const int l = it / 384, r = it % 384, ks = r / 24, ch = r % 24;
            __syncthreads();
            if (F.tid < 384) { const int w = F.tid >> 7, dd = F.tid & 127, d = ks * 128 + dd; const float cv = (w < 2) ? c[w * DM + d] : cctx[d]; sv[F.tid] = cv / (1.f + expf(-cv)); }
            __syncthreads();
            const int j = ch * 512 + F.tid;
            const float* W = adaw + (size_t)l * DM * 12288 + (size_t)(ks * 128) * 12288 + j;
            float a0 = 0.f, a1 = 0.f, a2 = 0.f;
#pragma unroll 8
            for (int dd = 0; dd < 128; ++dd) { const float wv = W[(size_t)dd * 12288]; a0 += sv[dd] * wv; a1 += sv[128 + dd] * wv; a2 += sv[256 + dd] * wv; }
            float* o = modp + (size_t)((l * 16 + ks) * 3) * 12288 + j;
            o[0] = a0; o[12288] = a1; o[2 * 12288] = a2;
        } else if (it < 792) {
            const int idx = (it - 768) * 512 + F.tid;
            float* tab = (float*)(F.ws + WS_ROPE);
            int pos, f, nf; float* cdst; float* sdst;
            if (idx < 4096) { pos = idx >> 4; f = idx & 15; nf = 16; cdst = tab + idx; sdst = tab + 4096 + idx; }
            else { const int i2 = idx - 4096; pos = i2 >> 5; f = i2 & 31; nf = 32; cdst = tab + 8192 + i2; sdst = tab + 16384 + i2; }
            const float inv = exp2f(-(float)f / (float)nf * 13.287712379549449f);
            const float ang = (float)pos * inv;
            double rev = (double)ang * 0.15915494309189535; rev -= floor(rev);
            const float fr = (float)rev;
            *cdst = __builtin_amdgcn_cosf(fr); *sdst = __builtin_amdgcn_sinf(fr);
        } else {
            const int l = F.wave >> 2, h = F.wave & 3; const float* lp = a->in[10] + (size_t)l * 4 * 4 * 64;
            float pa = lp[(0 * 4 + h) * 64 + F.lane] * lp[(1 * 4 + h) * 64 + F.lane], pb = lp[(2 * 4 + h) * 64 + F.lane] * lp[(3 * 4 + h) * 64 + F.lane];
            pa = wave_sum(pa); pb = wave_sum(pb);
            const float lam_init = (l == 0) ? 0.2f : 0.35550906759f;
            if (F.lane == 0) ((float*)(F.ws + WS_LAM))[l * 4 + h] = expf(pa) - expf(pb) + lam_init;
        }
    }
}

__device__ __forceinline__ int map_win(int j) { return j < NMIX ? j : -1; }
__device__ __forceinline__ int map_gate(int R) { const int pn = R >> 8, c = R & 255; const int i = 2 * (c >> 7) + ((c & 31) >> 4), oc = 64 * pn + 16 * ((c & 127) >> 5) + (c & 15); return NMIX + i * DM + oc; }
__device__ __forceinline__ int map_up(int R) { const int pn = R >> 8, c = R & 255; return (c >> 7) * FF + 128 * pn + (c & 127); }
template <int MAP> __device__ __forceinline__ void transpose_item(const float* __restrict__ W, int Nsrc, int K, bf16raw* __restrict__ WT, int kb, int nb, float* scr, int lane) {
    const int k0 = 64 * kb, n0 = 32 * nb; const int jr = n0 + (lane & 31);
    const int col = (MAP == 0) ? jr : (MAP == 1) ? map_win(jr) : (MAP == 2) ? map_gate(jr) : map_up(jr);
#pragma unroll 8
    for (int i = 0; i < 32; ++i) { const int kk = 2 * i + (lane >> 5); scr[kk * 33 + (lane & 31)] = (col >= 0) ? W[(size_t)(k0 + kk) * Nsrc + col] : 0.f; }
    asm volatile("s_waitcnt lgkmcnt(0)" ::: "memory");
    const int cch = lane & 7;
#pragma unroll
    for (int j = 0; j < 4; ++j) { const int n = (lane >> 3) + 8 * j; const float* s = scr + (8 * cch) * 33 + n;
        u32x4_t o; o.x = pk2(s[0 * 33], s[1 * 33]); o.y = pk2(s[2 * 33], s[3 * 33]); o.z = pk2(s[4 * 33], s[5 * 33]); o.w = pk2(s[6 * 33], s[7 * 33]);
        *(u32x4_t*)(WT + (size_t)(n0 + n) * K + k0 + 8 * cch) = o; }
    asm volatile("s_waitcnt lgkmcnt(0)" ::: "memory");
}
__device__ __forceinline__ void s1_phase(const Frame& F, CArgsP0 a, int l) {
    if (l == 0) {
        const float* modp = (const float*)(F.ws + WS_MODP); float* mod = (float*)(F.ws + WS_MOD); const float* adab = a->in[5];
        for (int idx = blockIdx.x * 512 + F.tid; idx < 2 * 3 * 12288; idx += F.G * 512) {
            const int l2 = idx / (3 * 12288), rem = idx - l2 * 3 * 12288, w = rem / 12288, j = rem - w * 12288;
            float s = adab[l2 * 12288 + j];
#pragma unroll
            for (int ks = 0; ks < 16; ++ks) s += modp[(size_t)((l2 * 16 + ks) * 3 + w) * 12288 + j];
            mod[idx] = s;
        }
    }
    float* scr = (float*)F.lds + F.wave * (64 * 33);
    const float* w_in = a->in[7] + (size_t)l * DM * DIN; const float* w_br = a->in[15] + (size_t)l * 4 * 512 * DM; const float* w_out = a->in[16] + (size_t)l * DM * DM;
    const float* w_up = a->in[18] + (size_t)l * DM * 2 * FF; const float* w_dn = a->in[19] + (size_t)l * FF * DM;
    constexpr int I_IN = 32 * (PP / 32), I_G = 32 * (8192 / 32), I_B = 4 * 8 * 64, I_O = 32 * 64, I_U = 32 * (2 * FF / 32), I_D = (FF / 64) * 64;
    constexpr int NITEMS = I_IN + I_G + I_B + I_O + I_U + I_D;
    for (int it = F.gw; it < NITEMS; it += F.NGW) {
        int r = it;
        if (r < I_IN) { const int nblk = PP / 32; transpose_item<1>(w_in, DIN, DM, (bf16raw*)(F.ws + WS_WIN), r / nblk, r % nblk, scr, F.lane); continue; } r -= I_IN;
        if (r < I_G) { const int nblk = 8192 / 32; transpose_item<2>(w_in, DIN, DM, (bf16raw*)(F.ws + WS_WG), r / nblk, r % nblk, scr, F.lane); continue; } r -= I_G;
        if (r < I_B) { const int i = r / 512, rr = r % 512; transpose_item<0>(w_br + (size_t)i * 512 * DM, DM, 512, (bf16raw*)(F.ws + WS_WB) + (size_t)i * DM * 512, rr / 64, rr % 64, scr, F.lane); continue; } r -= I_B;
        if (r < I_O) { transpose_item<0>(w_out, DM, DM, (bf16raw*)(F.ws + WS_WOUT), r / 64, r % 64, scr, F.lane); continue; } r -= I_O;
        if (r < I_U) { const int nblk = 2 * FF / 32; transpose_item<3>(w_up, 2 * FF, DM, (bf16raw*)(F.ws + WS_WUP), r / nblk, r % nblk, scr, F.lane); continue; } r -= I_U;
        transpose_item<0>(w_dn, DM, FF, (bf16raw*)(F.ws + WS_WDN), r / 64, r % 64, scr, F.lane);
    }
}

__device__ __forceinline__ void norm_mod_phase(const Frame& F, const XPtr xin, const bf16raw* delta, const XOut xout, const float* __restrict__ gam, const float* __restrict__ modl, int shi, int sci, bf16raw* out) {
    constexpr int RPW = 17;
    int curw = -1; f32x4_t ca[8], cb[8];
    const int rbeg = F.gw * RPW, rend = (rbeg + RPW < MROWS) ? rbeg + RPW : MROWS;
    for (int r = rbeg; r < rend; ++r) {
        const int b = r / TPB, t = r - b * TPB, w = (t < CTX) ? 2 : b;
        if (w != curw) { curw = w;
#pragma unroll
            for (int j = 0; j < 8; ++j) { const int col = 4 * F.lane + 256 * j; const f32x4_t g = *(const f32x4_t*)(gam + col), sc = *(const f32x4_t*)(modl + (size_t)w * 12288 + sci * 2048 + col);
                ca[j] = g * (sc + 1.0f); cb[j] = *(const f32x4_t*)(modl + (size_t)w * 12288 + shi * 2048 + col); } }
        const f32x4_t* xr = (const f32x4_t*)xin.row(r) + F.lane;
        f32x4_t v[8]; float s = 0.f;
#pragma unroll
        for (int j = 0; j < 8; ++j) v[j] = xr[64 * j];
        if (delta) { const u32x2_t* dr = (const u32x2_t*)(delta + (size_t)r * DM) + F.lane; u32x2_t dv[8];
#pragma unroll
            for (int j = 0; j < 8; ++j) dv[j] = dr[64 * j];
            f32x4_t* xw = (f32x4_t*)xout.row(r) + F.lane;
#pragma unroll
            for (int j = 0; j < 8; ++j) { v[j].x += bflo(dv[j].x); v[j].y += bfhi(dv[j].x); v[j].z += bflo(dv[j].y); v[j].w += bfhi(dv[j].y); xw[64 * j] = v[j]; } }
#pragma unroll
        for (int j = 0; j < 8; ++j) s += (v[j].x * v[j].x + v[j].y * v[j].y) + (v[j].z * v[j].z + v[j].w * v[j].w);
        const float rstd = 1.0f / sqrtf(wave_sum(s) * (1.f / DM) + NORM_EPS);
        u32x2_t* o8 = (u32x2_t*)(out + (size_t)r * DM) + F.lane;
#pragma unroll
        for (int j = 0; j < 8; ++j) { const f32x4_t y = v[j] * rstd * ca[j] + cb[j]; u32x2_t w2; w2.x = pk2(y.x, y.y); w2.y = pk2(y.z, y.w); o8[64 * j] = w2; }
    }
}
__device__ __forceinline__ void final_norm_phase(const Frame& F, float* x, const bf16raw* __restrict__ delta, const float* __restrict__ gam) {
    for (int r = F.gw; r < NBATCH * SEQ; r += F.NGW) {
        f32x4_t* xr = (f32x4_t*)(x + (size_t)r * DM) + F.lane; f32x4_t v[8]; float s = 0.f;
        const int b = r / SEQ, ur = b * TPB + CTX + (r - b * SEQ);
        const u32x2_t* dr = (const u32x2_t*)(delta + (size_t)ur * DM) + F.lane;
#pragma unroll
        for (int j = 0; j < 8; ++j) { v[j] = xr[64 * j]; const u32x2_t d = dr[64 * j]; v[j].x += bflo(d.x); v[j].y += bfhi(d.x); v[j].z += bflo(d.y); v[j].w += bfhi(d.y);
            s += (v[j].x * v[j].x + v[j].y * v[j].y) + (v[j].z * v[j].z + v[j].w * v[j].w); }
        const float rstd = 1.0f / sqrtf(wave_sum(s) * (1.f / DM) + NORM_EPS);
#pragma unroll
        for (int j = 0; j < 8; ++j) xr[64 * j] = v[j] * rstd * *(const f32x4_t*)(gam + 4 * F.lane + 256 * j);
    }
}

__device__ __forceinline__ void rope_decode(int vp, int& x1c, int& x2c, int& f0, int& axis, int& hcol, bool& d128, bool& isq) {
    x1c = 0; x2c = 0; f0 = 0; axis = 0; hcol = 0; d128 = false; isq = true;
    if (vp < 48) { d128 = true; isq = vp < 32; const int v2 = isq ? vp : vp - 32; const int head = v2 >> 3, i = v2 & 7; axis = i >> 2; const int j = i & 3; f0 = 8 * j;
        const int base = (isq ? C_GQ : C_GK) + head * 128 + axis * 64; x1c = base + 8 * j; x2c = x1c + 32; hcol = axis * 64 + 8 * j; }
    else if (vp < 152) { const int v3 = vp - 48, seg = v3 >> 5, w = v3 & 31, head = w >> 2, i = w & 3; axis = i >> 1; const int j = i & 1; f0 = 8 * j;
        const int sb = (seg == 0) ? C_DQ : (seg == 1) ? C_DK : (seg == 2) ? C_SQ : C_SK; const int base = sb + head * 64 + axis * 32; x1c = base + 8 * j; x2c = x1c + 16; }
}
__device__ __forceinline__ void rope_phase(const Frame& F, bf16raw* P, const float* __restrict__ qg, const float* __restrict__ kg) {
    const float* tab = (const float*)(F.ws + WS_ROPE);
    int x1c[3], x2c[3], f0[3], axis[3], hcol[3]; bool d128[3], isq[3], act[3];
#pragma unroll
    for (int pass = 0; pass < 3; ++pass) { const int vp = pass * 64 + F.lane; act[pass] = vp < 152; rope_decode(vp, x1c[pass], x2c[pass], f0[pass], axis[pass], hcol[pass], d128[pass], isq[pass]); }
    for (int r = F.gw; r < MROWS; r += F.NGW) {
        const int b = r / TPB, t = r - b * TPB; const bool latent = t >= CTX; const int pos = t - CTX, prow = pos >> 6, pcol = pos & 63;
        bf16raw* Pr = P + (size_t)r * PP;
        u32x4_t w1[3], w2[3];
#pragma unroll
        for (int pass = 0; pass < 3; ++pass) { const bool ld = act[pass] && (d128[pass] || latent);
            if (ld) { w1[pass] = *(const u32x4_t*)(Pr + x1c[pass]); w2[pass] = *(const u32x4_t*)(Pr + x2c[pass]); } else { w1[pass] = (u32x4_t){0u, 0u, 0u, 0u}; w2[pass] = w1[pass]; } }
#pragma unroll
        for (int pass = 0; pass < 3; ++pass) {
            float x1[8], x2[8]; unpack8(w1[pass], x1); unpack8(w2[pass], x2);
            if (pass == 0) {
                float ss = 0.f;
#pragma unroll
                for (int e = 0; e < 8; ++e) ss += x1[e] * x1[e] + x2[e] * x2[e];
                ss += __shfl_xor(ss, 1); ss += __shfl_xor(ss, 2); ss += __shfl_xor(ss, 4);
                if (d128[0]) { const float rstd = 1.0f / sqrtf(ss * (1.f / 128.f) + NORM_EPS); const float* gn = isq[0] ? qg : kg;
#pragma unroll
                    for (int e = 0; e < 8; ++e) { x1[e] = x1[e] * rstd * gn[hcol[0] + e]; x2[e] = x2[e] * rstd * gn[hcol[0] + 32 + e]; } }
            }
            if (act[pass] && latent) {
                const int p = axis[pass] ? pcol : prow;
                const float* ct = d128[pass] ? tab + 8192 + p * 32 + f0[pass] : tab + p * 16 + f0[pass]; const float* st = d128[pass] ? tab + 16384 + p * 32 + f0[pass] : tab + 4096 + p * 16 + f0[pass];
#pragma unroll
                for (int e = 0; e < 8; ++e) { const float cc = ct[e], sn = st[e], a1 = x1[e], a2 = x2[e]; x1[e] = a1 * cc - a2 * sn; x2[e] = a2 * cc + a1 * sn; }
            }
            if (act[pass] && (d128[pass] || latent)) { *(u32x4_t*)(Pr + x1c[pass]) = pack8(x1); *(u32x4_t*)(Pr + x2c[pass]) = pack8(x2); }
        }
    }
}

__device__ __forceinline__ int tbmap(int dir, int j) { return dir == 0 ? j : (j == 0 ? 1 : (j == 1 ? 0 : 131 - j)); }
__device__ __forceinline__ float log_sigmoid_f(float x) { return fminf(x, 0.f) - log1pf(expf(-fabsf(x))); }
__device__ __forceinline__ void gate_scan(const bf16raw* __restrict__ P, const float* __restrict__ gb, int r0, int head, int dir, int lane, float (&ig)[2], float (&bc)[2], float& blast) {
    float lf[2];
#pragma unroll
    for (int k = 0; k < 2; ++k) { const int s = 2 * lane + k, tok = dir ? 127 - s : s; const bf16raw* pr = P + (size_t)(r0 + tok) * PP + C_MG;
        ig[k] = bf1(pr[(2 * dir) * 4 + head]) + gb[(2 * dir) * 4 + head]; lf[k] = log_sigmoid_f(bf1(pr[(2 * dir + 1) * 4 + head]) + gb[(2 * dir + 1) * 4 + head]); }
    const float c1 = lf[0] + lf[1]; float v = c1;
#pragma unroll
    for (int o = 1; o < 64; o <<= 1) { const float tt = __shfl_up(v, o); if (lane >= o) v += tt; }
    const float excl = v - c1; bc[0] = excl + lf[0]; bc[1] = excl + c1; blast = __shfl(v, 63);
}
__device__ __forceinline__ void mlstm_a_phase(const Frame& F, const bf16raw* __restrict__ P, const float* __restrict__ gb) {
    float* ks = (float*)F.lds;
    float* vs = ks + 128 * 64;
    float* wts = vs + 128 * 128;
    float* CST = (float*)(F.ws + WS_CST); float* NST = (float*)(F.ws + WS_NST); float* MSC = (float*)(F.ws + WS_MSC);
    for (int u = blockIdx.x; u < 16 * NCHUNK; u += F.G) {
        const int chain = u / NCHUNK, tb = u - chain * NCHUNK, bb = chain >> 3, head = (chain >> 1) & 3, dir = chain & 1;
        const int r0 = bb * TPB + tb * 128;
        __syncthreads();
        if (F.wave == 0) {
            float ig[2], bc[2], bl; gate_scan(P, gb, r0, head, dir, F.lane, ig, bc, bl);
            const float lw0 = bl - bc[0] + ig[0], lw1 = bl - bc[1] + ig[1]; const float ml = wave_max(fmaxf(lw0, lw1));
            const int s0 = 2 * F.lane; wts[dir ? 127 - s0 : s0] = expf(lw0 - ml); wts[dir ? 126 - s0 : s0 + 1] = expf(lw1 - ml);
            if (F.lane == 0) { MSC[chain * NCHUNK + tb] = bl; MSC[16 * NCHUNK + chain * NCHUNK + tb] = ml; }
        }
        __syncthreads();
#pragma unroll
        for (int i = 0; i < 2; ++i) { const int vi = F.tid + 512 * i, tok = vi >> 3, c8 = (vi & 7) * 8; float f[8]; unpack8(*(const u32x4_t*)(P + (size_t)(r0 + tok) * PP + C_MK + head * 64 + c8), f);
            const float w = wts[tok] * 0.125f;
#pragma unroll
            for (int e = 0; e < 8; ++e) ks[tok * 64 + c8 + e] = f[e] * w; }
#pragma unroll
        for (int i = 0; i < 4; ++i) { const int vi = F.tid + 512 * i, tok = vi >> 4, c8 = (vi & 15) * 8; float f[8]; unpack8(*(const u32x4_t*)(P + (size_t)(r0 + tok) * PP + C_MV + head * 128 + c8), f);
#pragma unroll
            for (int e = 0; e < 8; ++e) vs[tok * 128 + c8 + e] = f[e]; }
        __syncthreads();
        const int vg = F.tid & 31, dg = F.tid >> 5;
        f32x4_t acc[4];
#pragma unroll
        for (int i = 0; i < 4; ++i) acc[i] = (f32x4_t){0.f, 0.f, 0.f, 0.f};
#pragma unroll 4
        for (int tok = 0; tok < 128; ++tok) { const f32x4_t vv = *(const f32x4_t*)(vs + tok * 128 + 4 * vg), kv = *(const f32x4_t*)(ks + tok * 64 + 4 * dg);
            acc[0] += kv * vv.x; acc[1] += kv * vv.y; acc[2] += kv * vv.z; acc[3] += kv * vv.w; }
        float* Co = CST + (size_t)(chain * NCHUNK + tb) * 8192;
#pragma unroll
        for (int i = 0; i < 4; ++i) *(f32x4_t*)(Co + (4 * vg + i) * 64 + 4 * dg) = acc[i];
        if (F.tid < 64) { float s = 0.f;
#pragma unroll 8
            for (int tok = 0; tok < 128; ++tok) s += ks[tok * 64 + F.tid];
            NST[(size_t)(chain * NCHUNK + tb) * 64 + F.tid] = s; }
    }
}
__device__ __forceinline__ void mlstm_b_phase(const Frame& F) {
    float* CST = (float*)(F.ws + WS_CST); float* NST = (float*)(F.ws + WS_NST); float* MSC = (float*)(F.ws + WS_MSC);
    const float* BL = MSC; const float* ML = MSC + 16 * NCHUNK; float* MS = MSC + 32 * NCHUNK;
    for (int e = blockIdx.x * 512 + F.tid; e < 16 * 8192; e += F.G * 512) {
        const int chain = e >> 13, idx = e & 8191, dir = chain & 1; const bool hn = idx < 64;
        float C = 0.f, nv = 0.f, m = 0.f;
        for (int j0 = 0; j0 < NCHUNK; j0 += 10) {
            float cl[10], nl[10], bl[10], ml[10];
#pragma unroll
            for (int i = 0; i < 10; ++i) { const int tb = tbmap(dir, j0 + i), ci = chain * NCHUNK + tb; cl[i] = CST[(size_t)ci * 8192 + idx]; nl[i] = hn ? NST[(size_t)ci * 64 + idx] : 0.f; bl[i] = BL[ci]; ml[i] = ML[ci]; }
#pragma unroll
            for (int i = 0; i < 10; ++i) { const int tb = tbmap(dir, j0 + i), ci = chain * NCHUNK + tb;
                CST[(size_t)ci * 8192 + idx] = C; if (hn) NST[(size_t)ci * 64 + idx] = nv; if (idx == 0) MS[ci] = m;
                const float mnew = fmaxf(bl[i] + m, ml[i]); const float dec = expf(bl[i] + m - mnew), wg = expf(ml[i] - mnew);
                C = dec * C + wg * cl[i]; nv = dec * nv + wg * nl[i]; m = mnew; }
        }
    }
}
__device__ __forceinline__ void mlstm_c_unit(const Frame& F, const bf16raw* __restrict__ P, const float* __restrict__ gb, const float* __restrict__ ng, bf16raw* __restrict__ Y, int bb, int head, int tb) {
    constexpr int KP = 72, SP = 132;
    bf16raw* qs = (bf16raw*)F.lds;
    bf16raw* kc = qs + 128 * 64;
    bf16raw* vs = kc + 128 * KP;
    float* Ss = (float*)(vs + 128 * 128);
    float* sm = Ss + 128 * SP;
    float* a_tok = sm, *M_tok = sm + 128, *bc_tok = sm + 256, *nst = sm + 384, *misc = sm + 448;
    const float* CST = (const float*)(F.ws + WS_CST); const float* NST = (const float*)(F.ws + WS_NST); const float* MS = (const float*)(F.ws + WS_MSC) + 32 * NCHUNK;
    const int r0 = bb * TPB + tb * 128;
    int tidl = F.tid; asm volatile("" : "+v"(tidl));
    const int vg = tidl & 15, tg = tidl >> 4;
    float hsum[4][8];
#pragma unroll
    for (int a = 0; a < 4; ++a)
#pragma unroll
        for (int e = 0; e < 8; ++e) hsum[a][e] = 0.f;
    for (int dir = 0; dir < 2; ++dir) {
        const int chain = bb * 8 + head * 2 + dir, ci = chain * NCHUNK + tb;
        __syncthreads();
        int tA = F.tid; asm volatile("" : "+v"(tA));
#pragma unroll
        for (int i = 0; i < 2; ++i) { const int vi = tA + 512 * i, tok = vi >> 3, c8 = (vi & 7) * 8; const bf16raw* pr = P + (size_t)(r0 + tok) * PP + head * 64 + c8;
            *(u32x4_t*)(qs + tok * 64 + c8) = *(const u32x4_t*)(pr + C_MQ); *(u32x4_t*)(kc + tok * KP + c8) = *(const u32x4_t*)(pr + C_MK); }
#pragma unroll
        for (int i = 0; i < 4; ++i) { const int vi = tA + 512 * i, tok = vi >> 4, c8 = (vi & 15) * 8; *(u32x4_t*)(vs + tok * 128 + c8) = *(const u32x4_t*)(P + (size_t)(r0 + tok) * PP + C_MV + head * 128 + c8); }
        const float m_prev = MS[ci];
        if (F.wave == 0) {
            float ig[2], bc[2], bl; gate_scan(P, gb, r0, head, dir, F.lane, ig, bc, bl);
            const float a0 = ig[0] - bc[0], a1 = ig[1] - bc[1];
            const float pm = fmaxf(a0, a1); float v = pm;
#pragma unroll
            for (int o = 1; o < 64; o <<= 1) { const float tt = __shfl_up(v, o); if (F.lane >= o) v = fmaxf(v, tt); }
            float ex = __shfl_up(v, 1); if (F.lane == 0) ex = -3.0e38f;
            const float M0 = fmaxf(m_prev, fmaxf(ex, a0)), M1 = fmaxf(m_prev, fmaxf(ex, pm));
            const int s0 = 2 * F.lane, t0 = dir ? 127 - s0 : s0, t1 = dir ? 126 - s0 : s0 + 1;
            a_tok[t0] = a0; a_tok[t1] = a1; M_tok[t0] = M0; M_tok[t1] = M1; bc_tok[t0] = bc[0]; bc_tok[t1] = bc[1];
        } else if (F.wave == 1) { nst[F.lane] = NST[(size_t)ci * 64 + F.lane]; }
        __syncthreads();
        {
            float sacc[4][8];
#pragma unroll
            for (int a = 0; a < 4; ++a)
#pragma unroll
                for (int i = 0; i < 8; ++i) sacc[a][i] = 0.f;
#pragma unroll 1
            for (int d0 = 0; d0 < 64; d0 += 8) {
                float qf[4][8];
#pragma unroll
                for (int a = 0; a < 4; ++a) unpack8(*(const u32x4_t*)(qs + (4 * tg + a) * 64 + d0), qf[a]);
#pragma unroll
                for (int i = 0; i < 8; ++i) { float kf[8]; unpack8(*(const u32x4_t*)(kc + (vg + 16 * i) * KP + d0), kf);
#pragma unroll
                    for (int a = 0; a < 4; ++a)
#pragma unroll
                        for (int e = 0; e < 8; ++e) sacc[a][i] += qf[a][e] * kf[e]; }
            }
#pragma unroll
            for (int a = 0; a < 4; ++a) { const int t = 4 * tg + a; const float Mt = M_tok[t];
#pragma unroll
                for (int i = 0; i < 8; ++i) { const int s = vg + 16 * i; const bool ok = dir ? (s >= t) : (s <= t);
                    Ss[t * SP + s] = ok ? sacc[a][i] * 0.125f * expf(a_tok[s] - Mt) : 0.f; } }
        }
        __syncthreads();
        {
            const float* Cg = CST + (size_t)ci * 8192;
#pragma unroll
            for (int i = 0; i < 4; ++i) { const int vi = tA + 512 * i, vrow = vi >> 4, c4 = (vi & 15) * 4; const f32x4_t cv = *(const f32x4_t*)(Cg + vrow * 64 + c4);
                u32x2_t w; w.x = pk2(cv.x, cv.y); w.y = pk2(cv.z, cv.w); *(u32x2_t*)(kc + vrow * KP + c4) = w; }
        }
        float num[4][8], rs[4];
#pragma unroll
        for (int a = 0; a < 4; ++a) { rs[a] = 0.f;
#pragma unroll
            for (int e = 0; e < 8; ++e) num[a][e] = 0.f; }
        {
            const int wv16 = 16 * F.wave;
            const int sbeg = dir ? wv16 : 0, send = dir ? 128 : wv16 + 16;
#pragma unroll 1
            for (int s0 = sbeg; s0 < send; s0 += 4) {
                f32x4_t S4[4];
#pragma unroll
                for (int a = 0; a < 4; ++a) S4[a] = *(const f32x4_t*)(Ss + (4 * tg + a) * SP + s0);
#pragma unroll
                for (int ss = 0; ss < 4; ++ss) { float vf[8]; unpack8(*(const u32x4_t*)(vs + (s0 + ss) * 128 + 8 * vg), vf);
#pragma unroll
                    for (int a = 0; a < 4; ++a) { const float sv = S4[a][ss]; rs[a] += sv;
#pragma unroll
                        for (int e = 0; e < 8; ++e) num[a][e] += sv * vf[e]; } }
            }
        }
        __syncthreads();
        {
            float qc[4][8], nq[4];
#pragma unroll
            for (int a = 0; a < 4; ++a) { nq[a] = 0.f;
#pragma unroll
                for (int e = 0; e < 8; ++e) qc[a][e] = 0.f; }
#pragma unroll 1
            for (int d0 = 0; d0 < 64; d0 += 8) {
                float qf[4][8];
#pragma unroll
                for (int a = 0; a < 4; ++a) { unpack8(*(const u32x4_t*)(qs + (4 * tg + a) * 64 + d0), qf[a]);
#pragma unroll
                    for (int e = 0; e < 8; ++e) nq[a] += nst[d0 + e] * qf[a][e]; }
#pragma unroll
                for (int e = 0; e < 8; ++e) { float cf[8]; unpack8(*(const u32x4_t*)(kc + (8 * vg + e) * KP + d0), cf);
#pragma unroll
                    for (int a = 0; a < 4; ++a)
#pragma unroll
                        for (int k = 0; k < 8; ++k) qc[a][e] += cf[k] * qf[a][k]; }
            }
#pragma unroll
            for (int a = 0; a < 4; ++a) { const int t = 4 * tg + a; const float Mt = M_tok[t], winter = expf(m_prev - Mt);
                const float den = winter * nq[a] + rs[a]; const float dn = fmaxf(fabsf(den), expf(-(bc_tok[t] + Mt))); const float inv = 1.0f / dn;
#pragma unroll
                for (int e = 0; e < 8; ++e) hsum[a][e] += (winter * qc[a][e] + num[a][e]) * inv; }
        }
    }
    float gmm[8];
#pragma unroll
    for (int e = 0; e < 8; ++e) gmm[e] = ng[head * 128 + 8 * vg + e];
#pragma unroll
    for (int a = 0; a < 4; ++a) { float ss = 0.f;
#pragma unroll
        for (int e = 0; e < 8; ++e) ss += hsum[a][e] * hsum[a][e];
        ss += __shfl_xor(ss, 1); ss += __shfl_xor(ss, 2); ss += __shfl_xor(ss, 4); ss += __shfl_xor(ss, 8);
        const float rstd = 1.0f / sqrtf(ss * (1.f / 128.f) + NORM_EPS);
        const int row = r0 + 4 * tg + a; float of[8]; unpack8(*(const u32x4_t*)(P + (size_t)row * PP + C_MO + head * 128 + 8 * vg), of);
        float yv[8];
#pragma unroll
        for (int e = 0; e < 8; ++e) yv[e] = hsum[a][e] * rstd * gmm[e] * sigmoid_f(of[e]);
        *(u32x4_t*)(Y + (size_t)row * DM + head * 128 + 8 * vg) = pack8(yv); }
    (void)misc;
}

#define KSWZ64(row, colB) ((row) * 128 + ((colB) ^ (((row) & 7) << 4)))
__device__ __forceinline__ void mlstm_c_unit_mfma(const Frame& F, const bf16raw* __restrict__ P, const float* __restrict__ gb, const float* __restrict__ ng, bf16raw* __restrict__ Y, int bb, int head, int tb) {
    using att::bf16x8; using att::f32x16; using att::crow;
    constexpr int CP = 72;
    constexpr int L_K = 0, L_V = 16384, L_C = 49152, L_SM = 86016, L_WS = 90112, L_HB = 0, HP = 132;
    char* lds = F.lds;
    int tid = F.tid; asm volatile("" : "+v"(tid));
    const int wid = F.wave, lane = tid & 63, r32 = lane & 31, hi = lane >> 5, dir = wid >> 2, rg = wid & 3;
    if (wid >= 4) __builtin_amdgcn_s_setprio(1);
    const float* CST = (const float*)(F.ws + WS_CST); const float* NST = (const float*)(F.ws + WS_NST); const float* MS = (const float*)(F.ws + WS_MSC) + 32 * NCHUNK;
    const int r0 = bb * TPB + tb * 128;
    float* sm = (float*)(lds + L_SM);
    float* wsc = (float*)(lds + L_WS) + wid * 64;
    __syncthreads();
#pragma unroll
    for (int i = 0; i < 2; ++i) { const int vi = tid + 512 * i, key = vi >> 3, c8 = (vi & 7) * 8;
        *(u32x4_t*)(lds + L_K + (key >> 6) * 8192 + KSWZ64(key & 63, c8 * 2)) = *(const u32x4_t*)(P + (size_t)(r0 + key) * PP + C_MK + head * 64 + c8); }
#pragma unroll
    for (int i = 0; i < 4; ++i) { const int vi = tid + 512 * i, key = vi >> 4, c8 = (vi & 15) * 8;
        *(u32x4_t*)(lds + L_V + (key >> 6) * 16384 + att::v_st(key & 63, c8)) = *(const u32x4_t*)(P + (size_t)(r0 + key) * PP + C_MV + head * 128 + c8); }
#pragma unroll
    for (int i = 0; i < 8; ++i) { const int vi = tid + 512 * i, d2 = vi >> 11, rem = vi & 2047, vrow = rem >> 4, c4 = (rem & 15) * 4;
        const int ci2 = (bb * 8 + head * 2 + d2) * NCHUNK + tb; const f32x4_t cv = *(const f32x4_t*)(CST + (size_t)ci2 * 8192 + vrow * 64 + c4);
        u32x2_t w; w.x = pk2(cv.x, cv.y); w.y = pk2(cv.z, cv.w); *(u32x2_t*)(lds + L_C + d2 * 18432 + (vrow * CP + c4) * 2) = w; }
    const int chain = bb * 8 + head * 2 + dir, ci = chain * NCHUNK + tb;
    const float m_prev = MS[ci];
    float* smd = sm + dir * 448;
    if (rg == 0) {
        float ig[2], bc[2], bl; gate_scan(P, gb, r0, head, dir, lane, ig, bc, bl);
        const float a0 = ig[0] - bc[0], a1 = ig[1] - bc[1]; const float pm = fmaxf(a0, a1); float v = pm;
#pragma unroll
        for (int o = 1; o < 64; o <<= 1) { const float tt = __shfl_up(v, o); if (lane >= o) v = fmaxf(v, tt); }
        float ex = __shfl_up(v, 1); if (lane == 0) ex = -3.0e38f;
        const float M0 = fmaxf(m_prev, fmaxf(ex, a0)), M1 = fmaxf(m_prev, fmaxf(ex, pm));
        const int s0 = 2 * lane, t0 = dir ? 127 - s0 : s0, t1 = dir ? 126 - s0 : s0 + 1;
        smd[t0] = a0; smd[t1] = a1; smd[128 + t0] = M0; smd[128 + t1] = M1; smd[256 + t0] = bc[0]; smd[256 + t1] = bc[1];
    } else if (rg == 1) { smd[384 + lane] = NST[(size_t)ci * 64 + lane]; }
    const int tq = 32 * rg + r32;
    bf16x8 qr[4];
#pragma unroll
    for (int d0 = 0; d0 < 4; ++d0) qr[d0] = *reinterpret_cast<const bf16x8*>(P + (size_t)(r0 + tq) * PP + C_MQ + head * 64 + d0 * 16 + hi * 8);
    __syncthreads();
    const float Mt = smd[128 + tq], winter = __expf(m_prev - Mt);
    float nq = 0.f; bf16x8 qs[4];
#pragma unroll
    for (int d0 = 0; d0 < 4; ++d0) { float qf[8]; unpack8(__builtin_bit_cast(u32x4_t, qr[d0]), qf); float qw[8];
#pragma unroll
        for (int e = 0; e < 8; ++e) { nq += smd[384 + d0 * 16 + hi * 8 + e] * qf[e]; qw[e] = qf[e] * winter; }
        qs[d0] = __builtin_bit_cast(bf16x8, pack8(qw)); }
    { auto rr = __builtin_amdgcn_permlane32_swap(__float_as_uint(nq), __float_as_uint(nq), false, false); nq = __uint_as_float(rr[0]) + __uint_as_float(rr[1]); }
    f32x16 o[4] = {};
    { const char* cb = lds + L_C + dir * 18432;
#pragma unroll
      for (int blk = 0; blk < 4; ++blk)
#pragma unroll
        for (int ks = 0; ks < 4; ++ks) { const bf16x8 cf = *reinterpret_cast<const bf16x8*>(cb + ((32 * blk + r32) * CP + 16 * ks + 8 * hi) * 2);
            o[blk] = __builtin_amdgcn_mfma_f32_32x32x16_bf16(qs[ks], cf, o[blk], 0, 0, 0); } }
    float rs = 0.f;
    const int vb0 = (int)(uintptr_t)(lds + L_V) + att::v_rd_base(lane);
    const int kt_lo = dir ? (rg >= 2 ? 1 : 0) : 0, kt_hi = dir ? 1 : (rg >= 2 ? 1 : 0);
    for (int kt = kt_lo; kt <= kt_hi; ++kt) {
        f32x16 p0 = {}, p1 = {};
        const char* Ks = lds + L_K + kt * 8192;
#pragma unroll
        for (int d0 = 0; d0 < 4; ++d0) { const int cbb = (d0 * 16 + hi * 8) * 2;
            const bf16x8 b0 = *reinterpret_cast<const bf16x8*>(Ks + KSWZ64(r32, cbb)), b1 = *reinterpret_cast<const bf16x8*>(Ks + KSWZ64(32 + r32, cbb));
            p0 = __builtin_amdgcn_mfma_f32_32x32x16_bf16(b0, qr[d0], p0, 0, 0, 0); p1 = __builtin_amdgcn_mfma_f32_32x32x16_bf16(b1, qr[d0], p1, 0, 0, 0); }
#pragma unroll
        for (int r = 0; r < 16; ++r) { const int s0_ = 64 * kt + crow(r, hi), s1_ = s0_ + 32;
            const bool ok0 = dir ? (s0_ >= tq) : (s0_ <= tq), ok1 = dir ? (s1_ >= tq) : (s1_ <= tq);
            const float w0 = ok0 ? 0.125f * __expf(smd[s0_] - Mt) : 0.f, w1 = ok1 ? 0.125f * __expf(smd[s1_] - Mt) : 0.f;
            p0[r] *= w0; p1[r] *= w1; rs += p0[r] + p1[r]; }
        bf16x8 pa0, pa1, pa2, pa3;
#define PK4M(Pv, BASE, OUT) do { unsigned a0 = att::cvtpk(Pv[BASE + 0], Pv[BASE + 1]), a1 = att::cvtpk(Pv[BASE + 2], Pv[BASE + 3]);   \
    unsigned b0 = att::cvtpk(Pv[BASE + 4], Pv[BASE + 5]), b1 = att::cvtpk(Pv[BASE + 6], Pv[BASE + 7]);                              \
    auto r0_ = __builtin_amdgcn_permlane32_swap(a0, b0, false, false); auto r1_ = __builtin_amdgcn_permlane32_swap(a1, b1, false, false); \
    u32x4_t w_ = {r0_[0], r1_[0], r0_[1], r1_[1]}; OUT = __builtin_bit_cast(bf16x8, w_); } while (0)
        PK4M(p0, 0, pa0); PK4M(p0, 8, pa1); PK4M(p1, 0, pa2); PK4M(p1, 8, pa3);
#undef PK4M
        __builtin_amdgcn_sched_barrier(0);
        const int vb = vb0 + kt * 16384;
        att::pv_one<0>(o[0], vb, pa0, pa1, pa2, pa3); att::pv_one<1>(o[1], vb, pa0, pa1, pa2, pa3); att::pv_one<2>(o[2], vb, pa0, pa1, pa2, pa3); att::pv_one<3>(o[3], vb, pa0, pa1, pa2, pa3);
    }
    { auto rr = __builtin_amdgcn_permlane32_swap(__float_as_uint(rs), __float_as_uint(rs), false, false); rs = __uint_as_float(rr[0]) + __uint_as_float(rr[1]); }
    const float den = winter * nq + rs; const float dn = fmaxf(fabsf(den), __expf(-(smd[256 + tq] + Mt)));
    if (hi == 0) wsc[r32] = 1.0f / dn;
    asm volatile("s_waitcnt lgkmcnt(0)" ::: "memory");
    float inv[16];
#pragma unroll
    for (int r = 0; r < 16; ++r) inv[r] = wsc[crow(r, hi)];
    __syncthreads();
    float* hb = (float*)(lds + L_HB);
    if (dir == 1) {
#pragma unroll
        for (int blk = 0; blk < 4; ++blk)
#pragma unroll
            for (int r = 0; r < 16; ++r) hb[(32 * rg + crow(r, hi)) * HP + 32 * blk + r32] = o[blk][r] * inv[r];
    }
    __syncthreads();
    __builtin_amdgcn_s_setprio(0);
    if (dir == 0) {
        float ss[16];
#pragma unroll
        for (int r = 0; r < 16; ++r) ss[r] = 0.f;
#pragma unroll
        for (int blk = 0; blk < 4; ++blk)
#pragma unroll
            for (int r = 0; r < 16; ++r) { const float h = o[blk][r] * inv[r] + hb[(32 * rg + crow(r, hi)) * HP + 32 * blk + r32]; o[blk][r] = h; ss[r] += h * h; }
#pragma unroll
        for (int r = 0; r < 16; ++r) { float s = ss[r]; s += __shfl_xor(s, 1); s += __shfl_xor(s, 2); s += __shfl_xor(s, 4); s += __shfl_xor(s, 8); s += __shfl_xor(s, 16); ss[r] = 1.0f / sqrtf(s * (1.f / 128.f) + NORM_EPS); }
#pragma unroll
        for (int blk = 0; blk < 4; ++blk) { const float gm = ng[head * 128 + 32 * blk + r32];
#pragma unroll
            for (int r = 0; r < 16; ++r) { const size_t row = (size_t)(r0 + 32 * rg + crow(r, hi));
                const float og = bf1(P[row * PP + C_MO + head * 128 + 32 * blk + r32]);
                const float yv = o[blk][r] * ss[r] * gm * sigmoid_f(og);
                Y[row * DM + head * 128 + 32 * blk + r32] = (bf16raw)(pk2(yv, 0.f) & 0xffffu); } }
    }
}

__device__ __forceinline__ void diff_post_phase(const Frame& F, const bf16raw* __restrict__ T, const float* __restrict__ lam, const float* __restrict__ g, float one_minus, bf16raw* __restrict__ Y) {
    const int h = F.lane >> 4, c8 = (F.lane & 15) * 8; const float lm = lam[h]; float gm[8];
#pragma unroll
    for (int e = 0; e < 8; ++e) gm[e] = g[h * 128 + c8 + e] * one_minus;
    for (int r = F.gw; r < MROWS; r += 2 * F.NGW) {
        const int r2 = r + F.NGW; const bool has2 = r2 < MROWS; const int rb = has2 ? r2 : r;
        const u32x4_t wa1 = *(const u32x4_t*)(T + (size_t)r * 1024 + (2 * h) * 128 + c8), wa2 = *(const u32x4_t*)(T + (size_t)r * 1024 + (2 * h + 1) * 128 + c8);
        const u32x4_t wb1 = *(const u32x4_t*)(T + (size_t)rb * 1024 + (2 * h) * 128 + c8), wb2 = *(const u32x4_t*)(T + (size_t)rb * 1024 + (2 * h + 1) * 128 + c8);
#pragma unroll
        for (int q = 0; q < 2; ++q) {
            float o1[8], o2[8]; unpack8(q ? wb1 : wa1, o1); unpack8(q ? wb2 : wa2, o2);
            float ss = 0.f;
#pragma unroll
            for (int e = 0; e < 8; ++e) { o1[e] -= lm * o2[e]; ss += o1[e] * o1[e]; }
            ss += __shfl_xor(ss, 1); ss += __shfl_xor(ss, 2); ss += __shfl_xor(ss, 4); ss += __shfl_xor(ss, 8);
            const float rstd = 1.0f / sqrtf(ss * (1.f / 128.f) + NORM_EPS);
#pragma unroll
            for (int e = 0; e < 8; ++e) o1[e] *= rstd * gm[e];
            if (q == 0 || has2) *(u32x4_t*)(Y + (size_t)(q ? r2 : r) * DM + 512 + h * 128 + c8) = pack8(o1);
        }
    }
}

__device__ __forceinline__ void mixer_phase(const Frame& F, CArgsP0 a, int l) {
    const hbf16* P = (const hbf16*)(F.ws + WS_P); hbf16* Yb = (hbf16*)(F.ws + WS_Y); hbf16* DT = (hbf16*)(F.ws + WS_DTMP);
    const bool lastl = (l == DEPTH - 1);
    const float* lamv = (const float*)(F.ws + WS_LAM) + l * 4; const float* dng = a->in[11] + l * 512; const float one_minus = (l == 0) ? 0.8f : 0.64449093241f;
    REPX(1) if (MX_MASK & 1) for (int k = F.vcu; k < 1024; k += F.G) {
        const int i = k >> 8, rem = k & 255;
        __syncthreads();
        if (i < 2) { const int id = i * 256 + rem, combo = id >> 6, qb = id & 63, bb = combo >> 2, h = combo & 3;
            const long rq = (long)bb * TPB + CTX + qb * 256, rk = (long)bb * TPB;
            att::attn_dense_body<64, DM, 1>(P + rq * PP + C_DQ + h * 128, P + rk * PP + C_DK + h * 128, P + rk * PP + C_DV + h * 128, Yb, TPB, 0, F.lds);
            __syncthreads();
            att::attn_dense_body<64, DM, 2>(P + rq * PP + C_DQ + h * 128 + 64, P + rk * PP + C_DK + h * 128, P + rk * PP + C_DV + h * 128, Yb + rq * DM + 512 + h * 128, TPB, 64, F.lds, lamv[h], dng + h * 128, one_minus);
        } else { const int id = (i - 2) * 256 + rem, combo = id >> 6, qb = id & 63, bb = combo >> 2, h = combo & 3;
            const long rq = (long)bb * TPB + CTX + qb * 256, rk = (long)bb * TPB;
            att::attn_dense_body<128, DM>(P + rq * PP + C_GQ + h * 128, P + rk * PP + C_GK + (h >> 1) * 128, P + rk * PP + C_GV + (h >> 1) * 128, Yb + rq * DM + 1536 + h * 128, TPB, 0, F.lds);
        }
    }
    if (!lastl && (MX_MASK & 1)) for (int k = F.vcu; k < 16; k += F.G) {
        __syncthreads();
        if (k < 8) { const int bb = k >> 2, h = k & 3; const long rq = (long)bb * TPB;
            att::attn_dense_body<64, DM, 1>(P + rq * PP + C_DQ + h * 128, P + rq * PP + C_DK + h * 128, P + rq * PP + C_DV + h * 128, Yb, CTX, 0, F.lds);
            __syncthreads();
            att::attn_dense_body<64, DM, 2>(P + rq * PP + C_DQ + h * 128 + 64, P + rq * PP + C_DK + h * 128, P + rq * PP + C_DV + h * 128, Yb + rq * DM + 512 + h * 128, CTX, 64, F.lds, lamv[h], dng + h * 128, one_minus);
        } else { const int k2 = k - 8, bb = k2 >> 2, h = k2 & 3; const long rq = (long)bb * TPB;
            att::attn_dense_body<128, DM>(P + rq * PP + C_GQ + h * 128, P + rq * PP + C_GK + (h >> 1) * 128, P + rq * PP + C_GV + (h >> 1) * 128, Yb + rq * DM + 1536 + h * 128, CTX, 0, F.lds);
        }
    }
    __syncthreads();
    const float* sinkl = a->in[12] + l * 8;
    REPX(2) if (MX_MASK & 2) for (int k = F.vcu; k < (lastl ? 1024 : 1040); k += F.G) {
        if (k < 1024) att::swa_unit(P, Yb, k >> 9, (k >> 8) & 1, k & 255, false, sinkl, F.lds);
        else { const int k2 = k - 1024; att::swa_unit(P, Yb, k2 >> 3, (k2 >> 2) & 1, k2 & 3, true, sinkl, F.lds); }
    }
    const float* gb = a->in[8] + l * 16; const float* ng = a->in[9] + l * 512;
    REPX(4) if (MX_MASK & 4) for (int k = F.vcu; k < (lastl ? 8 * (NCHUNK - 2) : 8 * NCHUNK); k += F.G) { int bb, head, tb;
        if (lastl) { bb = k / (4 * (NCHUNK - 2)); const int rem = k - bb * 4 * (NCHUNK - 2); head = rem / (NCHUNK - 2); tb = 2 + rem - head * (NCHUNK - 2); }
        else { bb = k / (4 * NCHUNK); const int rem = k - bb * 4 * NCHUNK; head = rem / NCHUNK; tb = rem - head * NCHUNK; }
#ifdef MLSTM_VALU
        mlstm_c_unit(F, (const bf16raw*)P, gb, ng, (bf16raw*)Yb, bb, head, tb);
#else
        mlstm_c_unit_mfma(F, (const bf16raw*)P, gb, ng, (bf16raw*)Yb, bb, head, tb);
#endif
    }
    __syncthreads();
}

__device__ __forceinline__ void stagger_start(int ticks) {
    const int grp = (blockIdx.x >> 3) & 3;
    if (grp) { const unsigned long long t0 = __builtin_amdgcn_s_memrealtime(); const unsigned long long d = (unsigned long long)(grp * ticks);
        while (__builtin_amdgcn_s_memrealtime() - t0 < d) __builtin_amdgcn_s_sleep(16); }
}
#ifndef STAG_GATE
#define STAG_GATE 0
#endif
#ifndef STAG_RESID
#define STAG_RESID 0
#endif
struct RowOrder { pg8::StaticOrder S; int skip;
    __device__ void init(int N, int G, int c, int skip_) { skip = skip_; S.init(skip_ ? NBATCH * SEQ : MROWS, N, G, c); }
    __device__ bool next(int i, pg8::Unit& u) const { if (!S.next(i, u)) return false; if (skip) u.pm += 1 + (u.pm >= 64 ? 1 : 0); return true; }
    __device__ __forceinline__ void a_ready(const pg8::Unit&) const {}
    __device__ __forceinline__ void done(const pg8::Unit&) const {}
};
typedef const __attribute__((address_space(4))) Args* CArgsP;
__device__ __forceinline__ CArgsP get_args() { CArgsP p = (CArgsP)__builtin_amdgcn_kernarg_segment_ptr(); asm volatile("" : "+s"(p)); return p; }
#define PHASE_BEGIN CArgsP ap = get_args(); unsigned char* ws = ap->ws; const Frame F = make_frame(ws, (char*)lds); (void)F;
__global__ void __launch_bounds__(512, 2) fwd_megakernel(Args a_unused) {
    extern __shared__ __attribute__((aligned(16))) unsigned char lds[];
    cg::grid_group grid = cg::this_grid();
    PG8_LAS unsigned char* glds = (PG8_LAS unsigned char*)lds;
    if (threadIdx.x < 16) ((LAS unsigned*)((LAS unsigned char*)lds + LDS_BARST))[threadIdx.x] = 0u;
    __syncthreads();
    { CArgsP ap0 = get_args(); (void)xcd_barrier_post((unsigned*)(ap0->ws + WS_BAR), (volatile LAS unsigned*)((LAS unsigned char*)lds + LDS_BARST)); }
#define GBAR() do { CArgsP apb = get_args(); XcdBarrier xb_; xb_.bar = (unsigned*)(apb->ws + WS_BAR); xb_.x = xb_xcc_id(); xb_.st = (volatile LAS unsigned*)((LAS unsigned char*)lds + LDS_BARST); xcd_barrier(xb_); } while (0)
    REP(1) if (PH_MASK & 1) { PHASE_BEGIN s0_phase(F, ap); }
    grid.sync();
#ifdef EXTRA_SYNCS
    for (int es = 0; es < EXTRA_SYNCS; ++es) GBAR();
#endif
#pragma unroll 1
    for (int l = 0; l < DEPTH; ++l) {
        REP(2) if (PH_MASK & 2) { PHASE_BEGIN s1_phase(F, ap, l); }
        GBAR();
        REP(4) if (PH_MASK & 4) { PHASE_BEGIN const float* modl = (const float*)(ws + WS_MOD) + (size_t)l * 3 * 12288;
            const XPtr xin = (l == 0) ? XPtr{ap->in[0], ap->in[2]} : XPtr{ap->out, (const float*)(ws + WS_XC)};
            norm_mod_phase(F, xin, (l == 0) ? (const bf16raw*)nullptr : (const bf16raw*)(ws + WS_H), XOut{ap->out, (float*)(ws + WS_XC)}, ap->in[6] + l * DM, modl, 0, 1, (bf16raw*)(ws + WS_H)); }
        GBAR();
        REP(8) if (PH_MASK & 8) { PHASE_BEGIN
            pg8::Gemm g{(const pg8::bf16_t*)(ws + WS_H), (const pg8::bf16_t*)(ws + WS_WIN), MROWS, PP, DM, DM, 0, 0}; pg8::StaticOrder S; S.init(MROWS, PP, F.G, (int)blockIdx.x);
            pg8::EpiBf16<0> E{(pg8::bf16_t*)(ws + WS_P), PP, nullptr, 0, 0, 1.f};
            pg8::gemm_phase<pg8::EpiBf16<0>, pg8::StaticOrder, P_ALIGN, true>(glds, g, S, E);
        }
        GBAR();
        if (PH_MASK & 16) { PHASE_BEGIN rope_phase(F, (bf16raw*)(ws + WS_P), ap->in[13] + l * 128, ap->in[14] + l * 128); }
#ifdef DBL_SCAN
        for (int rs_ = 0; rs_ < 2; ++rs_) {
#endif
        REP(32) if (PH_MASK & 32) { PHASE_BEGIN mlstm_a_phase(F, (const bf16raw*)(ws + WS_P), ap->in[8] + l * 16); }
        GBAR();
        if (PH_MASK & 64) { PHASE_BEGIN mlstm_b_phase(F); }
        GBAR();
#ifdef DBL_SCAN
        }
#endif
        if (PH_MASK & 128) { PHASE_BEGIN mixer_phase(F, ap, l); }
        GBAR();
        REP(512) if (PH_MASK & 512) { PHASE_BEGIN
            pg8::Gemm g{(const pg8::bf16_t*)(ws + WS_Y), (const pg8::bf16_t*)(ws + WS_WB), MROWS, 8192, 512, DM, 8, 512}; RowOrder S; S.init(8192, F.G, (int)blockIdx.x, l == DEPTH - 1);
            pg8::EpiBf16<0> E{(pg8::bf16_t*)(ws + WS_BIG), DM, nullptr, DM, (size_t)MROWS * DM, 1.f};
            pg8::gemm_phase<pg8::EpiBf16<0>, RowOrder, BR_ALIGN, true>(glds, g, S, E);
        }
        GBAR();
        REP(1024) if (PH_MASK & 1024) { PHASE_BEGIN
            pg8::Gemm g{(const pg8::bf16_t*)(ws + WS_H), (const pg8::bf16_t*)(ws + WS_WG), MROWS, 8192, DM, DM, 0, 0}; RowOrder S; S.init(8192, F.G, (int)blockIdx.x, l == DEPTH - 1);
            pg8::EpiGate E{(const pg8::bf16_t*)(ws + WS_BIG), (pg8::bf16_t*)(ws + WS_Y), (size_t)MROWS * DM};
            if (STAG_GATE) stagger_start(STAG_GATE);
#ifdef PROBE_GATE_KLOOP
            { pg8::EpiNone E0{(float*)(ws + WS_ZT)}; pg8::gemm_phase<pg8::EpiNone, RowOrder, GATE_ALIGN, true>(glds, g, S, E0); }
#endif
            pg8::gemm_phase<pg8::EpiGate, RowOrder, GATE_ALIGN, true>(glds, g, S, E);
        }
        GBAR();
        if (PH_MASK & 2048) { PHASE_BEGIN
            const float* modl = (const float*)(ws + WS_MOD) + (size_t)l * 3 * 12288;
            pg8::Gemm g{(const pg8::bf16_t*)(ws + WS_Y), (const pg8::bf16_t*)(ws + WS_WOUT), MROWS, DM, DM, DM, 0, 0}; RowOrder S; S.init(DM, F.G, (int)blockIdx.x, l == DEPTH - 1);
            pg8::EpiDelta E{(pg8::bf16_t*)(ws + WS_H), modl, 2};
            pg8::gemm_phase<pg8::EpiDelta, RowOrder, true, true>(glds, g, S, E);
        }
        GBAR();
        REP(4) if (PH_MASK & 4) { PHASE_BEGIN const float* modl = (const float*)(ws + WS_MOD) + (size_t)l * 3 * 12288;
            const XPtr xin2 = (l == 0) ? XPtr{ap->in[0], ap->in[2]} : XPtr{ap->out, (const float*)(ws + WS_XC)};
            norm_mod_phase(F, xin2, (const bf16raw*)(ws + WS_H), XOut{ap->out, (float*)(ws + WS_XC)}, ap->in[17] + l * DM, modl, 3, 4, (bf16raw*)(ws + WS_H)); }
        GBAR();
        REP(4096) if (PH_MASK & 4096) { PHASE_BEGIN
            pg8::Gemm g{(const pg8::bf16_t*)(ws + WS_H), (const pg8::bf16_t*)(ws + WS_WUP), MROWS, 2 * FF, DM, DM, 0, 0}; RowOrder S; S.init(2 * FF, F.G, (int)blockIdx.x, l == DEPTH - 1);
            pg8::EpiSwiGLU E{(pg8::bf16_t*)(ws + WS_BIG), FF};
            pg8::gemm_phase<pg8::EpiSwiGLU, RowOrder, UP_ALIGN, true>(glds, g, S, E);
        }
        GBAR();
        if (PH_MASK & 8192) { PHASE_BEGIN
            const float* modl = (const float*)(ws + WS_MOD) + (size_t)l * 3 * 12288;
            pg8::Gemm g{(const pg8::bf16_t*)(ws + WS_BIG), (const pg8::bf16_t*)(ws + WS_WDN), MROWS, DM, FF, FF, 0, 0}; RowOrder S; S.init(DM, F.G, (int)blockIdx.x, l == DEPTH - 1);
            pg8::EpiDelta E{(pg8::bf16_t*)(ws + WS_H), modl, 5};
            pg8::gemm_phase<pg8::EpiDelta, RowOrder, true, true>(glds, g, S, E);
        }
        GBAR();
    }
    if (PH_MASK & 16384) { PHASE_BEGIN final_norm_phase(F, ap->out, (const bf16raw*)(ws + WS_H), ap->in[20]); }
}

extern "C" void kernel_launch(void* const* d_in, const int* in_sizes, int n_in, void* d_out, int out_size, void* d_ws, size_t ws_size, hipStream_t stream) {
    static int grid = 0;
    if (grid == 0) {
        if (n_in != 21 || out_size != NBATCH * SEQ * DM || ws_size < WS_END) { fprintf(stderr, "kernel_launch: unexpected shapes: n_in %d out %d ws %zu (need %zu)\n", n_in, out_size, ws_size, (size_t)WS_END); grid = -1; return; }
        int dev = 0, cus = 0, per_cu = 0;
        if (hipGetDevice(&dev) != hipSuccess || hipDeviceGetAttribute(&cus, hipDeviceAttributeMultiprocessorCount, dev) != hipSuccess) { grid = -1; return; }
        if (hipFuncSetAttribute((const void*)fwd_megakernel, hipFuncAttributeMaxDynamicSharedMemorySize, LDS_BYTES) != hipSuccess) { fprintf(stderr, "kernel_launch: hipFuncSetAttribute failed\n"); grid = -1; return; }
        if (hipOccupancyMaxActiveBlocksPerMultiprocessor(&per_cu, (const void*)fwd_megakernel, 512, LDS_BYTES) != hipSuccess || per_cu < 1) per_cu = 1;
        (void)hipGetLastError();
        grid = cus;
        fprintf(stderr, "kernel_launch: cus %d per_cu %d grid %d ws %zu\n", cus, per_cu, grid, ws_size);
    }
    if (grid < 0) return;
    Args a{};
    for (int i = 0; i < 21; ++i) a.in[i] = (const float*)d_in[i];
    a.out = (float*)d_out; a.ws = (unsigned char*)d_ws;
    (void)hipMemsetAsync((char*)d_ws + WS_BAR, 0, XCD_BAR_WORDS * 4, stream);
    void* args[] = {&a};
    const hipError_t e = hipLaunchCooperativeKernel((const void*)fwd_megakernel, dim3(grid), dim3(512), args, LDS_BYTES, stream);
    if (e != hipSuccess) fprintf(stderr, "kernel_launch: cooperative launch failed: %s (grid %d)\n", hipGetErrorString(e), grid);
}
```

```cpp
#include <hip/hip_runtime.h>
#include <hip/hip_bf16.h>
#include <hip/hip_cooperative_groups.h>
#include <cstdio>
#include <cstdint>
namespace cg = cooperative_groups;

constexpr int DM = 2048, NBATCH = 2, SEQ = 16384, CTX = 256, DEPTH = 2;
constexpr int TPB = SEQ + CTX;
constexpr int MROWS = NBATCH * TPB;
constexpr int DIN = 13072, NMIX = 4880, PP = 5120;
constexpr int FF = 5632;
constexpr int C_MQ = 0, C_MK = 256, C_MV = 512, C_MO = 1024, C_MG = 1536, C_DQ = 1552, C_DK = 2064, C_DV = 2576, C_SQ = 3088, C_SK = 3600, C_SV = 3728,
              C_GQ = 3856, C_GK = 4368, C_GV = 4624;
constexpr int NCHUNK = TPB / 128;
constexpr float NORM_EPS = 1e-6f;

constexpr size_t MiB = 1u << 20;
constexpr size_t WS_MODP = 0;
constexpr size_t WS_MOD = 5 * MiB;
constexpr size_t WS_ROPE = 5 * MiB + 512 * 1024;
constexpr size_t WS_LAM = 5 * MiB + 768 * 1024;
constexpr size_t WS_MSC = 6 * MiB;
constexpr size_t WS_NST = 6 * MiB + 512 * 1024;
constexpr size_t WS_W = 8 * MiB;
constexpr size_t WS_WIN = WS_W, WS_WG = WS_WIN + 20 * MiB, WS_WB = WS_WG + 32 * MiB, WS_WOUT = WS_WB + 8 * MiB, WS_WUP = WS_WOUT + 8 * MiB, WS_WDN = WS_WUP + 44 * MiB;
constexpr size_t WS_H = WS_WDN + 22 * MiB;
constexpr size_t WS_Y = WS_H + 130 * MiB;
constexpr size_t WS_XC = WS_Y + 130 * MiB;
constexpr size_t WS_BIG = WS_XC + 4 * MiB;
constexpr size_t WS_P = WS_BIG, WS_DTMP = WS_BIG + 325 * MiB, WS_CST = WS_BIG + 390 * MiB;
constexpr size_t WS_END = WS_BIG + 520 * MiB;
static_assert(WS_H == 142 * MiB && WS_END == 926 * MiB, "ws map");
static_assert((size_t)MROWS * PP * 2 <= 325 * MiB && (size_t)MROWS * 1024 * 2 <= 65 * MiB && (size_t)16 * NCHUNK * 8192 * 4 <= 65 * MiB, "big map");
static_assert((size_t)4 * MROWS * DM * 2 <= 520 * MiB && (size_t)MROWS * FF * 2 <= 520 * MiB, "big map 2");

constexpr int LDS_BYTES = 147456;

typedef unsigned short bf16raw;
typedef float f32x4_t __attribute__((ext_vector_type(4)));
typedef float f32x2_t __attribute__((ext_vector_type(2)));
typedef unsigned u32x4_t __attribute__((ext_vector_type(4)));
typedef unsigned u32x2_t __attribute__((ext_vector_type(2)));
typedef __bf16 bf16x2_t __attribute__((ext_vector_type(2)));

__device__ __forceinline__ unsigned pk2(float lo, float hi) { f32x2_t v = {lo, hi}; bf16x2_t b = __builtin_convertvector(v, bf16x2_t); return __builtin_bit_cast(unsigned, b); }
__device__ __forceinline__ float bflo(unsigned u) { return __uint_as_float(u << 16); }
__device__ __forceinline__ float bfhi(unsigned u) { return __uint_as_float(u & 0xffff0000u); }
__device__ __forceinline__ float bf1(bf16raw u) { return __uint_as_float(((unsigned)u) << 16); }
__device__ __forceinline__ void unpack8(const u32x4_t w, float* f) { f[0] = bflo(w.x); f[1] = bfhi(w.x); f[2] = bflo(w.y); f[3] = bfhi(w.y); f[4] = bflo(w.z); f[5] = bfhi(w.z); f[6] = bflo(w.w); f[7] = bfhi(w.w); }
__device__ __forceinline__ u32x4_t pack8(const float* f) { u32x4_t w; w.x = pk2(f[0], f[1]); w.y = pk2(f[2], f[3]); w.z = pk2(f[4], f[5]); w.w = pk2(f[6], f[7]); return w; }
__device__ __forceinline__ float wave_sum(float v) {
#pragma unroll
    for (int o = 1; o < 64; o <<= 1) v += __shfl_xor(v, o);
    return v;
}
__device__ __forceinline__ float wave_max(float v) {
#pragma unroll
    for (int o = 1; o < 64; o <<= 1) v = fmaxf(v, __shfl_xor(v, o));
    return v;
}
__device__ __forceinline__ float sigmoid_f(float x) { return __builtin_amdgcn_rcpf(1.f + __expf(-x)); }

struct XPtr { const float* lat; const float* ctx;
    __device__ __forceinline__ const float* row(int r) const { const int b = r / TPB, t = r - b * TPB; return t < CTX ? ctx + ((size_t)b * CTX + t) * DM : lat + ((size_t)b * SEQ + (t - CTX)) * DM; } };
struct XOut { float* lat; float* ctx;
    __device__ __forceinline__ float* row(int r) const { const int b = r / TPB, t = r - b * TPB; return t < CTX ? ctx + ((size_t)b * CTX + t) * DM : lat + ((size_t)b * SEQ + (t - CTX)) * DM; } };

namespace pg8 {
#define PG8_LAS __attribute__((address_space(3)))
typedef unsigned short bf16_t;
typedef short bf16x8 __attribute__((ext_vector_type(8)));
typedef float f32x4 __attribute__((ext_vector_type(4)));
typedef unsigned u32x4 __attribute__((ext_vector_type(4)));
constexpr int BM = 256, BK = 64, HALF = 128, HTB = HALF * BK * 2  , STAGE_BYTES = 8 * HTB, NXCD = 8, WGM = 8;

__host__ __device__ __forceinline__ int lds_byte(int r, int c) { const int st = (r >> 4) * 2 + (c >> 5), rr = r & 15, cc = c & 31, ob = rr * 64 + cc * 2; return st * 1024 + (ob ^ (((ob >> 9) & 1) << 5)); }
__host__ __device__ __forceinline__ void stage_rc(int b, int& R, int& C) { const int st = b / 1024, sb = b % 1024, swz = sb ^ (((sb >> 9) & 1) << 5); R = (st >> 1) * 16 + swz / 64; C = (st & 1) * 32 + (swz % 64) / 2; }
__host__ __device__ __forceinline__ int perm32(int rho) { const int n = rho >> 4, i = rho & 15; return 8 * (i >> 2) + 4 * n + (i & 3); }

struct Unit { int pm, pn; };
struct Gemm { const bf16_t* A; const bf16_t* Bt; int M, N, K; int lda; int agrp; int agstride; };

struct StaticOrder {
    int nM, nN, nwg, G, c;
    __host__ __device__ void init(int M, int N, int G_, int c_) { nM = M / BM; nN = N / BM; nwg = nM * nN; G = G_; c = c_; }
    __host__ __device__ bool next(int i, Unit& u) const {
        const long L = (long)i * G + c; if (L >= nwg) return false;
        int wgid = (int)L; { const int q = nwg / NXCD, r = nwg % NXCD, xcd = wgid % NXCD, off = wgid / NXCD; wgid = (xcd < r ? xcd * (q + 1) : r * (q + 1) + (xcd - r) * q) + off; }
        const int nig = WGM * nN, gid = wgid / nig, fm = gid * WGM, gsz = (nM - fm) < WGM ? (nM - fm) : WGM;
        u.pm = fm + ((wgid % nig) % gsz); u.pn = (wgid % nig) / gsz; return true;
    }
    __device__ __forceinline__ void a_ready(const Unit&) const {}
    __device__ __forceinline__ void done(const Unit&) const {}
};

__device__ __forceinline__ unsigned cvt_pk_bf16(float lo, float hi) { unsigned r; asm volatile("v_cvt_pk_bf16_f32 %0, %1, %2" : "=v"(r) : "v"(lo), "v"(hi)); return r; }
typedef float f32x2 __attribute__((ext_vector_type(2)));
__device__ __forceinline__ f32x2 gelu_pk(f32x2 v) {
    const f32x2 av = __builtin_elementwise_abs(v), d = av * 0.2316418882f + 1.0f;
    f32x2 t; t.x = __builtin_amdgcn_rcpf(d.x); t.y = __builtin_amdgcn_rcpf(d.y);
    f32x2 q = t * 0.5307027145f + (-0.7265760135f); q = q * t + 0.7107068705f; q = q * t + (-0.142248368f); q = q * t + 0.127414796f; q = q * t;
    const f32x2 s = (v * v) * (-0.72134752044f);
    f32x2 e; e.x = __builtin_amdgcn_exp2f(s.x); e.y = __builtin_amdgcn_exp2f(s.y);
    const f32x2 m = v * (q * e), r = v - m;
    f32x2 o; o.x = v.x < 0.f ? m.x : r.x; o.y = v.y < 0.f ? m.y : r.y; return o;
}

template <int ACT  > struct EpiBf16 {
    static constexpr bool PERM = true, AFTER_DRAIN = false; static_assert(ACT == 0 || ACT == 1, "EpiBf16: ACT is 0 (none) or 1 (gelu_pk)");
    bf16_t* O; int ldc; const float* bias; int split_cols; size_t split_stride; float scale0;
    __device__ __forceinline__ void operator()(const f32x4 (&acc)[2][2][4][2], const Unit& u, int wr, int wc, int fr, int fq) const {
        asm volatile("" : "+v"(fr), "+v"(fq));
        const int row0 = u.pm * BM + wr * 64 + fr; int colt = u.pn * BM; bf16_t* base = O;
        float sc = 1.f; if (split_cols) { const int t = colt / split_cols; base += (size_t)t * split_stride; colt -= t * split_cols; if (t == 0) sc = scale0; }
        const int col0 = colt + wc * 32 + 8 * fq, bcol0 = u.pn * BM + wc * 32 + 8 * fq;
        f32x4 bv[2][2];
#pragma unroll
        for (int bj = 0; bj < 2; ++bj)
#pragma unroll
            for (int n = 0; n < 2; ++n) bv[bj][n] = bias ? *(const f32x4*)(bias + bcol0 + bj * HALF + 4 * n) : (f32x4){0.f, 0.f, 0.f, 0.f};
#pragma unroll
        for (int ai = 0; ai < 2; ++ai)
#pragma unroll
            for (int m = 0; m < 4; ++m) { bf16_t* rowp = base + (size_t)(row0 + ai * HALF + m * 16) * ldc + col0;
#pragma unroll
                for (int bj = 0; bj < 2; ++bj) { f32x4 v0 = acc[ai][bj][m][0] + bv[bj][0], v1 = acc[ai][bj][m][1] + bv[bj][1];
                    if (ACT == 1) { f32x2 a = gelu_pk((f32x2){v0[0], v0[1]}), b = gelu_pk((f32x2){v0[2], v0[3]}), c = gelu_pk((f32x2){v1[0], v1[1]}), d = gelu_pk((f32x2){v1[2], v1[3]});
                        v0 = (f32x4){a.x, a.y, b.x, b.y}; v1 = (f32x4){c.x, c.y, d.x, d.y}; }
                    v0 = v0 * sc; v1 = v1 * sc; u32x4 w; w.x = cvt_pk_bf16(v0[0], v0[1]); w.y = cvt_pk_bf16(v0[2], v0[3]); w.z = cvt_pk_bf16(v1[0], v1[1]); w.w = cvt_pk_bf16(v1[2], v1[3]);
                    *(u32x4*)(rowp + bj * HALF) = w; } }
    }
};

__device__ __forceinline__ float sigm(float x) { return __builtin_amdgcn_rcpf(1.f + __expf(-x)); }
struct EpiGate {
    static constexpr bool PERM = false, AFTER_DRAIN = false;
    const bf16_t* Bq; bf16_t* out; size_t bstride;
    __device__ __forceinline__ void operator()(const f32x4 (&acc)[2][2][4][2], const Unit& u, int wr, int wc, int fr, int fq) const {
        asm volatile("" : "+v"(fr), "+v"(fq));
        typedef unsigned u32x2 __attribute__((ext_vector_type(2)));
        const int oc = u.pn * 64 + wc * 16 + fq * 4;
        u32x2 bv[2][4][4];
#pragma unroll
        for (int ai = 0; ai < 2; ++ai)
#pragma unroll
            for (int m = 0; m < 4; ++m) { const size_t off = (size_t)(u.pm * BM + ai * HALF + wr * 64 + m * 16 + fr) * 2048 + oc;
#pragma unroll
                for (int i = 0; i < 4; ++i) bv[ai][m][i] = *(const u32x2*)(Bq + (size_t)i * bstride + off); }
#pragma unroll
        for (int ai = 0; ai < 2; ++ai)
#pragma unroll
            for (int m = 0; m < 4; ++m) {
                const size_t off = (size_t)(u.pm * BM + ai * HALF + wr * 64 + m * 16 + fr) * 2048 + oc;
                f32x4 s = (f32x4){0.f, 0.f, 0.f, 0.f};
#pragma unroll
                for (int bj = 0; bj < 2; ++bj)
#pragma unroll
                    for (int n = 0; n < 2; ++n) { const f32x4 g = acc[ai][bj][m][n]; const u32x2 b = bv[ai][m][2 * bj + n];
                        s[0] += sigm(g[0]) * __uint_as_float(b.x << 16); s[1] += sigm(g[1]) * __uint_as_float(b.x & 0xffff0000u);
                        s[2] += sigm(g[2]) * __uint_as_float(b.y << 16); s[3] += sigm(g[3]) * __uint_as_float(b.y & 0xffff0000u); }
                u32x2 w; w.x = cvt_pk_bf16(s[0], s[1]); w.y = cvt_pk_bf16(s[2], s[3]);
                *(u32x2*)(out + off) = w; }
    }
};
struct EpiBranchTiled {
    static constexpr bool PERM = true, AFTER_DRAIN = false;
    bf16_t* Bq;
    __device__ __forceinline__ void operator()(const f32x4 (&acc)[2][2][4][2], const Unit& u, int wr, int wc, int fr, int fq) const {
        asm volatile("" : "+v"(fr), "+v"(fq));
        const int t = u.pn >> 3, ct = u.pn & 7;
#pragma unroll
        for (int bj = 0; bj < 2; ++bj) { const int c0 = ct * 256 + bj * HALF + wc * 32 + 8 * fq, png = c0 >> 6, cc = c0 & 63;
            bf16_t* ub = Bq + (size_t)(u.pm * 32 + png) * 65536 + t * 64 + cc;
#pragma unroll
            for (int ai = 0; ai < 2; ++ai)
#pragma unroll
                for (int m = 0; m < 4; ++m) { const int rr = ai * HALF + wr * 64 + m * 16 + fr; const f32x4 v0 = acc[ai][bj][m][0], v1 = acc[ai][bj][m][1];
                    u32x4 w; w.x = cvt_pk_bf16(v0[0], v0[1]); w.y = cvt_pk_bf16(v0[2], v0[3]); w.z = cvt_pk_bf16(v1[0], v1[1]); w.w = cvt_pk_bf16(v1[2], v1[3]);
                    *(u32x4*)(ub + rr * 256) = w; } }
    }
};
struct EpiResid {
    static constexpr bool PERM = false, AFTER_DRAIN = false;
    const float* in_lat; const float* in_ctx; float* out_lat; float* out_ctx; const float* modl; int gidx;
    __device__ __forceinline__ void operator()(const f32x4 (&acc)[2][2][4][2], const Unit& u, int wr, int wc, int fr, int fq) const {
        asm volatile("" : "+v"(fr), "+v"(fq));
        const int b = u.pm / 65, tb = u.pm - b * 65; const bool isctx = (tb == 0);
        const float* gv = modl + (size_t)(isctx ? 2 : b) * 12288 + gidx * 2048;
        const float* xi = isctx ? in_ctx + (size_t)b * 256 * 2048 : in_lat + ((size_t)b * 16384 + (size_t)(tb - 1) * 256) * 2048;
        float* xo = isctx ? out_ctx + (size_t)b * 256 * 2048 : out_lat + ((size_t)b * 16384 + (size_t)(tb - 1) * 256) * 2048;
        const int col0 = u.pn * BM + wc * 32 + 4 * fq;
#pragma unroll
        for (int bj = 0; bj < 2; ++bj)
#pragma unroll
            for (int n = 0; n < 2; ++n) { const f32x4 gg = *(const f32x4*)(gv + col0 + bj * HALF + n * 16);
                f32x4 xv[2][4];
#pragma unroll
                for (int ai = 0; ai < 2; ++ai)
#pragma unroll
                    for (int m = 0; m < 4; ++m) xv[ai][m] = *(const f32x4*)(xi + (size_t)(ai * HALF + wr * 64 + m * 16 + fr) * 2048 + col0 + bj * HALF + n * 16);
#pragma unroll
                for (int ai = 0; ai < 2; ++ai)
#pragma unroll
                    for (int m = 0; m < 4; ++m) *(f32x4*)(xo + (size_t)(ai * HALF + wr * 64 + m * 16 + fr) * 2048 + col0 + bj * HALF + n * 16) = xv[ai][m] + gg * acc[ai][bj][m][n];
                asm volatile("" ::: "memory"); }
    }
};
struct EpiDelta {
    static constexpr bool PERM = true, AFTER_DRAIN = false;
    bf16_t* D; const float* modl; int gidx;
    __device__ __forceinline__ void operator()(const f32x4 (&acc)[2][2][4][2], const Unit& u, int wr, int wc, int fr, int fq) const {
        asm volatile("" : "+v"(fr), "+v"(fq));
        const int b = u.pm / 65, tb = u.pm - b * 65; const bool isctx = (tb == 0);
        const float* gv = modl + (size_t)(isctx ? 2 : b) * 12288 + gidx * 2048;
        const int col0 = u.pn * BM + wc * 32 + 8 * fq;
#pragma unroll
        for (int bj = 0; bj < 2; ++bj) { const f32x4 g0 = *(const f32x4*)(gv + col0 + bj * HALF), g1 = *(const f32x4*)(gv + col0 + bj * HALF + 4);
#pragma unroll
            for (int ai = 0; ai < 2; ++ai)
#pragma unroll
                for (int m = 0; m < 4; ++m) { const f32x4 v0 = acc[ai][bj][m][0] * g0, v1 = acc[ai][bj][m][1] * g1;
                    u32x4 w; w.x = cvt_pk_bf16(v0[0], v0[1]); w.y = cvt_pk_bf16(v0[2], v0[3]); w.z = cvt_pk_bf16(v1[0], v1[1]); w.w = cvt_pk_bf16(v1[2], v1[3]);
                    *(u32x4*)(D + (size_t)(u.pm * BM + ai * HALF + wr * 64 + m * 16 + fr) * 2048 + col0 + bj * HALF) = w; } }
    }
};
struct EpiSwiGLU {
    static constexpr bool PERM = true, AFTER_DRAIN = false;
    bf16_t* hid; int ldh;
    __device__ __forceinline__ void operator()(const f32x4 (&acc)[2][2][4][2], const Unit& u, int wr, int wc, int fr, int fq) const {
        asm volatile("" : "+v"(fr), "+v"(fq));
        const int hc = u.pn * 128 + wc * 32 + 8 * fq;
#pragma unroll
        for (int ai = 0; ai < 2; ++ai)
#pragma unroll
            for (int m = 0; m < 4; ++m) { bf16_t* p = hid + (size_t)(u.pm * BM + ai * HALF + wr * 64 + m * 16 + fr) * ldh + hc;
                f32x4 v[2];
#pragma unroll
                for (int n = 0; n < 2; ++n) { const f32x4 g = acc[ai][0][m][n], up = acc[ai][1][m][n];
#pragma unroll
                    for (int e = 0; e < 4; ++e) v[n][e] = g[e] * sigm(g[e]) * up[e]; }
                u32x4 w; w.x = cvt_pk_bf16(v[0][0], v[0][1]); w.y = cvt_pk_bf16(v[0][2], v[0][3]); w.z = cvt_pk_bf16(v[1][0], v[1][1]); w.w = cvt_pk_bf16(v[1][2], v[1][3]);
                *(u32x4*)p = w; }
    }
};


struct EpiNone {
    static constexpr bool PERM = false, AFTER_DRAIN = false;
    float* sink;
    __device__ __forceinline__ void operator()(const f32x4 (&acc)[2][2][4][2], const Unit& u, int wr, int wc, int fr, int fq) const {
        asm volatile("" : "+v"(fr), "+v"(fq));
        if (u.pm < 0) {
#pragma unroll
            for (int ai = 0; ai < 2; ++ai)
#pragma unroll
                for (int bj = 0; bj < 2; ++bj)
#pragma unroll
                    for (int m = 0; m < 4; ++m)
#pragma unroll
                        for (int n = 0; n < 2; ++n) *(f32x4*)(sink + ((((ai * 2 + bj) * 4 + m) * 2 + n) * 64 + fr + 16 * fq) * 4) = acc[ai][bj][m][n];
        }
    }
};
template <class Epi, class Sched, bool ALIGN_EPI = false, bool SP2 = false>
__device__ __forceinline__ void gemm_phase(PG8_LAS unsigned char* lds, const Gemm g, const Sched& S, const Epi& E) {
    int tid_ = threadIdx.x; asm volatile("" : "+v"(tid_)); const int tid = tid_, wid = __builtin_amdgcn_readfirstlane(tid >> 6), lane = tid & 63, wr = wid >> 2, wc = wid & 3, fr = lane & 15, fq = lane >> 4;
    const int K = g.K, nt = K / BK;
    unsigned voffA[2], voffB[2];
#pragma unroll
    for (int i = 0; i < 2; ++i) { int R, C; stage_rc(tid * 16 + i * 8192, R, C); const int Rb = Epi::PERM ? ((R & ~31) + perm32(R & 31)) : R;
        voffA[i] = (unsigned)(R * g.lda + C) * 2u; voffB[i] = (unsigned)(Rb * K + C) * 2u; }
    const size_t kstep = (size_t)(BK * 2);
    const size_t hstepB = (size_t)HALF * K * 2, hstepA = (size_t)HALF * g.lda * 2;
    const size_t tstepA = 2 * hstepA, tstepB = 2 * hstepB;
    const unsigned ldsw = (unsigned)wid * 1024u;
    const int aoff = lds_byte(wr * 64 + fr, fq * 8), boff = lds_byte(wc * 32 + fr, fq * 8);
#define PG8_SA(b, h) (((b) * 2 + (h)) * HTB)
#define PG8_SB(b, h) ((4 + (b) * 2 + (h)) * HTB)
#define PG8_STAGE(bufoff, gbase, voff) do { _Pragma("unroll") for (int _i = 0; _i < 2; ++_i) \
        __builtin_amdgcn_global_load_lds((const unsigned*)((const char*)(gbase) + (voff)[_i]), (PG8_LAS unsigned*)(lds + (bufoff) + ldsw + _i * 8192), 16, 0, 0); } while (0)
#define PG8_LDA(dst, b, h) do { _Pragma("unroll") for (int m = 0; m < 4; ++m) _Pragma("unroll") for (int k = 0; k < 2; ++k) dst[m][k] = *(const PG8_LAS bf16x8*)(lds + PG8_SA(b, h) + aoff + m * 2048 + k * 1024); } while (0)
#define PG8_LDB(dst, b, h) do { _Pragma("unroll") for (int n = 0; n < 2; ++n) _Pragma("unroll") for (int k = 0; k < 2; ++k) dst[n][k] = *(const PG8_LAS bf16x8*)(lds + PG8_SB(b, h) + boff + n * 2048 + k * 1024); } while (0)
#define PG8_MMA(ai, bj, At, Bt) do { __builtin_amdgcn_s_setprio(1); _Pragma("unroll") for (int m = 0; m < 4; ++m) _Pragma("unroll") for (int n = 0; n < 2; ++n) _Pragma("unroll") for (int k = 0; k < 2; ++k) \
        acc[ai][bj][m][n] = __builtin_amdgcn_mfma_f32_16x16x32_bf16(Bt[n][k], At[m][k], acc[ai][bj][m][n], 0, 0, 0); __builtin_amdgcn_s_setprio(0); } while (0)
#define PG8_WAIT_V(n) asm volatile("s_waitcnt vmcnt(" #n ")" ::: "memory")
#define PG8_WAIT_L(n) asm volatile("s_waitcnt lgkmcnt(" #n ")" ::: "memory")
#define PG8_BAR __builtin_amdgcn_s_barrier()
#define PG8_SCHED __builtin_amdgcn_sched_barrier(0)
    Unit cur, nxt; int ui = 0;
    if (!S.next(0, cur)) return;
    f32x4 acc[2][2][4][2];
#pragma unroll
    for (int a = 0; a < 2; ++a)
#pragma unroll
        for (int b = 0; b < 2; ++b)
#pragma unroll
            for (int m = 0; m < 4; ++m)
#pragma unroll
                for (int n = 0; n < 2; ++n) acc[a][b][m][n] = (f32x4){0.f, 0.f, 0.f, 0.f};
    bf16x8 At[4][2], B0[2][2], B1[2][2];
    const char* cA = (const char*)g.A + (size_t)cur.pm * tstepA + (g.agrp ? (size_t)(cur.pn / g.agrp) * g.agstride * 2 : 0); const char* cB = (const char*)g.Bt + (size_t)cur.pn * tstepB;
    S.a_ready(cur);
    if constexpr (SP2) {
        PG8_STAGE(PG8_SB(0, 0), cB, voffB); PG8_STAGE(PG8_SB(0, 1), cB + hstepB, voffB); PG8_STAGE(PG8_SA(0, 0), cA, voffA); PG8_STAGE(PG8_SA(0, 1), cA + hstepA, voffA);
        if (wr == 1) PG8_BAR;
        PG8_WAIT_V(2); PG8_BAR;
        PG8_STAGE(PG8_SB(1, 0), cB + kstep, voffB); PG8_STAGE(PG8_SA(1, 0), cA + kstep, voffA); PG8_STAGE(PG8_SB(1, 1), cB + hstepB + kstep, voffB);
        PG8_WAIT_V(6); PG8_BAR;
    } else {
        PG8_STAGE(PG8_SB(0, 0), cB, voffB); PG8_STAGE(PG8_SA(0, 0), cA, voffA); PG8_STAGE(PG8_SB(0, 1), cB + hstepB, voffB); PG8_STAGE(PG8_SA(0, 1), cA + hstepA, voffA);
        if (wr == 1) PG8_BAR;
        PG8_WAIT_V(4); PG8_BAR;
        PG8_STAGE(PG8_SB(1, 0), cB + kstep, voffB); PG8_STAGE(PG8_SA(1, 0), cA + kstep, voffA); PG8_STAGE(PG8_SB(1, 1), cB + hstepB + kstep, voffB);
        PG8_WAIT_V(6); PG8_BAR;
    }
    for (;;) {
        const bool has_next = S.next(ui + 1, nxt);
        const char* nA = has_next ? (const char*)g.A + (size_t)nxt.pm * tstepA + (g.agrp ? (size_t)(nxt.pn / g.agrp) * g.agstride * 2 : 0) : cA; const char* nB = has_next ? (const char*)g.Bt + (size_t)nxt.pn * tstepB : cB;
        for (int t = 0; t < nt; t += 2) {
            const bool last = (t == nt - 2);
            const char* a1 = cA + (size_t)(t + 1) * kstep;
            const char* a2 = last ? nA : cA + (size_t)(t + 2) * kstep; const char* b2 = last ? nB : cB + (size_t)(t + 2) * kstep;
            const char* a3 = a2 + kstep; const char* b3 = b2 + kstep;
            if (last && has_next) S.a_ready(nxt);
            if constexpr (SP2) {
            PG8_LDB(B0, 0, 0); PG8_LDB(B1, 0, 1); PG8_SCHED; PG8_LDA(At, 0, 0); PG8_STAGE(PG8_SA(1, 1), a1 + hstepA, voffA);
            PG8_WAIT_V(8); PG8_WAIT_L(0); PG8_BAR; PG8_MMA(0, 0, At, B0); PG8_MMA(0, 1, At, B1); PG8_BAR; PG8_SCHED;
            PG8_LDA(At, 0, 1); PG8_STAGE(PG8_SB(0, 0), b2, voffB); PG8_STAGE(PG8_SB(0, 1), b2 + hstepB, voffB); PG8_STAGE(PG8_SA(0, 0), a2, voffA);
            PG8_WAIT_V(8); PG8_WAIT_L(0); PG8_BAR; PG8_MMA(1, 0, At, B0); PG8_MMA(1, 1, At, B1); PG8_BAR; PG8_SCHED;
            PG8_LDB(B0, 1, 0); PG8_LDB(B1, 1, 1); PG8_SCHED; PG8_LDA(At, 1, 0); PG8_STAGE(PG8_SA(0, 1), a2 + hstepA, voffA);
            PG8_WAIT_V(8); PG8_WAIT_L(0); PG8_BAR; PG8_MMA(0, 0, At, B0); PG8_MMA(0, 1, At, B1); PG8_BAR; PG8_SCHED;
            PG8_LDA(At, 1, 1); PG8_STAGE(PG8_SB(1, 0), b3, voffB); PG8_STAGE(PG8_SB(1, 1), b3 + hstepB, voffB); PG8_STAGE(PG8_SA(1, 0), a3, voffA);
            PG8_WAIT_V(8); PG8_WAIT_L(0); PG8_BAR; PG8_MMA(1, 0, At, B0); PG8_MMA(1, 1, At, B1); PG8_BAR; PG8_SCHED;
            } else {
            PG8_LDB(B0, 0, 0); PG8_SCHED; PG8_LDA(At, 0, 0); PG8_STAGE(PG8_SA(1, 1), a1 + hstepA, voffA);
            PG8_WAIT_L(8); PG8_BAR; PG8_WAIT_L(0); PG8_MMA(0, 0, At, B0); PG8_BAR; PG8_SCHED;
            PG8_LDB(B1, 0, 1); PG8_STAGE(PG8_SB(0, 0), b2, voffB);
            PG8_BAR; PG8_WAIT_L(0); PG8_MMA(0, 1, At, B1); PG8_BAR;
            PG8_LDA(At, 0, 1); PG8_STAGE(PG8_SA(0, 0), a2, voffA);
            PG8_BAR; PG8_WAIT_L(0); PG8_MMA(1, 0, At, B0); PG8_BAR; PG8_SCHED;
            PG8_STAGE(PG8_SB(0, 1), b2 + hstepB, voffB);
            PG8_WAIT_V(6); PG8_BAR; PG8_MMA(1, 1, At, B1); PG8_BAR;
            PG8_LDB(B0, 1, 0); PG8_SCHED; PG8_LDA(At, 1, 0); PG8_STAGE(PG8_SA(0, 1), a2 + hstepA, voffA);
            PG8_WAIT_L(8); PG8_BAR; PG8_WAIT_L(0); PG8_MMA(0, 0, At, B0); PG8_BAR; PG8_SCHED;
            PG8_LDB(B1, 1, 1); PG8_STAGE(PG8_SB(1, 0), b3, voffB);
            PG8_BAR; PG8_WAIT_L(0); PG8_MMA(0, 1, At, B1); PG8_BAR;
            PG8_LDA(At, 1, 1); PG8_STAGE(PG8_SA(1, 0), a3, voffA);
            PG8_BAR; PG8_WAIT_L(0); PG8_MMA(1, 0, At, B0); PG8_BAR; PG8_SCHED;
            PG8_STAGE(PG8_SB(1, 1), b3 + hstepB, voffB);
            PG8_WAIT_V(6); PG8_BAR; PG8_MMA(1, 1, At, B1); PG8_BAR;
            }
        }
        if constexpr (ALIGN_EPI) { if (wr == 0) PG8_BAR; }
        if constexpr (!Epi::AFTER_DRAIN) { E(acc, cur, wr, wc, fr, fq); S.done(cur); }
        if (!has_next) break;
#pragma unroll
        for (int a = 0; a < 2; ++a)
#pragma unroll
            for (int b = 0; b < 2; ++b)
#pragma unroll
                for (int m = 0; m < 4; ++m)
#pragma unroll
                    for (int n = 0; n < 2; ++n) acc[a][b][m][n] = (f32x4){0.f, 0.f, 0.f, 0.f};
        cur = nxt; cA = nA; cB = nB; ++ui;
        if constexpr (ALIGN_EPI) { if (wr == 1) PG8_BAR; }
    }
    PG8_WAIT_V(0);
    if constexpr (!ALIGN_EPI) { if (wr == 0) PG8_BAR; }
    PG8_BAR;
    if constexpr (Epi::AFTER_DRAIN) { E.fused(acc, cur, wr, wc, fr, fq, lds, wid, lane); S.done(cur); }
#undef PG8_SA
#undef PG8_SB
#undef PG8_STAGE
#undef PG8_LDA
#undef PG8_LDB
#undef PG8_MMA
#undef PG8_WAIT_V
#undef PG8_WAIT_L
#undef PG8_BAR
#undef PG8_SCHED
}
}
#ifndef ATT_SDEPTH
#define ATT_SDEPTH 1
#endif
namespace att {
using bf16 = __hip_bfloat16;
constexpr int NW = 8, QBLK = 32, KVBLK = 64, SDEPTH = ATT_SDEPTH;
constexpr float THR = 8.f;
constexpr size_t SHM_V = KVBLK * 128 * 2, SHM_K = KVBLK * 128 * 2, SHM_ATTN = 2 * SHM_V + 2 * SHM_K + NW * 64 * 4;
using bf16x8 = __attribute__((ext_vector_type(8))) short;
using s16x4  = __attribute__((ext_vector_type(4))) short;
using f32x16 = __attribute__((ext_vector_type(16))) float;
using f32x8  = __attribute__((ext_vector_type(8))) float;
using u32x4  = __attribute__((ext_vector_type(4))) unsigned;
#define KSWZ(row, colB) ((row) * 256 + ((colB) ^ (((row) & 7) << 4)))
#define SBAR() __builtin_amdgcn_sched_barrier(0)
__device__ __forceinline__ int crow(int r, int hi) { return (r & 3) + 8 * (r >> 2) + 4 * hi; }
__device__ __forceinline__ unsigned cvtpk(float lo, float hi) {
  unsigned r; asm volatile("v_cvt_pk_bf16_f32 %0, %1, %2" : "=v"(r) : "v"(lo), "v"(hi)); return r;
}
template <int DQK> __device__ __forceinline__ void partialSM(f32x16& p0, f32x16& p1, float& m_reg, float& mn, float& alpha) {
  constexpr float SCALE = (DQK == 64) ? 0.125f : 0.088388347648318440f; constexpr float C = SCALE * 1.4426950408889634f;
  float pmax = p0[0]; for (int r = 1; r < 16; ++r) pmax = fmaxf(pmax, p0[r]); for (int r = 0; r < 16; ++r) pmax = fmaxf(pmax, p1[r]);
  { auto rr = __builtin_amdgcn_permlane32_swap(__float_as_uint(pmax), __float_as_uint(pmax), false, false);
    pmax = fmaxf(__uint_as_float(rr[0]), __uint_as_float(rr[1])); }
  if (__builtin_expect(__all(pmax - m_reg <= THR / SCALE), 1)) { mn = m_reg; alpha = 1.f; }
  else { mn = fmaxf(m_reg, pmax); alpha = __builtin_amdgcn_exp2f((m_reg - mn) * C); m_reg = mn; }
  float mnC = -mn * C;
  for (int r = 0; r < 16; ++r) p0[r] = fmaf(p0[r], C, mnC); for (int r = 0; r < 16; ++r) p1[r] = fmaf(p1[r], C, mnC);
  for (int r = 0; r < 16; ++r) p0[r] = __builtin_amdgcn_exp2f(p0[r]);
}
__device__ __forceinline__ void finishSM(f32x16& p0, f32x16& p1, float alpha, float& l_reg, bf16x8& pa0, bf16x8& pa1, bf16x8& pa2, bf16x8& pa3) {
  for (int r = 0; r < 16; ++r) p1[r] = __builtin_amdgcn_exp2f(p1[r]);
  float ps = 0; for (int r = 0; r < 16; ++r) ps += p0[r]; for (int r = 0; r < 16; ++r) ps += p1[r];
  { auto rr = __builtin_amdgcn_permlane32_swap(__float_as_uint(ps), __float_as_uint(ps), false, false);
    ps = __uint_as_float(rr[0]) + __uint_as_float(rr[1]); }
  l_reg = l_reg * alpha + ps;
#define PK4(P, BASE, OUT) do { unsigned a0 = cvtpk(P[BASE + 0], P[BASE + 1]), a1 = cvtpk(P[BASE + 2], P[BASE + 3]);   \
    unsigned b0 = cvtpk(P[BASE + 4], P[BASE + 5]), b1 = cvtpk(P[BASE + 6], P[BASE + 7]);                              \
    auto r0 = __builtin_amdgcn_permlane32_swap(a0, b0, false, false); auto r1 = __builtin_amdgcn_permlane32_swap(a1, b1, false, false); \
    u32x4 w = {r0[0], r1[0], r0[1], r1[1]}; OUT = *reinterpret_cast<bf16x8*>(&w); } while (0)
  PK4(p0, 0, pa0); PK4(p0, 8, pa1); PK4(p1, 0, pa2); PK4(p1, 8, pa3);
#undef PK4
}
template <int DQK> __device__ __forceinline__ void qkt(f32x16& p0, f32x16& p1, const bf16* Ks, const bf16x8* qr, int r32, int hi, int kcol0) {
  p0 = f32x16{}; p1 = f32x16{};
#pragma unroll
  for (int d0 = 0; d0 < DQK / 16; ++d0) { int cb = (kcol0 + d0 * 16 + hi * 8) * 2;
    bf16x8 b0 = *reinterpret_cast<const bf16x8*>((const char*)Ks + KSWZ(r32, cb));
    bf16x8 b1 = *reinterpret_cast<const bf16x8*>((const char*)Ks + KSWZ(32 + r32, cb));
    p0 = __builtin_amdgcn_mfma_f32_32x32x16_bf16(b0, qr[d0], p0, 0, 0, 0);
    p1 = __builtin_amdgcn_mfma_f32_32x32x16_bf16(b1, qr[d0], p1, 0, 0, 0); }
}
__device__ __forceinline__ void qktn(f32x16& p0, f32x16& p1, const bf16* Ks, const bf16x8* qr, int r32, int hi, int kcol0, const f32x16& negm) {
#pragma unroll
  for (int d0 = 0; d0 < 4; ++d0) { int cb = (kcol0 + d0 * 16 + hi * 8) * 2;
    bf16x8 b0 = *reinterpret_cast<const bf16x8*>((const char*)Ks + KSWZ(r32, cb));
    bf16x8 b1 = *reinterpret_cast<const bf16x8*>((const char*)Ks + KSWZ(32 + r32, cb));
    if (d0 == 0) { p0 = __builtin_amdgcn_mfma_f32_32x32x16_bf16(b0, qr[0], negm, 0, 0, 0); p1 = __builtin_amdgcn_mfma_f32_32x32x16_bf16(b1, qr[0], negm, 0, 0, 0); }
    else { p0 = __builtin_amdgcn_mfma_f32_32x32x16_bf16(b0, qr[d0], p0, 0, 0, 0); p1 = __builtin_amdgcn_mfma_f32_32x32x16_bf16(b1, qr[d0], p1, 0, 0, 0); } }
}
template <bool FIRST> __device__ __forceinline__ void partialSMn(f32x16& p0, f32x16& p1, float& mref, f32x16& negm, float& alpha) {
  constexpr float THRL = THR * 1.4426950408889634f;
  float pmax = p0[0]; for (int r = 1; r < 16; ++r) pmax = fmaxf(pmax, p0[r]); for (int r = 0; r < 16; ++r) pmax = fmaxf(pmax, p1[r]);
  { auto rr = __builtin_amdgcn_permlane32_swap(__float_as_uint(pmax), __float_as_uint(pmax), false, false);
    pmax = fmaxf(__uint_as_float(rr[0]), __uint_as_float(rr[1])); }
  if (!FIRST && __builtin_expect(__all(pmax <= THRL), 1)) { alpha = 1.f; }
  else { const float dl = FIRST ? pmax : fmaxf(pmax, 0.f); mref += dl; alpha = FIRST ? 1.f : __builtin_amdgcn_exp2f(-dl);
    for (int r = 0; r < 16; ++r) { p0[r] -= dl; p1[r] -= dl; }
    const float nm = -mref; for (int r = 0; r < 16; ++r) negm[r] = nm; }
  for (int r = 0; r < 16; ++r) p0[r] = __builtin_amdgcn_exp2f(p0[r]);
}
__device__ __forceinline__ int v_st(int k, int c) { const int kk = (k & ~0xC) | ((k & 4) << 1) | ((k & 8) >> 1); return ((kk >> 3) * 4 + (c >> 5)) * 512 + ((kk & 7) * 32 + (c & 31)) * 2; }
__device__ __forceinline__ int v_rd_base(int lane) { return ((lane & 3) << 3) | (((lane >> 2) & 3) << 6) | (((lane >> 4) & 1) << 5) | (((lane >> 5) & 1) << 8); }
constexpr int v_rd_off(int d0, int ks, int half) { return d0 * 512 + ks * 4096 + half * 2048; }
template <int OFF> __device__ __forceinline__ s16x4 tr_read(int vb) {
  s16x4 r; asm volatile("ds_read_b64_tr_b16 %0, %1 offset:%2" : "=&v"(r) : "v"(vb), "i"(OFF) : "memory"); return r;
}
template <int D0> __device__ __forceinline__ void pv_one(f32x16& od, int vb, bf16x8 pa0, bf16x8 pa1, bf16x8 pa2, bf16x8 pa3) {
  const s16x4 l0 = tr_read<v_rd_off(D0, 0, 0)>(vb), h0 = tr_read<v_rd_off(D0, 0, 1)>(vb), l1 = tr_read<v_rd_off(D0, 1, 0)>(vb), h1 = tr_read<v_rd_off(D0, 1, 1)>(vb);
  const s16x4 l2 = tr_read<v_rd_off(D0, 2, 0)>(vb), h2 = tr_read<v_rd_off(D0, 2, 1)>(vb), l3 = tr_read<v_rd_off(D0, 3, 0)>(vb), h3 = tr_read<v_rd_off(D0, 3, 1)>(vb);
  asm volatile("s_waitcnt lgkmcnt(0)" ::: "memory"); SBAR();
#define PK(L, H) (bf16x8){L[0], L[1], L[2], L[3], H[0], H[1], H[2], H[3]}
  od = __builtin_amdgcn_mfma_f32_32x32x16_bf16(pa0, PK(l0, h0), od, 0, 0, 0);
  od = __builtin_amdgcn_mfma_f32_32x32x16_bf16(pa1, PK(l1, h1), od, 0, 0, 0);
  od = __builtin_amdgcn_mfma_f32_32x32x16_bf16(pa2, PK(l2, h2), od, 0, 0, 0);
  od = __builtin_amdgcn_mfma_f32_32x32x16_bf16(pa3, PK(l3, h3), od, 0, 0, 0);
#undef PK
}
template <int KS> __device__ __forceinline__ void pv_ks(f32x16* o, int vb, bf16x8 pa) {
  const s16x4 l0 = tr_read<v_rd_off(0, KS, 0)>(vb), h0 = tr_read<v_rd_off(0, KS, 1)>(vb), l1 = tr_read<v_rd_off(1, KS, 0)>(vb), h1 = tr_read<v_rd_off(1, KS, 1)>(vb);
  const s16x4 l2 = tr_read<v_rd_off(2, KS, 0)>(vb), h2 = tr_read<v_rd_off(2, KS, 1)>(vb), l3 = tr_read<v_rd_off(3, KS, 0)>(vb), h3 = tr_read<v_rd_off(3, KS, 1)>(vb);
  asm volatile("s_waitcnt lgkmcnt(0)" ::: "memory"); SBAR();
#define PK(L, H) (bf16x8){L[0], L[1], L[2], L[3], H[0], H[1], H[2], H[3]}
  o[0] = __builtin_amdgcn_mfma_f32_32x32x16_bf16(pa, PK(l0, h0), o[0], 0, 0, 0);
  o[1] = __builtin_amdgcn_mfma_f32_32x32x16_bf16(pa, PK(l1, h1), o[1], 0, 0, 0);
  o[2] = __builtin_amdgcn_mfma_f32_32x32x16_bf16(pa, PK(l2, h2), o[2], 0, 0, 0);
  o[3] = __builtin_amdgcn_mfma_f32_32x32x16_bf16(pa, PK(l3, h3), o[3], 0, 0, 0);
#undef PK
}
#define PVR(D0, l0, h0, l1, h1, l2, h2, l3, h3) const s16x4 l0 = tr_read<v_rd_off(D0, 0, 0)>(vb), h0 = tr_read<v_rd_off(D0, 0, 1)>(vb), l1 = tr_read<v_rd_off(D0, 1, 0)>(vb), h1 = tr_read<v_rd_off(D0, 1, 1)>(vb), \
    l2 = tr_read<v_rd_off(D0, 2, 0)>(vb), h2 = tr_read<v_rd_off(D0, 2, 1)>(vb), l3 = tr_read<v_rd_off(D0, 3, 0)>(vb), h3 = tr_read<v_rd_off(D0, 3, 1)>(vb)
#define PK(L, H) (bf16x8){L[0], L[1], L[2], L[3], H[0], H[1], H[2], H[3]}
#define PVM(od, l0, h0, l1, h1, l2, h2, l3, h3) do { od = __builtin_amdgcn_mfma_f32_32x32x16_bf16(pa0, PK(l0, h0), od, 0, 0, 0); od = __builtin_amdgcn_mfma_f32_32x32x16_bf16(pa1, PK(l1, h1), od, 0, 0, 0); \
    od = __builtin_amdgcn_mfma_f32_32x32x16_bf16(pa2, PK(l2, h2), od, 0, 0, 0); od = __builtin_amdgcn_mfma_f32_32x32x16_bf16(pa3, PK(l3, h3), od, 0, 0, 0); } while (0)
__device__ __forceinline__ void pv_d0(f32x16* o, int vb, bf16x8 pa0, bf16x8 pa1, bf16x8 pa2, bf16x8 pa3) {
#ifndef PV_PIPE
  pv_one<0>(o[0], vb, pa0, pa1, pa2, pa3); pv_one<1>(o[1], vb, pa0, pa1, pa2, pa3); pv_one<2>(o[2], vb, pa0, pa1, pa2, pa3); pv_one<3>(o[3], vb, pa0, pa1, pa2, pa3);
#else
  PVR(0, a0, a1, a2, a3, a4, a5, a6, a7);
  PVR(1, b0, b1, b2, b3, b4, b5, b6, b7);
  asm volatile("s_waitcnt lgkmcnt(8)" ::: "memory"); SBAR();
  PVM(o[0], a0, a1, a2, a3, a4, a5, a6, a7); SBAR();
  PVR(2, c0, c1, c2, c3, c4, c5, c6, c7);
  asm volatile("s_waitcnt lgkmcnt(8)" ::: "memory"); SBAR();
  PVM(o[1], b0, b1, b2, b3, b4, b5, b6, b7); SBAR();
  PVR(3, d0, d1, d2, d3, d4, d5, d6, d7);
  asm volatile("s_waitcnt lgkmcnt(8)" ::: "memory"); SBAR();
  PVM(o[2], c0, c1, c2, c3, c4, c5, c6, c7); SBAR();
  asm volatile("s_waitcnt lgkmcnt(0)" ::: "memory"); SBAR();
  PVM(o[3], d0, d1, d2, d3, d4, d5, d6, d7);
#endif
}
#undef PVR
#undef PVM
#undef PK
constexpr int STASH_OFF = 67584;
template <int DQK, int LDO, int MODE = 0>
__device__ __forceinline__ void attn_dense_body(const bf16* __restrict__ Qb, const bf16* __restrict__ Kh, const bf16* __restrict__ Vh,
                                                bf16* __restrict__ Ob, int seq, int kcol0, char* lds, float lam = 0.f, const float* __restrict__ gvec = nullptr, float gmul = 1.f) {
  constexpr int LDQ = PP, LDK = PP;
  constexpr float SCALE = (DQK == 64) ? 0.125f : 0.088388347648318440f;
  int tid = threadIdx.x; asm volatile("" : "+v"(tid)); const int wid = tid >> 6, lane = tid & 63, r32 = lane & 31, hi = lane >> 5;
  if (__builtin_amdgcn_readfirstlane(tid) >= 256) __builtin_amdgcn_s_setprio(1);
  bf16* V_lds = (bf16*)lds; bf16* K_lds = (bf16*)(lds + 2 * SHM_V);
  float* ws = (float*)(lds + 2 * SHM_V + 2 * SHM_K) + wid * 64; float* li_l = ws; float* al_l = ws + 32;
  float m_reg = (DQK == 64) ? 0.f : -1e30f, l_reg = 0; f32x16 o[4] = {}; bf16x8 qr[DQK / 16];
  f32x16 negm = {};
  const bf16* Qw = Qb + (long)(wid * QBLK + r32) * LDQ + hi * 8;
#pragma unroll
  for (int d0 = 0; d0 < DQK / 16; ++d0) qr[d0] = *reinterpret_cast<const bf16x8*>(Qw + d0 * 16);
  const int sr = tid >> 4, sc = (tid & 15) * 8, vst0 = v_st(sr, sc), vst1 = v_st(32 + sr, sc);
  const int vb0 = (int)(uintptr_t)V_lds + v_rd_base(lane);
  struct { bf16x8 vs0, vs1, ks0, ks1; } sr_[SDEPTH];
#define SLOAD(i, k0) do { sr_[i].vs0 = *reinterpret_cast<const bf16x8*>(&Vh[(long)((k0) + sr) * LDK + sc]); sr_[i].vs1 = *reinterpret_cast<const bf16x8*>(&Vh[(long)((k0) + 32 + sr) * LDK + sc]); \
    sr_[i].ks0 = *reinterpret_cast<const bf16x8*>(&Kh[(long)((k0) + sr) * LDK + sc]); sr_[i].ks1 = *reinterpret_cast<const bf16x8*>(&Kh[(long)((k0) + 32 + sr) * LDK + sc]); } while (0)
#define SWRITE(b, i) do { *(bf16x8*)((char*)V_lds + (b) * SHM_V + vst0) = sr_[i].vs0;          \
    *(bf16x8*)((char*)V_lds + (b) * SHM_V + vst1) = sr_[i].vs1; int kc = sc * 2;               \
    *(bf16x8*)((char*)K_lds + (b) * SHM_K + KSWZ(sr, kc)) = sr_[i].ks0;                       \
    *(bf16x8*)((char*)K_lds + (b) * SHM_K + KSWZ(32 + sr, kc)) = sr_[i].ks1; } while (0)
#define SWAIT() do { if constexpr (SDEPTH == 2) asm volatile("s_waitcnt vmcnt(4)" ::: "memory"); else asm volatile("s_waitcnt vmcnt(0)" ::: "memory"); } while (0)
#define RESC(a) do { if (__any((a) < 1.f)) { if (hi == 0) al_l[r32] = (a); asm volatile("s_waitcnt lgkmcnt(0)" ::: "memory"); \
    for (int d = 0; d < 4; ++d) for (int r = 0; r < 16; ++r) o[d][r] *= al_l[crow(r, hi)]; } } while (0)
  f32x16 pA0, pA1, pB0, pB1; float mnA, mnB, alA, alB; bf16x8 pa0, pa1, pa2, pa3; const int NT = seq / KVBLK;
  constexpr int SE = 0, SO = SDEPTH - 1;
  SLOAD(SE, 0); asm volatile("s_waitcnt vmcnt(0)" ::: "memory"); SWRITE(0, SE); __syncthreads();
  if constexpr (DQK == 64) { qktn(pA0, pA1, K_lds, qr, r32, hi, kcol0, negm); partialSMn<true>(pA0, pA1, m_reg, negm, alA); }
  else { qkt<DQK>(pA0, pA1, K_lds, qr, r32, hi, kcol0); partialSM<DQK>(pA0, pA1, m_reg, mnA, alA); }
  SLOAD(SO, KVBLK); if constexpr (SDEPTH == 2) { if (2 < NT) SLOAD(SE, 2 * KVBLK); }
  SWAIT(); SWRITE(1, SO); __syncthreads();
  for (int j = 1; j + 1 < NT; j += 2) {
    SBAR(); if constexpr (DQK == 64) qktn(pB0, pB1, (bf16*)((char*)K_lds + SHM_K), qr, r32, hi, kcol0, negm); else qkt<DQK>(pB0, pB1, (bf16*)((char*)K_lds + SHM_K), qr, r32, hi, kcol0);
    finishSM(pA0, pA1, alA, l_reg, pa0, pa1, pa2, pa3); SBAR();
    SLOAD(SO, (j + SDEPTH) * KVBLK); SBAR();
    pv_d0(o, vb0, pa0, pa1, pa2, pa3); if constexpr (DQK == 64) partialSMn<false>(pB0, pB1, m_reg, negm, alB); else partialSM<DQK>(pB0, pB1, m_reg, mnB, alB);
    __syncthreads(); SWAIT(); SWRITE(0, SE);
    RESC(alB); __syncthreads();
    SBAR(); if constexpr (DQK == 64) qktn(pA0, pA1, K_lds, qr, r32, hi, kcol0, negm); else qkt<DQK>(pA0, pA1, K_lds, qr, r32, hi, kcol0);
    finishSM(pB0, pB1, alB, l_reg, pa0, pa1, pa2, pa3); SBAR();
    if (SDEPTH == 1 || j + 3 < NT) SLOAD(SE, (j + 1 + SDEPTH) * KVBLK); SBAR();
    pv_d0(o, vb0 + (int)SHM_V, pa0, pa1, pa2, pa3); if constexpr (DQK == 64) partialSMn<false>(pA0, pA1, m_reg, negm, alA); else partialSM<DQK>(pA0, pA1, m_reg, mnA, alA);
    __syncthreads(); SWAIT(); SWRITE(1, SO);
    RESC(alA); __syncthreads();
  }
  SBAR(); if constexpr (DQK == 64) qktn(pB0, pB1, (bf16*)((char*)K_lds + SHM_K), qr, r32, hi, kcol0, negm); else qkt<DQK>(pB0, pB1, (bf16*)((char*)K_lds + SHM_K), qr, r32, hi, kcol0);
  finishSM(pA0, pA1, alA, l_reg, pa0, pa1, pa2, pa3); SBAR();
  pv_d0(o, vb0, pa0, pa1, pa2, pa3); if constexpr (DQK == 64) partialSMn<false>(pB0, pB1, m_reg, negm, alB); else partialSM<DQK>(pB0, pB1, m_reg, mnB, alB);
  __syncthreads(); RESC(alB);
  finishSM(pB0, pB1, alB, l_reg, pa0, pa1, pa2, pa3); SBAR();
  pv_d0(o, vb0 + (int)SHM_V, pa0, pa1, pa2, pa3);
  if (hi == 0) li_l[r32] = l_reg; asm volatile("s_waitcnt lgkmcnt(0)" ::: "memory");
  float rli[16];
#pragma unroll
  for (int r = 0; r < 16; ++r) rli[r] = __builtin_amdgcn_rcpf(li_l[crow(r, hi)]);
  if constexpr (MODE == 0) {
  bf16* Ow = Ob + (long)(wid * QBLK) * LDO;
#pragma unroll
  for (int r = 0; r < 16; ++r) { int orow = crow(r, hi);
    for (int d0 = 0; d0 < 4; ++d0) Ow[(long)orow * LDO + d0 * 32 + r32] = __float2bfloat16(o[d0][r] * rli[r]); }
  } else if constexpr (MODE == 1) {
  bf16* st = (bf16*)(lds + STASH_OFF) + (wid * QBLK) * 128;
#pragma unroll
  for (int r = 0; r < 16; ++r) { int orow = crow(r, hi);
    for (int d0 = 0; d0 < 4; ++d0) st[orow * 128 + d0 * 32 + r32] = __float2bfloat16(o[d0][r] * rli[r]); }
  } else {
  const bf16* st = (const bf16*)(lds + STASH_OFF) + (wid * QBLK) * 128;
  float ssq[16];
#pragma unroll
  for (int r = 0; r < 16; ++r) { int orow = crow(r, hi); float s = 0.f;
    for (int d0 = 0; d0 < 4; ++d0) { const float v = __bfloat162float(st[orow * 128 + d0 * 32 + r32]) - lam * (o[d0][r] * rli[r]); o[d0][r] = v; s += v * v; }
    s += __shfl_xor(s, 1); s += __shfl_xor(s, 2); s += __shfl_xor(s, 4); s += __shfl_xor(s, 8); s += __shfl_xor(s, 16);
    ssq[r] = 1.0f / sqrtf(s * (1.f / 128.f) + NORM_EPS); }
  bf16* Ow = Ob + (long)(wid * QBLK) * LDO;
#pragma unroll
  for (int d0 = 0; d0 < 4; ++d0) { const float gm = gvec[d0 * 32 + r32] * gmul;
#pragma unroll
    for (int r = 0; r < 16; ++r) Ow[(long)crow(r, hi) * LDO + d0 * 32 + r32] = __float2bfloat16(o[d0][r] * ssq[r] * gm); }
  }
  __builtin_amdgcn_s_setprio(0);
#undef SLOAD
#undef SWRITE
#undef SWAIT
#undef RESC
}

__device__ __forceinline__ void swa_unit(const bf16* __restrict__ P, bf16* __restrict__ Y, int bb, int kvh, int qblk, bool isctx, const float* __restrict__ sinkl, char* lds) {
  constexpr float SCALE = 0.125f;
  int tid = threadIdx.x; asm volatile("" : "+v"(tid)); const int wid = tid >> 6, lane = tid & 63, r32 = lane & 31, hi = lane >> 5;
  if (__builtin_amdgcn_readfirstlane(tid) >= 256) __builtin_amdgcn_s_setprio(1);
  const int head = kvh * 4 + (wid & 3), half = wid >> 2;
  bf16* V_lds = (bf16*)lds; bf16* K_lds = (bf16*)(lds + 2 * SHM_V);
  float* ws = (float*)(lds + 2 * SHM_V + 2 * SHM_K) + wid * 64; float* li_l = ws; float* al_l = ws + 32;
  const long rowq0 = (long)bb * TPB + (isctx ? 0 : CTX) + qblk * 64 + half * 32;
  const bf16* Qw = P + (rowq0 + r32) * PP + C_SQ + head * 64 + hi * 8;
  bf16x8 qr[4];
#pragma unroll
  for (int d0 = 0; d0 < 4; ++d0) qr[d0] = *reinterpret_cast<const bf16x8*>(Qw + d0 * 16);
  float m_reg = sinkl[head] * (1.f / SCALE), l_reg = 1.f; f32x16 o[2] = {};
  const int sr = tid >> 3, sc = (tid & 7) * 8, vst = v_st(sr, sc);
  const int vb0 = (int)(uintptr_t)V_lds + v_rd_base(lane);
  const int qpos = qblk * 64 + half * 32 + r32;
  int jlo = 0, nband = 0;
  if (!isctx) { const int q0 = qblk * 64; jlo = (q0 >= 128) ? 0 : (128 - q0) / 64; int jhi = (SEQ - 64 - q0 + 128) / 64; if (jhi > 4) jhi = 4; nband = jhi - jlo + 1; }
  const int ntile = 4 + nband;
  const long kbase = (long)bb * TPB;
#define SWA_KROW(tt) ((tt) < 4 ? kbase + (tt) * 64 : kbase + CTX + (qblk * 64 - 128 + ((tt) - 4 + jlo) * 64))
  bf16x8 kreg, vreg;
  { const long kr = SWA_KROW(0); kreg = *reinterpret_cast<const bf16x8*>(P + (kr + sr) * PP + C_SK + kvh * 64 + sc); vreg = *reinterpret_cast<const bf16x8*>(P + (kr + sr) * PP + C_SV + kvh * 64 + sc); }
  __syncthreads();
  for (int t = 0; t < ntile; ++t) {
    const int buf = t & 1; const bool band = (t >= 4); const int kpos0 = qblk * 64 - 128 + (t - 4 + jlo) * 64;
    *(bf16x8*)((char*)K_lds + buf * SHM_K + KSWZ(sr, sc * 2)) = kreg; *(bf16x8*)((char*)V_lds + buf * SHM_V + vst) = vreg;
    if (t + 1 < ntile) { const long kr = SWA_KROW(t + 1); kreg = *reinterpret_cast<const bf16x8*>(P + (kr + sr) * PP + C_SK + kvh * 64 + sc); vreg = *reinterpret_cast<const bf16x8*>(P + (kr + sr) * PP + C_SV + kvh * 64 + sc); }
    __syncthreads();
    f32x16 p0, p1; float mn, alpha; bf16x8 pa0, pa1, pa2, pa3;
    qkt<64>(p0, p1, (const bf16*)((const char*)K_lds + buf * SHM_K), qr, r32, hi, 0);
    if (band) {
#pragma unroll
      for (int r = 0; r < 16; ++r) { const int d0_ = qpos - (kpos0 + crow(r, hi)); if (d0_ > 128 || d0_ < -128) p0[r] = -1e30f; const int d1_ = d0_ - 32; if (d1_ > 128 || d1_ < -128) p1[r] = -1e30f; }
    }
    partialSM<64>(p0, p1, m_reg, mn, alpha);
    if (__any(alpha < 1.f)) { if (hi == 0) al_l[r32] = alpha; asm volatile("s_waitcnt lgkmcnt(0)" ::: "memory");
#pragma unroll
      for (int d = 0; d < 2; ++d)
#pragma unroll
        for (int r = 0; r < 16; ++r) o[d][r] *= al_l[crow(r, hi)]; }
    finishSM(p0, p1, alpha, l_reg, pa0, pa1, pa2, pa3); SBAR();
    pv_one<0>(o[0], vb0 + buf * (int)SHM_V, pa0, pa1, pa2, pa3); pv_one<1>(o[1], vb0 + buf * (int)SHM_V, pa0, pa1, pa2, pa3);
  }
#undef SWA_KROW
  if (hi == 0) li_l[r32] = l_reg; asm volatile("s_waitcnt lgkmcnt(0)" ::: "memory");
  float rli[16];
#pragma unroll
  for (int r = 0; r < 16; ++r) rli[r] = __builtin_amdgcn_rcpf(li_l[crow(r, hi)]);
  bf16* Ow = Y + rowq0 * DM + 1024 + head * 64;
#pragma unroll
  for (int r = 0; r < 16; ++r) { const int orow = crow(r, hi);
#pragma unroll
    for (int d0 = 0; d0 < 2; ++d0) Ow[(long)orow * DM + d0 * 32 + r32] = __float2bfloat16(o[d0][r] * rli[r]); }
  __builtin_amdgcn_s_setprio(0);
  __syncthreads();
}
#undef KSWZ
#undef SBAR
}

#define LAS __attribute__((address_space(3)))
#ifndef PH_MASK
#define PH_MASK 0xFFFFF
#endif
#ifndef MX_MASK
#define MX_MASK 15
#endif
#ifndef P_ALIGN
#define P_ALIGN true
#endif
#ifndef BR_ALIGN
#define BR_ALIGN true
#endif
#ifndef UP_ALIGN
#define UP_ALIGN true
#endif
#ifndef GATE_ALIGN
#define GATE_ALIGN false
#endif
#ifndef RESID_ALIGN
#define RESID_ALIGN false
#endif
#ifndef DBL_MASK
#define DBL_MASK 0
#endif
#ifndef DBL_MX
#define DBL_MX 0
#endif
#ifdef DBL_RESID
#define RESID_LOOP for (int rr_ = 0; rr_ < 2; ++rr_)
#else
#define RESID_LOOP for (int rr_ = 1; rr_ < 2; ++rr_)
#endif
#define REP(bit) for (int rep_ = 0; rep_ < ((DBL_MASK & (bit)) ? 2 : 1); ++rep_)
#define REPX(bit) for (int rep_ = 0; rep_ < ((DBL_MX & (bit)) ? 2 : 1); ++rep_)
typedef __hip_bfloat16 hbf16;
constexpr size_t WS_ZT = 7 * MiB + 256 * 1024;
struct Args { const float* in[21]; float* out; unsigned char* ws; int pad0, pad1; };
struct Frame { int tid, lane, wave, G, vcu, gw, NGW; unsigned char* ws; char* lds; };

#define XB_TMO      128
#define XB_XCNT(j)  (256  + 64 * (j))
#define XB_XSUB(j)  (1280 + 64 * (j))
#define XB_XGEN(j)  (2304 + 64 * (j))
#define XB_TOP      3328
#define XB_TOPGEN   3392
#define XCD_BAR_WORDS 3456
#define XB_SPIN_CAP (1u << 18)

__device__ __forceinline__ unsigned xb_ld(unsigned* p)              { return __hip_atomic_load(p, __ATOMIC_RELAXED, __HIP_MEMORY_SCOPE_AGENT); }
__device__ __forceinline__ unsigned xb_add(unsigned* p, unsigned v) { return __hip_atomic_fetch_add(p, v, __ATOMIC_RELAXED, __HIP_MEMORY_SCOPE_AGENT); }
__device__ __forceinline__ unsigned xb_xcc_id() { return (unsigned)__builtin_amdgcn_s_getreg((3 << 11) | 20) & 0xFu; }
#define XB_SPIN(cond, bar) do { unsigned _sp = 0; while (cond) { __builtin_amdgcn_s_sleep(1); \
    if ((++_sp & 255u) == 0u) { if (xb_ld(&(bar)[XB_TMO])) break; if (_sp > XB_SPIN_CAP) { atomicAdd(&(bar)[XB_TMO], 1u); break; } } } } while (0)

struct XcdBarrier {
    unsigned* bar; unsigned x;
    volatile LAS unsigned* st;
};

__device__ __forceinline__ XcdBarrier xcd_barrier_post(unsigned* bar, volatile LAS unsigned* st) {
    XcdBarrier b; b.bar = bar; b.x = xb_xcc_id(); b.st = st;
    if (threadIdx.x == 0) (void)xb_add(&bar[XB_XCNT(b.x)], 1u);
    return b;
}
__device__ __forceinline__ void xcd_barrier_complete(unsigned* bar, unsigned x, unsigned& nloc, unsigned& nx) {
    const unsigned G = gridDim.x * gridDim.y * gridDim.z;
    unsigned sum, cnt, mine, sp = 0u;
    for (;;) {
        sum = 0u; cnt = 0u; mine = 0u;
#pragma unroll
        for (unsigned j = 0; j < 16; ++j) { const unsigned c = xb_ld(&bar[XB_XCNT(j)]); sum += c; cnt += (c > 0u) ? 1u : 0u; mine = (j == x) ? c : mine; }
        if (sum == G) break;
        __builtin_amdgcn_s_sleep(1);
        if ((++sp & 255u) == 0u) { if (xb_ld(&bar[XB_TMO])) break; if (sp > XB_SPIN_CAP) { atomicAdd(&bar[XB_TMO], 1u); break; } }
    }
    nloc = mine > 0u ? mine : 1u; nx = cnt > 0u ? cnt : 1u;
}

__device__ __forceinline__ void xcd_barrier(const XcdBarrier& b) {
    asm volatile("s_waitcnt vmcnt(0)" ::: "memory");
    __syncthreads();
    if (threadIdx.x == 0) {
        unsigned* bar = b.bar;
        __builtin_amdgcn_s_waitcnt(0);
        unsigned nloc = b.st[0], nx = b.st[1];
        if (nloc == 0u) { xcd_barrier_complete(bar, b.x, nloc, nx); b.st[0] = nloc; b.st[1] = nx; }
        const unsigned old = xb_add(&bar[XB_XSUB(b.x)], 1u);
        const unsigned gen = old / nloc;
        if (old + 1u == (gen + 1u) * nloc) {
            __builtin_amdgcn_fence(__ATOMIC_RELEASE, "agent");
            asm volatile("s_waitcnt vmcnt(0)" ::: "memory");
            const unsigned og = xb_add(&bar[XB_TOP], 1u);
            const unsigned tg = og / nx;
            if (og + 1u == (tg + 1u) * nx) xb_add(&bar[XB_TOPGEN], 1u);
            else XB_SPIN(xb_ld(&bar[XB_TOPGEN]) == tg, bar);
            __builtin_amdgcn_fence(__ATOMIC_ACQUIRE, "agent");
            xb_add(&bar[XB_XGEN(b.x)], 1u);
            asm volatile("s_waitcnt vmcnt(0)" ::: "memory");
        } else {
            XB_SPIN(xb_ld(&bar[XB_XGEN(b.x)]) == gen, bar);
            __builtin_amdgcn_fence(__ATOMIC_ACQUIRE, "agent");
            asm volatile("s_waitcnt vmcnt(0)" ::: "memory");
        }
    }
    __syncthreads();
}

constexpr size_t WS_BAR = 7 * MiB + 512 * 1024;
constexpr int LDS_BARST = LDS_BYTES - 64;
__device__ __forceinline__ Frame make_frame(unsigned char* ws, char* lds) {
    Frame F; int t = threadIdx.x; asm volatile("" : "+v"(t)); F.tid = t; F.lane = t & 63; F.wave = __builtin_amdgcn_readfirstlane(t >> 6); F.G = gridDim.x;
    { const int bx = blockIdx.x; F.vcu = (F.G % 8 == 0) ? (bx % 8) * (F.G / 8) + bx / 8 : bx; }
    F.gw = F.vcu * 8 + F.wave; F.NGW = F.G * 8; F.ws = ws; F.lds = lds; return F;
}
typedef const __attribute__((address_space(4))) Args* CArgsP0;
__device__ __forceinline__ void s0_phase(const Frame& F, CArgsP0 a) {
    float* sv = (float*)F.lds;
    float* modp = (float*)(F.ws + WS_MODP);
    const float* c = a->in[1]; const float* cctx = a->in[3]; const float* adaw = a->in[4];
    for (int i = blockIdx.x * 512 + F.tid; i < 3 * 12288; i += F.G * 512) ((float*)(F.ws + WS_ZT))[i] = 0.f;
    for (int it = blockIdx.x; it < 793; it += F.G) {
        if (it < 768) {
            const int l = it / 384, r = it % 384, ks = r / 24, ch = r % 24;
            __syncthreads();
            if (F.tid < 384) { const int w = F.tid >> 7, dd = F.tid & 127, d = ks * 128 + dd; const float cv = (w < 2) ? c[w * DM + d] : cctx[d]; sv[F.tid] = cv / (1.f + expf(-cv)); }
            __syncthreads();
            const int j = ch * 512 + F.tid;
            const float* W = adaw + (size_t)l * DM * 12288 + (size_t)(ks * 128) * 12288 + j;
            float a0 = 0.f, a1 = 0.f, a2 = 0.f;
#pragma unroll 8
            for (int dd = 0; dd < 128; ++dd) { const float wv = W[(size_t)dd * 12288]; a0 += sv[dd] * wv; a1 += sv[128 + dd] * wv; a2 += sv[256 + dd] * wv; }
            float* o = modp + (size_t)((l * 16 + ks) * 3) * 12288 + j;
            o[0] = a0; o[12288] = a1; o[2 * 12288] = a2;
        } else if (it < 792) {
            const int idx = (it - 768) * 512 + F.tid;
            float* tab = (float*)(F.ws + WS_ROPE);
            int pos, f, nf; float* cdst; float* sdst;
            if (idx < 4096) { pos = idx >> 4; f = idx & 15; nf = 16; cdst = tab + idx; sdst = tab + 4096 + idx; }
            else { const int i2 = idx - 4096; pos = i2 >> 5; f = i2 & 31; nf = 32; cdst = tab + 8192 + i2; sdst = tab + 16384 + i2; }
            const float inv = exp2f(-(float)f / (float)nf * 13.287712379549449f);
            const float ang = (float)pos * inv;
            double rev = (double)ang * 0.15915494309189535; rev -= floor(rev);
            const float fr = (float)rev;
            *cdst = __builtin_amdgcn_cosf(fr); *sdst = __builtin_amdgcn_sinf(fr);
        } else {
            const int l = F.wave >> 2, h = F.wave & 3; const float* lp = a->in[10] + (size_t)l * 4 * 4 * 64;
            float pa = lp[(0 * 4 + h) * 64 + F.lane] * lp[(1 * 4 + h) * 64 + F.lane], pb = lp[(2 * 4 + h) * 64 + F.lane] * lp[(3 * 4 + h) * 64 + F.lane];
            pa = wave_sum(pa); pb = wave_sum(pb);
            const float lam_init = (l == 0) ? 0.2f : 0.35550906759f;
            if (F.lane == 0) ((float*)(F.ws + WS_LAM))[l * 4 + h] = expf(pa) - expf(pb) + lam_init;
        }
    }
}

__device__ __forceinline__ int map_win(int j) { return j < NMIX ? j : -1; }
__device__ __forceinline__ int map_gate(int R) { const int pn = R >> 8, c = R & 255; const int i = 2 * (c >> 7) + ((c & 31) >> 4), oc = 64 * pn + 16 * ((c & 127) >> 5) + (c & 15); return NMIX + i * DM + oc; }
__device__ __forceinline__ int map_up(int R) { const int pn = R >> 8, c = R & 255; return (c >> 7) * FF + 128 * pn + (c & 127); }
template <int MAP> __device__ __forceinline__ void transpose_item(const float* __restrict__ W, int Nsrc, int K, bf16raw* __restrict__ WT, int kb, int nb, float* scr, int lane) {
    const int k0 = 64 * kb, n0 = 32 * nb; const int jr = n0 + (lane & 31);
    const int col = (MAP == 0) ? jr : (MAP == 1) ? map_win(jr) : (MAP == 2) ? map_gate(jr) : map_up(jr);
#pragma unroll 8
    for (int i = 0; i < 32; ++i) { const int kk = 2 * i + (lane >> 5); scr[kk * 33 + (lane & 31)] = (col >= 0) ? W[(size_t)(k0 + kk) * Nsrc + col] : 0.f; }
    asm volatile("s_waitcnt lgkmcnt(0)" ::: "memory");
    const int cch = lane & 7;
#pragma unroll
    for (int j = 0; j < 4; ++j) { const int n = (lane >> 3) + 8 * j; const float* s = scr + (8 * cch) * 33 + n;
        u32x4_t o; o.x = pk2(s[0 * 33], s[1 * 33]); o.y = pk2(s[2 * 33], s[3 * 33]); o.z = pk2(s[4 * 33], s[5 * 33]); o.w = pk2(s[6 * 33], s[7 * 33]);
        *(u32x4_t*)(WT + (size_t)(n0 + n) * K + k0 + 8 * cch) = o; }
    asm volatile("s_waitcnt lgkmcnt(0)" ::: "memory");
}
__device__ __forceinline__ void s1_phase(const Frame& F, CArgsP0 a, int l) {
    if (l == 0) {
        const float* modp = (const float*)(F.ws + WS_MODP); float* mod = (float*)(F.ws + WS_MOD); const float* adab = a->in[5];
        for (int idx = blockIdx.x * 512 + F.tid; idx < 2 * 3 * 12288; idx += F.G * 512) {
            const int l2 = idx / (3 * 12288), rem = idx - l2 * 3 * 12288, w = rem / 12288, j = rem - w * 12288;
            float s = adab[l2 * 12288 + j];
#pragma unroll
            for (int ks = 0; ks < 16; ++ks) s += modp[(size_t)((l2 * 16 + ks) * 3 + w) * 12288 + j];
            mod[idx] = s;
        }
    }
    float* scr = (float*)F.lds + F.wave * (64 * 33);
    const float* w_in = a->in[7] + (size_t)l * DM * DIN; const float* w_br = a->in[15] + (size_t)l * 4 * 512 * DM; const float* w_out = a->in[16] + (size_t)l * DM * DM;
    const float* w_up = a->in[18] + (size_t)l * DM * 2 * FF; const float* w_dn = a->in[19] + (size_t)l * FF * DM;
    constexpr int I_IN = 32 * (PP / 32), I_G = 32 * (8192 / 32), I_B = 4 * 8 * 64, I_O = 32 * 64, I_U = 32 * (2 * FF / 32), I_D = (FF / 64) * 64;
    constexpr int NITEMS = I_IN + I_G + I_B + I_O + I_U + I_D;
    for (int it = F.gw; it < NITEMS; it += F.NGW) {
        int r = it;
        if (r < I_IN) { const int nblk = PP / 32; transpose_item<1>(w_in, DIN, DM, (bf16raw*)(F.ws + WS_WIN), r / nblk, r % nblk, scr, F.lane); continue; } r -= I_IN;
        if (r < I_G) { const int nblk = 8192 / 32; transpose_item<2>(w_in, DIN, DM, (bf16raw*)(F.ws + WS_WG), r / nblk, r % nblk, scr, F.lane); continue; } r -= I_G;
        if (r < I_B) { const int i = r / 512, rr = r % 512; transpose_item<0>(w_br + (size_t)i * 512 * DM, DM, 512, (bf16raw*)(F.ws + WS_WB) + (size_t)i * DM * 512, rr / 64, rr % 64, scr, F.lane); continue; } r -= I_B;
        if (r < I_O) { transpose_item<0>(w_out, DM, DM, (bf16raw*)(F.ws + WS_WOUT), r / 64, r % 64, scr, F.lane); continue; } r -= I_O;
        if (r < I_U) { const int nblk = 2 * FF / 32; transpose_item<3>(w_up, 2 * FF, DM, (bf16raw*)(F.ws + WS_WUP), r / nblk, r % nblk, scr, F.lane); continue; } r -= I_U;
        transpose_item<0>(w_dn, DM, FF, (bf16raw*)(F.ws + WS_WDN), r / 64, r % 64, scr, F.lane);
    }
}

__device__ __forceinline__ void norm_mod_phase(const Frame& F, const XPtr xin, const bf16raw* delta, const XOut xout, const float* __restrict__ gam, const float* __restrict__ modl, int shi, int sci, bf16raw* out) {
    constexpr int RPW = 17;
    int curw = -1; f32x4_t ca[8], cb[8];
    const int rbeg = F.gw * RPW, rend = (rbeg + RPW < MROWS) ? rbeg + RPW : MROWS;
    for (int r = rbeg; r < rend; ++r) {
        const int b = r / TPB, t = r - b * TPB, w = (t < CTX) ? 2 : b;
        if (w != curw) { curw = w;
#pragma unroll
            for (int j = 0; j < 8; ++j) { const int col = 4 * F.lane + 256 * j; const f32x4_t g = *(const f32x4_t*)(gam + col), sc = *(const f32x4_t*)(modl + (size_t)w * 12288 + sci * 2048 + col);
                ca[j] = g * (sc + 1.0f); cb[j] = *(const f32x4_t*)(modl + (size_t)w * 12288 + shi * 2048 + col); } }
        const f32x4_t* xr = (const f32x4_t*)xin.row(r) + F.lane;
        f32x4_t v[8]; float s = 0.f;
#pragma unroll
        for (int j = 0; j < 8; ++j) v[j] = xr[64 * j];
        if (delta) { const u32x2_t* dr = (const u32x2_t*)(delta + (size_t)r * DM) + F.lane; u32x2_t dv[8];
#pragma unroll
            for (int j = 0; j < 8; ++j) dv[j] = dr[64 * j];
            f32x4_t* xw = (f32x4_t*)xout.row(r) + F.lane;
#pragma unroll
            for (int j = 0; j < 8; ++j) { v[j].x += bflo(dv[j].x); v[j].y += bfhi(dv[j].x); v[j].z += bflo(dv[j].y); v[j].w += bfhi(dv[j].y); xw[64 * j] = v[j]; } }
#pragma unroll
        for (int j = 0; j < 8; ++j) s += (v[j].x * v[j].x + v[j].y * v[j].y) + (v[j].z * v[j].z + v[j].w * v[j].w);
        const float rstd = 1.0f / sqrtf(wave_sum(s) * (1.f / DM) + NORM_EPS);
        u32x2_t* o8 = (u32x2_t*)(out + (size_t)r * DM) + F.lane;
#pragma unroll
        for (int j = 0; j < 8; ++j) { const f32x4_t y = v[j] * rstd * ca[j] + cb[j]; u32x2_t w2; w2.x = pk2(y.x, y.y); w2.y = pk2(y.z, y.w); o8[64 * j] = w2; }
    }
}
__device__ __forceinline__ void final_norm_phase(const Frame& F, float* x, const bf16raw* __restrict__ delta, const float* __restrict__ gam) {
    for (int r = F.gw; r < NBATCH * SEQ; r += F.NGW) {
        f32x4_t* xr = (f32x4_t*)(x + (size_t)r * DM) + F.lane; f32x4_t v[8]; float s = 0.f;
        const int b = r / SEQ, ur = b * TPB + CTX + (r - b * SEQ);
        const u32x2_t* dr = (const u32x2_t*)(delta + (size_t)ur * DM) + F.lane;
#pragma unroll
        for (int j = 0; j < 8; ++j) { v[j] = xr[64 * j]; const u32x2_t d = dr[64 * j]; v[j].x += bflo(d.x); v[j].y += bfhi(d.x); v[j].z += bflo(d.y); v[j].w += bfhi(d.y);
            s += (v[j].x * v[j].x + v[j].y * v[j].y) + (v[j].z * v[j].z + v[j].w * v[j].w); }
        const float rstd = 1.0f / sqrtf(wave_sum(s) * (1.f / DM) + NORM_EPS);
#pragma unroll
        for (int j = 0; j < 8; ++j) xr[64 * j] = v[j] * rstd * *(const f32x4_t*)(gam + 4 * F.lane + 256 * j);
    }
}

__device__ __forceinline__ void rope_decode(int vp, int& x1c, int& x2c, int& f0, int& axis, int& hcol, bool& d128, bool& isq, bool& isdq) {
    x1c = 0; x2c = 0; f0 = 0; axis = 0; hcol = 0; d128 = false; isq = true; isdq = (vp >= 48 && vp < 80);
    if (vp < 48) { d128 = true; isq = vp < 32; const int v2 = isq ? vp : vp - 32; const int head = v2 >> 3, i = v2 & 7; axis = i >> 2; const int j = i & 3; f0 = 8 * j;
        const int base = (isq ? C_GQ : C_GK) + head * 128 + axis * 64; x1c = base + 8 * j; x2c = x1c + 32; hcol = axis * 64 + 8 * j; }
    else if (vp < 152) { const int v3 = vp - 48, seg = v3 >> 5, w = v3 & 31, head = w >> 2, i = w & 3; axis = i >> 1; const int j = i & 1; f0 = 8 * j;
        const int sb = (seg == 0) ? C_DQ : (seg == 1) ? C_DK : (seg == 2) ? C_SQ : C_SK; const int base = sb + head * 64 + axis * 32; x1c = base + 8 * j; x2c = x1c + 16; }
}
__device__ __forceinline__ void rope_phase(const Frame& F, bf16raw* P, const float* __restrict__ qg, const float* __restrict__ kg) {
    const float* tab = (const float*)(F.ws + WS_ROPE);
    int x1c[3], x2c[3], f0[3], axis[3], hcol[3]; bool d128[3], isq[3], act[3], isdq[3];
#pragma unroll
    for (int pass = 0; pass < 3; ++pass) { const int vp = pass * 64 + F.lane; act[pass] = vp < 152; rope_decode(vp, x1c[pass], x2c[pass], f0[pass], axis[pass], hcol[pass], d128[pass], isq[pass], isdq[pass]); }
    for (int r = F.gw; r < MROWS; r += F.NGW) {
        const int b = r / TPB, t = r - b * TPB; const bool latent = t >= CTX; const int pos = t - CTX, prow = pos >> 6, pcol = pos & 63;
        bf16raw* Pr = P + (size_t)r * PP;
        u32x4_t w1[3], w2[3];
#pragma unroll
        for (int pass = 0; pass < 3; ++pass) { const bool ld = act[pass] && (d128[pass] || latent || isdq[pass]);
            if (ld) { w1[pass] = *(const u32x4_t*)(Pr + x1c[pass]); w2[pass] = *(const u32x4_t*)(Pr + x2c[pass]); } else { w1[pass] = (u32x4_t){0u, 0u, 0u, 0u}; w2[pass] = w1[pass]; } }
#pragma unroll
        for (int pass = 0; pass < 3; ++pass) {
            float x1[8], x2[8]; unpack8(w1[pass], x1); unpack8(w2[pass], x2);
            if (pass == 0) {
                float ss = 0.f;
#pragma unroll
                for (int e = 0; e < 8; ++e) ss += x1[e] * x1[e] + x2[e] * x2[e];
                ss += __shfl_xor(ss, 1); ss += __shfl_xor(ss, 2); ss += __shfl_xor(ss, 4);
                if (d128[0]) { const float rstd = 1.0f / sqrtf(ss * (1.f / 128.f) + NORM_EPS); const float* gn = isq[0] ? qg : kg;
#pragma unroll
                    for (int e = 0; e < 8; ++e) { x1[e] = x1[e] * rstd * gn[hcol[0] + e]; x2[e] = x2[e] * rstd * gn[hcol[0] + 32 + e]; } }
            }
            if (act[pass] && latent) {
                const int p = axis[pass] ? pcol : prow;
                const float* ct = d128[pass] ? tab + 8192 + p * 32 + f0[pass] : tab + p * 16 + f0[pass]; const float* st = d128[pass] ? tab + 16384 + p * 32 + f0[pass] : tab + 4096 + p * 16 + f0[pass];
#pragma unroll
                for (int e = 0; e < 8; ++e) { const float cc = ct[e], sn = st[e], a1 = x1[e], a2 = x2[e]; x1[e] = a1 * cc - a2 * sn; x2[e] = a2 * cc + a1 * sn; }
            }
            if (isdq[pass]) {
#pragma unroll
                for (int e = 0; e < 8; ++e) { x1[e] *= 0.18033688011112042f; x2[e] *= 0.18033688011112042f; } }
            if (act[pass] && (d128[pass] || latent || isdq[pass])) { *(u32x4_t*)(Pr + x1c[pass]) = pack8(x1); *(u32x4_t*)(Pr + x2c[pass]) = pack8(x2); }
        }
    }
}

__device__ __forceinline__ int tbmap(int dir, int j) { return dir == 0 ? j : (j == 0 ? 1 : (j == 1 ? 0 : 131 - j)); }
__device__ __forceinline__ float log_sigmoid_f(float x) { return fminf(x, 0.f) - log1pf(expf(-fabsf(x))); }
__device__ __forceinline__ void gate_scan(const bf16raw* __restrict__ P, const float* __restrict__ gb, int r0, int head, int dir, int lane, float (&ig)[2], float (&bc)[2], float& blast) {
    float lf[2];
#pragma unroll
    for (int k = 0; k < 2; ++k) { const int s = 2 * lane + k, tok = dir ? 127 - s : s; const bf16raw* pr = P + (size_t)(r0 + tok) * PP + C_MG;
        ig[k] = bf1(pr[(2 * dir) * 4 + head]) + gb[(2 * dir) * 4 + head]; lf[k] = log_sigmoid_f(bf1(pr[(2 * dir + 1) * 4 + head]) + gb[(2 * dir + 1) * 4 + head]); }
    const float c1 = lf[0] + lf[1]; float v = c1;
#pragma unroll
    for (int o = 1; o < 64; o <<= 1) { const float tt = __shfl_up(v, o); if (lane >= o) v += tt; }
    const float excl = v - c1; bc[0] = excl + lf[0]; bc[1] = excl + c1; blast = __shfl(v, 63);
}
__device__ __forceinline__ void mlstm_a_phase(const Frame& F, const bf16raw* __restrict__ P, const float* __restrict__ gb) {
    float* ks = (float*)F.lds;
    float* vs = ks + 128 * 64;
    float* wts = vs + 128 * 128;
    float* CST = (float*)(F.ws + WS_CST); float* NST = (float*)(F.ws + WS_NST); float* MSC = (float*)(F.ws + WS_MSC);
    for (int u = blockIdx.x; u < 16 * NCHUNK; u += F.G) {
        const int chain = u / NCHUNK, tb = u - chain * NCHUNK, bb = chain >> 3, head = (chain >> 1) & 3, dir = chain & 1;
        const int r0 = bb * TPB + tb * 128;
        __syncthreads();
        if (F.wave == 0) {
            float ig[2], bc[2], bl; gate_scan(P, gb, r0, head, dir, F.lane, ig, bc, bl);
            const float lw0 = bl - bc[0] + ig[0], lw1 = bl - bc[1] + ig[1]; const float ml = wave_max(fmaxf(lw0, lw1));
            const int s0 = 2 * F.lane; wts[dir ? 127 - s0 : s0] = expf(lw0 - ml); wts[dir ? 126 - s0 : s0 + 1] = expf(lw1 - ml);
            if (F.lane == 0) { MSC[chain * NCHUNK + tb] = bl; MSC[16 * NCHUNK + chain * NCHUNK + tb] = ml; }
        }
        __syncthreads();
#pragma unroll
        for (int i = 0; i < 2; ++i) { const int vi = F.tid + 512 * i, tok = vi >> 3, c8 = (vi & 7) * 8; float f[8]; unpack8(*(const u32x4_t*)(P + (size_t)(r0 + tok) * PP + C_MK + head * 64 + c8), f);
            const float w = wts[tok] * 0.125f;
#pragma unroll
            for (int e = 0; e < 8; ++e) ks[tok * 64 + c8 + e] = f[e] * w; }
#pragma unroll
        for (int i = 0; i < 4; ++i) { const int vi = F.tid + 512 * i, tok = vi >> 4, c8 = (vi & 15) * 8; float f[8]; unpack8(*(const u32x4_t*)(P + (size_t)(r0 + tok) * PP + C_MV + head * 128 + c8), f);
#pragma unroll
            for (int e = 0; e < 8; ++e) vs[tok * 128 + c8 + e] = f[e]; }
        __syncthreads();
        const int vg = F.tid & 31, dg = F.tid >> 5;
        f32x4_t acc[4];
#pragma unroll
        for (int i = 0; i < 4; ++i) acc[i] = (f32x4_t){0.f, 0.f, 0.f, 0.f};
#pragma unroll 4
        for (int tok = 0; tok < 128; ++tok) { const f32x4_t vv = *(const f32x4_t*)(vs + tok * 128 + 4 * vg), kv = *(const f32x4_t*)(ks + tok * 64 + 4 * dg);
            acc[0] += kv * vv.x; acc[1] += kv * vv.y; acc[2] += kv * vv.z; acc[3] += kv * vv.w; }
        float* Co = CST + (size_t)(chain * NCHUNK + tb) * 8192;
#pragma unroll
        for (int i = 0; i < 4; ++i) *(f32x4_t*)(Co + (4 * vg + i) * 64 + 4 * dg) = acc[i];
        if (F.tid < 64) { float s = 0.f;
#pragma unroll 8
            for (int tok = 0; tok < 128; ++tok) s += ks[tok * 64 + F.tid];
            NST[(size_t)(chain * NCHUNK + tb) * 64 + F.tid] = s; }
    }
}
__device__ __forceinline__ void mlstm_b_phase(const Frame& F) {
    float* CST = (float*)(F.ws + WS_CST); float* NST = (float*)(F.ws + WS_NST); float* MSC = (float*)(F.ws + WS_MSC);
    const float* BL = MSC; const float* ML = MSC + 16 * NCHUNK; float* MS = MSC + 32 * NCHUNK;
    for (int e = blockIdx.x * 512 + F.tid; e < 16 * 8192; e += F.G * 512) {
        const int chain = e >> 13, idx = e & 8191, dir = chain & 1; const bool hn = idx < 64;
        float C = 0.f, nv = 0.f, m = 0.f;
        for (int j0 = 0; j0 < NCHUNK; j0 += 10) {
            float cl[10], nl[10], bl[10], ml[10];
#pragma unroll
            for (int i = 0; i < 10; ++i) { const int tb = tbmap(dir, j0 + i), ci = chain * NCHUNK + tb; cl[i] = CST[(size_t)ci * 8192 + idx]; nl[i] = hn ? NST[(size_t)ci * 64 + idx] : 0.f; bl[i] = BL[ci]; ml[i] = ML[ci]; }
#pragma unroll
            for (int i = 0; i < 10; ++i) { const int tb = tbmap(dir, j0 + i), ci = chain * NCHUNK + tb;
                CST[(size_t)ci * 8192 + idx] = C; if (hn) NST[(size_t)ci * 64 + idx] = nv; if (idx == 0) MS[ci] = m;
                const float mnew = fmaxf(bl[i] + m, ml[i]); const float dec = expf(bl[i] + m - mnew), wg = expf(ml[i] - mnew);
                C = dec * C + wg * cl[i]; nv = dec * nv + wg * nl[i]; m = mnew; }
        }
    }
}
__device__ __forceinline__ void mlstm_c_unit(const Frame& F, const bf16raw* __restrict__ P, const float* __restrict__ gb, const float* __restrict__ ng, bf16raw* __restrict__ Y, int bb, int head, int tb) {
    constexpr int KP = 72, SP = 132;
    bf16raw* qs = (bf16raw*)F.lds;
    bf16raw* kc = qs + 128 * 64;
    bf16raw* vs = kc + 128 * KP;
    float* Ss = (float*)(vs + 128 * 128);
    float* sm = Ss + 128 * SP;
    float* a_tok = sm, *M_tok = sm + 128, *bc_tok = sm + 256, *nst = sm + 384, *misc = sm + 448;
    const float* CST = (const float*)(F.ws + WS_CST); const float* NST = (const float*)(F.ws + WS_NST); const float* MS = (const float*)(F.ws + WS_MSC) + 32 * NCHUNK;
    const int r0 = bb * TPB + tb * 128;
    int tidl = F.tid; asm volatile("" : "+v"(tidl));
    const int vg = tidl & 15, tg = tidl >> 4;
    float hsum[4][8];
#pragma unroll
    for (int a = 0; a < 4; ++a)
#pragma unroll
        for (int e = 0; e < 8; ++e) hsum[a][e] = 0.f;
    for (int dir = 0; dir < 2; ++dir) {
        const int chain = bb * 8 + head * 2 + dir, ci = chain * NCHUNK + tb;
        __syncthreads();
        int tA = F.tid; asm volatile("" : "+v"(tA));
#pragma unroll
        for (int i = 0; i < 2; ++i) { const int vi = tA + 512 * i, tok = vi >> 3, c8 = (vi & 7) * 8; const bf16raw* pr = P + (size_t)(r0 + tok) * PP + head * 64 + c8;
            *(u32x4_t*)(qs + tok * 64 + c8) = *(const u32x4_t*)(pr + C_MQ); *(u32x4_t*)(kc + tok * KP + c8) = *(const u32x4_t*)(pr + C_MK); }
#pragma unroll
        for (int i = 0; i < 4; ++i) { const int vi = tA + 512 * i, tok = vi >> 4, c8 = (vi & 15) * 8; *(u32x4_t*)(vs + tok * 128 + c8) = *(const u32x4_t*)(P + (size_t)(r0 + tok) * PP + C_MV + head * 128 + c8); }
        const float m_prev = MS[ci];
        if (F.wave == 0) {
            float ig[2], bc[2], bl; gate_scan(P, gb, r0, head, dir, F.lane, ig, bc, bl);
            const float a0 = ig[0] - bc[0], a1 = ig[1] - bc[1];
            const float pm = fmaxf(a0, a1); float v = pm;
#pragma unroll
            for (int o = 1; o < 64; o <<= 1) { const float tt = __shfl_up(v, o); if (F.lane >= o) v = fmaxf(v, tt); }
            float ex = __shfl_up(v, 1); if (F.lane == 0) ex = -3.0e38f;
            const float M0 = fmaxf(m_prev, fmaxf(ex, a0)), M1 = fmaxf(m_prev, fmaxf(ex, pm));
            const int s0 = 2 * F.lane, t0 = dir ? 127 - s0 : s0, t1 = dir ? 126 - s0 : s0 + 1;
            a_tok[t0] = a0; a_tok[t1] = a1; M_tok[t0] = M0; M_tok[t1] = M1; bc_tok[t0] = bc[0]; bc_tok[t1] = bc[1];
        } else if (F.wave == 1) { nst[F.lane] = NST[(size_t)ci * 64 + F.lane]; }
        __syncthreads();
        {
            float sacc[4][8];
#pragma unroll
            for (int a = 0; a < 4; ++a)
#pragma unroll
                for (int i = 0; i < 8; ++i) sacc[a][i] = 0.f;
#pragma unroll 1
            for (int d0 = 0; d0 < 64; d0 += 8) {
                float qf[4][8];
#pragma unroll
                for (int a = 0; a < 4; ++a) unpack8(*(const u32x4_t*)(qs + (4 * tg + a) * 64 + d0), qf[a]);
#pragma unroll
                for (int i = 0; i < 8; ++i) { float kf[8]; unpack8(*(const u32x4_t*)(kc + (vg + 16 * i) * KP + d0), kf);
#pragma unroll
                    for (int a = 0; a < 4; ++a)
#pragma unroll
                        for (int e = 0; e < 8; ++e) sacc[a][i] += qf[a][e] * kf[e]; }
            }
#pragma unroll
            for (int a = 0; a < 4; ++a) { const int t = 4 * tg + a; const float Mt = M_tok[t];
#pragma unroll
                for (int i = 0; i < 8; ++i) { const int s = vg + 16 * i; const bool ok = dir ? (s >= t) : (s <= t);
                    Ss[t * SP + s] = ok ? sacc[a][i] * 0.125f * expf(a_tok[s] - Mt) : 0.f; } }
        }
        __syncthreads();
        {
            const float* Cg = CST + (size_t)ci * 8192;
#pragma unroll
            for (int i = 0; i < 4; ++i) { const int vi = tA + 512 * i, vrow = vi >> 4, c4 = (vi & 15) * 4; const f32x4_t cv = *(const f32x4_t*)(Cg + vrow * 64 + c4);
                u32x2_t w; w.x = pk2(cv.x, cv.y); w.y = pk2(cv.z, cv.w); *(u32x2_t*)(kc + vrow * KP + c4) = w; }
        }
        float num[4][8], rs[4];
#pragma unroll
        for (int a = 0; a < 4; ++a) { rs[a] = 0.f;
#pragma unroll
            for (int e = 0; e < 8; ++e) num[a][e] = 0.f; }
        {
            const int wv16 = 16 * F.wave;
            const int sbeg = dir ? wv16 : 0, send = dir ? 128 : wv16 + 16;
#pragma unroll 1
            for (int s0 = sbeg; s0 < send; s0 += 4) {
                f32x4_t S4[4];
#pragma unroll
                for (int a = 0; a < 4; ++a) S4[a] = *(const f32x4_t*)(Ss + (4 * tg + a) * SP + s0);
#pragma unroll
                for (int ss = 0; ss < 4; ++ss) { float vf[8]; unpack8(*(const u32x4_t*)(vs + (s0 + ss) * 128 + 8 * vg), vf);
#pragma unroll
                    for (int a = 0; a < 4; ++a) { const float sv = S4[a][ss]; rs[a] += sv;
#pragma unroll
                        for (int e = 0; e < 8; ++e) num[a][e] += sv * vf[e]; } }
            }
        }
        __syncthreads();
        {
            float qc[4][8], nq[4];
#pragma unroll
            for (int a = 0; a < 4; ++a) { nq[a] = 0.f;
#pragma unroll
                for (int e = 0; e < 8; ++e) qc[a][e] = 0.f; }
#pragma unroll 1
            for (int d0 = 0; d0 < 64; d0 += 8) {
                float qf[4][8];
#pragma unroll
                for (int a = 0; a < 4; ++a) { unpack8(*(const u32x4_t*)(qs + (4 * tg + a) * 64 + d0), qf[a]);
#pragma unroll
                    for (int e = 0; e < 8; ++e) nq[a] += nst[d0 + e] * qf[a][e]; }
#pragma unroll
                for (int e = 0; e < 8; ++e) { float cf[8]; unpack8(*(const u32x4_t*)(kc + (8 * vg + e) * KP + d0), cf);
#pragma unroll
                    for (int a = 0; a < 4; ++a)
#pragma unroll
                        for (int k = 0; k < 8; ++k) qc[a][e] += cf[k] * qf[a][k]; }
            }
#pragma unroll
            for (int a = 0; a < 4; ++a) { const int t = 4 * tg + a; const float Mt = M_tok[t], winter = expf(m_prev - Mt);
                const float den = winter * nq[a] + rs[a]; const float dn = fmaxf(fabsf(den), expf(-(bc_tok[t] + Mt))); const float inv = 1.0f / dn;
#pragma unroll
                for (int e = 0; e < 8; ++e) hsum[a][e] += (winter * qc[a][e] + num[a][e]) * inv; }
        }
    }
    float gmm[8];
#pragma unroll
    for (int e = 0; e < 8; ++e) gmm[e] = ng[head * 128 + 8 * vg + e];
#pragma unroll
    for (int a = 0; a < 4; ++a) { float ss = 0.f;
#pragma unroll
        for (int e = 0; e < 8; ++e) ss += hsum[a][e] * hsum[a][e];
        ss += __shfl_xor(ss, 1); ss += __shfl_xor(ss, 2); ss += __shfl_xor(ss, 4); ss += __shfl_xor(ss, 8);
        const float rstd = 1.0f / sqrtf(ss * (1.f / 128.f) + NORM_EPS);
        const int row = r0 + 4 * tg + a; float of[8]; unpack8(*(const u32x4_t*)(P + (size_t)row * PP + C_MO + head * 128 + 8 * vg), of);
        float yv[8];
#pragma unroll
        for (int e = 0; e < 8; ++e) yv[e] = hsum[a][e] * rstd * gmm[e] * sigmoid_f(of[e]);
        *(u32x4_t*)(Y + (size_t)row * DM + head * 128 + 8 * vg) = pack8(yv); }
    (void)misc;
}

#define KSWZ64(row, colB) ((row) * 128 + ((colB) ^ (((row) & 7) << 4)))
__device__ __forceinline__ void mlstm_c_unit_mfma(const Frame& F, const bf16raw* __restrict__ P, const float* __restrict__ gb, const float* __restrict__ ng, bf16raw* __restrict__ Y, int bb, int head, int tb) {
    using att::bf16x8; using att::f32x16; using att::crow;
    constexpr int CP = 72;
    constexpr int L_K = 0, L_V = 16384, L_C = 49152, L_SM = 86016, L_WS = 90112, L_HB = 0, HP = 132;
    char* lds = F.lds;
    int tid = F.tid; asm volatile("" : "+v"(tid));
    const int wid = F.wave, lane = tid & 63, r32 = lane & 31, hi = lane >> 5, dir = wid >> 2, rg = wid & 3;
    const float* CST = (const float*)(F.ws + WS_CST); const float* NST = (const float*)(F.ws + WS_NST); const float* MS = (const float*)(F.ws + WS_MSC) + 32 * NCHUNK;
    const int r0 = bb * TPB + tb * 128;
    float* sm = (float*)(lds + L_SM);
    float* wsc = (float*)(lds + L_WS) + wid * 64;
    __syncthreads();
#pragma unroll
    for (int i = 0; i < 2; ++i) { const int vi = tid + 512 * i, key = vi >> 3, c8 = (vi & 7) * 8;
        *(u32x4_t*)(lds + L_K + (key >> 6) * 8192 + KSWZ64(key & 63, c8 * 2)) = *(const u32x4_t*)(P + (size_t)(r0 + key) * PP + C_MK + head * 64 + c8); }
#pragma unroll
    for (int i = 0; i < 4; ++i) { const int vi = tid + 512 * i, key = vi >> 4, c8 = (vi & 15) * 8;
        *(u32x4_t*)(lds + L_V + (key >> 6) * 16384 + att::v_st(key & 63, c8)) = *(const u32x4_t*)(P + (size_t)(r0 + key) * PP + C_MV + head * 128 + c8); }
#pragma unroll
    for (int i = 0; i < 8; ++i) { const int vi = tid + 512 * i, d2 = vi >> 11, rem = vi & 2047, vrow = rem >> 4, c4 = (rem & 15) * 4;
        const int ci2 = (bb * 8 + head * 2 + d2) * NCHUNK + tb; const f32x4_t cv = *(const f32x4_t*)(CST + (size_t)ci2 * 8192 + vrow * 64 + c4);
        u32x2_t w; w.x = pk2(cv.x, cv.y); w.y = pk2(cv.z, cv.w); *(u32x2_t*)(lds + L_C + d2 * 18432 + (vrow * CP + c4) * 2) = w; }
    const int chain = bb * 8 + head * 2 + dir, ci = chain * NCHUNK + tb;
    const float m_prev = MS[ci];
    float* smd = sm + dir * 448;
    if (rg == 0) {
        float ig[2], bc[2], bl; gate_scan(P, gb, r0, head, dir, lane, ig, bc, bl);
        const float a0 = ig[0] - bc[0], a1 = ig[1] - bc[1]; const float pm = fmaxf(a0, a1); float v = pm;
#pragma unroll
        for (int o = 1; o < 64; o <<= 1) { const float tt = __shfl_up(v, o); if (lane >= o) v = fmaxf(v, tt); }
        float ex = __shfl_up(v, 1); if (lane == 0) ex = -3.0e38f;
        const float M0 = fmaxf(m_prev, fmaxf(ex, a0)), M1 = fmaxf(m_prev, fmaxf(ex, pm));
        const int s0 = 2 * lane, t0 = dir ? 127 - s0 : s0, t1 = dir ? 126 - s0 : s0 + 1;
        smd[t0] = a0; smd[t1] = a1; smd[128 + t0] = M0; smd[128 + t1] = M1; smd[256 + t0] = bc[0]; smd[256 + t1] = bc[1];
    } else if (rg == 1) { smd[384 + lane] = NST[(size_t)ci * 64 + lane]; }
    const int tq = 32 * rg + r32;
    bf16x8 qr[4];
#pragma unroll
    for (int d0 = 0; d0 < 4; ++d0) qr[d0] = *reinterpret_cast<const bf16x8*>(P + (size_t)(r0 + tq) * PP + C_MQ + head * 64 + d0 * 16 + hi * 8);
    __syncthreads();
    const float Mt = smd[128 + tq], winter = __expf(m_prev - Mt);
    float nq = 0.f; bf16x8 qs[4];
#pragma unroll
    for (int d0 = 0; d0 < 4; ++d0) { float qf[8]; unpack8(__builtin_bit_cast(u32x4_t, qr[d0]), qf); float qw[8];
#pragma unroll
        for (int e = 0; e < 8; ++e) { nq += smd[384 + d0 * 16 + hi * 8 + e] * qf[e]; qw[e] = qf[e] * winter; }
        qs[d0] = __builtin_bit_cast(bf16x8, pack8(qw)); }
    { auto rr = __builtin_amdgcn_permlane32_swap(__float_as_uint(nq), __float_as_uint(nq), false, false); nq = __uint_as_float(rr[0]) + __uint_as_float(rr[1]); }
    f32x16 o[4] = {};
    { const char* cb = lds + L_C + dir * 18432;
#pragma unroll
      for (int blk = 0; blk < 4; ++blk)
#pragma unroll
        for (int ks = 0; ks < 4; ++ks) { const bf16x8 cf = *reinterpret_cast<const bf16x8*>(cb + ((32 * blk + r32) * CP + 16 * ks + 8 * hi) * 2);
            o[blk] = __builtin_amdgcn_mfma_f32_32x32x16_bf16(qs[ks], cf, o[blk], 0, 0, 0); } }
    float rs = 0.f;
    const int vb0 = (int)(uintptr_t)(lds + L_V) + att::v_rd_base(lane);
    const int kt_lo = dir ? (rg >= 2 ? 1 : 0) : 0, kt_hi = dir ? 1 : (rg >= 2 ? 1 : 0);
    for (int kt = kt_lo; kt <= kt_hi; ++kt) {
        f32x16 p0 = {}, p1 = {};
        const char* Ks = lds + L_K + kt * 8192;
#pragma unroll
        for (int d0 = 0; d0 < 4; ++d0) { const int cbb = (d0 * 16 + hi * 8) * 2;
            const bf16x8 b0 = *reinterpret_cast<const bf16x8*>(Ks + KSWZ64(r32, cbb)), b1 = *reinterpret_cast<const bf16x8*>(Ks + KSWZ64(32 + r32, cbb));
            p0 = __builtin_amdgcn_mfma_f32_32x32x16_bf16(b0, qr[d0], p0, 0, 0, 0); p1 = __builtin_amdgcn_mfma_f32_32x32x16_bf16(b1, qr[d0], p1, 0, 0, 0); }
#pragma unroll
        for (int r = 0; r < 16; ++r) { const int s0_ = 64 * kt + crow(r, hi), s1_ = s0_ + 32;
            const bool ok0 = dir ? (s0_ >= tq) : (s0_ <= tq), ok1 = dir ? (s1_ >= tq) : (s1_ <= tq);
            const float w0 = ok0 ? 0.125f * __expf(smd[s0_] - Mt) : 0.f, w1 = ok1 ? 0.125f * __expf(smd[s1_] - Mt) : 0.f;
            p0[r] *= w0; p1[r] *= w1; rs += p0[r] + p1[r]; }
        bf16x8 pa0, pa1, pa2, pa3;
#define PK4M(Pv, BASE, OUT) do { unsigned a0 = att::cvtpk(Pv[BASE + 0], Pv[BASE + 1]), a1 = att::cvtpk(Pv[BASE + 2], Pv[BASE + 3]);   \
    unsigned b0 = att::cvtpk(Pv[BASE + 4], Pv[BASE + 5]), b1 = att::cvtpk(Pv[BASE + 6], Pv[BASE + 7]);                              \
    auto r0_ = __builtin_amdgcn_permlane32_swap(a0, b0, false, false); auto r1_ = __builtin_amdgcn_permlane32_swap(a1, b1, false, false); \
    u32x4_t w_ = {r0_[0], r1_[0], r0_[1], r1_[1]}; OUT = __builtin_bit_cast(bf16x8, w_); } while (0)
        PK4M(p0, 0, pa0); PK4M(p0, 8, pa1); PK4M(p1, 0, pa2); PK4M(p1, 8, pa3);
#undef PK4M
        __builtin_amdgcn_sched_barrier(0);
        const int vb = vb0 + kt * 16384;
        att::pv_one<0>(o[0], vb, pa0, pa1, pa2, pa3); att::pv_one<1>(o[1], vb, pa0, pa1, pa2, pa3); att::pv_one<2>(o[2], vb, pa0, pa1, pa2, pa3); att::pv_one<3>(o[3], vb, pa0, pa1, pa2, pa3);
    }
    { auto rr = __builtin_amdgcn_permlane32_swap(__float_as_uint(rs), __float_as_uint(rs), false, false); rs = __uint_as_float(rr[0]) + __uint_as_float(rr[1]); }
    const float den = winter * nq + rs; const float dn = fmaxf(fabsf(den), __expf(-(smd[256 + tq] + Mt)));
    if (hi == 0) wsc[r32] = 1.0f / dn;
    asm volatile("s_waitcnt lgkmcnt(0)" ::: "memory");
    float inv[16];
#pragma unroll
    for (int r = 0; r < 16; ++r) inv[r] = wsc[crow(r, hi)];
    __syncthreads();
    float* hb = (float*)(lds + L_HB);
    if (dir == 1) {
#pragma unroll
        for (int blk = 0; blk < 4; ++blk)
#pragma unroll
            for (int r = 0; r < 16; ++r) hb[(32 * rg + crow(r, hi)) * HP + 32 * blk + r32] = o[blk][r] * inv[r];
    }
    __syncthreads();
    if (dir == 0) {
        float ss[16];
#pragma unroll
        for (int r = 0; r < 16; ++r) ss[r] = 0.f;
#pragma unroll
        for (int blk = 0; blk < 4; ++blk)
#pragma unroll
            for (int r = 0; r < 16; ++r) { const float h = o[blk][r] * inv[r] + hb[(32 * rg + crow(r, hi)) * HP + 32 * blk + r32]; o[blk][r] = h; ss[r] += h * h; }
#pragma unroll
        for (int r = 0; r < 16; ++r) { float s = ss[r]; s += __shfl_xor(s, 1); s += __shfl_xor(s, 2); s += __shfl_xor(s, 4); s += __shfl_xor(s, 8); s += __shfl_xor(s, 16); ss[r] = 1.0f / sqrtf(s * (1.f / 128.f) + NORM_EPS); }
#pragma unroll
        for (int blk = 0; blk < 4; ++blk) { const float gm = ng[head * 128 + 32 * blk + r32];
#pragma unroll
            for (int r = 0; r < 16; ++r) { const size_t row = (size_t)(r0 + 32 * rg + crow(r, hi));
                const float og = bf1(P[row * PP + C_MO + head * 128 + 32 * blk + r32]);
                const float yv = o[blk][r] * ss[r] * gm * sigmoid_f(og);
                Y[row * DM + head * 128 + 32 * blk + r32] = (bf16raw)(pk2(yv, 0.f) & 0xffffu); } }
    }
}

__device__ __forceinline__ void diff_post_phase(const Frame& F, const bf16raw* __restrict__ T, const float* __restrict__ lam, const float* __restrict__ g, float one_minus, bf16raw* __restrict__ Y) {
    const int h = F.lane >> 4, c8 = (F.lane & 15) * 8; const float lm = lam[h]; float gm[8];
#pragma unroll
    for (int e = 0; e < 8; ++e) gm[e] = g[h * 128 + c8 + e] * one_minus;
    for (int r = F.gw; r < MROWS; r += 2 * F.NGW) {
        const int r2 = r + F.NGW; const bool has2 = r2 < MROWS; const int rb = has2 ? r2 : r;
        const u32x4_t wa1 = *(const u32x4_t*)(T + (size_t)r * 1024 + (2 * h) * 128 + c8), wa2 = *(const u32x4_t*)(T + (size_t)r * 1024 + (2 * h + 1) * 128 + c8);
        const u32x4_t wb1 = *(const u32x4_t*)(T + (size_t)rb * 1024 + (2 * h) * 128 + c8), wb2 = *(const u32x4_t*)(T + (size_t)rb * 1024 + (2 * h + 1) * 128 + c8);
#pragma unroll
        for (int q = 0; q < 2; ++q) {
            float o1[8], o2[8]; unpack8(q ? wb1 : wa1, o1); unpack8(q ? wb2 : wa2, o2);
            float ss = 0.f;
#pragma unroll
            for (int e = 0; e < 8; ++e) { o1[e] -= lm * o2[e]; ss += o1[e] * o1[e]; }
            ss += __shfl_xor(ss, 1); ss += __shfl_xor(ss, 2); ss += __shfl_xor(ss, 4); ss += __shfl_xor(ss, 8);
            const float rstd = 1.0f / sqrtf(ss * (1.f / 128.f) + NORM_EPS);
#pragma unroll
            for (int e = 0; e < 8; ++e) o1[e] *= rstd * gm[e];
            if (q == 0 || has2) *(u32x4_t*)(Y + (size_t)(q ? r2 : r) * DM + 512 + h * 128 + c8) = pack8(o1);
        }
    }
}

__device__ __forceinline__ void mixer_phase(const Frame& F, CArgsP0 a, int l) {
    const hbf16* P = (const hbf16*)(F.ws + WS_P); hbf16* Yb = (hbf16*)(F.ws + WS_Y); hbf16* DT = (hbf16*)(F.ws + WS_DTMP);
    const bool lastl = (l == DEPTH - 1);
    const float* lamv = (const float*)(F.ws + WS_LAM) + l * 4; const float* dng = a->in[11] + l * 512; const float one_minus = (l == 0) ? 0.8f : 0.64449093241f;
    REPX(1) if (MX_MASK & 1) for (int k = F.vcu; k < 1024; k += F.G) {
        const int i = k >> 8, rem = k & 255;
        __syncthreads();
        if (i < 2) { const int id = i * 256 + rem, combo = id >> 6, qb = id & 63, bb = combo >> 2, h = combo & 3;
            const long rq = (long)bb * TPB + CTX + qb * 256, rk = (long)bb * TPB;
            att::attn_dense_body<64, DM, 1>(P + rq * PP + C_DQ + h * 128, P + rk * PP + C_DK + h * 128, P + rk * PP + C_DV + h * 128, Yb, TPB, 0, F.lds);
            __syncthreads();
            att::attn_dense_body<64, DM, 2>(P + rq * PP + C_DQ + h * 128 + 64, P + rk * PP + C_DK + h * 128, P + rk * PP + C_DV + h * 128, Yb + rq * DM + 512 + h * 128, TPB, 64, F.lds, lamv[h], dng + h * 128, one_minus);
        } else { const int id = (i - 2) * 256 + rem, combo = id >> 6, qb = id & 63, bb = combo >> 2, h = combo & 3;
            const long rq = (long)bb * TPB + CTX + qb * 256, rk = (long)bb * TPB;
            att::attn_dense_body<128, DM>(P + rq * PP + C_GQ + h * 128, P + rk * PP + C_GK + (h >> 1) * 128, P + rk * PP + C_GV + (h >> 1) * 128, Yb + rq * DM + 1536 + h * 128, TPB, 0, F.lds);
        }
    }
    if (!lastl && (MX_MASK & 1)) for (int k = F.vcu; k < 16; k += F.G) {
        __syncthreads();
        if (k < 8) { const int bb = k >> 2, h = k & 3; const long rq = (long)bb * TPB;
            att::attn_dense_body<64, DM, 1>(P + rq * PP + C_DQ + h * 128, P + rq * PP + C_DK + h * 128, P + rq * PP + C_DV + h * 128, Yb, CTX, 0, F.lds);
            __syncthreads();
            att::attn_dense_body<64, DM, 2>(P + rq * PP + C_DQ + h * 128 + 64, P + rq * PP + C_DK + h * 128, P + rq * PP + C_DV + h * 128, Yb + rq * DM + 512 + h * 128, CTX, 64, F.lds, lamv[h], dng + h * 128, one_minus);
        } else { const int k2 = k - 8, bb = k2 >> 2, h = k2 & 3; const long rq = (long)bb * TPB;
            att::attn_dense_body<128, DM>(P + rq * PP + C_GQ + h * 128, P + rq * PP + C_GK + (h >> 1) * 128, P + rq * PP + C_GV + (h >> 1) * 128, Yb + rq * DM + 1536 + h * 128, CTX, 0, F.lds);
        }
    }
    __syncthreads();
    const float* sinkl = a->in[12] + l * 8;
    REPX(2) if (MX_MASK & 2) for (int k = F.vcu; k < (lastl ? 1024 : 1040); k += F.G) {
        if (k < 1024) att::swa_unit(P, Yb, k >> 9, (k >> 8) & 1, k & 255, false, sinkl, F.lds);
        else { const int k2 = k - 1024; att::swa_unit(P, Yb, k2 >> 3, (k2 >> 2) & 1, k2 & 3, true, sinkl, F.lds); }
    }
    const float* gb = a->in[8] + l * 16; const float* ng = a->in[9] + l * 512;
    REPX(4) if (MX_MASK & 4) for (int k = F.vcu; k < (lastl ? 8 * (NCHUNK - 2) : 8 * NCHUNK); k += F.G) { int bb, head, tb;
        if (lastl) { bb = k / (4 * (NCHUNK - 2)); const int rem = k - bb * 4 * (NCHUNK - 2); head = rem / (NCHUNK - 2); tb = 2 + rem - head * (NCHUNK - 2); }
        else { bb = k / (4 * NCHUNK); const int rem = k - bb * 4 * NCHUNK; head = rem / NCHUNK; tb = rem - head * NCHUNK; }
#ifdef MLSTM_VALU
        mlstm_c_unit(F, (const bf16raw*)P, gb, ng, (bf16raw*)Yb, bb, head, tb);
#else
        mlstm_c_unit_mfma(F, (const bf16raw*)P, gb, ng, (bf16raw*)Yb, bb, head, tb);
#endif
    }
    __syncthreads();
}

__device__ __forceinline__ void stagger_start(int ticks) {
    const int grp = (blockIdx.x >> 3) & 3;
    if (grp) { const unsigned long long t0 = __builtin_amdgcn_s_memrealtime(); const unsigned long long d = (unsigned long long)(grp * ticks);
        while (__builtin_amdgcn_s_memrealtime() - t0 < d) __builtin_amdgcn_s_sleep(16); }
}
#ifndef STAG_GATE
#define STAG_GATE 0
#endif
#ifndef STAG_RESID
#define STAG_RESID 0
#endif
struct RowOrder { pg8::StaticOrder S; int skip;
    __device__ void init(int N, int G, int c, int skip_) { skip = skip_; S.init(skip_ ? NBATCH * SEQ : MROWS, N, G, c); }
    __device__ bool next(int i, pg8::Unit& u) const { if (!S.next(i, u)) return false; if (skip) u.pm += 1 + (u.pm >= 64 ? 1 : 0); return true; }
    __device__ __forceinline__ void a_ready(const pg8::Unit&) const {}
    __device__ __forceinline__ void done(const pg8::Unit&) const {}
};
typedef const __attribute__((address_space(4))) Args* CArgsP;
__device__ __forceinline__ CArgsP get_args() { CArgsP p = (CArgsP)__builtin_amdgcn_kernarg_segment_ptr(); asm volatile("" : "+s"(p)); return p; }
#define PHASE_BEGIN CArgsP ap = get_args(); unsigned char* ws = ap->ws; const Frame F = make_frame(ws, (char*)lds); (void)F;
__global__ void __launch_bounds__(512, 2) fwd_megakernel(Args a_unused) {
    extern __shared__ __attribute__((aligned(16))) unsigned char lds[];
    cg::grid_group grid = cg::this_grid();
    PG8_LAS unsigned char* glds = (PG8_LAS unsigned char*)lds;
    if (threadIdx.x < 16) ((LAS unsigned*)((LAS unsigned char*)lds + LDS_BARST))[threadIdx.x] = 0u;
    __syncthreads();
    { CArgsP ap0 = get_args(); (void)xcd_barrier_post((unsigned*)(ap0->ws + WS_BAR), (volatile LAS unsigned*)((LAS unsigned char*)lds + LDS_BARST)); }
#define GBAR() do { CArgsP apb = get_args(); XcdBarrier xb_; xb_.bar = (unsigned*)(apb->ws + WS_BAR); xb_.x = xb_xcc_id(); xb_.st = (volatile LAS unsigned*)((LAS unsigned char*)lds + LDS_BARST); xcd_barrier(xb_); } while (0)
    REP(1) if (PH_MASK & 1) { PHASE_BEGIN s0_phase(F, ap); }
    grid.sync();
#ifdef EXTRA_SYNCS
    for (int es = 0; es < EXTRA_SYNCS; ++es) GBAR();
#endif
#pragma unroll 1
    for (int l = 0; l < DEPTH; ++l) {
        REP(2) if (PH_MASK & 2) { PHASE_BEGIN s1_phase(F, ap, l); }
        GBAR();
        REP(4) if (PH_MASK & 4) { PHASE_BEGIN const float* modl = (const float*)(ws + WS_MOD) + (size_t)l * 3 * 12288;
            const XPtr xin = (l == 0) ? XPtr{ap->in[0], ap->in[2]} : XPtr{ap->out, (const float*)(ws + WS_XC)};
            norm_mod_phase(F, xin, (l == 0) ? (const bf16raw*)nullptr : (const bf16raw*)(ws + WS_H), XOut{ap->out, (float*)(ws + WS_XC)}, ap->in[6] + l * DM, modl, 0, 1, (bf16raw*)(ws + WS_H)); }
        GBAR();
        REP(8) if (PH_MASK & 8) { PHASE_BEGIN
            pg8::Gemm g{(const pg8::bf16_t*)(ws + WS_H), (const pg8::bf16_t*)(ws + WS_WIN), MROWS, PP, DM, DM, 0, 0}; pg8::StaticOrder S; S.init(MROWS, PP, F.G, (int)blockIdx.x);
            pg8::EpiBf16<0> E{(pg8::bf16_t*)(ws + WS_P), PP, nullptr, 0, 0, 1.f};
            pg8::gemm_phase<pg8::EpiBf16<0>, pg8::StaticOrder, P_ALIGN, true>(glds, g, S, E);
        }
        GBAR();
        if (PH_MASK & 16) { PHASE_BEGIN rope_phase(F, (bf16raw*)(ws + WS_P), ap->in[13] + l * 128, ap->in[14] + l * 128); }
#ifdef DBL_SCAN
        for (int rs_ = 0; rs_ < 2; ++rs_) {
#endif
        REP(32) if (PH_MASK & 32) { PHASE_BEGIN mlstm_a_phase(F, (const bf16raw*)(ws + WS_P), ap->in[8] + l * 16); }
        GBAR();
        if (PH_MASK & 64) { PHASE_BEGIN mlstm_b_phase(F); }
        GBAR();
#ifdef DBL_SCAN
        }
#endif
        if (PH_MASK & 128) { PHASE_BEGIN mixer_phase(F, ap, l); }
        GBAR();
        REP(512) if (PH_MASK & 512) { PHASE_BEGIN
            pg8::Gemm g{(const pg8::bf16_t*)(ws + WS_Y), (const pg8::bf16_t*)(ws + WS_WB), MROWS, 8192, 512, DM, 8, 512}; RowOrder S; S.init(8192, F.G, (int)blockIdx.x, l == DEPTH - 1);
            pg8::EpiBf16<0> E{(pg8::bf16_t*)(ws + WS_BIG), DM, nullptr, DM, (size_t)MROWS * DM, 1.f};
            pg8::gemm_phase<pg8::EpiBf16<0>, RowOrder, BR_ALIGN, true>(glds, g, S, E);
        }
        GBAR();
        REP(1024) if (PH_MASK & 1024) { PHASE_BEGIN
            pg8::Gemm g{(const pg8::bf16_t*)(ws + WS_H), (const pg8::bf16_t*)(ws + WS_WG), MROWS, 8192, DM, DM, 0, 0}; RowOrder S; S.init(8192, F.G, (int)blockIdx.x, l == DEPTH - 1);
            pg8::EpiGate E{(const pg8::bf16_t*)(ws + WS_BIG), (pg8::bf16_t*)(ws + WS_Y), (size_t)MROWS * DM};
            if (STAG_GATE) stagger_start(STAG_GATE);
#ifdef PROBE_GATE_KLOOP
            { pg8::EpiNone E0{(float*)(ws + WS_ZT)}; pg8::gemm_phase<pg8::EpiNone, RowOrder, GATE_ALIGN, true>(glds, g, S, E0); }
#endif
            pg8::gemm_phase<pg8::EpiGate, RowOrder, GATE_ALIGN, true>(glds, g, S, E);
        }
        GBAR();
        if (PH_MASK & 2048) { PHASE_BEGIN
            const float* modl = (const float*)(ws + WS_MOD) + (size_t)l * 3 * 12288;
            pg8::Gemm g{(const pg8::bf16_t*)(ws + WS_Y), (const pg8::bf16_t*)(ws + WS_WOUT), MROWS, DM, DM, DM, 0, 0}; RowOrder S; S.init(DM, F.G, (int)blockIdx.x, l == DEPTH - 1);
            pg8::EpiDelta E{(pg8::bf16_t*)(ws + WS_H), modl, 2};
            pg8::gemm_phase<pg8::EpiDelta, RowOrder, true, true>(glds, g, S, E);
        }
        GBAR();
        REP(4) if (PH_MASK & 4) { PHASE_BEGIN const float* modl = (const float*)(ws + WS_MOD) + (size_t)l * 3 * 12288;
            const XPtr xin2 = (l == 0) ? XPtr{ap->in[0], ap->in[2]} : XPtr{ap->out, (const float*)(ws + WS_XC)};
            norm_mod_phase(F, xin2, (const bf16raw*)(ws + WS_H), XOut{ap->out, (float*)(ws + WS_XC)}, ap->in[17] + l * DM, modl, 3, 4, (bf16raw*)(ws + WS_H)); }
        GBAR();
        REP(4096) if (PH_MASK & 4096) { PHASE_BEGIN
            pg8::Gemm g{(const pg8::bf16_t*)(ws + WS_H), (const pg8::bf16_t*)(ws + WS_WUP), MROWS, 2 * FF, DM, DM, 0, 0}; RowOrder S; S.init(2 * FF, F.G, (int)blockIdx.x, l == DEPTH - 1);
            pg8::EpiSwiGLU E{(pg8::bf16_t*)(ws + WS_BIG), FF};
            pg8::gemm_phase<pg8::EpiSwiGLU, RowOrder, UP_ALIGN, true>(glds, g, S, E);
        }
        GBAR();
        if (PH_MASK & 8192) { PHASE_BEGIN
            const float* modl = (const float*)(ws + WS_MOD) + (size_t)l * 3 * 12288;
            pg8::Gemm g{(const pg8::bf16_t*)(ws + WS_BIG), (const pg8::bf16_t*)(ws + WS_WDN), MROWS, DM, FF, FF, 0, 0}; RowOrder S; S.init(DM, F.G, (int)blockIdx.x, l == DEPTH - 1);
            pg8::EpiDelta E{(pg8::bf16_t*)(ws + WS_H), modl, 5};
            pg8::gemm_phase<pg8::EpiDelta, RowOrder, true, true>(glds, g, S, E);
        }
        GBAR();
    }
    if (PH_MASK & 16384) { PHASE_BEGIN final_norm_phase(F, ap->out, (const bf16raw*)(ws + WS_H), ap->in[20]); }
}

extern "C" void kernel_launch(void* const* d_in, const int* in_sizes, int n_in, void* d_out, int out_size, void* d_ws, size_t ws_size, hipStream_t stream) {
    static int grid = 0;
    if (grid == 0) {
        if (n_in != 21 || out_size != NBATCH * SEQ * DM || ws_size < WS_END) { fprintf(stderr, "kernel_launch: unexpected shapes: n_in %d out %d ws %zu (need %zu)\n", n_in, out_size, ws_size, (size_t)WS_END); grid = -1; return; }
        int dev = 0, cus = 0, per_cu = 0;
        if (hipGetDevice(&dev) != hipSuccess || hipDeviceGetAttribute(&cus, hipDeviceAttributeMultiprocessorCount, dev) != hipSuccess) { grid = -1; return; }
        if (hipFuncSetAttribute((const void*)fwd_megakernel, hipFuncAttributeMaxDynamicSharedMemorySize, LDS_BYTES) != hipSuccess) { fprintf(stderr, "kernel_launch: hipFuncSetAttribute failed\n"); grid = -1; return; }
        if (hipOccupancyMaxActiveBlocksPerMultiprocessor(&per_cu, (const void*)fwd_megakernel, 512, LDS_BYTES) != hipSuccess || per_cu < 1) per_cu = 1;
        (void)hipGetLastError();
        grid = cus;
        fprintf(stderr, "kernel_launch: cus %d per_cu %d grid %d ws %zu\n", cus, per_cu, grid, ws_size);
    }
    if (grid < 0) return;
    Args a{};
    for (int i = 0; i < 21; ++i) a.in[i] = (const float*)d_in[i];
    a.out = (float*)d_out; a.ws = (unsigned char*)d_ws;
    (void)hipMemsetAsync((char*)d_ws + WS_BAR, 0, XCD_BAR_WORDS * 4, stream);
    void* args[] = {&a};
    const hipError_t e = hipLaunchCooperativeKernel((const void*)fwd_megakernel, dim3(grid), dim3(512), args, LDS_BYTES, stream);
    if (e != hipSuccess) fprintf(stderr, "kernel_launch: cooperative launch failed: %s (grid %d)\n", hipGetErrorString(e), grid);
}
```

```cpp
#include <hip/hip_runtime.h>
#include <hip/hip_bf16.h>
#include <hip/hip_cooperative_groups.h>
#include <cstdio>
#include <cstdint>
namespace cg = cooperative_groups;

constexpr int DM = 2048, NBATCH = 2, SEQ = 16384, CTX = 256, DEPTH = 2;
constexpr int TPB = SEQ + CTX;
constexpr int MROWS = NBATCH * TPB;
constexpr int DIN = 13072, NMIX = 4880, PP = 5120;
constexpr int FF = 5632;
constexpr int C_MQ = 0, C_MK = 256, C_MV = 512, C_MO = 1024, C_MG = 1536, C_DQ = 1552, C_DK = 2064, C_DV = 2576, C_SQ = 3088, C_SK = 3600, C_SV = 3728,
              C_GQ = 3856, C_GK = 4368, C_GV = 4624;
constexpr int NCHUNK = TPB / 128;
constexpr float NORM_EPS = 1e-6f;

constexpr size_t MiB = 1u << 20;
constexpr size_t WS_MODP = 0;
constexpr size_t WS_MOD = 5 * MiB;
constexpr size_t WS_ROPE = 5 * MiB + 512 * 1024;
constexpr size_t WS_LAM = 5 * MiB + 768 * 1024;
constexpr size_t WS_MSC = 6 * MiB;
constexpr size_t WS_NST = 6 * MiB + 512 * 1024;
constexpr size_t WS_W = 8 * MiB;
constexpr size_t WS_WIN = WS_W, WS_WG = WS_WIN + 20 * MiB, WS_WB = WS_WG + 32 * MiB, WS_WOUT = WS_WB + 8 * MiB, WS_WUP = WS_WOUT + 8 * MiB, WS_WDN = WS_WUP + 44 * MiB;
constexpr size_t WS_H = WS_WDN + 22 * MiB;
constexpr size_t WS_Y = WS_H + 130 * MiB;
constexpr size_t WS_XC = WS_Y + 130 * MiB;
constexpr size_t WS_BIG = WS_XC + 4 * MiB;
constexpr size_t WS_P = WS_BIG, WS_DTMP = WS_BIG + 325 * MiB, WS_CST = WS_BIG + 390 * MiB;
constexpr size_t WS_END = WS_BIG + 520 * MiB;
static_assert(WS_H == 142 * MiB && WS_END == 926 * MiB, "ws map");
static_assert((size_t)MROWS * PP * 2 <= 325 * MiB && (size_t)MROWS * 1024 * 2 <= 65 * MiB && (size_t)16 * NCHUNK * 8192 * 4 <= 65 * MiB, "big map");
static_assert((size_t)4 * MROWS * DM * 2 <= 520 * MiB && (size_t)MROWS * FF * 2 <= 520 * MiB, "big map 2");

constexpr int LDS_BYTES = 147456;

typedef unsigned short bf16raw;
typedef float f32x4_t __attribute__((ext_vector_type(4)));
typedef float f32x2_t __attribute__((ext_vector_type(2)));
typedef unsigned u32x4_t __attribute__((ext_vector_type(4)));
typedef unsigned u32x2_t __attribute__((ext_vector_type(2)));
typedef __bf16 bf16x2_t __attribute__((ext_vector_type(2)));

__device__ __forceinline__ unsigned pk2(float lo, float hi) { f32x2_t v = {lo, hi}; bf16x2_t b = __builtin_convertvector(v, bf16x2_t); return __builtin_bit_cast(unsigned, b); }
__device__ __forceinline__ float bflo(unsigned u) { return __uint_as_float(u << 16); }
__device__ __forceinline__ float bfhi(unsigned u) { return __uint_as_float(u & 0xffff0000u); }
__device__ __forceinline__ float bf1(bf16raw u) { return __uint_as_float(((unsigned)u) << 16); }
__device__ __forceinline__ void unpack8(const u32x4_t w, float* f) { f[0] = bflo(w.x); f[1] = bfhi(w.x); f[2] = bflo(w.y); f[3] = bfhi(w.y); f[4] = bflo(w.z); f[5] = bfhi(w.z); f[6] = bflo(w.w); f[7] = bfhi(w.w); }
__device__ __forceinline__ u32x4_t pack8(const float* f) { u32x4_t w; w.x = pk2(f[0], f[1]); w.y = pk2(f[2], f[3]); w.z = pk2(f[4], f[5]); w.w = pk2(f[6], f[7]); return w; }
__device__ __forceinline__ float wave_sum(float v) {
#pragma unroll
    for (int o = 1; o < 64; o <<= 1) v += __shfl_xor(v, o);
    return v;
}
__device__ __forceinline__ float wave_max(float v) {
#pragma unroll
    for (int o = 1; o < 64; o <<= 1) v = fmaxf(v, __shfl_xor(v, o));
    return v;
}
__device__ __forceinline__ float sigmoid_f(float x) { return __builtin_amdgcn_rcpf(1.f + __expf(-x)); }

struct XPtr { const float* lat; const float* ctx;
    __device__ __forceinline__ const float* row(int r) const { const int b = r / TPB, t = r - b * TPB; return t < CTX ? ctx + ((size_t)b * CTX + t) * DM : lat + ((size_t)b * SEQ + (t - CTX)) * DM; } };
struct XOut { float* lat; float* ctx;
    __device__ __forceinline__ float* row(int r) const { const int b = r / TPB, t = r - b * TPB; return t < CTX ? ctx + ((size_t)b * CTX + t) * DM : lat + ((size_t)b * SEQ + (t - CTX)) * DM; } };

namespace pg8 {
#define PG8_LAS __attribute__((address_space(3)))
typedef unsigned short bf16_t;
typedef short bf16x8 __attribute__((ext_vector_type(8)));
typedef float f32x4 __attribute__((ext_vector_type(4)));
typedef unsigned u32x4 __attribute__((ext_vector_type(4)));
constexpr int BM = 256, BK = 64, HALF = 128, HTB = HALF * BK * 2  , STAGE_BYTES = 8 * HTB, NXCD = 8, WGM = 8;

__host__ __device__ __forceinline__ int lds_byte(int r, int c) { const int st = (r >> 4) * 2 + (c >> 5), rr = r & 15, cc = c & 31, ob = rr * 64 + cc * 2; return st * 1024 + (ob ^ (((ob >> 9) & 1) << 5)); }
__host__ __device__ __forceinline__ void stage_rc(int b, int& R, int& C) { const int st = b / 1024, sb = b % 1024, swz = sb ^ (((sb >> 9) & 1) << 5); R = (st >> 1) * 16 + swz / 64; C = (st & 1) * 32 + (swz % 64) / 2; }
__host__ __device__ __forceinline__ int perm32(int rho) { const int n = rho >> 4, i = rho & 15; return 8 * (i >> 2) + 4 * n + (i & 3); }

struct Unit { int pm, pn; };
struct Gemm { const bf16_t* A; const bf16_t* Bt; int M, N, K; int lda; int agrp; int agstride; };

struct StaticOrder {
    int nM, nN, nwg, G, c;
    __host__ __device__ void init(int M, int N, int G_, int c_) { nM = M / BM; nN = N / BM; nwg = nM * nN; G = G_; c = c_; }
    __host__ __device__ bool next(int i, Unit& u) const {
        const long L = (long)i * G + c; if (L >= nwg) return false;
        int wgid = (int)L; { const int q = nwg / NXCD, r = nwg % NXCD, xcd = wgid % NXCD, off = wgid / NXCD; wgid = (xcd < r ? xcd * (q + 1) : r * (q + 1) + (xcd - r) * q) + off; }
        const int nig = WGM * nN, gid = wgid / nig, fm = gid * WGM, gsz = (nM - fm) < WGM ? (nM - fm) : WGM;
        u.pm = fm + ((wgid % nig) % gsz); u.pn = (wgid % nig) / gsz; return true;
    }
    __device__ __forceinline__ void a_ready(const Unit&) const {}
    __device__ __forceinline__ void done(const Unit&) const {}
};

__device__ __forceinline__ unsigned cvt_pk_bf16(float lo, float hi) { unsigned r; asm volatile("v_cvt_pk_bf16_f32 %0, %1, %2" : "=v"(r) : "v"(lo), "v"(hi)); return r; }
typedef float f32x2 __attribute__((ext_vector_type(2)));
__device__ __forceinline__ f32x2 gelu_pk(f32x2 v) {
    const f32x2 av = __builtin_elementwise_abs(v), d = av * 0.2316418882f + 1.0f;
    f32x2 t; t.x = __builtin_amdgcn_rcpf(d.x); t.y = __builtin_amdgcn_rcpf(d.y);
    f32x2 q = t * 0.5307027145f + (-0.7265760135f); q = q * t + 0.7107068705f; q = q * t + (-0.142248368f); q = q * t + 0.127414796f; q = q * t;
    const f32x2 s = (v * v) * (-0.72134752044f);
    f32x2 e; e.x = __builtin_amdgcn_exp2f(s.x); e.y = __builtin_amdgcn_exp2f(s.y);
    const f32x2 m = v * (q * e), r = v - m;
    f32x2 o; o.x = v.x < 0.f ? m.x : r.x; o.y = v.y < 0.f ? m.y : r.y; return o;
}

template <int ACT  > struct EpiBf16 {
    static constexpr bool PERM = true, AFTER_DRAIN = false; static_assert(ACT == 0 || ACT == 1, "EpiBf16: ACT is 0 (none) or 1 (gelu_pk)");
    bf16_t* O; int ldc; const float* bias; int split_cols; size_t split_stride; float scale0;
    __device__ __forceinline__ void operator()(const f32x4 (&acc)[2][2][4][2], const Unit& u, int wr, int wc, int fr, int fq) const {
        asm volatile("" : "+v"(fr), "+v"(fq));
        const int row0 = u.pm * BM + wr * 64 + fr; int colt = u.pn * BM; bf16_t* base = O;
        float sc = 1.f; if (split_cols) { const int t = colt / split_cols; base += (size_t)t * split_stride; colt -= t * split_cols; if (t == 0) sc = scale0; }
        const int col0 = colt + wc * 32 + 8 * fq, bcol0 = u.pn * BM + wc * 32 + 8 * fq;
        f32x4 bv[2][2];
#pragma unroll
        for (int bj = 0; bj < 2; ++bj)
#pragma unroll
            for (int n = 0; n < 2; ++n) bv[bj][n] = bias ? *(const f32x4*)(bias + bcol0 + bj * HALF + 4 * n) : (f32x4){0.f, 0.f, 0.f, 0.f};
#pragma unroll
        for (int ai = 0; ai < 2; ++ai)
#pragma unroll
            for (int m = 0; m < 4; ++m) { bf16_t* rowp = base + (size_t)(row0 + ai * HALF + m * 16) * ldc + col0;
#pragma unroll
                for (int bj = 0; bj < 2; ++bj) { f32x4 v0 = acc[ai][bj][m][0] + bv[bj][0], v1 = acc[ai][bj][m][1] + bv[bj][1];
                    if (ACT == 1) { f32x2 a = gelu_pk((f32x2){v0[0], v0[1]}), b = gelu_pk((f32x2){v0[2], v0[3]}), c = gelu_pk((f32x2){v1[0], v1[1]}), d = gelu_pk((f32x2){v1[2], v1[3]});
                        v0 = (f32x4){a.x, a.y, b.x, b.y}; v1 = (f32x4){c.x, c.y, d.x, d.y}; }
                    v0 = v0 * sc; v1 = v1 * sc; u32x4 w; w.x = cvt_pk_bf16(v0[0], v0[1]); w.y = cvt_pk_bf16(v0[2], v0[3]); w.z = cvt_pk_bf16(v1[0], v1[1]); w.w = cvt_pk_bf16(v1[2], v1[3]);
                    *(u32x4*)(rowp + bj * HALF) = w; } }
    }
};

__device__ __forceinline__ float sigm(float x) { return __builtin_amdgcn_rcpf(1.f + __expf(-x)); }
struct EpiGate {
    static constexpr bool PERM = false, AFTER_DRAIN = false;
    const bf16_t* Bq; bf16_t* out; size_t bstride;
    __device__ __forceinline__ void operator()(const f32x4 (&acc)[2][2][4][2], const Unit& u, int wr, int wc, int fr, int fq) const {
        asm volatile("" : "+v"(fr), "+v"(fq));
        typedef unsigned u32x2 __attribute__((ext_vector_type(2)));
        const int oc = u.pn * 64 + wc * 16 + fq * 4;
        u32x2 bv[2][4][4];
#pragma unroll
        for (int ai = 0; ai < 2; ++ai)
#pragma unroll
            for (int m = 0; m < 4; ++m) { const size_t off = (size_t)(u.pm * BM + ai * HALF + wr * 64 + m * 16 + fr) * 2048 + oc;
#pragma unroll
                for (int i = 0; i < 4; ++i) bv[ai][m][i] = *(const u32x2*)(Bq + (size_t)i * bstride + off); }
#pragma unroll
        for (int ai = 0; ai < 2; ++ai)
#pragma unroll
            for (int m = 0; m < 4; ++m) {
                const size_t off = (size_t)(u.pm * BM + ai * HALF + wr * 64 + m * 16 + fr) * 2048 + oc;
                f32x4 s = (f32x4){0.f, 0.f, 0.f, 0.f};
#pragma unroll
                for (int bj = 0; bj < 2; ++bj)
#pragma unroll
                    for (int n = 0; n < 2; ++n) { const f32x4 g = acc[ai][bj][m][n]; const u32x2 b = bv[ai][m][2 * bj + n];
                        s[0] += sigm(g[0]) * __uint_as_float(b.x << 16); s[1] += sigm(g[1]) * __uint_as_float(b.x & 0xffff0000u);
                        s[2] += sigm(g[2]) * __uint_as_float(b.y << 16); s[3] += sigm(g[3]) * __uint_as_float(b.y & 0xffff0000u); }
                u32x2 w; w.x = cvt_pk_bf16(s[0], s[1]); w.y = cvt_pk_bf16(s[2], s[3]);
                *(u32x2*)(out + off) = w; }
    }
};
struct EpiBranchTiled {
    static constexpr bool PERM = true, AFTER_DRAIN = false;
    bf16_t* Bq;
    __device__ __forceinline__ void operator()(const f32x4 (&acc)[2][2][4][2], const Unit& u, int wr, int wc, int fr, int fq) const {
        asm volatile("" : "+v"(fr), "+v"(fq));
        const int t = u.pn >> 3, ct = u.pn & 7;
#pragma unroll
        for (int bj = 0; bj < 2; ++bj) { const int c0 = ct * 256 + bj * HALF + wc * 32 + 8 * fq, png = c0 >> 6, cc = c0 & 63;
            bf16_t* ub = Bq + (size_t)(u.pm * 32 + png) * 65536 + t * 64 + cc;
#pragma unroll
            for (int ai = 0; ai < 2; ++ai)
#pragma unroll
                for (int m = 0; m < 4; ++m) { const int rr = ai * HALF + wr * 64 + m * 16 + fr; const f32x4 v0 = acc[ai][bj][m][0], v1 = acc[ai][bj][m][1];
                    u32x4 w; w.x = cvt_pk_bf16(v0[0], v0[1]); w.y = cvt_pk_bf16(v0[2], v0[3]); w.z = cvt_pk_bf16(v1[0], v1[1]); w.w = cvt_pk_bf16(v1[2], v1[3]);
                    *(u32x4*)(ub + rr * 256) = w; } }
    }
};
struct EpiResid {
    static constexpr bool PERM = false, AFTER_DRAIN = false;
    const float* in_lat; const float* in_ctx; float* out_lat; float* out_ctx; const float* modl; int gidx;
    __device__ __forceinline__ void operator()(const f32x4 (&acc)[2][2][4][2], const Unit& u, int wr, int wc, int fr, int fq) const {
        asm volatile("" : "+v"(fr), "+v"(fq));
        const int b = u.pm / 65, tb = u.pm - b * 65; const bool isctx = (tb == 0);
        const float* gv = modl + (size_t)(isctx ? 2 : b) * 12288 + gidx * 2048;
        const float* xi = isctx ? in_ctx + (size_t)b * 256 * 2048 : in_lat + ((size_t)b * 16384 + (size_t)(tb - 1) * 256) * 2048;
        float* xo = isctx ? out_ctx + (size_t)b * 256 * 2048 : out_lat + ((size_t)b * 16384 + (size_t)(tb - 1) * 256) * 2048;
        const int col0 = u.pn * BM + wc * 32 + 4 * fq;
#pragma unroll
        for (int bj = 0; bj < 2; ++bj)
#pragma unroll
            for (int n = 0; n < 2; ++n) { const f32x4 gg = *(const f32x4*)(gv + col0 + bj * HALF + n * 16);
                f32x4 xv[2][4];
#pragma unroll
                for (int ai = 0; ai < 2; ++ai)
#pragma unroll
                    for (int m = 0; m < 4; ++m) xv[ai][m] = *(const f32x4*)(xi + (size_t)(ai * HALF + wr * 64 + m * 16 + fr) * 2048 + col0 + bj * HALF + n * 16);
#pragma unroll
                for (int ai = 0; ai < 2; ++ai)
#pragma unroll
                    for (int m = 0; m < 4; ++m) *(f32x4*)(xo + (size_t)(ai * HALF + wr * 64 + m * 16 + fr) * 2048 + col0 + bj * HALF + n * 16) = xv[ai][m] + gg * acc[ai][bj][m][n];
                asm volatile("" ::: "memory"); }
    }
};
struct EpiDelta {
    static constexpr bool PERM = true, AFTER_DRAIN = false;
    bf16_t* D; const float* modl; int gidx;
    __device__ __forceinline__ void operator()(const f32x4 (&acc)[2][2][4][2], const Unit& u, int wr, int wc, int fr, int fq) const {
        asm volatile("" : "+v"(fr), "+v"(fq));
        const int b = u.pm / 65, tb = u.pm - b * 65; const bool isctx = (tb == 0);
        const float* gv = modl + (size_t)(isctx ? 2 : b) * 12288 + gidx * 2048;
        const int col0 = u.pn * BM + wc * 32 + 8 * fq;
#pragma unroll
        for (int bj = 0; bj < 2; ++bj) { const f32x4 g0 = *(const f32x4*)(gv + col0 + bj * HALF), g1 = *(const f32x4*)(gv + col0 + bj * HALF + 4);
#pragma unroll
            for (int ai = 0; ai < 2; ++ai)
#pragma unroll
                for (int m = 0; m < 4; ++m) { const f32x4 v0 = acc[ai][bj][m][0] * g0, v1 = acc[ai][bj][m][1] * g1;
                    u32x4 w; w.x = cvt_pk_bf16(v0[0], v0[1]); w.y = cvt_pk_bf16(v0[2], v0[3]); w.z = cvt_pk_bf16(v1[0], v1[1]); w.w = cvt_pk_bf16(v1[2], v1[3]);
                    *(u32x4*)(D + (size_t)(u.pm * BM + ai * HALF + wr * 64 + m * 16 + fr) * 2048 + col0 + bj * HALF) = w; } }
    }
};
struct EpiSwiGLU {
    static constexpr bool PERM = true, AFTER_DRAIN = false;
    bf16_t* hid; int ldh;
    __device__ __forceinline__ void operator()(const f32x4 (&acc)[2][2][4][2], const Unit& u, int wr, int wc, int fr, int fq) const {
        asm volatile("" : "+v"(fr), "+v"(fq));
        const int hc = u.pn * 128 + wc * 32 + 8 * fq;
#pragma unroll
        for (int ai = 0; ai < 2; ++ai)
#pragma unroll
            for (int m = 0; m < 4; ++m) { bf16_t* p = hid + (size_t)(u.pm * BM + ai * HALF + wr * 64 + m * 16 + fr) * ldh + hc;
                f32x4 v[2];
#pragma unroll
                for (int n = 0; n < 2; ++n) { const f32x4 g = acc[ai][0][m][n], up = acc[ai][1][m][n];
#pragma unroll
                    for (int e = 0; e < 4; ++e) v[n][e] = g[e] * sigm(g[e]) * up[e]; }
                u32x4 w; w.x = cvt_pk_bf16(v[0][0], v[0][1]); w.y = cvt_pk_bf16(v[0][2], v[0][3]); w.z = cvt_pk_bf16(v[1][0], v[1][1]); w.w = cvt_pk_bf16(v[1][2], v[1][3]);
                *(u32x4*)p = w; }
    }
};


struct EpiNone {
    static constexpr bool PERM = false, AFTER_DRAIN = false;
    float* sink;
    __device__ __forceinline__ void operator()(const f32x4 (&acc)[2][2][4][2], const Unit& u, int wr, int wc, int fr, int fq) const {
        asm volatile("" : "+v"(fr), "+v"(fq));
        if (u.pm < 0) {
#pragma unroll
            for (int ai = 0; ai < 2; ++ai)
#pragma unroll
                for (int bj = 0; bj < 2; ++bj)
#pragma unroll
                    for (int m = 0; m < 4; ++m)
#pragma unroll
                        for (int n = 0; n < 2; ++n) *(f32x4*)(sink + ((((ai * 2 + bj) * 4 + m) * 2 + n) * 64 + fr + 16 * fq) * 4) = acc[ai][bj][m][n];
        }
    }
};
template <class Epi, class Sched, bool ALIGN_EPI = false, bool SP2 = false>
__device__ __forceinline__ void gemm_phase(PG8_LAS unsigned char* lds, const Gemm g, const Sched& S, const Epi& E) {
    int tid_ = threadIdx.x; asm volatile("" : "+v"(tid_)); const int tid = tid_, wid = __builtin_amdgcn_readfirstlane(tid >> 6), lane = tid & 63, wr = wid >> 2, wc = wid & 3, fr = lane & 15, fq = lane >> 4;
    const int K = g.K, nt = K / BK;
    unsigned voffA[2], voffB[2];
#pragma unroll
    for (int i = 0; i < 2; ++i) { int R, C; stage_rc(tid * 16 + i * 8192, R, C); const int Rb = Epi::PERM ? ((R & ~31) + perm32(R & 31)) : R;
        voffA[i] = (unsigned)(R * g.lda + C) * 2u; voffB[i] = (unsigned)(Rb * K + C) * 2u; }
    const size_t kstep = (size_t)(BK * 2);
    const size_t hstepB = (size_t)HALF * K * 2, hstepA = (size_t)HALF * g.lda * 2;
    const size_t tstepA = 2 * hstepA, tstepB = 2 * hstepB;
    const unsigned ldsw = (unsigned)wid * 1024u;
    const int aoff = lds_byte(wr * 64 + fr, fq * 8), boff = lds_byte(wc * 32 + fr, fq * 8);
#define PG8_SA(b, h) (((b) * 2 + (h)) * HTB)
#define PG8_SB(b, h) ((4 + (b) * 2 + (h)) * HTB)
#define PG8_STAGE(bufoff, gbase, voff) do { _Pragma("unroll") for (int _i = 0; _i < 2; ++_i) \
        __builtin_amdgcn_global_load_lds((const unsigned*)((const char*)(gbase) + (voff)[_i]), (PG8_LAS unsigned*)(lds + (bufoff) + ldsw + _i * 8192), 16, 0, 0); } while (0)
#define PG8_LDA(dst, b, h) do { _Pragma("unroll") for (int m = 0; m < 4; ++m) _Pragma("unroll") for (int k = 0; k < 2; ++k) dst[m][k] = *(const PG8_LAS bf16x8*)(lds + PG8_SA(b, h) + aoff + m * 2048 + k * 1024); } while (0)
#define PG8_LDB(dst, b, h) do { _Pragma("unroll") for (int n = 0; n < 2; ++n) _Pragma("unroll") for (int k = 0; k < 2; ++k) dst[n][k] = *(const PG8_LAS bf16x8*)(lds + PG8_SB(b, h) + boff + n * 2048 + k * 1024); } while (0)
#define PG8_MMA(ai, bj, At, Bt) do { __builtin_amdgcn_s_setprio(1); _Pragma("unroll") for (int m = 0; m < 4; ++m) _Pragma("unroll") for (int n = 0; n < 2; ++n) _Pragma("unroll") for (int k = 0; k < 2; ++k) \
        acc[ai][bj][m][n] = __builtin_amdgcn_mfma_f32_16x16x32_bf16(Bt[n][k], At[m][k], acc[ai][bj][m][n], 0, 0, 0); __builtin_amdgcn_s_setprio(0); } while (0)
#define PG8_WAIT_V(n) asm volatile("s_waitcnt vmcnt(" #n ")" ::: "memory")
#define PG8_WAIT_L(n) asm volatile("s_waitcnt lgkmcnt(" #n ")" ::: "memory")
#define PG8_BAR __builtin_amdgcn_s_barrier()
#define PG8_SCHED __builtin_amdgcn_sched_barrier(0)
    Unit cur, nxt; int ui = 0;
    if (!S.next(0, cur)) return;
    f32x4 acc[2][2][4][2];
#pragma unroll
    for (int a = 0; a < 2; ++a)
#pragma unroll
        for (int b = 0; b < 2; ++b)
#pragma unroll
            for (int m = 0; m < 4; ++m)
#pragma unroll
                for (int n = 0; n < 2; ++n) acc[a][b][m][n] = (f32x4){0.f, 0.f, 0.f, 0.f};
    bf16x8 At[4][2], B0[2][2], B1[2][2];
    const char* cA = (const char*)g.A + (size_t)cur.pm * tstepA + (g.agrp ? (size_t)(cur.pn / g.agrp) * g.agstride * 2 : 0); const char* cB = (const char*)g.Bt + (size_t)cur.pn * tstepB;
    S.a_ready(cur);
    if constexpr (SP2) {
        PG8_STAGE(PG8_SB(0, 0), cB, voffB); PG8_STAGE(PG8_SB(0, 1), cB + hstepB, voffB); PG8_STAGE(PG8_SA(0, 0), cA, voffA); PG8_STAGE(PG8_SA(0, 1), cA + hstepA, voffA);
        if (wr == 1) PG8_BAR;
        PG8_WAIT_V(2); PG8_BAR;
        PG8_STAGE(PG8_SB(1, 0), cB + kstep, voffB); PG8_STAGE(PG8_SA(1, 0), cA + kstep, voffA); PG8_STAGE(PG8_SB(1, 1), cB + hstepB + kstep, voffB);
        PG8_WAIT_V(6); PG8_BAR;
    } else {
        PG8_STAGE(PG8_SB(0, 0), cB, voffB); PG8_STAGE(PG8_SA(0, 0), cA, voffA); PG8_STAGE(PG8_SB(0, 1), cB + hstepB, voffB); PG8_STAGE(PG8_SA(0, 1), cA + hstepA, voffA);
        if (wr == 1) PG8_BAR;
        PG8_WAIT_V(4); PG8_BAR;
        PG8_STAGE(PG8_SB(1, 0), cB + kstep, voffB); PG8_STAGE(PG8_SA(1, 0), cA + kstep, voffA); PG8_STAGE(PG8_SB(1, 1), cB + hstepB + kstep, voffB);
        PG8_WAIT_V(6); PG8_BAR;
    }
    for (;;) {
        const bool has_next = S.next(ui + 1, nxt);
        const char* nA = has_next ? (const char*)g.A + (size_t)nxt.pm * tstepA + (g.agrp ? (size_t)(nxt.pn / g.agrp) * g.agstride * 2 : 0) : cA; const char* nB = has_next ? (const char*)g.Bt + (size_t)nxt.pn * tstepB : cB;
        for (int t = 0; t < nt; t += 2) {
            const bool last = (t == nt - 2);
            const char* a1 = cA + (size_t)(t + 1) * kstep;
            const char* a2 = last ? nA : cA + (size_t)(t + 2) * kstep; const char* b2 = last ? nB : cB + (size_t)(t + 2) * kstep;
            const char* a3 = a2 + kstep; const char* b3 = b2 + kstep;
            if (last && has_next) S.a_ready(nxt);
            if constexpr (SP2) {
            PG8_LDB(B0, 0, 0); PG8_LDB(B1, 0, 1); PG8_SCHED; PG8_LDA(At, 0, 0); PG8_STAGE(PG8_SA(1, 1), a1 + hstepA, voffA);
            PG8_WAIT_V(8); PG8_WAIT_L(0); PG8_BAR; PG8_MMA(0, 0, At, B0); PG8_MMA(0, 1, At, B1); PG8_BAR; PG8_SCHED;
            PG8_LDA(At, 0, 1); PG8_STAGE(PG8_SB(0, 0), b2, voffB); PG8_STAGE(PG8_SB(0, 1), b2 + hstepB, voffB); PG8_STAGE(PG8_SA(0, 0), a2, voffA);
            PG8_WAIT_V(8); PG8_WAIT_L(0); PG8_BAR; PG8_MMA(1, 0, At, B0); PG8_MMA(1, 1, At, B1); PG8_BAR; PG8_SCHED;
            PG8_LDB(B0, 1, 0); PG8_LDB(B1, 1, 1); PG8_SCHED; PG8_LDA(At, 1, 0); PG8_STAGE(PG8_SA(0, 1), a2 + hstepA, voffA);
            PG8_WAIT_V(8); PG8_WAIT_L(0); PG8_BAR; PG8_MMA(0, 0, At, B0); PG8_MMA(0, 1, At, B1); PG8_BAR; PG8_SCHED;
            PG8_LDA(At, 1, 1); PG8_STAGE(PG8_SB(1, 0), b3, voffB); PG8_STAGE(PG8_SB(1, 1), b3 + hstepB, voffB); PG8_STAGE(PG8_SA(1, 0), a3, voffA);
            PG8_WAIT_V(8); PG8_WAIT_L(0); PG8_BAR; PG8_MMA(1, 0, At, B0); PG8_MMA(1, 1, At, B1); PG8_BAR; PG8_SCHED;
            } else {
            PG8_LDB(B0, 0, 0); PG8_SCHED; PG8_LDA(At, 0, 0); PG8_STAGE(PG8_SA(1, 1), a1 + hstepA, voffA);
            PG8_WAIT_L(8); PG8_BAR; PG8_WAIT_L(0); PG8_MMA(0, 0, At, B0); PG8_BAR; PG8_SCHED;
            PG8_LDB(B1, 0, 1); PG8_STAGE(PG8_SB(0, 0), b2, voffB);
            PG8_BAR; PG8_WAIT_L(0); PG8_MMA(0, 1, At, B1); PG8_BAR;
            PG8_LDA(At, 0, 1); PG8_STAGE(PG8_SA(0, 0), a2, voffA);
            PG8_BAR; PG8_WAIT_L(0); PG8_MMA(1, 0, At, B0); PG8_BAR; PG8_SCHED;
            PG8_STAGE(PG8_SB(0, 1), b2 + hstepB, voffB);
            PG8_WAIT_V(6); PG8_BAR; PG8_MMA(1, 1, At, B1); PG8_BAR;
            PG8_LDB(B0, 1, 0); PG8_SCHED; PG8_LDA(At, 1, 0); PG8_STAGE(PG8_SA(0, 1), a2 + hstepA, voffA);
            PG8_WAIT_L(8); PG8_BAR; PG8_WAIT_L(0); PG8_MMA(0, 0, At, B0); PG8_BAR; PG8_SCHED;
            PG8_LDB(B1, 1, 1); PG8_STAGE(PG8_SB(1, 0), b3, voffB);
            PG8_BAR; PG8_WAIT_L(0); PG8_MMA(0, 1, At, B1); PG8_BAR;
            PG8_LDA(At, 1, 1); PG8_STAGE(PG8_SA(1, 0), a3, voffA);
            PG8_BAR; PG8_WAIT_L(0); PG8_MMA(1, 0, At, B0); PG8_BAR; PG8_SCHED;
            PG8_STAGE(PG8_SB(1, 1), b3 + hstepB, voffB);
            PG8_WAIT_V(6); PG8_BAR; PG8_MMA(1, 1, At, B1); PG8_BAR;
            }
        }
        if constexpr (ALIGN_EPI) { if (wr == 0) PG8_BAR; }
        if constexpr (!Epi::AFTER_DRAIN) { E(acc, cur, wr, wc, fr, fq); S.done(cur); }
        if (!has_next) break;
#pragma unroll
        for (int a = 0; a < 2; ++a)
#pragma unroll
            for (int b = 0; b < 2; ++b)
#pragma unroll
                for (int m = 0; m < 4; ++m)
#pragma unroll
                    for (int n = 0; n < 2; ++n) acc[a][b][m][n] = (f32x4){0.f, 0.f, 0.f, 0.f};
        cur = nxt; cA = nA; cB = nB; ++ui;
        if constexpr (ALIGN_EPI) { if (wr == 1) PG8_BAR; }
    }
    PG8_WAIT_V(0);
    if constexpr (!ALIGN_EPI) { if (wr == 0) PG8_BAR; }
    PG8_BAR;
    if constexpr (Epi::AFTER_DRAIN) { E.fused(acc, cur, wr, wc, fr, fq, lds, wid, lane); S.done(cur); }
#undef PG8_SA
#undef PG8_SB
#undef PG8_STAGE
#undef PG8_LDA
#undef PG8_LDB
#undef PG8_MMA
#undef PG8_WAIT_V
#undef PG8_WAIT_L
#undef PG8_BAR
#undef PG8_SCHED
}
}
#ifndef ATT_SDEPTH
#define ATT_SDEPTH 1
#endif
#ifndef ATT_ACCINIT128
#define ATT_ACCINIT128 1
#endif
namespace att {
using bf16 = __hip_bfloat16;
constexpr int NW = 8, QBLK = 32, KVBLK = 64, SDEPTH = ATT_SDEPTH;
constexpr float THR = 8.f;
constexpr size_t SHM_V = KVBLK * 128 * 2, SHM_K = KVBLK * 128 * 2, SHM_ATTN = 2 * SHM_V + 2 * SHM_K + NW * 64 * 4;
using bf16x8 = __attribute__((ext_vector_type(8))) short;
using s16x4  = __attribute__((ext_vector_type(4))) short;
using f32x16 = __attribute__((ext_vector_type(16))) float;
using f32x8  = __attribute__((ext_vector_type(8))) float;
using u32x4  = __attribute__((ext_vector_type(4))) unsigned;
#define KSWZ(row, colB) ((row) * 256 + ((colB) ^ (((row) & 7) << 4)))
#define SBAR() __builtin_amdgcn_sched_barrier(0)
__device__ __forceinline__ int crow(int r, int hi) { return (r & 3) + 8 * (r >> 2) + 4 * hi; }
__device__ __forceinline__ unsigned cvtpk(float lo, float hi) {
  unsigned r; asm volatile("v_cvt_pk_bf16_f32 %0, %1, %2" : "=v"(r) : "v"(lo), "v"(hi)); return r;
}
template <int DQK> __device__ __forceinline__ void partialSM(f32x16& p0, f32x16& p1, float& m_reg, float& mn, float& alpha) {
  constexpr float SCALE = (DQK == 64) ? 0.125f : 0.088388347648318440f; constexpr float C = SCALE * 1.4426950408889634f;
  float pmax = p0[0]; for (int r = 1; r < 16; ++r) pmax = fmaxf(pmax, p0[r]); for (int r = 0; r < 16; ++r) pmax = fmaxf(pmax, p1[r]);
  { auto rr = __builtin_amdgcn_permlane32_swap(__float_as_uint(pmax), __float_as_uint(pmax), false, false);
    pmax = fmaxf(__uint_as_float(rr[0]), __uint_as_float(rr[1])); }
  if (__builtin_expect(__all(pmax - m_reg <= THR / SCALE), 1)) { mn = m_reg; alpha = 1.f; }
  else { mn = fmaxf(m_reg, pmax); alpha = __builtin_amdgcn_exp2f((m_reg - mn) * C); m_reg = mn; }
  float mnC = -mn * C;
  for (int r = 0; r < 16; ++r) p0[r] = fmaf(p0[r], C, mnC); for (int r = 0; r < 16; ++r) p1[r] = fmaf(p1[r], C, mnC);
  for (int r = 0; r < 16; ++r) p0[r] = __builtin_amdgcn_exp2f(p0[r]);
}
__device__ __forceinline__ void finishSM(f32x16& p0, f32x16& p1, float alpha, float& l_reg, bf16x8& pa0, bf16x8& pa1, bf16x8& pa2, bf16x8& pa3) {
  for (int r = 0; r < 16; ++r) p1[r] = __builtin_amdgcn_exp2f(p1[r]);
  float ps = 0; for (int r = 0; r < 16; ++r) ps += p0[r]; for (int r = 0; r < 16; ++r) ps += p1[r];
  { auto rr = __builtin_amdgcn_permlane32_swap(__float_as_uint(ps), __float_as_uint(ps), false, false);
    ps = __uint_as_float(rr[0]) + __uint_as_float(rr[1]); }
  l_reg = l_reg * alpha + ps;
#define PK4(P, BASE, OUT) do { unsigned a0 = cvtpk(P[BASE + 0], P[BASE + 1]), a1 = cvtpk(P[BASE + 2], P[BASE + 3]);   \
    unsigned b0 = cvtpk(P[BASE + 4], P[BASE + 5]), b1 = cvtpk(P[BASE + 6], P[BASE + 7]);                              \
    auto r0 = __builtin_amdgcn_permlane32_swap(a0, b0, false, false); auto r1 = __builtin_amdgcn_permlane32_swap(a1, b1, false, false); \
    u32x4 w = {r0[0], r1[0], r0[1], r1[1]}; OUT = *reinterpret_cast<bf16x8*>(&w); } while (0)
  PK4(p0, 0, pa0); PK4(p0, 8, pa1); PK4(p1, 0, pa2); PK4(p1, 8, pa3);
#undef PK4
}
template <int DQK> __device__ __forceinline__ void qkt(f32x16& p0, f32x16& p1, const bf16* Ks, const bf16x8* qr, int r32, int hi, int kcol0) {
  p0 = f32x16{}; p1 = f32x16{};
#pragma unroll
  for (int d0 = 0; d0 < DQK / 16; ++d0) { int cb = (kcol0 + d0 * 16 + hi * 8) * 2;
    bf16x8 b0 = *reinterpret_cast<const bf16x8*>((const char*)Ks + KSWZ(r32, cb));
    bf16x8 b1 = *reinterpret_cast<const bf16x8*>((const char*)Ks + KSWZ(32 + r32, cb));
    p0 = __builtin_amdgcn_mfma_f32_32x32x16_bf16(b0, qr[d0], p0, 0, 0, 0);
    p1 = __builtin_amdgcn_mfma_f32_32x32x16_bf16(b1, qr[d0], p1, 0, 0, 0); }
}
template <int DQK> __device__ __forceinline__ void qktn(f32x16& p0, f32x16& p1, const bf16* Ks, const bf16x8* qr, int r32, int hi, int kcol0, const f32x16& negm) {
#pragma unroll
  for (int d0 = 0; d0 < DQK / 16; ++d0) { int cb = (kcol0 + d0 * 16 + hi * 8) * 2;
    bf16x8 b0 = *reinterpret_cast<const bf16x8*>((const char*)Ks + KSWZ(r32, cb));
    bf16x8 b1 = *reinterpret_cast<const bf16x8*>((const char*)Ks + KSWZ(32 + r32, cb));
    if (d0 == 0) { p0 = __builtin_amdgcn_mfma_f32_32x32x16_bf16(b0, qr[0], negm, 0, 0, 0); p1 = __builtin_amdgcn_mfma_f32_32x32x16_bf16(b1, qr[0], negm, 0, 0, 0); }
    else { p0 = __builtin_amdgcn_mfma_f32_32x32x16_bf16(b0, qr[d0], p0, 0, 0, 0); p1 = __builtin_amdgcn_mfma_f32_32x32x16_bf16(b1, qr[d0], p1, 0, 0, 0); } }
}
template <bool FIRST> __device__ __forceinline__ void partialSMn(f32x16& p0, f32x16& p1, float& mref, f32x16& negm, float& alpha) {
  constexpr float THRL = THR * 1.4426950408889634f;
  float pmax = p0[0]; for (int r = 1; r < 16; ++r) pmax = fmaxf(pmax, p0[r]); for (int r = 0; r < 16; ++r) pmax = fmaxf(pmax, p1[r]);
  { auto rr = __builtin_amdgcn_permlane32_swap(__float_as_uint(pmax), __float_as_uint(pmax), false, false);
    pmax = fmaxf(__uint_as_float(rr[0]), __uint_as_float(rr[1])); }
  if (!FIRST && __builtin_expect(__all(pmax <= THRL), 1)) { alpha = 1.f; }
  else { const float dl = FIRST ? pmax : fmaxf(pmax, 0.f); mref += dl; alpha = FIRST ? 1.f : __builtin_amdgcn_exp2f(-dl);
    for (int r = 0; r < 16; ++r) { p0[r] -= dl; p1[r] -= dl; }
    const float nm = -mref; for (int r = 0; r < 16; ++r) negm[r] = nm; }
  for (int r = 0; r < 16; ++r) p0[r] = __builtin_amdgcn_exp2f(p0[r]);
}
__device__ __forceinline__ int v_st(int k, int c) { const int kk = (k & ~0xC) | ((k & 4) << 1) | ((k & 8) >> 1); return ((kk >> 3) * 4 + (c >> 5)) * 512 + ((kk & 7) * 32 + (c & 31)) * 2; }
__device__ __forceinline__ int v_rd_base(int lane) { return ((lane & 3) << 3) | (((lane >> 2) & 3) << 6) | (((lane >> 4) & 1) << 5) | (((lane >> 5) & 1) << 8); }
constexpr int v_rd_off(int d0, int ks, int half) { return d0 * 512 + ks * 4096 + half * 2048; }
template <int OFF> __device__ __forceinline__ s16x4 tr_read(int vb) {
  s16x4 r; asm volatile("ds_read_b64_tr_b16 %0, %1 offset:%2" : "=&v"(r) : "v"(vb), "i"(OFF) : "memory"); return r;
}
template <int D0> __device__ __forceinline__ void pv_one(f32x16& od, int vb, bf16x8 pa0, bf16x8 pa1, bf16x8 pa2, bf16x8 pa3) {
  const s16x4 l0 = tr_read<v_rd_off(D0, 0, 0)>(vb), h0 = tr_read<v_rd_off(D0, 0, 1)>(vb), l1 = tr_read<v_rd_off(D0, 1, 0)>(vb), h1 = tr_read<v_rd_off(D0, 1, 1)>(vb);
  const s16x4 l2 = tr_read<v_rd_off(D0, 2, 0)>(vb), h2 = tr_read<v_rd_off(D0, 2, 1)>(vb), l3 = tr_read<v_rd_off(D0, 3, 0)>(vb), h3 = tr_read<v_rd_off(D0, 3, 1)>(vb);
  asm volatile("s_waitcnt lgkmcnt(0)" ::: "memory"); SBAR();
#define PK(L, H) (bf16x8){L[0], L[1], L[2], L[3], H[0], H[1], H[2], H[3]}
  od = __builtin_amdgcn_mfma_f32_32x32x16_bf16(pa0, PK(l0, h0), od, 0, 0, 0);
  od = __builtin_amdgcn_mfma_f32_32x32x16_bf16(pa1, PK(l1, h1), od, 0, 0, 0);
  od = __builtin_amdgcn_mfma_f32_32x32x16_bf16(pa2, PK(l2, h2), od, 0, 0, 0);
  od = __builtin_amdgcn_mfma_f32_32x32x16_bf16(pa3, PK(l3, h3), od, 0, 0, 0);
#undef PK
}
template <int KS> __device__ __forceinline__ void pv_ks(f32x16* o, int vb, bf16x8 pa) {
  const s16x4 l0 = tr_read<v_rd_off(0, KS, 0)>(vb), h0 = tr_read<v_rd_off(0, KS, 1)>(vb), l1 = tr_read<v_rd_off(1, KS, 0)>(vb), h1 = tr_read<v_rd_off(1, KS, 1)>(vb);
  const s16x4 l2 = tr_read<v_rd_off(2, KS, 0)>(vb), h2 = tr_read<v_rd_off(2, KS, 1)>(vb), l3 = tr_read<v_rd_off(3, KS, 0)>(vb), h3 = tr_read<v_rd_off(3, KS, 1)>(vb);
  asm volatile("s_waitcnt lgkmcnt(0)" ::: "memory"); SBAR();
#define PK(L, H) (bf16x8){L[0], L[1], L[2], L[3], H[0], H[1], H[2], H[3]}
  o[0] = __builtin_amdgcn_mfma_f32_32x32x16_bf16(pa, PK(l0, h0), o[0], 0, 0, 0);
  o[1] = __builtin_amdgcn_mfma_f32_32x32x16_bf16(pa, PK(l1, h1), o[1], 0, 0, 0);
  o[2] = __builtin_amdgcn_mfma_f32_32x32x16_bf16(pa, PK(l2, h2), o[2], 0, 0, 0);
  o[3] = __builtin_amdgcn_mfma_f32_32x32x16_bf16(pa, PK(l3, h3), o[3], 0, 0, 0);
#undef PK
}
#define PVR(D0, l0, h0, l1, h1, l2, h2, l3, h3) const s16x4 l0 = tr_read<v_rd_off(D0, 0, 0)>(vb), h0 = tr_read<v_rd_off(D0, 0, 1)>(vb), l1 = tr_read<v_rd_off(D0, 1, 0)>(vb), h1 = tr_read<v_rd_off(D0, 1, 1)>(vb), \
    l2 = tr_read<v_rd_off(D0, 2, 0)>(vb), h2 = tr_read<v_rd_off(D0, 2, 1)>(vb), l3 = tr_read<v_rd_off(D0, 3, 0)>(vb), h3 = tr_read<v_rd_off(D0, 3, 1)>(vb)
#define PK(L, H) (bf16x8){L[0], L[1], L[2], L[3], H[0], H[1], H[2], H[3]}
#define PVM(od, l0, h0, l1, h1, l2, h2, l3, h3) do { od = __builtin_amdgcn_mfma_f32_32x32x16_bf16(pa0, PK(l0, h0), od, 0, 0, 0); od = __builtin_amdgcn_mfma_f32_32x32x16_bf16(pa1, PK(l1, h1), od, 0, 0, 0); \
    od = __builtin_amdgcn_mfma_f32_32x32x16_bf16(pa2, PK(l2, h2), od, 0, 0, 0); od = __builtin_amdgcn_mfma_f32_32x32x16_bf16(pa3, PK(l3, h3), od, 0, 0, 0); } while (0)
__device__ __forceinline__ void pv_d0(f32x16* o, int vb, bf16x8 pa0, bf16x8 pa1, bf16x8 pa2, bf16x8 pa3) {
#ifndef PV_PIPE
  pv_one<0>(o[0], vb, pa0, pa1, pa2, pa3); pv_one<1>(o[1], vb, pa0, pa1, pa2, pa3); pv_one<2>(o[2], vb, pa0, pa1, pa2, pa3); pv_one<3>(o[3], vb, pa0, pa1, pa2, pa3);
#else
  PVR(0, a0, a1, a2, a3, a4, a5, a6, a7);
  PVR(1, b0, b1, b2, b3, b4, b5, b6, b7);
  asm volatile("s_waitcnt lgkmcnt(8)" ::: "memory"); SBAR();
  PVM(o[0], a0, a1, a2, a3, a4, a5, a6, a7); SBAR();
  PVR(2, c0, c1, c2, c3, c4, c5, c6, c7);
  asm volatile("s_waitcnt lgkmcnt(8)" ::: "memory"); SBAR();
  PVM(o[1], b0, b1, b2, b3, b4, b5, b6, b7); SBAR();
  PVR(3, d0, d1, d2, d3, d4, d5, d6, d7);
  asm volatile("s_waitcnt lgkmcnt(8)" ::: "memory"); SBAR();
  PVM(o[2], c0, c1, c2, c3, c4, c5, c6, c7); SBAR();
  asm volatile("s_waitcnt lgkmcnt(0)" ::: "memory"); SBAR();
  PVM(o[3], d0, d1, d2, d3, d4, d5, d6, d7);
#endif
}
#undef PVR
#undef PVM
#undef PK
constexpr int STASH_OFF = 67584;
template <int DQK, int LDO, int MODE = 0>
__device__ __forceinline__ void attn_dense_body(const bf16* __restrict__ Qb, const bf16* __restrict__ Kh, const bf16* __restrict__ Vh,
                                                bf16* __restrict__ Ob, int seq, int kcol0, char* lds, float lam = 0.f, const float* __restrict__ gvec = nullptr, float gmul = 1.f) {
  constexpr int LDQ = PP, LDK = PP;
  constexpr float SCALE = (DQK == 64) ? 0.125f : 0.088388347648318440f;
  int tid = threadIdx.x; asm volatile("" : "+v"(tid)); const int wid = tid >> 6, lane = tid & 63, r32 = lane & 31, hi = lane >> 5;
  if (__builtin_amdgcn_readfirstlane(tid) >= 256) __builtin_amdgcn_s_setprio(1);
  bf16* V_lds = (bf16*)lds; bf16* K_lds = (bf16*)(lds + 2 * SHM_V);
  float* ws = (float*)(lds + 2 * SHM_V + 2 * SHM_K) + wid * 64; float* li_l = ws; float* al_l = ws + 32;
  constexpr bool ACCINIT = (DQK == 64) || ATT_ACCINIT128; float m_reg = ACCINIT ? 0.f : -1e30f, l_reg = 0; f32x16 o[4] = {}; bf16x8 qr[DQK / 16];
  f32x16 negm = {};
  const bf16* Qw = Qb + (long)(wid * QBLK + r32) * LDQ + hi * 8;
#pragma unroll
  for (int d0 = 0; d0 < DQK / 16; ++d0) qr[d0] = *reinterpret_cast<const bf16x8*>(Qw + d0 * 16);
  const int sr = tid >> 4, sc = (tid & 15) * 8, vst0 = v_st(sr, sc), vst1 = v_st(32 + sr, sc);
  const int vb0 = (int)(uintptr_t)V_lds + v_rd_base(lane);
  struct { bf16x8 vs0, vs1, ks0, ks1; } sr_[SDEPTH];
#define SLOAD(i, k0) do { sr_[i].vs0 = *reinterpret_cast<const bf16x8*>(&Vh[(long)((k0) + sr) * LDK + sc]); sr_[i].vs1 = *reinterpret_cast<const bf16x8*>(&Vh[(long)((k0) + 32 + sr) * LDK + sc]); \
    sr_[i].ks0 = *reinterpret_cast<const bf16x8*>(&Kh[(long)((k0) + sr) * LDK + sc]); sr_[i].ks1 = *reinterpret_cast<const bf16x8*>(&Kh[(long)((k0) + 32 + sr) * LDK + sc]); } while (0)
#define SWRITE(b, i) do { *(bf16x8*)((char*)V_lds + (b) * SHM_V + vst0) = sr_[i].vs0;          \
    *(bf16x8*)((char*)V_lds + (b) * SHM_V + vst1) = sr_[i].vs1; int kc = sc * 2;               \
    *(bf16x8*)((char*)K_lds + (b) * SHM_K + KSWZ(sr, kc)) = sr_[i].ks0;                       \
    *(bf16x8*)((char*)K_lds + (b) * SHM_K + KSWZ(32 + sr, kc)) = sr_[i].ks1; } while (0)
#define SWAIT() do { if constexpr (SDEPTH == 2) asm volatile("s_waitcnt vmcnt(4)" ::: "memory"); else asm volatile("s_waitcnt vmcnt(0)" ::: "memory"); } while (0)
#define RESC(a) do { if (__any((a) < 1.f)) { if (hi == 0) al_l[r32] = (a); asm volatile("s_waitcnt lgkmcnt(0)" ::: "memory"); \
    for (int d = 0; d < 4; ++d) for (int r = 0; r < 16; ++r) o[d][r] *= al_l[crow(r, hi)]; } } while (0)
  f32x16 pA0, pA1, pB0, pB1; float mnA, mnB, alA, alB; bf16x8 pa0, pa1, pa2, pa3; const int NT = seq / KVBLK;
  constexpr int SE = 0, SO = SDEPTH - 1;
  SLOAD(SE, 0); asm volatile("s_waitcnt vmcnt(0)" ::: "memory"); SWRITE(0, SE); __syncthreads();
  if constexpr (ACCINIT) { qktn<DQK>(pA0, pA1, K_lds, qr, r32, hi, kcol0, negm); partialSMn<true>(pA0, pA1, m_reg, negm, alA); }
  else { qkt<DQK>(pA0, pA1, K_lds, qr, r32, hi, kcol0); partialSM<DQK>(pA0, pA1, m_reg, mnA, alA); }
  SLOAD(SO, KVBLK); if constexpr (SDEPTH == 2) { if (2 < NT) SLOAD(SE, 2 * KVBLK); }
  SWAIT(); SWRITE(1, SO); __syncthreads();
  for (int j = 1; j + 1 < NT; j += 2) {
    SBAR(); if constexpr (ACCINIT) qktn<DQK>(pB0, pB1, (bf16*)((char*)K_lds + SHM_K), qr, r32, hi, kcol0, negm); else qkt<DQK>(pB0, pB1, (bf16*)((char*)K_lds + SHM_K), qr, r32, hi, kcol0);
    finishSM(pA0, pA1, alA, l_reg, pa0, pa1, pa2, pa3); SBAR();
    SLOAD(SO, (j + SDEPTH) * KVBLK); SBAR();
    pv_d0(o, vb0, pa0, pa1, pa2, pa3); if constexpr (ACCINIT) partialSMn<false>(pB0, pB1, m_reg, negm, alB); else partialSM<DQK>(pB0, pB1, m_reg, mnB, alB);
    __syncthreads(); SWAIT(); SWRITE(0, SE);
    RESC(alB); __syncthreads();
    SBAR(); if constexpr (ACCINIT) qktn<DQK>(pA0, pA1, K_lds, qr, r32, hi, kcol0, negm); else qkt<DQK>(pA0, pA1, K_lds, qr, r32, hi, kcol0);
    finishSM(pB0, pB1, alB, l_reg, pa0, pa1, pa2, pa3); SBAR();
    if (SDEPTH == 1 || j + 3 < NT) SLOAD(SE, (j + 1 + SDEPTH) * KVBLK); SBAR();
    pv_d0(o, vb0 + (int)SHM_V, pa0, pa1, pa2, pa3); if constexpr (ACCINIT) partialSMn<false>(pA0, pA1, m_reg, negm, alA); else partialSM<DQK>(pA0, pA1, m_reg, mnA, alA);
    __syncthreads(); SWAIT(); SWRITE(1, SO);
    RESC(alA); __syncthreads();
  }
  SBAR(); if constexpr (ACCINIT) qktn<DQK>(pB0, pB1, (bf16*)((char*)K_lds + SHM_K), qr, r32, hi, kcol0, negm); else qkt<DQK>(pB0, pB1, (bf16*)((char*)K_lds + SHM_K), qr, r32, hi, kcol0);
  finishSM(pA0, pA1, alA, l_reg, pa0, pa1, pa2, pa3); SBAR();
  pv_d0(o, vb0, pa0, pa1, pa2, pa3); if constexpr (ACCINIT) partialSMn<false>(pB0, pB1, m_reg, negm, alB); else partialSM<DQK>(pB0, pB1, m_reg, mnB, alB);
  __syncthreads(); RESC(alB);
  finishSM(pB0, pB1, alB, l_reg, pa0, pa1, pa2, pa3); SBAR();
  pv_d0(o, vb0 + (int)SHM_V, pa0, pa1, pa2, pa3);
  if (hi == 0) li_l[r32] = l_reg; asm volatile("s_waitcnt lgkmcnt(0)" ::: "memory");
  float rli[16];
#pragma unroll
  for (int r = 0; r < 16; ++r) rli[r] = __builtin_amdgcn_rcpf(li_l[crow(r, hi)]);
  if constexpr (MODE == 0) {
  bf16* Ow = Ob + (long)(wid * QBLK) * LDO;
#pragma unroll
  for (int r = 0; r < 16; ++r) { int orow = crow(r, hi);
    for (int d0 = 0; d0 < 4; ++d0) Ow[(long)orow * LDO + d0 * 32 + r32] = __float2bfloat16(o[d0][r] * rli[r]); }
  } else if constexpr (MODE == 1) {
  bf16* st = (bf16*)(lds + STASH_OFF) + (wid * QBLK) * 128;
#pragma unroll
  for (int r = 0; r < 16; ++r) { int orow = crow(r, hi);
    for (int d0 = 0; d0 < 4; ++d0) st[orow * 128 + d0 * 32 + r32] = __float2bfloat16(o[d0][r] * rli[r]); }
  } else {
  const bf16* st = (const bf16*)(lds + STASH_OFF) + (wid * QBLK) * 128;
  float ssq[16];
#pragma unroll
  for (int r = 0; r < 16; ++r) { int orow = crow(r, hi); float s = 0.f;
    for (int d0 = 0; d0 < 4; ++d0) { const float v = __bfloat162float(st[orow * 128 + d0 * 32 + r32]) - lam * (o[d0][r] * rli[r]); o[d0][r] = v; s += v * v; }
    s += __shfl_xor(s, 1); s += __shfl_xor(s, 2); s += __shfl_xor(s, 4); s += __shfl_xor(s, 8); s += __shfl_xor(s, 16);
    ssq[r] = 1.0f / sqrtf(s * (1.f / 128.f) + NORM_EPS); }
  bf16* Ow = Ob + (long)(wid * QBLK) * LDO;
#pragma unroll
  for (int d0 = 0; d0 < 4; ++d0) { const float gm = gvec[d0 * 32 + r32] * gmul;
#pragma unroll
    for (int r = 0; r < 16; ++r) Ow[(long)crow(r, hi) * LDO + d0 * 32 + r32] = __float2bfloat16(o[d0][r] * ssq[r] * gm); }
  }
  __builtin_amdgcn_s_setprio(0);
#undef SLOAD
#undef SWRITE
#undef SWAIT
#undef RESC
}

__device__ __forceinline__ void swa_unit(const bf16* __restrict__ P, bf16* __restrict__ Y, int bb, int kvh, int qblk, bool isctx, const float* __restrict__ sinkl, char* lds) {
  constexpr float SCALE = 0.125f;
  int tid = threadIdx.x; asm volatile("" : "+v"(tid)); const int wid = tid >> 6, lane = tid & 63, r32 = lane & 31, hi = lane >> 5;
  if (__builtin_amdgcn_readfirstlane(tid) >= 256) __builtin_amdgcn_s_setprio(1);
  const int head = kvh * 4 + (wid & 3), half = wid >> 2;
  bf16* V_lds = (bf16*)lds; bf16* K_lds = (bf16*)(lds + 2 * SHM_V);
  float* ws = (float*)(lds + 2 * SHM_V + 2 * SHM_K) + wid * 64; float* li_l = ws; float* al_l = ws + 32;
  const long rowq0 = (long)bb * TPB + (isctx ? 0 : CTX) + qblk * 64 + half * 32;
  const bf16* Qw = P + (rowq0 + r32) * PP + C_SQ + head * 64 + hi * 8;
  bf16x8 qr[4];
#pragma unroll
  for (int d0 = 0; d0 < 4; ++d0) qr[d0] = *reinterpret_cast<const bf16x8*>(Qw + d0 * 16);
  float m_reg = sinkl[head] * (1.f / SCALE), l_reg = 1.f; f32x16 o[2] = {};
  const int sr = tid >> 3, sc = (tid & 7) * 8, vst = v_st(sr, sc);
  const int vb0 = (int)(uintptr_t)V_lds + v_rd_base(lane);
  const int qpos = qblk * 64 + half * 32 + r32;
  int jlo = 0, nband = 0;
  if (!isctx) { const int q0 = qblk * 64; jlo = (q0 >= 128) ? 0 : (128 - q0) / 64; int jhi = (SEQ - 64 - q0 + 128) / 64; if (jhi > 4) jhi = 4; nband = jhi - jlo + 1; }
  const int ntile = 4 + nband;
  const long kbase = (long)bb * TPB;
#define SWA_KROW(tt) ((tt) < 4 ? kbase + (tt) * 64 : kbase + CTX + (qblk * 64 - 128 + ((tt) - 4 + jlo) * 64))
  bf16x8 kreg, vreg;
  { const long kr = SWA_KROW(0); kreg = *reinterpret_cast<const bf16x8*>(P + (kr + sr) * PP + C_SK + kvh * 64 + sc); vreg = *reinterpret_cast<const bf16x8*>(P + (kr + sr) * PP + C_SV + kvh * 64 + sc); }
  __syncthreads();
  for (int t = 0; t < ntile; ++t) {
    const int buf = t & 1; const bool band = (t >= 4); const int kpos0 = qblk * 64 - 128 + (t - 4 + jlo) * 64;
    *(bf16x8*)((char*)K_lds + buf * SHM_K + KSWZ(sr, sc * 2)) = kreg; *(bf16x8*)((char*)V_lds + buf * SHM_V + vst) = vreg;
    if (t + 1 < ntile) { const long kr = SWA_KROW(t + 1); kreg = *reinterpret_cast<const bf16x8*>(P + (kr + sr) * PP + C_SK + kvh * 64 + sc); vreg = *reinterpret_cast<const bf16x8*>(P + (kr + sr) * PP + C_SV + kvh * 64 + sc); }
    __syncthreads();
    f32x16 p0, p1; float mn, alpha; bf16x8 pa0, pa1, pa2, pa3;
    qkt<64>(p0, p1, (const bf16*)((const char*)K_lds + buf * SHM_K), qr, r32, hi, 0);
    if (band) {
#pragma unroll
      for (int r = 0; r < 16; ++r) { const int d0_ = qpos - (kpos0 + crow(r, hi)); if (d0_ > 128 || d0_ < -128) p0[r] = -1e30f; const int d1_ = d0_ - 32; if (d1_ > 128 || d1_ < -128) p1[r] = -1e30f; }
    }
    partialSM<64>(p0, p1, m_reg, mn, alpha);
    if (__any(alpha < 1.f)) { if (hi == 0) al_l[r32] = alpha; asm volatile("s_waitcnt lgkmcnt(0)" ::: "memory");
#pragma unroll
      for (int d = 0; d < 2; ++d)
#pragma unroll
        for (int r = 0; r < 16; ++r) o[d][r] *= al_l[crow(r, hi)]; }
    finishSM(p0, p1, alpha, l_reg, pa0, pa1, pa2, pa3); SBAR();
    pv_one<0>(o[0], vb0 + buf * (int)SHM_V, pa0, pa1, pa2, pa3); pv_one<1>(o[1], vb0 + buf * (int)SHM_V, pa0, pa1, pa2, pa3);
  }
#undef SWA_KROW
  if (hi == 0) li_l[r32] = l_reg; asm volatile("s_waitcnt lgkmcnt(0)" ::: "memory");
  float rli[16];
#pragma unroll
  for (int r = 0; r < 16; ++r) rli[r] = __builtin_amdgcn_rcpf(li_l[crow(r, hi)]);
  bf16* Ow = Y + rowq0 * DM + 1024 + head * 64;
#pragma unroll
  for (int r = 0; r < 16; ++r) { const int orow = crow(r, hi);
#pragma unroll
    for (int d0 = 0; d0 < 2; ++d0) Ow[(long)orow * DM + d0 * 32 + r32] = __float2bfloat16(o[d0][r] * rli[r]); }
  __builtin_amdgcn_s_setprio(0);
  __syncthreads();
}
#undef KSWZ
#undef SBAR
}

#define LAS __attribute__((address_space(3)))
#ifndef PH_MASK
#define PH_MASK 0xFFFFF
#endif
#ifndef MX_MASK
#define MX_MASK 15
#endif
#ifndef P_ALIGN
#define P_ALIGN true
#endif
#ifndef BR_ALIGN
#define BR_ALIGN true
#endif
#ifndef UP_ALIGN
#define UP_ALIGN true
#endif
#ifndef GATE_ALIGN
#define GATE_ALIGN false
#endif
#ifndef RESID_ALIGN
#define RESID_ALIGN false
#endif
#ifndef DBL_MASK
#define DBL_MASK 0
#endif
#ifndef DBL_MX
#define DBL_MX 0
#endif
#ifdef DBL_RESID
#define RESID_LOOP for (int rr_ = 0; rr_ < 2; ++rr_)
#else
#define RESID_LOOP for (int rr_ = 1; rr_ < 2; ++rr_)
#endif
#define REP(bit) for (int rep_ = 0; rep_ < ((DBL_MASK & (bit)) ? 2 : 1); ++rep_)
#define REPX(bit) for (int rep_ = 0; rep_ < ((DBL_MX & (bit)) ? 2 : 1); ++rep_)
typedef __hip_bfloat16 hbf16;
constexpr size_t WS_ZT = 7 * MiB + 256 * 1024;
struct Args { const float* in[21]; float* out; unsigned char* ws; int pad0, pad1; };
struct Frame { int tid, lane, wave, G, vcu, gw, NGW; unsigned char* ws; char* lds; };

#define XB_TMO      128
#define XB_XCNT(j)  (256  + 64 * (j))
#define XB_XSUB(j)  (1280 + 64 * (j))
#define XB_XGEN(j)  (2304 + 64 * (j))
#define XB_TOP      3328
#define XB_TOPGEN   3392
#define XCD_BAR_WORDS 3456
#define XB_SPIN_CAP (1u << 18)

__device__ __forceinline__ unsigned xb_ld(unsigned* p)              { return __hip_atomic_load(p, __ATOMIC_RELAXED, __HIP_MEMORY_SCOPE_AGENT); }
__device__ __forceinline__ unsigned xb_add(unsigned* p, unsigned v) { return __hip_atomic_fetch_add(p, v, __ATOMIC_RELAXED, __HIP_MEMORY_SCOPE_AGENT); }
__device__ __forceinline__ unsigned xb_xcc_id() { return (unsigned)__builtin_amdgcn_s_getreg((3 << 11) | 20) & 0xFu; }
#define XB_SPIN(cond, bar) do { unsigned _sp = 0; while (cond) { __builtin_amdgcn_s_sleep(1); \
    if ((++_sp & 255u) == 0u) { if (xb_ld(&(bar)[XB_TMO])) break; if (_sp > XB_SPIN_CAP) { atomicAdd(&(bar)[XB_TMO], 1u); break; } } } } while (0)

struct XcdBarrier {
    unsigned* bar; unsigned x;
    volatile LAS unsigned* st;
};

__device__ __forceinline__ XcdBarrier xcd_barrier_post(unsigned* bar, volatile LAS unsigned* st) {
    XcdBarrier b; b.bar = bar; b.x = xb_xcc_id(); b.st = st;
    if (threadIdx.x == 0) (void)xb_add(&bar[XB_XCNT(b.x)], 1u);
    return b;
}
__device__ __forceinline__ void xcd_barrier_complete(unsigned* bar, unsigned x, unsigned& nloc, unsigned& nx) {
    const unsigned G = gridDim.x * gridDim.y * gridDim.z;
    unsigned sum, cnt, mine, sp = 0u;
    for (;;) {
        sum = 0u; cnt = 0u; mine = 0u;
#pragma unroll
        for (unsigned j = 0; j < 16; ++j) { const unsigned c = xb_ld(&bar[XB_XCNT(j)]); sum += c; cnt += (c > 0u) ? 1u : 0u; mine = (j == x) ? c : mine; }
        if (sum == G) break;
        __builtin_amdgcn_s_sleep(1);
        if ((++sp & 255u) == 0u) { if (xb_ld(&bar[XB_TMO])) break; if (sp > XB_SPIN_CAP) { atomicAdd(&bar[XB_TMO], 1u); break; } }
    }
    nloc = mine > 0u ? mine : 1u; nx = cnt > 0u ? cnt : 1u;
}

__device__ __forceinline__ void xcd_barrier(const XcdBarrier& b) {
    asm volatile("s_waitcnt vmcnt(0)" ::: "memory");
    __syncthreads();
    if (threadIdx.x == 0) {
        unsigned* bar = b.bar;
        __builtin_amdgcn_s_waitcnt(0);
        unsigned nloc = b.st[0], nx = b.st[1];
        if (nloc == 0u) { xcd_barrier_complete(bar, b.x, nloc, nx); b.st[0] = nloc; b.st[1] = nx; }
        const unsigned old = xb_add(&bar[XB_XSUB(b.x)], 1u);
        const unsigned gen = old / nloc;
        if (old + 1u == (gen + 1u) * nloc) {
            __builtin_amdgcn_fence(__ATOMIC_RELEASE, "agent");
            asm volatile("s_waitcnt vmcnt(0)" ::: "memory");
            const unsigned og = xb_add(&bar[XB_TOP], 1u);
            const unsigned tg = og / nx;
            if (og + 1u == (tg + 1u) * nx) xb_add(&bar[XB_TOPGEN], 1u);
            else XB_SPIN(xb_ld(&bar[XB_TOPGEN]) == tg, bar);
            __builtin_amdgcn_fence(__ATOMIC_ACQUIRE, "agent");
            xb_add(&bar[XB_XGEN(b.x)], 1u);
            asm volatile("s_waitcnt vmcnt(0)" ::: "memory");
        } else {
            XB_SPIN(xb_ld(&bar[XB_XGEN(b.x)]) == gen, bar);
            __builtin_amdgcn_fence(__ATOMIC_ACQUIRE, "agent");
            asm volatile("s_waitcnt vmcnt(0)" ::: "memory");
        }
    }
    __syncthreads();
}

constexpr size_t WS_BAR = 7 * MiB + 512 * 1024;
constexpr int LDS_BARST = LDS_BYTES - 64;
__device__ __forceinline__ Frame make_frame(unsigned char* ws, char* lds) {
    Frame F; int t = threadIdx.x; asm volatile("" : "+v"(t)); F.tid = t; F.lane = t & 63; F.wave = __builtin_amdgcn_readfirstlane(t >> 6); F.G = gridDim.x;
    { const int bx = blockIdx.x; F.vcu = (F.G % 8 == 0) ? (bx % 8) * (F.G / 8) + bx / 8 : bx; }
    F.gw = F.vcu * 8 + F.wave; F.NGW = F.G * 8; F.ws = ws; F.lds = lds; return F;
}
typedef const __attribute__((address_space(4))) Args* CArgsP0;
__device__ __forceinline__ void s0_phase(const Frame& F, CArgsP0 a) {
    float* sv = (float*)F.lds;
    float* modp = (float*)(F.ws + WS_MODP);
    const float* c = a->in[1]; const float* cctx = a->in[3]; const float* adaw = a->in[4];
    for (int i = blockIdx.x * 512 + F.tid; i < 3 * 12288; i += F.G * 512) ((float*)(F.ws + WS_ZT))[i] = 0.f;
    for (int it = blockIdx.x; it < 793; it += F.G) {
        if (it < 768) {
            const int l = it / 384, r = it % 384, ks = r / 24, ch = r % 24;
            __syncthreads();
            if (F.tid < 384) { const int w = F.tid >> 7, dd = F.tid & 127, d = ks * 128 + dd; const float cv = (w < 2) ? c[w * DM + d] : cctx[d]; sv[F.tid] = cv / (1.f + expf(-cv)); }
            __syncthreads();
            const int j = ch * 512 + F.tid;
            const float* W = adaw + (size_t)l * DM * 12288 + (size_t)(ks * 128) * 12288 + j;
            float a0 = 0.f, a1 = 0.f, a2 = 0.f;
#pragma unroll 8
            for (int dd = 0; dd < 128; ++dd) { const float wv = W[(size_t)dd * 12288]; a0 += sv[dd] * wv; a1 += sv[128 + dd] * wv; a2 += sv[256 + dd] * wv; }
            float* o = modp + (size_t)((l * 16 + ks) * 3) * 12288 + j;
            o[0] = a0; o[12288] = a1; o[2 * 12288] = a2;
        } else if (it < 792) {
            const int idx = (it - 768) * 512 + F.tid;
            float* tab = (float*)(F.ws + WS_ROPE);
            int pos, f, nf; float* cdst; float* sdst;
            if (idx < 4096) { pos = idx >> 4; f = idx & 15; nf = 16; cdst = tab + idx; sdst = tab + 4096 + idx; }
            else { const int i2 = idx - 4096; pos = i2 >> 5; f = i2 & 31; nf = 32; cdst = tab + 8192 + i2; sdst = tab + 16384 + i2; }
            const float inv = exp2f(-(float)f / (float)nf * 13.287712379549449f);
            const float ang = (float)pos * inv;
            double rev = (double)ang * 0.15915494309189535; rev -= floor(rev);
            const float fr = (float)rev;
            *cdst = __builtin_amdgcn_cosf(fr); *sdst = __builtin_amdgcn_sinf(fr);
        } else {
            const int l = F.wave >> 2, h = F.wave & 3; const float* lp = a->in[10] + (size_t)l * 4 * 4 * 64;
            float pa = lp[(0 * 4 + h) * 64 + F.lane] * lp[(1 * 4 + h) * 64 + F.lane], pb = lp[(2 * 4 + h) * 64 + F.lane] * lp[(3 * 4 + h) * 64 + F.lane];
            pa = wave_sum(pa); pb = wave_sum(pb);
            const float lam_init = (l == 0) ? 0.2f : 0.35550906759f;
            if (F.lane == 0) ((float*)(F.ws + WS_LAM))[l * 4 + h] = expf(pa) - expf(pb) + lam_init;
        }
    }
}

__device__ __forceinline__ int map_win(int j) { return j < NMIX ? j : -1; }
__device__ __forceinline__ int map_gate(int R) { const int pn = R >> 8, c = R & 255; const int i = 2 * (c >> 7) + ((c & 31) >> 4), oc = 64 * pn + 16 * ((c & 127) >> 5) + (c & 15); return NMIX + i * DM + oc; }
__device__ __forceinline__ int map_up(int R) { const int pn = R >> 8, c = R & 255; return (c >> 7) * FF + 128 * pn + (c & 127); }
template <int MAP> __device__ __forceinline__ void transpose_item(const float* __restrict__ W, int Nsrc, int K, bf16raw* __restrict__ WT, int kb, int nb, float* scr, int lane) {
    const int k0 = 64 * kb, n0 = 32 * nb; const int jr = n0 + (lane & 31);
    const int col = (MAP == 0) ? jr : (MAP == 1) ? map_win(jr) : (MAP == 2) ? map_gate(jr) : map_up(jr);
#pragma unroll 8
    for (int i = 0; i < 32; ++i) { const int kk = 2 * i + (lane >> 5); scr[kk * 33 + (lane & 31)] = (col >= 0) ? W[(size_t)(k0 + kk) * Nsrc + col] : 0.f; }
    asm volatile("s_waitcnt lgkmcnt(0)" ::: "memory");
    const int cch = lane & 7;
#pragma unroll
    for (int j = 0; j < 4; ++j) { const int n = (lane >> 3) + 8 * j; const float* s = scr + (8 * cch) * 33 + n;
        u32x4_t o; o.x = pk2(s[0 * 33], s[1 * 33]); o.y = pk2(s[2 * 33], s[3 * 33]); o.z = pk2(s[4 * 33], s[5 * 33]); o.w = pk2(s[6 * 33], s[7 * 33]);
        *(u32x4_t*)(WT + (size_t)(n0 + n) * K + k0 + 8 * cch) = o; }
    asm volatile("s_waitcnt lgkmcnt(0)" ::: "memory");
}
__device__ __forceinline__ void s1_phase(const Frame& F, CArgsP0 a, int l) {
    if (l == 0) {
        const float* modp = (const float*)(F.ws + WS_MODP); float* mod = (float*)(F.ws + WS_MOD); const float* adab = a->in[5];
        for (int idx = blockIdx.x * 512 + F.tid; idx < 2 * 3 * 12288; idx += F.G * 512) {
            const int l2 = idx / (3 * 12288), rem = idx - l2 * 3 * 12288, w = rem / 12288, j = rem - w * 12288;
            float s = adab[l2 * 12288 + j];
#pragma unroll
            for (int ks = 0; ks < 16; ++ks) s += modp[(size_t)((l2 * 16 + ks) * 3 + w) * 12288 + j];
            mod[idx] = s;
        }
    }
    float* scr = (float*)F.lds + F.wave * (64 * 33);
    const float* w_in = a->in[7] + (size_t)l * DM * DIN; const float* w_br = a->in[15] + (size_t)l * 4 * 512 * DM; const float* w_out = a->in[16] + (size_t)l * DM * DM;
    const float* w_up = a->in[18] + (size_t)l * DM * 2 * FF; const float* w_dn = a->in[19] + (size_t)l * FF * DM;
    constexpr int I_IN = 32 * (PP / 32), I_G = 32 * (8192 / 32), I_B = 4 * 8 * 64, I_O = 32 * 64, I_U = 32 * (2 * FF / 32), I_D = (FF / 64) * 64;
    constexpr int NITEMS = I_IN + I_G + I_B + I_O + I_U + I_D;
    for (int it = F.gw; it < NITEMS; it += F.NGW) {
        int r = it;
        if (r < I_IN) { const int nblk = PP / 32; transpose_item<1>(w_in, DIN, DM, (bf16raw*)(F.ws + WS_WIN), r / nblk, r % nblk, scr, F.lane); continue; } r -= I_IN;
        if (r < I_G) { const int nblk = 8192 / 32; transpose_item<2>(w_in, DIN, DM, (bf16raw*)(F.ws + WS_WG), r / nblk, r % nblk, scr, F.lane); continue; } r -= I_G;
        if (r < I_B) { const int i = r / 512, rr = r % 512; transpose_item<0>(w_br + (size_t)i * 512 * DM, DM, 512, (bf16raw*)(F.ws + WS_WB) + (size_t)i * DM * 512, rr / 64, rr % 64, scr, F.lane); continue; } r -= I_B;
        if (r < I_O) { transpose_item<0>(w_out, DM, DM, (bf16raw*)(F.ws + WS_WOUT), r / 64, r % 64, scr, F.lane); continue; } r -= I_O;
        if (r < I_U) { const int nblk = 2 * FF / 32; transpose_item<3>(w_up, 2 * FF, DM, (bf16raw*)(F.ws + WS_WUP), r / nblk, r % nblk, scr, F.lane); continue; } r -= I_U;
        transpose_item<0>(w_dn, DM, FF, (bf16raw*)(F.ws + WS_WDN), r / 64, r % 64, scr, F.lane);
    }
}

__device__ __forceinline__ void norm_mod_phase(const Frame& F, const XPtr xin, const bf16raw* delta, const XOut xout, const float* __restrict__ gam, const float* __restrict__ modl, int shi, int sci, bf16raw* out) {
    constexpr int RPW = 17;
    int curw = -1; f32x4_t ca[8], cb[8];
    const int rbeg = F.gw * RPW, rend = (rbeg + RPW < MROWS) ? rbeg + RPW : MROWS;
    for (int r = rbeg; r < rend; ++r) {
        const int b = r / TPB, t = r - b * TPB, w = (t < CTX) ? 2 : b;
        if (w != curw) { curw = w;
#pragma unroll
            for (int j = 0; j < 8; ++j) { const int col = 4 * F.lane + 256 * j; const f32x4_t g = *(const f32x4_t*)(gam + col), sc = *(const f32x4_t*)(modl + (size_t)w * 12288 + sci * 2048 + col);
                ca[j] = g * (sc + 1.0f); cb[j] = *(const f32x4_t*)(modl + (size_t)w * 12288 + shi * 2048 + col); } }
        const f32x4_t* xr = (const f32x4_t*)xin.row(r) + F.lane;
        f32x4_t v[8]; float s = 0.f;
#pragma unroll
        for (int j = 0; j < 8; ++j) v[j] = xr[64 * j];
        if (delta) { const u32x2_t* dr = (const u32x2_t*)(delta + (size_t)r * DM) + F.lane; u32x2_t dv[8];
#pragma unroll
            for (int j = 0; j < 8; ++j) dv[j] = dr[64 * j];
            f32x4_t* xw = (f32x4_t*)xout.row(r) + F.lane;
#pragma unroll
            for (int j = 0; j < 8; ++j) { v[j].x += bflo(dv[j].x); v[j].y += bfhi(dv[j].x); v[j].z += bflo(dv[j].y); v[j].w += bfhi(dv[j].y); xw[64 * j] = v[j]; } }
#pragma unroll
        for (int j = 0; j < 8; ++j) s += (v[j].x * v[j].x + v[j].y * v[j].y) + (v[j].z * v[j].z + v[j].w * v[j].w);
        const float rstd = 1.0f / sqrtf(wave_sum(s) * (1.f / DM) + NORM_EPS);
        u32x2_t* o8 = (u32x2_t*)(out + (size_t)r * DM) + F.lane;
#pragma unroll
        for (int j = 0; j < 8; ++j) { const f32x4_t y = v[j] * rstd * ca[j] + cb[j]; u32x2_t w2; w2.x = pk2(y.x, y.y); w2.y = pk2(y.z, y.w); o8[64 * j] = w2; }
    }
}
__device__ __forceinline__ void final_norm_phase(const Frame& F, float* x, const bf16raw* __restrict__ delta, const float* __restrict__ gam) {
    for (int r = F.gw; r < NBATCH * SEQ; r += F.NGW) {
        f32x4_t* xr = (f32x4_t*)(x + (size_t)r * DM) + F.lane; f32x4_t v[8]; float s = 0.f;
        const int b = r / SEQ, ur = b * TPB + CTX + (r - b * SEQ);
        const u32x2_t* dr = (const u32x2_t*)(delta + (size_t)ur * DM) + F.lane;
#pragma unroll
        for (int j = 0; j < 8; ++j) { v[j] = xr[64 * j]; const u32x2_t d = dr[64 * j]; v[j].x += bflo(d.x); v[j].y += bfhi(d.x); v[j].z += bflo(d.y); v[j].w += bfhi(d.y);
            s += (v[j].x * v[j].x + v[j].y * v[j].y) + (v[j].z * v[j].z + v[j].w * v[j].w); }
        const float rstd = 1.0f / sqrtf(wave_sum(s) * (1.f / DM) + NORM_EPS);
#pragma unroll
        for (int j = 0; j < 8; ++j) xr[64 * j] = v[j] * rstd * *(const f32x4_t*)(gam + 4 * F.lane + 256 * j);
    }
}

__device__ __forceinline__ void rope_decode(int vp, int& x1c, int& x2c, int& f0, int& axis, int& hcol, bool& d128, bool& isq, bool& isdq) {
    x1c = 0; x2c = 0; f0 = 0; axis = 0; hcol = 0; d128 = false; isq = true; isdq = (vp >= 48 && vp < 80);
    if (vp < 48) { d128 = true; isq = vp < 32; const int v2 = isq ? vp : vp - 32; const int head = v2 >> 3, i = v2 & 7; axis = i >> 2; const int j = i & 3; f0 = 8 * j;
        const int base = (isq ? C_GQ : C_GK) + head * 128 + axis * 64; x1c = base + 8 * j; x2c = x1c + 32; hcol = axis * 64 + 8 * j; }
    else if (vp < 152) { const int v3 = vp - 48, seg = v3 >> 5, w = v3 & 31, head = w >> 2, i = w & 3; axis = i >> 1; const int j = i & 1; f0 = 8 * j;
        const int sb = (seg == 0) ? C_DQ : (seg == 1) ? C_DK : (seg == 2) ? C_SQ : C_SK; const int base = sb + head * 64 + axis * 32; x1c = base + 8 * j; x2c = x1c + 16; }
}
__device__ __forceinline__ void rope_phase(const Frame& F, bf16raw* P, const float* __restrict__ qg, const float* __restrict__ kg) {
    const float* tab = (const float*)(F.ws + WS_ROPE);
    int x1c[3], x2c[3], f0[3], axis[3], hcol[3]; bool d128[3], isq[3], act[3], isdq[3];
#pragma unroll
    for (int pass = 0; pass < 3; ++pass) { const int vp = pass * 64 + F.lane; act[pass] = vp < 152; rope_decode(vp, x1c[pass], x2c[pass], f0[pass], axis[pass], hcol[pass], d128[pass], isq[pass], isdq[pass]); }
    for (int r = F.gw; r < MROWS; r += F.NGW) {
        const int b = r / TPB, t = r - b * TPB; const bool latent = t >= CTX; const int pos = t - CTX, prow = pos >> 6, pcol = pos & 63;
        bf16raw* Pr = P + (size_t)r * PP;
        u32x4_t w1[3], w2[3];
#pragma unroll
        for (int pass = 0; pass < 3; ++pass) { const bool ld = act[pass] && (d128[pass] || latent || isdq[pass]);
            if (ld) { w1[pass] = *(const u32x4_t*)(Pr + x1c[pass]); w2[pass] = *(const u32x4_t*)(Pr + x2c[pass]); } else { w1[pass] = (u32x4_t){0u, 0u, 0u, 0u}; w2[pass] = w1[pass]; } }
#pragma unroll
        for (int pass = 0; pass < 3; ++pass) {
            float x1[8], x2[8]; unpack8(w1[pass], x1); unpack8(w2[pass], x2);
            if (pass == 0) {
                float ss = 0.f;
#pragma unroll
                for (int e = 0; e < 8; ++e) ss += x1[e] * x1[e] + x2[e] * x2[e];
                ss += __shfl_xor(ss, 1); ss += __shfl_xor(ss, 2); ss += __shfl_xor(ss, 4);
                if (d128[0]) { const float rstd = 1.0f / sqrtf(ss * (1.f / 128.f) + NORM_EPS); const float* gn = isq[0] ? qg : kg;
#pragma unroll
                    for (int e = 0; e < 8; ++e) { x1[e] = x1[e] * rstd * gn[hcol[0] + e]; x2[e] = x2[e] * rstd * gn[hcol[0] + 32 + e]; } }
            }
            if (act[pass] && latent) {
                const int p = axis[pass] ? pcol : prow;
                const float* ct = d128[pass] ? tab + 8192 + p * 32 + f0[pass] : tab + p * 16 + f0[pass]; const float* st = d128[pass] ? tab + 16384 + p * 32 + f0[pass] : tab + 4096 + p * 16 + f0[pass];
#pragma unroll
                for (int e = 0; e < 8; ++e) { const float cc = ct[e], sn = st[e], a1 = x1[e], a2 = x2[e]; x1[e] = a1 * cc - a2 * sn; x2[e] = a2 * cc + a1 * sn; }
            }
            if (ATT_ACCINIT128 && pass == 0 && d128[0] && isq[0]) {
#pragma unroll
                for (int e = 0; e < 8; ++e) { x1[e] *= 0.12751743074602467f; x2[e] *= 0.12751743074602467f; } }
            if (isdq[pass]) {
#pragma unroll
                for (int e = 0; e < 8; ++e) { x1[e] *= 0.18033688011112042f; x2[e] *= 0.18033688011112042f; } }
            if (act[pass] && (d128[pass] || latent || isdq[pass])) { *(u32x4_t*)(Pr + x1c[pass]) = pack8(x1); *(u32x4_t*)(Pr + x2c[pass]) = pack8(x2); }
        }
    }
}

__device__ __forceinline__ int tbmap(int dir, int j) { return dir == 0 ? j : (j == 0 ? 1 : (j == 1 ? 0 : 131 - j)); }
__device__ __forceinline__ float log_sigmoid_f(float x) { return fminf(x, 0.f) - log1pf(expf(-fabsf(x))); }
__device__ __forceinline__ void gate_scan(const bf16raw* __restrict__ P, const float* __restrict__ gb, int r0, int head, int dir, int lane, float (&ig)[2], float (&bc)[2], float& blast) {
    float lf[2];
#pragma unroll
    for (int k = 0; k < 2; ++k) { const int s = 2 * lane + k, tok = dir ? 127 - s : s; const bf16raw* pr = P + (size_t)(r0 + tok) * PP + C_MG;
        ig[k] = bf1(pr[(2 * dir) * 4 + head]) + gb[(2 * dir) * 4 + head]; lf[k] = log_sigmoid_f(bf1(pr[(2 * dir + 1) * 4 + head]) + gb[(2 * dir + 1) * 4 + head]); }
    const float c1 = lf[0] + lf[1]; float v = c1;
#pragma unroll
    for (int o = 1; o < 64; o <<= 1) { const float tt = __shfl_up(v, o); if (lane >= o) v += tt; }
    const float excl = v - c1; bc[0] = excl + lf[0]; bc[1] = excl + c1; blast = __shfl(v, 63);
}
__device__ __forceinline__ void mlstm_a_phase(const Frame& F, const bf16raw* __restrict__ P, const float* __restrict__ gb) {
    float* ks = (float*)F.lds;
    float* vs = ks + 128 * 64;
    float* wts = vs + 128 * 128;
    float* CST = (float*)(F.ws + WS_CST); float* NST = (float*)(F.ws + WS_NST); float* MSC = (float*)(F.ws + WS_MSC);
    for (int u = blockIdx.x; u < 16 * NCHUNK; u += F.G) {
        const int chain = u / NCHUNK, tb = u - chain * NCHUNK, bb = chain >> 3, head = (chain >> 1) & 3, dir = chain & 1;
        const int r0 = bb * TPB + tb * 128;
        __syncthreads();
        if (F.wave == 0) {
            float ig[2], bc[2], bl; gate_scan(P, gb, r0, head, dir, F.lane, ig, bc, bl);
            const float lw0 = bl - bc[0] + ig[0], lw1 = bl - bc[1] + ig[1]; const float ml = wave_max(fmaxf(lw0, lw1));
            const int s0 = 2 * F.lane; wts[dir ? 127 - s0 : s0] = expf(lw0 - ml); wts[dir ? 126 - s0 : s0 + 1] = expf(lw1 - ml);
            if (F.lane == 0) { MSC[chain * NCHUNK + tb] = bl; MSC[16 * NCHUNK + chain * NCHUNK + tb] = ml; }
        }
        __syncthreads();
#pragma unroll
        for (int i = 0; i < 2; ++i) { const int vi = F.tid + 512 * i, tok = vi >> 3, c8 = (vi & 7) * 8; float f[8]; unpack8(*(const u32x4_t*)(P + (size_t)(r0 + tok) * PP + C_MK + head * 64 + c8), f);
            const float w = wts[tok] * 0.125f;
#pragma unroll
            for (int e = 0; e < 8; ++e) ks[tok * 64 + c8 + e] = f[e] * w; }
#pragma unroll
        for (int i = 0; i < 4; ++i) { const int vi = F.tid + 512 * i, tok = vi >> 4, c8 = (vi & 15) * 8; float f[8]; unpack8(*(const u32x4_t*)(P + (size_t)(r0 + tok) * PP + C_MV + head * 128 + c8), f);
#pragma unroll
            for (int e = 0; e < 8; ++e) vs[tok * 128 + c8 + e] = f[e]; }
        __syncthreads();
        const int vg = F.tid & 31, dg = F.tid >> 5;
        f32x4_t acc[4];
#pragma unroll
        for (int i = 0; i < 4; ++i) acc[i] = (f32x4_t){0.f, 0.f, 0.f, 0.f};
#pragma unroll 4
        for (int tok = 0; tok < 128; ++tok) { const f32x4_t vv = *(const f32x4_t*)(vs + tok * 128 + 4 * vg), kv = *(const f32x4_t*)(ks + tok * 64 + 4 * dg);
            acc[0] += kv * vv.x; acc[1] += kv * vv.y; acc[2] += kv * vv.z; acc[3] += kv * vv.w; }
        float* Co = CST + (size_t)(chain * NCHUNK + tb) * 8192;
#pragma unroll
        for (int i = 0; i < 4; ++i) *(f32x4_t*)(Co + (4 * vg + i) * 64 + 4 * dg) = acc[i];
        if (F.tid < 64) { float s = 0.f;
#pragma unroll 8
            for (int tok = 0; tok < 128; ++tok) s += ks[tok * 64 + F.tid];
            NST[(size_t)(chain * NCHUNK + tb) * 64 + F.tid] = s; }
    }
}
__device__ __forceinline__ void mlstm_b_phase(const Frame& F) {
    float* CST = (float*)(F.ws + WS_CST); float* NST = (float*)(F.ws + WS_NST); float* MSC = (float*)(F.ws + WS_MSC);
    const float* BL = MSC; const float* ML = MSC + 16 * NCHUNK; float* MS = MSC + 32 * NCHUNK;
    for (int e = blockIdx.x * 512 + F.tid; e < 16 * 8192; e += F.G * 512) {
        const int chain = e >> 13, idx = e & 8191, dir = chain & 1; const bool hn = idx < 64;
        float C = 0.f, nv = 0.f, m = 0.f;
        for (int j0 = 0; j0 < NCHUNK; j0 += 10) {
            float cl[10], nl[10], bl[10], ml[10];
#pragma unroll
            for (int i = 0; i < 10; ++i) { const int tb = tbmap(dir, j0 + i), ci = chain * NCHUNK + tb; cl[i] = CST[(size_t)ci * 8192 + idx]; nl[i] = hn ? NST[(size_t)ci * 64 + idx] : 0.f; bl[i] = BL[ci]; ml[i] = ML[ci]; }
#pragma unroll
            for (int i = 0; i < 10; ++i) { const int tb = tbmap(dir, j0 + i), ci = chain * NCHUNK + tb;
                CST[(size_t)ci * 8192 + idx] = C; if (hn) NST[(size_t)ci * 64 + idx] = nv; if (idx == 0) MS[ci] = m;
                const float mnew = fmaxf(bl[i] + m, ml[i]); const float dec = expf(bl[i] + m - mnew), wg = expf(ml[i] - mnew);
                C = dec * C + wg * cl[i]; nv = dec * nv + wg * nl[i]; m = mnew; }
        }
    }
}
__device__ __forceinline__ void mlstm_c_unit(const Frame& F, const bf16raw* __restrict__ P, const float* __restrict__ gb, const float* __restrict__ ng, bf16raw* __restrict__ Y, int bb, int head, int tb) {
    constexpr int KP = 72, SP = 132;
    bf16raw* qs = (bf16raw*)F.lds;
    bf16raw* kc = qs + 128 * 64;
    bf16raw* vs = kc + 128 * KP;
    float* Ss = (float*)(vs + 128 * 128);
    float* sm = Ss + 128 * SP;
    float* a_tok = sm, *M_tok = sm + 128, *bc_tok = sm + 256, *nst = sm + 384, *misc = sm + 448;
    const float* CST = (const float*)(F.ws + WS_CST); const float* NST = (const float*)(F.ws + WS_NST); const float* MS = (const float*)(F.ws + WS_MSC) + 32 * NCHUNK;
    const int r0 = bb * TPB + tb * 128;
    int tidl = F.tid; asm volatile("" : "+v"(tidl));
    const int vg = tidl & 15, tg = tidl >> 4;
    float hsum[4][8];
#pragma unroll
    for (int a = 0; a < 4; ++a)
#pragma unroll
        for (int e = 0; e < 8; ++e) hsum[a][e] = 0.f;
    for (int dir = 0; dir < 2; ++dir) {
        const int chain = bb * 8 + head * 2 + dir, ci = chain * NCHUNK + tb;
        __syncthreads();
        int tA = F.tid; asm volatile("" : "+v"(tA));
#pragma unroll
        for (int i = 0; i < 2; ++i) { const int vi = tA + 512 * i, tok = vi >> 3, c8 = (vi & 7) * 8; const bf16raw* pr = P + (size_t)(r0 + tok) * PP + head * 64 + c8;
            *(u32x4_t*)(qs + tok * 64 + c8) = *(const u32x4_t*)(pr + C_MQ); *(u32x4_t*)(kc + tok * KP + c8) = *(const u32x4_t*)(pr + C_MK); }
#pragma unroll
        for (int i = 0; i < 4; ++i) { const int vi = tA + 512 * i, tok = vi >> 4, c8 = (vi & 15) * 8; *(u32x4_t*)(vs + tok * 128 + c8) = *(const u32x4_t*)(P + (size_t)(r0 + tok) * PP + C_MV + head * 128 + c8); }
        const float m_prev = MS[ci];
        if (F.wave == 0) {
            float ig[2], bc[2], bl; gate_scan(P, gb, r0, head, dir, F.lane, ig, bc, bl);
            const float a0 = ig[0] - bc[0], a1 = ig[1] - bc[1];
            const float pm = fmaxf(a0, a1); float v = pm;
#pragma unroll
            for (int o = 1; o < 64; o <<= 1) { const float tt = __shfl_up(v, o); if (F.lane >= o) v = fmaxf(v, tt); }
            float ex = __shfl_up(v, 1); if (F.lane == 0) ex = -3.0e38f;
            const float M0 = fmaxf(m_prev, fmaxf(ex, a0)), M1 = fmaxf(m_prev, fmaxf(ex, pm));
            const int s0 = 2 * F.lane, t0 = dir ? 127 - s0 : s0, t1 = dir ? 126 - s0 : s0 + 1;
            a_tok[t0] = a0; a_tok[t1] = a1; M_tok[t0] = M0; M_tok[t1] = M1; bc_tok[t0] = bc[0]; bc_tok[t1] = bc[1];
        } else if (F.wave == 1) { nst[F.lane] = NST[(size_t)ci * 64 + F.lane]; }
        __syncthreads();
        {
            float sacc[4][8];
#pragma unroll
            for (int a = 0; a < 4; ++a)
#pragma unroll
                for (int i = 0; i < 8; ++i) sacc[a][i] = 0.f;
#pragma unroll 1
            for (int d0 = 0; d0 < 64; d0 += 8) {
                float qf[4][8];
#pragma unroll
                for (int a = 0; a < 4; ++a) unpack8(*(const u32x4_t*)(qs + (4 * tg + a) * 64 + d0), qf[a]);
#pragma unroll
                for (int i = 0; i < 8; ++i) { float kf[8]; unpack8(*(const u32x4_t*)(kc + (vg + 16 * i) * KP + d0), kf);
#pragma unroll
                    for (int a = 0; a < 4; ++a)
#pragma unroll
                        for (int e = 0; e < 8; ++e) sacc[a][i] += qf[a][e] * kf[e]; }
            }
#pragma unroll
            for (int a = 0; a < 4; ++a) { const int t = 4 * tg + a; const float Mt = M_tok[t];
#pragma unroll
                for (int i = 0; i < 8; ++i) { const int s = vg + 16 * i; const bool ok = dir ? (s >= t) : (s <= t);
                    Ss[t * SP + s] = ok ? sacc[a][i] * 0.125f * expf(a_tok[s] - Mt) : 0.f; } }
        }
        __syncthreads();
        {
            const float* Cg = CST + (size_t)ci * 8192;
#pragma unroll
            for (int i = 0; i < 4; ++i) { const int vi = tA + 512 * i, vrow = vi >> 4, c4 = (vi & 15) * 4; const f32x4_t cv = *(const f32x4_t*)(Cg + vrow * 64 + c4);
                u32x2_t w; w.x = pk2(cv.x, cv.y); w.y = pk2(cv.z, cv.w); *(u32x2_t*)(kc + vrow * KP + c4) = w; }
        }
        float num[4][8], rs[4];
#pragma unroll
        for (int a = 0; a < 4; ++a) { rs[a] = 0.f;
#pragma unroll
            for (int e = 0; e < 8; ++e) num[a][e] = 0.f; }
        {
            const int wv16 = 16 * F.wave;
            const int sbeg = dir ? wv16 : 0, send = dir ? 128 : wv16 + 16;
#pragma unroll 1
            for (int s0 = sbeg; s0 < send; s0 += 4) {
                f32x4_t S4[4];
#pragma unroll
                for (int a = 0; a < 4; ++a) S4[a] = *(const f32x4_t*)(Ss + (4 * tg + a) * SP + s0);
#pragma unroll
                for (int ss = 0; ss < 4; ++ss) { float vf[8]; unpack8(*(const u32x4_t*)(vs + (s0 + ss) * 128 + 8 * vg), vf);
#pragma unroll
                    for (int a = 0; a < 4; ++a) { const float sv = S4[a][ss]; rs[a] += sv;
#pragma unroll
                        for (int e = 0; e < 8; ++e) num[a][e] += sv * vf[e]; } }
            }
        }
        __syncthreads();
        {
            float qc[4][8], nq[4];
#pragma unroll
            for (int a = 0; a < 4; ++a) { nq[a] = 0.f;
#pragma unroll
                for (int e = 0; e < 8; ++e) qc[a][e] = 0.f; }
#pragma unroll 1
            for (int d0 = 0; d0 < 64; d0 += 8) {
                float qf[4][8];
#pragma unroll
                for (int a = 0; a < 4; ++a) { unpack8(*(const u32x4_t*)(qs + (4 * tg + a) * 64 + d0), qf[a]);
#pragma unroll
                    for (int e = 0; e < 8; ++e) nq[a] += nst[d0 + e] * qf[a][e]; }
#pragma unroll
                for (int e = 0; e < 8; ++e) { float cf[8]; unpack8(*(const u32x4_t*)(kc + (8 * vg + e) * KP + d0), cf);
#pragma unroll
                    for (int a = 0; a < 4; ++a)
#pragma unroll
                        for (int k = 0; k < 8; ++k) qc[a][e] += cf[k] * qf[a][k]; }
            }
#pragma unroll
            for (int a = 0; a < 4; ++a) { const int t = 4 * tg + a; const float Mt = M_tok[t], winter = expf(m_prev - Mt);
                const float den = winter * nq[a] + rs[a]; const float dn = fmaxf(fabsf(den), expf(-(bc_tok[t] + Mt))); const float inv = 1.0f / dn;
#pragma unroll
                for (int e = 0; e < 8; ++e) hsum[a][e] += (winter * qc[a][e] + num[a][e]) * inv; }
        }
    }
    float gmm[8];
#pragma unroll
    for (int e = 0; e < 8; ++e) gmm[e] = ng[head * 128 + 8 * vg + e];
#pragma unroll
    for (int a = 0; a < 4; ++a) { float ss = 0.f;
#pragma unroll
        for (int e = 0; e < 8; ++e) ss += hsum[a][e] * hsum[a][e];
        ss += __shfl_xor(ss, 1); ss += __shfl_xor(ss, 2); ss += __shfl_xor(ss, 4); ss += __shfl_xor(ss, 8);
        const float rstd = 1.0f / sqrtf(ss * (1.f / 128.f) + NORM_EPS);
        const int row = r0 + 4 * tg + a; float of[8]; unpack8(*(const u32x4_t*)(P + (size_t)row * PP + C_MO + head * 128 + 8 * vg), of);
        float yv[8];
#pragma unroll
        for (int e = 0; e < 8; ++e) yv[e] = hsum[a][e] * rstd * gmm[e] * sigmoid_f(of[e]);
        *(u32x4_t*)(Y + (size_t)row * DM + head * 128 + 8 * vg) = pack8(yv); }
    (void)misc;
}

#define KSWZ64(row, colB) ((row) * 128 + ((colB) ^ (((row) & 7) << 4)))
__device__ __forceinline__ void mlstm_c_unit_mfma(const Frame& F, const bf16raw* __restrict__ P, const float* __restrict__ gb, const float* __restrict__ ng, bf16raw* __restrict__ Y, int bb, int head, int tb) {
    using att::bf16x8; using att::f32x16; using att::crow;
    constexpr int CP = 72;
    constexpr int L_K = 0, L_V = 16384, L_C = 49152, L_SM = 86016, L_WS = 90112, L_HB = 0, HP = 132;
    char* lds = F.lds;
    int tid = F.tid; asm volatile("" : "+v"(tid));
    const int wid = F.wave, lane = tid & 63, r32 = lane & 31, hi = lane >> 5, dir = wid >> 2, rg = wid & 3;
    const float* CST = (const float*)(F.ws + WS_CST); const float* NST = (const float*)(F.ws + WS_NST); const float* MS = (const float*)(F.ws + WS_MSC) + 32 * NCHUNK;
    const int r0 = bb * TPB + tb * 128;
    float* sm = (float*)(lds + L_SM);
    float* wsc = (float*)(lds + L_WS) + wid * 64;
    __syncthreads();
#pragma unroll
    for (int i = 0; i < 2; ++i) { const int vi = tid + 512 * i, key = vi >> 3, c8 = (vi & 7) * 8;
        *(u32x4_t*)(lds + L_K + (key >> 6) * 8192 + KSWZ64(key & 63, c8 * 2)) = *(const u32x4_t*)(P + (size_t)(r0 + key) * PP + C_MK + head * 64 + c8); }
#pragma unroll
    for (int i = 0; i < 4; ++i) { const int vi = tid + 512 * i, key = vi >> 4, c8 = (vi & 15) * 8;
        *(u32x4_t*)(lds + L_V + (key >> 6) * 16384 + att::v_st(key & 63, c8)) = *(const u32x4_t*)(P + (size_t)(r0 + key) * PP + C_MV + head * 128 + c8); }
#pragma unroll
    for (int i = 0; i < 8; ++i) { const int vi = tid + 512 * i, d2 = vi >> 11, rem = vi & 2047, vrow = rem >> 4, c4 = (rem & 15) * 4;
        const int ci2 = (bb * 8 + head * 2 + d2) * NCHUNK + tb; const f32x4_t cv = *(const f32x4_t*)(CST + (size_t)ci2 * 8192 + vrow * 64 + c4);
        u32x2_t w; w.x = pk2(cv.x, cv.y); w.y = pk2(cv.z, cv.w); *(u32x2_t*)(lds + L_C + d2 * 18432 + (vrow * CP + c4) * 2) = w; }
    const int chain = bb * 8 + head * 2 + dir, ci = chain * NCHUNK + tb;
    const float m_prev = MS[ci];
    float* smd = sm + dir * 448;
    if (rg == 0) {
        float ig[2], bc[2], bl; gate_scan(P, gb, r0, head, dir, lane, ig, bc, bl);
        const float a0 = ig[0] - bc[0], a1 = ig[1] - bc[1]; const float pm = fmaxf(a0, a1); float v = pm;
#pragma unroll
        for (int o = 1; o < 64; o <<= 1) { const float tt = __shfl_up(v, o); if (lane >= o) v = fmaxf(v, tt); }
        float ex = __shfl_up(v, 1); if (lane == 0) ex = -3.0e38f;
        const float M0 = fmaxf(m_prev, fmaxf(ex, a0)), M1 = fmaxf(m_prev, fmaxf(ex, pm));
        const int s0 = 2 * lane, t0 = dir ? 127 - s0 : s0, t1 = dir ? 126 - s0 : s0 + 1;
        smd[t0] = a0; smd[t1] = a1; smd[128 + t0] = M0; smd[128 + t1] = M1; smd[256 + t0] = bc[0]; smd[256 + t1] = bc[1];
    } else if (rg == 1) { smd[384 + lane] = NST[(size_t)ci * 64 + lane]; }
    const int tq = 32 * rg + r32;
    bf16x8 qr[4];
#pragma unroll
    for (int d0 = 0; d0 < 4; ++d0) qr[d0] = *reinterpret_cast<const bf16x8*>(P + (size_t)(r0 + tq) * PP + C_MQ + head * 64 + d0 * 16 + hi * 8);
    __syncthreads();
    const float Mt = smd[128 + tq], winter = __expf(m_prev - Mt);
    float nq = 0.f; bf16x8 qs[4];
#pragma unroll
    for (int d0 = 0; d0 < 4; ++d0) { float qf[8]; unpack8(__builtin_bit_cast(u32x4_t, qr[d0]), qf); float qw[8];
#pragma unroll
        for (int e = 0; e < 8; ++e) { nq += smd[384 + d0 * 16 + hi * 8 + e] * qf[e]; qw[e] = qf[e] * winter; }
        qs[d0] = __builtin_bit_cast(bf16x8, pack8(qw)); }
    { auto rr = __builtin_amdgcn_permlane32_swap(__float_as_uint(nq), __float_as_uint(nq), false, false); nq = __uint_as_float(rr[0]) + __uint_as_float(rr[1]); }
    f32x16 o[4] = {};
    { const char* cb = lds + L_C + dir * 18432;
#pragma unroll
      for (int blk = 0; blk < 4; ++blk)
#pragma unroll
        for (int ks = 0; ks < 4; ++ks) { const bf16x8 cf = *reinterpret_cast<const bf16x8*>(cb + ((32 * blk + r32) * CP + 16 * ks + 8 * hi) * 2);
            o[blk] = __builtin_amdgcn_mfma_f32_32x32x16_bf16(qs[ks], cf, o[blk], 0, 0, 0); } }
    float rs = 0.f;
    const int vb0 = (int)(uintptr_t)(lds + L_V) + att::v_rd_base(lane);
    const int kt_lo = dir ? (rg >= 2 ? 1 : 0) : 0, kt_hi = dir ? 1 : (rg >= 2 ? 1 : 0);
    for (int kt = kt_lo; kt <= kt_hi; ++kt) {
        f32x16 p0 = {}, p1 = {};
        const char* Ks = lds + L_K + kt * 8192;
#pragma unroll
        for (int d0 = 0; d0 < 4; ++d0) { const int cbb = (d0 * 16 + hi * 8) * 2;
            const bf16x8 b0 = *reinterpret_cast<const bf16x8*>(Ks + KSWZ64(r32, cbb)), b1 = *reinterpret_cast<const bf16x8*>(Ks + KSWZ64(32 + r32, cbb));
            p0 = __builtin_amdgcn_mfma_f32_32x32x16_bf16(b0, qr[d0], p0, 0, 0, 0); p1 = __builtin_amdgcn_mfma_f32_32x32x16_bf16(b1, qr[d0], p1, 0, 0, 0); }
#pragma unroll
        for (int r = 0; r < 16; ++r) { const int s0_ = 64 * kt + crow(r, hi), s1_ = s0_ + 32;
            const bool ok0 = dir ? (s0_ >= tq) : (s0_ <= tq), ok1 = dir ? (s1_ >= tq) : (s1_ <= tq);
            const float w0 = ok0 ? 0.125f * __expf(smd[s0_] - Mt) : 0.f, w1 = ok1 ? 0.125f * __expf(smd[s1_] - Mt) : 0.f;
            p0[r] *= w0; p1[r] *= w1; rs += p0[r] + p1[r]; }
        bf16x8 pa0, pa1, pa2, pa3;
#define PK4M(Pv, BASE, OUT) do { unsigned a0 = att::cvtpk(Pv[BASE + 0], Pv[BASE + 1]), a1 = att::cvtpk(Pv[BASE + 2], Pv[BASE + 3]);   \
    unsigned b0 = att::cvtpk(Pv[BASE + 4], Pv[BASE + 5]), b1 = att::cvtpk(Pv[BASE + 6], Pv[BASE + 7]);                              \
    auto r0_ = __builtin_amdgcn_permlane32_swap(a0, b0, false, false); auto r1_ = __builtin_amdgcn_permlane32_swap(a1, b1, false, false); \
    u32x4_t w_ = {r0_[0], r1_[0], r0_[1], r1_[1]}; OUT = __builtin_bit_cast(bf16x8, w_); } while (0)
        PK4M(p0, 0, pa0); PK4M(p0, 8, pa1); PK4M(p1, 0, pa2); PK4M(p1, 8, pa3);
#undef PK4M
        __builtin_amdgcn_sched_barrier(0);
        const int vb = vb0 + kt * 16384;
        att::pv_one<0>(o[0], vb, pa0, pa1, pa2, pa3); att::pv_one<1>(o[1], vb, pa0, pa1, pa2, pa3); att::pv_one<2>(o[2], vb, pa0, pa1, pa2, pa3); att::pv_one<3>(o[3], vb, pa0, pa1, pa2, pa3);
    }
    { auto rr = __builtin_amdgcn_permlane32_swap(__float_as_uint(rs), __float_as_uint(rs), false, false); rs = __uint_as_float(rr[0]) + __uint_as_float(rr[1]); }
    const float den = winter * nq + rs; const float dn = fmaxf(fabsf(den), __expf(-(smd[256 + tq] + Mt)));
    if (hi == 0) wsc[r32] = 1.0f / dn;
    asm volatile("s_waitcnt lgkmcnt(0)" ::: "memory");
    float inv[16];
#pragma unroll
    for (int r = 0; r < 16; ++r) inv[r] = wsc[crow(r, hi)];
    __syncthreads();
    float* hb = (float*)(lds + L_HB);
    if (dir == 1) {
#pragma unroll
        for (int blk = 0; blk < 4; ++blk)
#pragma unroll
            for (int r = 0; r < 16; ++r) hb[(32 * rg + crow(r, hi)) * HP + 32 * blk + r32] = o[blk][r] * inv[r];
    }
    __syncthreads();
    if (dir == 0) {
        float ss[16];
#pragma unroll
        for (int r = 0; r < 16; ++r) ss[r] = 0.f;
#pragma unroll
        for (int blk = 0; blk < 4; ++blk)
#pragma unroll
            for (int r = 0; r < 16; ++r) { const float h = o[blk][r] * inv[r] + hb[(32 * rg + crow(r, hi)) * HP + 32 * blk + r32]; o[blk][r] = h; ss[r] += h * h; }
#pragma unroll
        for (int r = 0; r < 16; ++r) { float s = ss[r]; s += __shfl_xor(s, 1); s += __shfl_xor(s, 2); s += __shfl_xor(s, 4); s += __shfl_xor(s, 8); s += __shfl_xor(s, 16); ss[r] = 1.0f / sqrtf(s * (1.f / 128.f) + NORM_EPS); }
#pragma unroll
        for (int blk = 0; blk < 4; ++blk) { const float gm = ng[head * 128 + 32 * blk + r32];
#pragma unroll
            for (int r = 0; r < 16; ++r) { const size_t row = (size_t)(r0 + 32 * rg + crow(r, hi));
                const float og = bf1(P[row * PP + C_MO + head * 128 + 32 * blk + r32]);
                const float yv = o[blk][r] * ss[r] * gm * sigmoid_f(og);
                Y[row * DM + head * 128 + 32 * blk + r32] = (bf16raw)(pk2(yv, 0.f) & 0xffffu); } }
    }
}

__device__ __forceinline__ void diff_post_phase(const Frame& F, const bf16raw* __restrict__ T, const float* __restrict__ lam, const float* __restrict__ g, float one_minus, bf16raw* __restrict__ Y) {
    const int h = F.lane >> 4, c8 = (F.lane & 15) * 8; const float lm = lam[h]; float gm[8];
#pragma unroll
    for (int e = 0; e < 8; ++e) gm[e] = g[h * 128 + c8 + e] * one_minus;
    for (int r = F.gw; r < MROWS; r += 2 * F.NGW) {
        const int r2 = r + F.NGW; const bool has2 = r2 < MROWS; const int rb = has2 ? r2 : r;
        const u32x4_t wa1 = *(const u32x4_t*)(T + (size_t)r * 1024 + (2 * h) * 128 + c8), wa2 = *(const u32x4_t*)(T + (size_t)r * 1024 + (2 * h + 1) * 128 + c8);
        const u32x4_t wb1 = *(const u32x4_t*)(T + (size_t)rb * 1024 + (2 * h) * 128 + c8), wb2 = *(const u32x4_t*)(T + (size_t)rb * 1024 + (2 * h + 1) * 128 + c8);
#pragma unroll
        for (int q = 0; q < 2; ++q) {
            float o1[8], o2[8]; unpack8(q ? wb1 : wa1, o1); unpack8(q ? wb2 : wa2, o2);
            float ss = 0.f;
#pragma unroll
            for (int e = 0; e < 8; ++e) { o1[e] -= lm * o2[e]; ss += o1[e] * o1[e]; }
            ss += __shfl_xor(ss, 1); ss += __shfl_xor(ss, 2); ss += __shfl_xor(ss, 4); ss += __shfl_xor(ss, 8);
            const float rstd = 1.0f / sqrtf(ss * (1.f / 128.f) + NORM_EPS);
#pragma unroll
            for (int e = 0; e < 8; ++e) o1[e] *= rstd * gm[e];
            if (q == 0 || has2) *(u32x4_t*)(Y + (size_t)(q ? r2 : r) * DM + 512 + h * 128 + c8) = pack8(o1);
        }
    }
}

__device__ __forceinline__ void mixer_phase(const Frame& F, CArgsP0 a, int l) {
    const hbf16* P = (const hbf16*)(F.ws + WS_P); hbf16* Yb = (hbf16*)(F.ws + WS_Y); hbf16* DT = (hbf16*)(F.ws + WS_DTMP);
    const bool lastl = (l == DEPTH - 1);
    const float* lamv = (const float*)(F.ws + WS_LAM) + l * 4; const float* dng = a->in[11] + l * 512; const float one_minus = (l == 0) ? 0.8f : 0.64449093241f;
    REPX(1) if (MX_MASK & 1) for (int k = F.vcu; k < 1024; k += F.G) {
        const int i = k >> 8, rem = k & 255;
        __syncthreads();
        if (i < 2) { const int id = i * 256 + rem, combo = id >> 6, qb = id & 63, bb = combo >> 2, h = combo & 3;
            const long rq = (long)bb * TPB + CTX + qb * 256, rk = (long)bb * TPB;
            att::attn_dense_body<64, DM, 1>(P + rq * PP + C_DQ + h * 128, P + rk * PP + C_DK + h * 128, P + rk * PP + C_DV + h * 128, Yb, TPB, 0, F.lds);
            __syncthreads();
            att::attn_dense_body<64, DM, 2>(P + rq * PP + C_DQ + h * 128 + 64, P + rk * PP + C_DK + h * 128, P + rk * PP + C_DV + h * 128, Yb + rq * DM + 512 + h * 128, TPB, 64, F.lds, lamv[h], dng + h * 128, one_minus);
        } else { const int id = (i - 2) * 256 + rem, combo = id >> 6, qb = id & 63, bb = combo >> 2, h = combo & 3;
            const long rq = (long)bb * TPB + CTX + qb * 256, rk = (long)bb * TPB;
            att::attn_dense_body<128, DM>(P + rq * PP + C_GQ + h * 128, P + rk * PP + C_GK + (h >> 1) * 128, P + rk * PP + C_GV + (h >> 1) * 128, Yb + rq * DM + 1536 + h * 128, TPB, 0, F.lds);
        }
    }
    if (!lastl && (MX_MASK & 1)) for (int k = F.vcu; k < 16; k += F.G) {
        __syncthreads();
        if (k < 8) { const int bb = k >> 2, h = k & 3; const long rq = (long)bb * TPB;
            att::attn_dense_body<64, DM, 1>(P + rq * PP + C_DQ + h * 128, P + rq * PP + C_DK + h * 128, P + rq * PP + C_DV + h * 128, Yb, CTX, 0, F.lds);
            __syncthreads();
            att::attn_dense_body<64, DM, 2>(P + rq * PP + C_DQ + h * 128 + 64, P + rq * PP + C_DK + h * 128, P + rq * PP + C_DV + h * 128, Yb + rq * DM + 512 + h * 128, CTX, 64, F.lds, lamv[h], dng + h * 128, one_minus);
        } else { const int k2 = k - 8, bb = k2 >> 2, h = k2 & 3; const long rq = (long)bb * TPB;
            att::attn_dense_body<128, DM>(P + rq * PP + C_GQ + h * 128, P + rq * PP + C_GK + (h >> 1) * 128, P + rq * PP + C_GV + (h >> 1) * 128, Yb + rq * DM + 1536 + h * 128, CTX, 0, F.lds);
        }
    }
    __syncthreads();
    const float* sinkl = a->in[12] + l * 8;
    REPX(2) if (MX_MASK & 2) for (int k = F.vcu; k < (lastl ? 1024 : 1040); k += F.G) {
        if (k < 1024) att::swa_unit(P, Yb, k >> 9, (k >> 8) & 1, k & 255, false, sinkl, F.lds);
        else { const int k2 = k - 1024; att::swa_unit(P, Yb, k2 >> 3, (k2 >> 2) & 1, k2 & 3, true, sinkl, F.lds); }
    }
    const float* gb = a->in[8] + l * 16; const float* ng = a->in[9] + l * 512;
    REPX(4) if (MX_MASK & 4) for (int k = F.vcu; k < (lastl ? 8 * (NCHUNK - 2) : 8 * NCHUNK); k += F.G) { int bb, head, tb;
        if (lastl) { bb = k / (4 * (NCHUNK - 2)); const int rem = k - bb * 4 * (NCHUNK - 2); head = rem / (NCHUNK - 2); tb = 2 + rem - head * (NCHUNK - 2); }
        else { bb = k / (4 * NCHUNK); const int rem = k - bb * 4 * NCHUNK; head = rem / NCHUNK; tb = rem - head * NCHUNK; }
#ifdef MLSTM_VALU
        mlstm_c_unit(F, (const bf16raw*)P, gb, ng, (bf16raw*)Yb, bb, head, tb);
#else
        mlstm_c_unit_mfma(F, (const bf16raw*)P, gb, ng, (bf16raw*)Yb, bb, head, tb);
#endif
    }
    __syncthreads();
}

__device__ __forceinline__ void stagger_start(int ticks) {
    const int grp = (blockIdx.x >> 3) & 3;
    if (grp) { const unsigned long long t0 = __builtin_amdgcn_s_memrealtime(); const unsigned long long d = (unsigned long long)(grp * ticks);
        while (__builtin_amdgcn_s_memrealtime() - t0 < d) __builtin_amdgcn_s_sleep(16); }
}
#ifndef STAG_GATE
#define STAG_GATE 0
#endif
#ifndef STAG_RESID
#define STAG_RESID 0
#endif
struct RowOrder { pg8::StaticOrder S; int skip;
    __device__ void init(int N, int G, int c, int skip_) { skip = skip_; S.init(skip_ ? NBATCH * SEQ : MROWS, N, G, c); }
    __device__ bool next(int i, pg8::Unit& u) const { if (!S.next(i, u)) return false; if (skip) u.pm += 1 + (u.pm >= 64 ? 1 : 0); return true; }
    __device__ __forceinline__ void a_ready(const pg8::Unit&) const {}
    __device__ __forceinline__ void done(const pg8::Unit&) const {}
};
typedef const __attribute__((address_space(4))) Args* CArgsP;
__device__ __forceinline__ CArgsP get_args() { CArgsP p = (CArgsP)__builtin_amdgcn_kernarg_segment_ptr(); asm volatile("" : "+s"(p)); return p; }
#define PHASE_BEGIN CArgsP ap = get_args(); unsigned char* ws = ap->ws; const Frame F = make_frame(ws, (char*)lds); (void)F;
__global__ void __launch_bounds__(512, 2) fwd_megakernel(Args a_unused) {
    extern __shared__ __attribute__((aligned(16))) unsigned char lds[];
    cg::grid_group grid = cg::this_grid();
    PG8_LAS unsigned char* glds = (PG8_LAS unsigned char*)lds;
    if (threadIdx.x < 16) ((LAS unsigned*)((LAS unsigned char*)lds + LDS_BARST))[threadIdx.x] = 0u;
    __syncthreads();
    { CArgsP ap0 = get_args(); (void)xcd_barrier_post((unsigned*)(ap0->ws + WS_BAR), (volatile LAS unsigned*)((LAS unsigned char*)lds + LDS_BARST)); }
#define GBAR() do { CArgsP apb = get_args(); XcdBarrier xb_; xb_.bar = (unsigned*)(apb->ws + WS_BAR); xb_.x = xb_xcc_id(); xb_.st = (volatile LAS unsigned*)((LAS unsigned char*)lds + LDS_BARST); xcd_barrier(xb_); } while (0)
    REP(1) if (PH_MASK & 1) { PHASE_BEGIN s0_phase(F, ap); }
    grid.sync();
#ifdef EXTRA_SYNCS
    for (int es = 0; es < EXTRA_SYNCS; ++es) GBAR();
#endif
#pragma unroll 1
    for (int l = 0; l < DEPTH; ++l) {
        REP(2) if (PH_MASK & 2) { PHASE_BEGIN s1_phase(F, ap, l); }
        GBAR();
        REP(4) if (PH_MASK & 4) { PHASE_BEGIN const float* modl = (const float*)(ws + WS_MOD) + (size_t)l * 3 * 12288;
            const XPtr xin = (l == 0) ? XPtr{ap->in[0], ap->in[2]} : XPtr{ap->out, (const float*)(ws + WS_XC)};
            norm_mod_phase(F, xin, (l == 0) ? (const bf16raw*)nullptr : (const bf16raw*)(ws + WS_H), XOut{ap->out, (float*)(ws + WS_XC)}, ap->in[6] + l * DM, modl, 0, 1, (bf16raw*)(ws + WS_H)); }
        GBAR();
        REP(8) if (PH_MASK & 8) { PHASE_BEGIN
            pg8::Gemm g{(const pg8::bf16_t*)(ws + WS_H), (const pg8::bf16_t*)(ws + WS_WIN), MROWS, PP, DM, DM, 0, 0}; pg8::StaticOrder S; S.init(MROWS, PP, F.G, (int)blockIdx.x);
            pg8::EpiBf16<0> E{(pg8::bf16_t*)(ws + WS_P), PP, nullptr, 0, 0, 1.f};
            pg8::gemm_phase<pg8::EpiBf16<0>, pg8::StaticOrder, P_ALIGN, true>(glds, g, S, E);
        }
        GBAR();
        if (PH_MASK & 16) { PHASE_BEGIN rope_phase(F, (bf16raw*)(ws + WS_P), ap->in[13] + l * 128, ap->in[14] + l * 128); }
#ifdef DBL_SCAN
        for (int rs_ = 0; rs_ < 2; ++rs_) {
#endif
        REP(32) if (PH_MASK & 32) { PHASE_BEGIN mlstm_a_phase(F, (const bf16raw*)(ws + WS_P), ap->in[8] + l * 16); }
        GBAR();
        if (PH_MASK & 64) { PHASE_BEGIN mlstm_b_phase(F); }
        GBAR();
#ifdef DBL_SCAN
        }
#endif
        if (PH_MASK & 128) { PHASE_BEGIN mixer_phase(F, ap, l); }
        GBAR();
        REP(512) if (PH_MASK & 512) { PHASE_BEGIN
            pg8::Gemm g{(const pg8::bf16_t*)(ws + WS_Y), (const pg8::bf16_t*)(ws + WS_WB), MROWS, 8192, 512, DM, 8, 512}; RowOrder S; S.init(8192, F.G, (int)blockIdx.x, l == DEPTH - 1);
            pg8::EpiBf16<0> E{(pg8::bf16_t*)(ws + WS_BIG), DM, nullptr, DM, (size_t)MROWS * DM, 1.f};
            pg8::gemm_phase<pg8::EpiBf16<0>, RowOrder, BR_ALIGN, true>(glds, g, S, E);
        }
        GBAR();
        REP(1024) if (PH_MASK & 1024) { PHASE_BEGIN
            pg8::Gemm g{(const pg8::bf16_t*)(ws + WS_H), (const pg8::bf16_t*)(ws + WS_WG), MROWS, 8192, DM, DM, 0, 0}; RowOrder S; S.init(8192, F.G, (int)blockIdx.x, l == DEPTH - 1);
            pg8::EpiGate E{(const pg8::bf16_t*)(ws + WS_BIG), (pg8::bf16_t*)(ws + WS_Y), (size_t)MROWS * DM};
            if (STAG_GATE) stagger_start(STAG_GATE);
#ifdef PROBE_GATE_KLOOP
            { pg8::EpiNone E0{(float*)(ws + WS_ZT)}; pg8::gemm_phase<pg8::EpiNone, RowOrder, GATE_ALIGN, true>(glds, g, S, E0); }
#endif
            pg8::gemm_phase<pg8::EpiGate, RowOrder, GATE_ALIGN, true>(glds, g, S, E);
        }
        GBAR();
        if (PH_MASK & 2048) { PHASE_BEGIN
            const float* modl = (const float*)(ws + WS_MOD) + (size_t)l * 3 * 12288;
            pg8::Gemm g{(const pg8::bf16_t*)(ws + WS_Y), (const pg8::bf16_t*)(ws + WS_WOUT), MROWS, DM, DM, DM, 0, 0}; RowOrder S; S.init(DM, F.G, (int)blockIdx.x, l == DEPTH - 1);
            pg8::EpiDelta E{(pg8::bf16_t*)(ws + WS_H), modl, 2};
            pg8::gemm_phase<pg8::EpiDelta, RowOrder, true, true>(glds, g, S, E);
        }
        GBAR();
        REP(4) if (PH_MASK & 4) { PHASE_BEGIN const float* modl = (const float*)(ws + WS_MOD) + (size_t)l * 3 * 12288;
            const XPtr xin2 = (l == 0) ? XPtr{ap->in[0], ap->in[2]} : XPtr{ap->out, (const float*)(ws + WS_XC)};
            norm_mod_phase(F, xin2, (const bf16raw*)(ws + WS_H), XOut{ap->out, (float*)(ws + WS_XC)}, ap->in[17] + l * DM, modl, 3, 4, (bf16raw*)(ws + WS_H)); }
        GBAR();
        REP(4096) if (PH_MASK & 4096) { PHASE_BEGIN
            pg8::Gemm g{(const pg8::bf16_t*)(ws + WS_H), (const pg8::bf16_t*)(ws + WS_WUP), MROWS, 2 * FF, DM, DM, 0, 0}; RowOrder S; S.init(2 * FF, F.G, (int)blockIdx.x, l == DEPTH - 1);
            pg8::EpiSwiGLU E{(pg8::bf16_t*)(ws + WS_BIG), FF};
            pg8::gemm_phase<pg8::EpiSwiGLU, RowOrder, UP_ALIGN, true>(glds, g, S, E);
        }
        GBAR();
        if (PH_MASK & 8192) { PHASE_BEGIN
            const float* modl = (const float*)(ws + WS_MOD) + (size_t)l * 3 * 12288;
            pg8::Gemm g{(const pg8::bf16_t*)(ws + WS_BIG), (const pg8::bf16_t*)(ws + WS_WDN), MROWS, DM, FF, FF, 0, 0}; RowOrder S; S.init(DM, F.G, (int)blockIdx.x, l == DEPTH - 1);
            pg8::EpiDelta E{(pg8::bf16_t*)(ws + WS_H), modl, 5};
            pg8::gemm_phase<pg8::EpiDelta, RowOrder, true, true>(glds, g, S, E);
        }
        GBAR();
    }
    if (PH_MASK & 16384) { PHASE_BEGIN final_norm_phase(F, ap->out, (const bf16raw*)(ws + WS_H), ap->in[20]); }
}

extern "C" void kernel_launch(void* const* d_in, const int* in_sizes, int n_in, void* d_out, int out_size, void* d_ws, size_t ws_size, hipStream_t stream) {
    static int grid = 0;
    if (grid == 0) {
        if (n_in != 21 || out_size != NBATCH * SEQ * DM || ws_size < WS_END) { fprintf(stderr, "kernel_launch: unexpected shapes: n_in %d out %d ws %zu (need %zu)\n", n_in, out_size, ws_size, (size_t)WS_END); grid = -1; return; }
        int dev = 0, cus = 0, per_cu = 0;
        if (hipGetDevice(&dev) != hipSuccess || hipDeviceGetAttribute(&cus, hipDeviceAttributeMultiprocessorCount, dev) != hipSuccess) { grid = -1; return; }
        if (hipFuncSetAttribute((const void*)fwd_megakernel, hipFuncAttributeMaxDynamicSharedMemorySize, LDS_BYTES) != hipSuccess) { fprintf(stderr, "kernel_launch: hipFuncSetAttribute failed\n"); grid = -1; return; }
        if (hipOccupancyMaxActiveBlocksPerMultiprocessor(&per_cu, (const void*)fwd_megakernel, 512, LDS_BYTES) != hipSuccess || per_cu < 1) per_cu = 1;
        (void)hipGetLastError();
        grid = cus;
        fprintf(stderr, "kernel_launch: cus %d per_cu %d grid %d ws %zu\n", cus, per_cu, grid, ws_size);
    }
    if (grid < 0) return;
    Args a{};
    for (int i = 0; i < 21; ++i) a.in[i] = (const float*)d_in[i];
    a.out = (float*)d_out; a.ws = (unsigned char*)d_ws;
    (void)hipMemsetAsync((char*)d_ws + WS_BAR, 0, XCD_BAR_WORDS * 4, stream);
    void* args[] = {&a};
    const hipError_t e = hipLaunchCooperativeKernel((const void*)fwd_megakernel, dim3(grid), dim3(512), args, LDS_BYTES, stream);
    if (e != hipSuccess) fprintf(stderr, "kernel_launch: cooperative launch failed: %s (grid %d)\n", hipGetErrorString(e), grid);
}
```

```cpp
#include <hip/hip_runtime.h>
#include <hip/hip_bf16.h>
#include <hip/hip_cooperative_groups.h>
#include <cstdio>
#include <cstdint>
namespace cg = cooperative_groups;

constexpr int DM = 2048, NBATCH = 2, SEQ = 16384, CTX = 256, DEPTH = 2;
constexpr int TPB = SEQ + CTX;
constexpr int MROWS = NBATCH * TPB;
constexpr int DIN = 13072, NMIX = 4880, PP = 5120;
constexpr int FF = 5632;
constexpr int C_MQ = 0, C_MK = 256, C_MV = 512, C_MO = 1024, C_MG = 1536, C_DQ = 1552, C_DK = 2064, C_DV = 2576, C_SQ = 3088, C_SK = 3600, C_SV = 3728,
              C_GQ = 3856, C_GK = 4368, C_GV = 4624;
constexpr int NCHUNK = TPB / 128;
constexpr float NORM_EPS = 1e-6f;

constexpr size_t MiB = 1u << 20;
constexpr size_t WS_MODP = 0;
constexpr size_t WS_MOD = 5 * MiB;
constexpr size_t WS_ROPE = 5 * MiB + 512 * 1024;
constexpr size_t WS_LAM = 5 * MiB + 768 * 1024;
constexpr size_t WS_MSC = 6 * MiB;
constexpr size_t WS_NST = 6 * MiB + 512 * 1024;
constexpr size_t WS_W = 8 * MiB;
constexpr size_t WS_WIN = WS_W, WS_WG = WS_WIN + 20 * MiB, WS_WB = WS_WG + 32 * MiB, WS_WOUT = WS_WB + 8 * MiB, WS_WUP = WS_WOUT + 8 * MiB, WS_WDN = WS_WUP + 44 * MiB;
constexpr size_t WS_H = WS_WDN + 22 * MiB;
constexpr size_t WS_Y = WS_H + 130 * MiB;
constexpr size_t WS_XC = WS_Y + 130 * MiB;
constexpr size_t WS_BIG = WS_XC + 4 * MiB;
constexpr size_t WS_P = WS_BIG, WS_DTMP = WS_BIG + 325 * MiB, WS_CST = WS_BIG + 390 * MiB;
constexpr size_t WS_END = WS_BIG + 520 * MiB;
static_assert(WS_H == 142 * MiB && WS_END == 926 * MiB, "ws map");
static_assert((size_t)MROWS * PP * 2 <= 325 * MiB && (size_t)MROWS * 1024 * 2 <= 65 * MiB && (size_t)16 * NCHUNK * 8192 * 4 <= 65 * MiB, "big map");
static_assert((size_t)4 * MROWS * DM * 2 <= 520 * MiB && (size_t)MROWS * FF * 2 <= 520 * MiB, "big map 2");

constexpr int LDS_BYTES = 147456;

typedef unsigned short bf16raw;
typedef float f32x4_t __attribute__((ext_vector_type(4)));
typedef float f32x2_t __attribute__((ext_vector_type(2)));
typedef unsigned u32x4_t __attribute__((ext_vector_type(4)));
typedef unsigned u32x2_t __attribute__((ext_vector_type(2)));
typedef __bf16 bf16x2_t __attribute__((ext_vector_type(2)));

__device__ __forceinline__ unsigned pk2(float lo, float hi) { f32x2_t v = {lo, hi}; bf16x2_t b = __builtin_convertvector(v, bf16x2_t); return __builtin_bit_cast(unsigned, b); }
__device__ __forceinline__ float bflo(unsigned u) { return __uint_as_float(u << 16); }
__device__ __forceinline__ float bfhi(unsigned u) { return __uint_as_float(u & 0xffff0000u); }
__device__ __forceinline__ float bf1(bf16raw u) { return __uint_as_float(((unsigned)u) << 16); }
__device__ __forceinline__ void unpack8(const u32x4_t w, float* f) { f[0] = bflo(w.x); f[1] = bfhi(w.x); f[2] = bflo(w.y); f[3] = bfhi(w.y); f[4] = bflo(w.z); f[5] = bfhi(w.z); f[6] = bflo(w.w); f[7] = bfhi(w.w); }
__device__ __forceinline__ u32x4_t pack8(const float* f) { u32x4_t w; w.x = pk2(f[0], f[1]); w.y = pk2(f[2], f[3]); w.z = pk2(f[4], f[5]); w.w = pk2(f[6], f[7]); return w; }
__device__ __forceinline__ float wave_sum(float v) {
#pragma unroll
    for (int o = 1; o < 64; o <<= 1) v += __shfl_xor(v, o);
    return v;
}
__device__ __forceinline__ float wave_max(float v) {
#pragma unroll
    for (int o = 1; o < 64; o <<= 1) v = fmaxf(v, __shfl_xor(v, o));
    return v;
}
__device__ __forceinline__ float sigmoid_f(float x) { return __builtin_amdgcn_rcpf(1.f + __expf(-x)); }

struct XPtr { const float* lat; const float* ctx;
    __device__ __forceinline__ const float* row(int r) const { const int b = r / TPB, t = r - b * TPB; return t < CTX ? ctx + ((size_t)b * CTX + t) * DM : lat + ((size_t)b * SEQ + (t - CTX)) * DM; } };
struct XOut { float* lat; float* ctx;
    __device__ __forceinline__ float* row(int r) const { const int b = r / TPB, t = r - b * TPB; return t < CTX ? ctx + ((size_t)b * CTX + t) * DM : lat + ((size_t)b * SEQ + (t - CTX)) * DM; } };

namespace pg8 {
#define PG8_LAS __attribute__((address_space(3)))
typedef unsigned short bf16_t;
typedef short bf16x8 __attribute__((ext_vector_type(8)));
typedef float f32x4 __attribute__((ext_vector_type(4)));
typedef unsigned u32x4 __attribute__((ext_vector_type(4)));
constexpr int BM = 256, BK = 64, HALF = 128, HTB = HALF * BK * 2  , STAGE_BYTES = 8 * HTB, NXCD = 8, WGM = 8;

__host__ __device__ __forceinline__ int lds_byte(int r, int c) { const int st = (r >> 4) * 2 + (c >> 5), rr = r & 15, cc = c & 31, ob = rr * 64 + cc * 2; return st * 1024 + (ob ^ (((ob >> 9) & 1) << 5)); }
__host__ __device__ __forceinline__ void stage_rc(int b, int& R, int& C) { const int st = b / 1024, sb = b % 1024, swz = sb ^ (((sb >> 9) & 1) << 5); R = (st >> 1) * 16 + swz / 64; C = (st & 1) * 32 + (swz % 64) / 2; }
__host__ __device__ __forceinline__ int perm32(int rho) { const int n = rho >> 4, i = rho & 15; return 8 * (i >> 2) + 4 * n + (i & 3); }

struct Unit { int pm, pn; };
struct Gemm { const bf16_t* A; const bf16_t* Bt; int M, N, K; int lda; int agrp; int agstride; };

struct StaticOrder {
    int nM, nN, nwg, G, c;
    __host__ __device__ void init(int M, int N, int G_, int c_) { nM = M / BM; nN = N / BM; nwg = nM * nN; G = G_; c = c_; }
    __host__ __device__ bool next(int i, Unit& u) const {
        const long L = (long)i * G + c; if (L >= nwg) return false;
        int wgid = (int)L; { const int q = nwg / NXCD, r = nwg % NXCD, xcd = wgid % NXCD, off = wgid / NXCD; wgid = (xcd < r ? xcd * (q + 1) : r * (q + 1) + (xcd - r) * q) + off; }
        const int nig = WGM * nN, gid = wgid / nig, fm = gid * WGM, gsz = (nM - fm) < WGM ? (nM - fm) : WGM;
        u.pm = fm + ((wgid % nig) % gsz); u.pn = (wgid % nig) / gsz; return true;
    }
    __device__ __forceinline__ void a_ready(const Unit&) const {}
    __device__ __forceinline__ void done(const Unit&) const {}
};

__device__ __forceinline__ unsigned cvt_pk_bf16(float lo, float hi) { unsigned r; asm volatile("v_cvt_pk_bf16_f32 %0, %1, %2" : "=v"(r) : "v"(lo), "v"(hi)); return r; }
typedef float f32x2 __attribute__((ext_vector_type(2)));
__device__ __forceinline__ f32x2 gelu_pk(f32x2 v) {
    const f32x2 av = __builtin_elementwise_abs(v), d = av * 0.2316418882f + 1.0f;
    f32x2 t; t.x = __builtin_amdgcn_rcpf(d.x); t.y = __builtin_amdgcn_rcpf(d.y);
    f32x2 q = t * 0.5307027145f + (-0.7265760135f); q = q * t + 0.7107068705f; q = q * t + (-0.142248368f); q = q * t + 0.127414796f; q = q * t;
    const f32x2 s = (v * v) * (-0.72134752044f);
    f32x2 e; e.x = __builtin_amdgcn_exp2f(s.x); e.y = __builtin_amdgcn_exp2f(s.y);
    const f32x2 m = v * (q * e), r = v - m;
    f32x2 o; o.x = v.x < 0.f ? m.x : r.x; o.y = v.y < 0.f ? m.y : r.y; return o;
}

template <int ACT  > struct EpiBf16 {
    static constexpr bool PERM = true, AFTER_DRAIN = false; static_assert(ACT == 0 || ACT == 1, "EpiBf16: ACT is 0 (none) or 1 (gelu_pk)");
    bf16_t* O; int ldc; const float* bias; int split_cols; size_t split_stride; float scale0;
    __device__ __forceinline__ void operator()(const f32x4 (&acc)[2][2][4][2], const Unit& u, int wr, int wc, int fr, int fq) const {
        asm volatile("" : "+v"(fr), "+v"(fq));
        const int row0 = u.pm * BM + wr * 64 + fr; int colt = u.pn * BM; bf16_t* base = O;
        float sc = 1.f; if (split_cols) { const int t = colt / split_cols; base += (size_t)t * split_stride; colt -= t * split_cols; if (t == 0) sc = scale0; }
        const int col0 = colt + wc * 32 + 8 * fq, bcol0 = u.pn * BM + wc * 32 + 8 * fq;
        f32x4 bv[2][2];
#pragma unroll
        for (int bj = 0; bj < 2; ++bj)
#pragma unroll
            for (int n = 0; n < 2; ++n) bv[bj][n] = bias ? *(const f32x4*)(bias + bcol0 + bj * HALF + 4 * n) : (f32x4){0.f, 0.f, 0.f, 0.f};
#pragma unroll
        for (int ai = 0; ai < 2; ++ai)
#pragma unroll
            for (int m = 0; m < 4; ++m) { bf16_t* rowp = base + (size_t)(row0 + ai * HALF + m * 16) * ldc + col0;
#pragma unroll
                for (int bj = 0; bj < 2; ++bj) { f32x4 v0 = acc[ai][bj][m][0] + bv[bj][0], v1 = acc[ai][bj][m][1] + bv[bj][1];
                    if (ACT == 1) { f32x2 a = gelu_pk((f32x2){v0[0], v0[1]}), b = gelu_pk((f32x2){v0[2], v0[3]}), c = gelu_pk((f32x2){v1[0], v1[1]}), d = gelu_pk((f32x2){v1[2], v1[3]});
                        v0 = (f32x4){a.x, a.y, b.x, b.y}; v1 = (f32x4){c.x, c.y, d.x, d.y}; }
                    v0 = v0 * sc; v1 = v1 * sc; u32x4 w; w.x = cvt_pk_bf16(v0[0], v0[1]); w.y = cvt_pk_bf16(v0[2], v0[3]); w.z = cvt_pk_bf16(v1[0], v1[1]); w.w = cvt_pk_bf16(v1[2], v1[3]);
                    *(u32x4*)(rowp + bj * HALF) = w; } }
    }
};

__device__ __forceinline__ float sigm(float x) { return __builtin_amdgcn_rcpf(1.f + __expf(-x)); }
struct EpiGate {
    static constexpr bool PERM = false, AFTER_DRAIN = false;
    const bf16_t* Bq; bf16_t* out; size_t bstride;
    __device__ __forceinline__ void operator()(const f32x4 (&acc)[2][2][4][2], const Unit& u, int wr, int wc, int fr, int fq) const {
        asm volatile("" : "+v"(fr), "+v"(fq));
        typedef unsigned u32x2 __attribute__((ext_vector_type(2)));
        const int oc = u.pn * 64 + wc * 16 + fq * 4;
        u32x2 bv[2][4][4];
#pragma unroll
        for (int ai = 0; ai < 2; ++ai)
#pragma unroll
            for (int m = 0; m < 4; ++m) { const size_t off = (size_t)(u.pm * BM + ai * HALF + wr * 64 + m * 16 + fr) * 2048 + oc;
#pragma unroll
                for (int i = 0; i < 4; ++i) bv[ai][m][i] = *(const u32x2*)(Bq + (size_t)i * bstride + off); }
#pragma unroll
        for (int ai = 0; ai < 2; ++ai)
#pragma unroll
            for (int m = 0; m < 4; ++m) {
                const size_t off = (size_t)(u.pm * BM + ai * HALF + wr * 64 + m * 16 + fr) * 2048 + oc;
                f32x4 s = (f32x4){0.f, 0.f, 0.f, 0.f};
#pragma unroll
                for (int bj = 0; bj < 2; ++bj)
#pragma unroll
                    for (int n = 0; n < 2; ++n) { const f32x4 g = acc[ai][bj][m][n]; const u32x2 b = bv[ai][m][2 * bj + n];
                        s[0] += sigm(g[0]) * __uint_as_float(b.x << 16); s[1] += sigm(g[1]) * __uint_as_float(b.x & 0xffff0000u);
                        s[2] += sigm(g[2]) * __uint_as_float(b.y << 16); s[3] += sigm(g[3]) * __uint_as_float(b.y & 0xffff0000u); }
                u32x2 w; w.x = cvt_pk_bf16(s[0], s[1]); w.y = cvt_pk_bf16(s[2], s[3]);
                *(u32x2*)(out + off) = w; }
    }
};
struct EpiBranchTiled {
    static constexpr bool PERM = true, AFTER_DRAIN = false;
    bf16_t* Bq;
    __device__ __forceinline__ void operator()(const f32x4 (&acc)[2][2][4][2], const Unit& u, int wr, int wc, int fr, int fq) const {
        asm volatile("" : "+v"(fr), "+v"(fq));
        const int t = u.pn >> 3, ct = u.pn & 7;
#pragma unroll
        for (int bj = 0; bj < 2; ++bj) { const int c0 = ct * 256 + bj * HALF + wc * 32 + 8 * fq, png = c0 >> 6, cc = c0 & 63;
            bf16_t* ub = Bq + (size_t)(u.pm * 32 + png) * 65536 + t * 64 + cc;
#pragma unroll
            for (int ai = 0; ai < 2; ++ai)
#pragma unroll
                for (int m = 0; m < 4; ++m) { const int rr = ai * HALF + wr * 64 + m * 16 + fr; const f32x4 v0 = acc[ai][bj][m][0], v1 = acc[ai][bj][m][1];
                    u32x4 w; w.x = cvt_pk_bf16(v0[0], v0[1]); w.y = cvt_pk_bf16(v0[2], v0[3]); w.z = cvt_pk_bf16(v1[0], v1[1]); w.w = cvt_pk_bf16(v1[2], v1[3]);
                    *(u32x4*)(ub + rr * 256) = w; } }
    }
};
struct EpiResid {
    static constexpr bool PERM = false, AFTER_DRAIN = false;
    const float* in_lat; const float* in_ctx; float* out_lat; float* out_ctx; const float* modl; int gidx;
    __device__ __forceinline__ void operator()(const f32x4 (&acc)[2][2][4][2], const Unit& u, int wr, int wc, int fr, int fq) const {
        asm volatile("" : "+v"(fr), "+v"(fq));
        const int b = u.pm / 65, tb = u.pm - b * 65; const bool isctx = (tb == 0);
        const float* gv = modl + (size_t)(isctx ? 2 : b) * 12288 + gidx * 2048;
        const float* xi = isctx ? in_ctx + (size_t)b * 256 * 2048 : in_lat + ((size_t)b * 16384 + (size_t)(tb - 1) * 256) * 2048;
        float* xo = isctx ? out_ctx + (size_t)b * 256 * 2048 : out_lat + ((size_t)b * 16384 + (size_t)(tb - 1) * 256) * 2048;
        const int col0 = u.pn * BM + wc * 32 + 4 * fq;
#pragma unroll
        for (int bj = 0; bj < 2; ++bj)
#pragma unroll
            for (int n = 0; n < 2; ++n) { const f32x4 gg = *(const f32x4*)(gv + col0 + bj * HALF + n * 16);
                f32x4 xv[2][4];
#pragma unroll
                for (int ai = 0; ai < 2; ++ai)
#pragma unroll
                    for (int m = 0; m < 4; ++m) xv[ai][m] = *(const f32x4*)(xi + (size_t)(ai * HALF + wr * 64 + m * 16 + fr) * 2048 + col0 + bj * HALF + n * 16);
#pragma unroll
                for (int ai = 0; ai < 2; ++ai)
#pragma unroll
                    for (int m = 0; m < 4; ++m) *(f32x4*)(xo + (size_t)(ai * HALF + wr * 64 + m * 16 + fr) * 2048 + col0 + bj * HALF + n * 16) = xv[ai][m] + gg * acc[ai][bj][m][n];
                asm volatile("" ::: "memory"); }
    }
};
struct EpiDelta {
    static constexpr bool PERM = true, AFTER_DRAIN = false;
    bf16_t* D; const float* modl; int gidx;
    __device__ __forceinline__ void operator()(const f32x4 (&acc)[2][2][4][2], const Unit& u, int wr, int wc, int fr, int fq) const {
        asm volatile("" : "+v"(fr), "+v"(fq));
        const int b = u.pm / 65, tb = u.pm - b * 65; const bool isctx = (tb == 0);
        const float* gv = modl + (size_t)(isctx ? 2 : b) * 12288 + gidx * 2048;
        const int col0 = u.pn * BM + wc * 32 + 8 * fq;
#pragma unroll
        for (int bj = 0; bj < 2; ++bj) { const f32x4 g0 = *(const f32x4*)(gv + col0 + bj * HALF), g1 = *(const f32x4*)(gv + col0 + bj * HALF + 4);
#pragma unroll
            for (int ai = 0; ai < 2; ++ai)
#pragma unroll
                for (int m = 0; m < 4; ++m) { const f32x4 v0 = acc[ai][bj][m][0] * g0, v1 = acc[ai][bj][m][1] * g1;
                    u32x4 w; w.x = cvt_pk_bf16(v0[0], v0[1]); w.y = cvt_pk_bf16(v0[2], v0[3]); w.z = cvt_pk_bf16(v1[0], v1[1]); w.w = cvt_pk_bf16(v1[2], v1[3]);
                    *(u32x4*)(D + (size_t)(u.pm * BM + ai * HALF + wr * 64 + m * 16 + fr) * 2048 + col0 + bj * HALF) = w; } }
    }
};
struct EpiSwiGLU {
    static constexpr bool PERM = true, AFTER_DRAIN = false;
    bf16_t* hid; int ldh;
    __device__ __forceinline__ void operator()(const f32x4 (&acc)[2][2][4][2], const Unit& u, int wr, int wc, int fr, int fq) const {
        asm volatile("" : "+v"(fr), "+v"(fq));
        const int hc = u.pn * 128 + wc * 32 + 8 * fq;
#pragma unroll
        for (int ai = 0; ai < 2; ++ai)
#pragma unroll
            for (int m = 0; m < 4; ++m) { bf16_t* p = hid + (size_t)(u.pm * BM + ai * HALF + wr * 64 + m * 16 + fr) * ldh + hc;
                f32x4 v[2];
#pragma unroll
                for (int n = 0; n < 2; ++n) { const f32x4 g = acc[ai][0][m][n], up = acc[ai][1][m][n];
#pragma unroll
                    for (int e = 0; e < 4; ++e) v[n][e] = g[e] * sigm(g[e]) * up[e]; }
                u32x4 w; w.x = cvt_pk_bf16(v[0][0], v[0][1]); w.y = cvt_pk_bf16(v[0][2], v[0][3]); w.z = cvt_pk_bf16(v[1][0], v[1][1]); w.w = cvt_pk_bf16(v[1][2], v[1][3]);
                *(u32x4*)p = w; }
    }
};


struct EpiNone {
    static constexpr bool PERM = false, AFTER_DRAIN = false;
    float* sink;
    __device__ __forceinline__ void operator()(const f32x4 (&acc)[2][2][4][2], const Unit& u, int wr, int wc, int fr, int fq) const {
        asm volatile("" : "+v"(fr), "+v"(fq));
        if (u.pm < 0) {
#pragma unroll
            for (int ai = 0; ai < 2; ++ai)
#pragma unroll
                for (int bj = 0; bj < 2; ++bj)
#pragma unroll
                    for (int m = 0; m < 4; ++m)
#pragma unroll
                        for (int n = 0; n < 2; ++n) *(f32x4*)(sink + ((((ai * 2 + bj) * 4 + m) * 2 + n) * 64 + fr + 16 * fq) * 4) = acc[ai][bj][m][n];
        }
    }
};
template <class Epi, class Sched, bool ALIGN_EPI = false, bool SP2 = false>
__device__ __forceinline__ void gemm_phase(PG8_LAS unsigned char* lds, const Gemm g, const Sched& S, const Epi& E) {
    int tid_ = threadIdx.x; asm volatile("" : "+v"(tid_)); const int tid = tid_, wid = __builtin_amdgcn_readfirstlane(tid >> 6), lane = tid & 63, wr = wid >> 2, wc = wid & 3, fr = lane & 15, fq = lane >> 4;
    const int K = g.K, nt = K / BK;
    unsigned voffA[2], voffB[2];
#pragma unroll
    for (int i = 0; i < 2; ++i) { int R, C; stage_rc(tid * 16 + i * 8192, R, C); const int Rb = Epi::PERM ? ((R & ~31) + perm32(R & 31)) : R;
        voffA[i] = (unsigned)(R * g.lda + C) * 2u; voffB[i] = (unsigned)(Rb * K + C) * 2u; }
    const size_t kstep = (size_t)(BK * 2);
    const size_t hstepB = (size_t)HALF * K * 2, hstepA = (size_t)HALF * g.lda * 2;
    const size_t tstepA = 2 * hstepA, tstepB = 2 * hstepB;
    const unsigned ldsw = (unsigned)wid * 1024u;
    const int aoff = lds_byte(wr * 64 + fr, fq * 8), boff = lds_byte(wc * 32 + fr, fq * 8);
#define PG8_SA(b, h) (((b) * 2 + (h)) * HTB)
#define PG8_SB(b, h) ((4 + (b) * 2 + (h)) * HTB)
#define PG8_STAGE(bufoff, gbase, voff) do { _Pragma("unroll") for (int _i = 0; _i < 2; ++_i) \
        __builtin_amdgcn_global_load_lds((const unsigned*)((const char*)(gbase) + (voff)[_i]), (PG8_LAS unsigned*)(lds + (bufoff) + ldsw + _i * 8192), 16, 0, 0); } while (0)
#define PG8_LDA(dst, b, h) do { _Pragma("unroll") for (int m = 0; m < 4; ++m) _Pragma("unroll") for (int k = 0; k < 2; ++k) dst[m][k] = *(const PG8_LAS bf16x8*)(lds + PG8_SA(b, h) + aoff + m * 2048 + k * 1024); } while (0)
#define PG8_LDB(dst, b, h) do { _Pragma("unroll") for (int n = 0; n < 2; ++n) _Pragma("unroll") for (int k = 0; k < 2; ++k) dst[n][k] = *(const PG8_LAS bf16x8*)(lds + PG8_SB(b, h) + boff + n * 2048 + k * 1024); } while (0)
#define PG8_MMA(ai, bj, At, Bt) do { __builtin_amdgcn_s_setprio(1); _Pragma("unroll") for (int m = 0; m < 4; ++m) _Pragma("unroll") for (int n = 0; n < 2; ++n) _Pragma("unroll") for (int k = 0; k < 2; ++k) \
        acc[ai][bj][m][n] = __builtin_amdgcn_mfma_f32_16x16x32_bf16(Bt[n][k], At[m][k], acc[ai][bj][m][n], 0, 0, 0); __builtin_amdgcn_s_setprio(0); } while (0)
#define PG8_WAIT_V(n) asm volatile("s_waitcnt vmcnt(" #n ")" ::: "memory")
#define PG8_WAIT_L(n) asm volatile("s_waitcnt lgkmcnt(" #n ")" ::: "memory")
#define PG8_BAR __builtin_amdgcn_s_barrier()
#define PG8_SCHED __builtin_amdgcn_sched_barrier(0)
    Unit cur, nxt; int ui = 0;
    if (!S.next(0, cur)) return;
    f32x4 acc[2][2][4][2];
#pragma unroll
    for (int a = 0; a < 2; ++a)
#pragma unroll
        for (int b = 0; b < 2; ++b)
#pragma unroll
            for (int m = 0; m < 4; ++m)
#pragma unroll
                for (int n = 0; n < 2; ++n) acc[a][b][m][n] = (f32x4){0.f, 0.f, 0.f, 0.f};
    bf16x8 At[4][2], B0[2][2], B1[2][2];
    const char* cA = (const char*)g.A + (size_t)cur.pm * tstepA + (g.agrp ? (size_t)(cur.pn / g.agrp) * g.agstride * 2 : 0); const char* cB = (const char*)g.Bt + (size_t)cur.pn * tstepB;
    S.a_ready(cur);
    if constexpr (SP2) {
        PG8_STAGE(PG8_SB(0, 0), cB, voffB); PG8_STAGE(PG8_SB(0, 1), cB + hstepB, voffB); PG8_STAGE(PG8_SA(0, 0), cA, voffA); PG8_STAGE(PG8_SA(0, 1), cA + hstepA, voffA);
        if (wr == 1) PG8_BAR;
        PG8_WAIT_V(2); PG8_BAR;
        PG8_STAGE(PG8_SB(1, 0), cB + kstep, voffB); PG8_STAGE(PG8_SA(1, 0), cA + kstep, voffA); PG8_STAGE(PG8_SB(1, 1), cB + hstepB + kstep, voffB);
        PG8_WAIT_V(6); PG8_BAR;
    } else {
        PG8_STAGE(PG8_SB(0, 0), cB, voffB); PG8_STAGE(PG8_SA(0, 0), cA, voffA); PG8_STAGE(PG8_SB(0, 1), cB + hstepB, voffB); PG8_STAGE(PG8_SA(0, 1), cA + hstepA, voffA);
        if (wr == 1) PG8_BAR;
        PG8_WAIT_V(4); PG8_BAR;
        PG8_STAGE(PG8_SB(1, 0), cB + kstep, voffB); PG8_STAGE(PG8_SA(1, 0), cA + kstep, voffA); PG8_STAGE(PG8_SB(1, 1), cB + hstepB + kstep, voffB);
        PG8_WAIT_V(6); PG8_BAR;
    }
    for (;;) {
        const bool has_next = S.next(ui + 1, nxt);
        const char* nA = has_next ? (const char*)g.A + (size_t)nxt.pm * tstepA + (g.agrp ? (size_t)(nxt.pn / g.agrp) * g.agstride * 2 : 0) : cA; const char* nB = has_next ? (const char*)g.Bt + (size_t)nxt.pn * tstepB : cB;
        for (int t = 0; t < nt; t += 2) {
            const bool last = (t == nt - 2);
            const char* a1 = cA + (size_t)(t + 1) * kstep;
            const char* a2 = last ? nA : cA + (size_t)(t + 2) * kstep; const char* b2 = last ? nB : cB + (size_t)(t + 2) * kstep;
            const char* a3 = a2 + kstep; const char* b3 = b2 + kstep;
            if (last && has_next) S.a_ready(nxt);
            if constexpr (SP2) {
            PG8_LDB(B0, 0, 0); PG8_LDB(B1, 0, 1); PG8_SCHED; PG8_LDA(At, 0, 0); PG8_STAGE(PG8_SA(1, 1), a1 + hstepA, voffA);
            PG8_WAIT_V(8); PG8_WAIT_L(0); PG8_BAR; PG8_MMA(0, 0, At, B0); PG8_MMA(0, 1, At, B1); PG8_BAR; PG8_SCHED;
            PG8_LDA(At, 0, 1); PG8_STAGE(PG8_SB(0, 0), b2, voffB); PG8_STAGE(PG8_SB(0, 1), b2 + hstepB, voffB); PG8_STAGE(PG8_SA(0, 0), a2, voffA);
            PG8_WAIT_V(8); PG8_WAIT_L(0); PG8_BAR; PG8_MMA(1, 0, At, B0); PG8_MMA(1, 1, At, B1); PG8_BAR; PG8_SCHED;
            PG8_LDB(B0, 1, 0); PG8_LDB(B1, 1, 1); PG8_SCHED; PG8_LDA(At, 1, 0); PG8_STAGE(PG8_SA(0, 1), a2 + hstepA, voffA);
            PG8_WAIT_V(8); PG8_WAIT_L(0); PG8_BAR; PG8_MMA(0, 0, At, B0); PG8_MMA(0, 1, At, B1); PG8_BAR; PG8_SCHED;
            PG8_LDA(At, 1, 1); PG8_STAGE(PG8_SB(1, 0), b3, voffB); PG8_STAGE(PG8_SB(1, 1), b3 + hstepB, voffB); PG8_STAGE(PG8_SA(1, 0), a3, voffA);
            PG8_WAIT_V(8); PG8_WAIT_L(0); PG8_BAR; PG8_MMA(1, 0, At, B0); PG8_MMA(1, 1, At, B1); PG8_BAR; PG8_SCHED;
            } else {
            PG8_LDB(B0, 0, 0); PG8_SCHED; PG8_LDA(At, 0, 0); PG8_STAGE(PG8_SA(1, 1), a1 + hstepA, voffA);
            PG8_WAIT_L(8); PG8_BAR; PG8_WAIT_L(0); PG8_MMA(0, 0, At, B0); PG8_BAR; PG8_SCHED;
            PG8_LDB(B1, 0, 1); PG8_STAGE(PG8_SB(0, 0), b2, voffB);
            PG8_BAR; PG8_WAIT_L(0); PG8_MMA(0, 1, At, B1); PG8_BAR;
            PG8_LDA(At, 0, 1); PG8_STAGE(PG8_SA(0, 0), a2, voffA);
            PG8_BAR; PG8_WAIT_L(0); PG8_MMA(1, 0, At, B0); PG8_BAR; PG8_SCHED;
            PG8_STAGE(PG8_SB(0, 1), b2 + hstepB, voffB);
            PG8_WAIT_V(6); PG8_BAR; PG8_MMA(1, 1, At, B1); PG8_BAR;
            PG8_LDB(B0, 1, 0); PG8_SCHED; PG8_LDA(At, 1, 0); PG8_STAGE(PG8_SA(0, 1), a2 + hstepA, voffA);
            PG8_WAIT_L(8); PG8_BAR; PG8_WAIT_L(0); PG8_MMA(0, 0, At, B0); PG8_BAR; PG8_SCHED;
            PG8_LDB(B1, 1, 1); PG8_STAGE(PG8_SB(1, 0), b3, voffB);
            PG8_BAR; PG8_WAIT_L(0); PG8_MMA(0, 1, At, B1); PG8_BAR;
            PG8_LDA(At, 1, 1); PG8_STAGE(PG8_SA(1, 0), a3, voffA);
            PG8_BAR; PG8_WAIT_L(0); PG8_MMA(1, 0, At, B0); PG8_BAR; PG8_SCHED;
            PG8_STAGE(PG8_SB(1, 1), b3 + hstepB, voffB);
            PG8_WAIT_V(6); PG8_BAR; PG8_MMA(1, 1, At, B1); PG8_BAR;
            }
        }
        if constexpr (ALIGN_EPI) { if (wr == 0) PG8_BAR; }
        if constexpr (!Epi::AFTER_DRAIN) { E(acc, cur, wr, wc, fr, fq); S.done(cur); }
        if (!has_next) break;
#pragma unroll
        for (int a = 0; a < 2; ++a)
#pragma unroll
            for (int b = 0; b < 2; ++b)
#pragma unroll
                for (int m = 0; m < 4; ++m)
#pragma unroll
                    for (int n = 0; n < 2; ++n) acc[a][b][m][n] = (f32x4){0.f, 0.f, 0.f, 0.f};
        cur = nxt; cA = nA; cB = nB; ++ui;
        if constexpr (ALIGN_EPI) { if (wr == 1) PG8_BAR; }
    }
    PG8_WAIT_V(0);
    if constexpr (!ALIGN_EPI) { if (wr == 0) PG8_BAR; }
    PG8_BAR;
    if constexpr (Epi::AFTER_DRAIN) { E.fused(acc, cur, wr, wc, fr, fq, lds, wid, lane); S.done(cur); }
#undef PG8_SA
#undef PG8_SB
#undef PG8_STAGE
#undef PG8_LDA
#undef PG8_LDB
#undef PG8_MMA
#undef PG8_WAIT_V
#undef PG8_WAIT_L
#undef PG8_BAR
#undef PG8_SCHED
}
}
#ifndef ATT_SDEPTH
#define ATT_SDEPTH 1
#endif
#ifndef ATT_ACCINIT128
#define ATT_ACCINIT128 1
#endif
namespace att {
using bf16 = __hip_bfloat16;
constexpr int NW = 8, QBLK = 32, KVBLK = 64, SDEPTH = ATT_SDEPTH;
constexpr float THR = 8.f;
constexpr size_t SHM_V = KVBLK * 128 * 2, SHM_K = KVBLK * 128 * 2, SHM_ATTN = 2 * SHM_V + 2 * SHM_K + NW * 64 * 4;
using bf16x8 = __attribute__((ext_vector_type(8))) short;
using s16x4  = __attribute__((ext_vector_type(4))) short;
using f32x16 = __attribute__((ext_vector_type(16))) float;
using f32x8  = __attribute__((ext_vector_type(8))) float;
using u32x4  = __attribute__((ext_vector_type(4))) unsigned;
#define KSWZ(row, colB) ((row) * 256 + ((colB) ^ (((row) & 7) << 4)))
#define SBAR() __builtin_amdgcn_sched_barrier(0)
__device__ __forceinline__ int crow(int r, int hi) { return (r & 3) + 8 * (r >> 2) + 4 * hi; }
__device__ __forceinline__ unsigned cvtpk(float lo, float hi) {
  unsigned r; asm volatile("v_cvt_pk_bf16_f32 %0, %1, %2" : "=v"(r) : "v"(lo), "v"(hi)); return r;
}
template <int DQK> __device__ __forceinline__ void partialSM(f32x16& p0, f32x16& p1, float& m_reg, float& mn, float& alpha) {
  constexpr float SCALE = (DQK == 64) ? 0.125f : 0.088388347648318440f; constexpr float C = SCALE * 1.4426950408889634f;
  float pmax = p0[0]; for (int r = 1; r < 16; ++r) pmax = fmaxf(pmax, p0[r]); for (int r = 0; r < 16; ++r) pmax = fmaxf(pmax, p1[r]);
  { auto rr = __builtin_amdgcn_permlane32_swap(__float_as_uint(pmax), __float_as_uint(pmax), false, false);
    pmax = fmaxf(__uint_as_float(rr[0]), __uint_as_float(rr[1])); }
  if (__builtin_expect(__all(pmax - m_reg <= THR / SCALE), 1)) { mn = m_reg; alpha = 1.f; }
  else { mn = fmaxf(m_reg, pmax); alpha = __builtin_amdgcn_exp2f((m_reg - mn) * C); m_reg = mn; }
  float mnC = -mn * C;
  for (int r = 0; r < 16; ++r) p0[r] = fmaf(p0[r], C, mnC); for (int r = 0; r < 16; ++r) p1[r] = fmaf(p1[r], C, mnC);
  for (int r = 0; r < 16; ++r) p0[r] = __builtin_amdgcn_exp2f(p0[r]);
}
__device__ __forceinline__ void finishSM(f32x16& p0, f32x16& p1, float alpha, float& l_reg, bf16x8& pa0, bf16x8& pa1, bf16x8& pa2, bf16x8& pa3) {
  for (int r = 0; r < 16; ++r) p1[r] = __builtin_amdgcn_exp2f(p1[r]);
  float ps = 0; for (int r = 0; r < 16; ++r) ps += p0[r]; for (int r = 0; r < 16; ++r) ps += p1[r];
  { auto rr = __builtin_amdgcn_permlane32_swap(__float_as_uint(ps), __float_as_uint(ps), false, false);
    ps = __uint_as_float(rr[0]) + __uint_as_float(rr[1]); }
  l_reg = l_reg * alpha + ps;
#define PK4(P, BASE, OUT) do { u32x4 w = {cvtpk(P[BASE + 0], P[BASE + 1]), cvtpk(P[BASE + 2], P[BASE + 3]), cvtpk(P[BASE + 4], P[BASE + 5]), cvtpk(P[BASE + 6], P[BASE + 7])}; OUT = *reinterpret_cast<bf16x8*>(&w); } while (0)
  PK4(p0, 0, pa0); PK4(p0, 8, pa1); PK4(p1, 0, pa2); PK4(p1, 8, pa3);
#undef PK4
}
template <int DQK> __device__ __forceinline__ void qkt(f32x16& p0, f32x16& p1, const bf16* Ks, const bf16x8* qr, int r32, int hi, int kcol0) {
  p0 = f32x16{}; p1 = f32x16{};
#pragma unroll
  for (int d0 = 0; d0 < DQK / 16; ++d0) { int cb = (kcol0 + d0 * 16 + hi * 8) * 2;
    bf16x8 b0 = *reinterpret_cast<const bf16x8*>((const char*)Ks + KSWZ(r32, cb));
    bf16x8 b1 = *reinterpret_cast<const bf16x8*>((const char*)Ks + KSWZ(32 + r32, cb));
    p0 = __builtin_amdgcn_mfma_f32_32x32x16_bf16(b0, qr[d0], p0, 0, 0, 0);
    p1 = __builtin_amdgcn_mfma_f32_32x32x16_bf16(b1, qr[d0], p1, 0, 0, 0); }
}
template <int DQK> __device__ __forceinline__ void qktn(f32x16& p0, f32x16& p1, const bf16* Ks, const bf16x8* qr, int r32, int hi, int kcol0, const f32x16& negm) {
#pragma unroll
  for (int d0 = 0; d0 < DQK / 16; ++d0) { int cb = (kcol0 + d0 * 16 + hi * 8) * 2;
    bf16x8 b0 = *reinterpret_cast<const bf16x8*>((const char*)Ks + KSWZ(r32, cb));
    bf16x8 b1 = *reinterpret_cast<const bf16x8*>((const char*)Ks + KSWZ(32 + r32, cb));
    if (d0 == 0) { p0 = __builtin_amdgcn_mfma_f32_32x32x16_bf16(b0, qr[0], negm, 0, 0, 0); p1 = __builtin_amdgcn_mfma_f32_32x32x16_bf16(b1, qr[0], negm, 0, 0, 0); }
    else { p0 = __builtin_amdgcn_mfma_f32_32x32x16_bf16(b0, qr[d0], p0, 0, 0, 0); p1 = __builtin_amdgcn_mfma_f32_32x32x16_bf16(b1, qr[d0], p1, 0, 0, 0); } }
}
template <bool FIRST> __device__ __forceinline__ void partialSMn(f32x16& p0, f32x16& p1, float& mref, f32x16& negm, float& alpha) {
  constexpr float THRL = THR * 1.4426950408889634f;
  float pmax = p0[0]; for (int r = 1; r < 16; ++r) pmax = fmaxf(pmax, p0[r]); for (int r = 0; r < 16; ++r) pmax = fmaxf(pmax, p1[r]);
  { auto rr = __builtin_amdgcn_permlane32_swap(__float_as_uint(pmax), __float_as_uint(pmax), false, false);
    pmax = fmaxf(__uint_as_float(rr[0]), __uint_as_float(rr[1])); }
  if (!FIRST && __builtin_expect(__all(pmax <= THRL), 1)) { alpha = 1.f; }
  else { const float dl = FIRST ? pmax : fmaxf(pmax, 0.f); mref += dl; alpha = FIRST ? 1.f : __builtin_amdgcn_exp2f(-dl);
    for (int r = 0; r < 16; ++r) { p0[r] -= dl; p1[r] -= dl; }
    const float nm = -mref; for (int r = 0; r < 16; ++r) negm[r] = nm; }
  for (int r = 0; r < 16; ++r) p0[r] = __builtin_amdgcn_exp2f(p0[r]);
}
__device__ __forceinline__ int v_st(int k, int c) { const int kk = k; return ((kk >> 3) * 4 + (c >> 5)) * 512 + ((kk & 7) * 32 + (c & 31)) * 2; }
__device__ __forceinline__ int v_rd_base(int lane) { return ((lane & 3) << 3) | (((lane >> 2) & 3) << 6) | (((lane >> 4) & 1) << 5) | (((lane >> 5) & 1) << 8); }
constexpr int v_rd_off(int d0, int ks, int half) { return d0 * 512 + ks * 4096 + half * 2048; }
template <int OFF> __device__ __forceinline__ s16x4 tr_read(int vb) {
  s16x4 r; asm volatile("ds_read_b64_tr_b16 %0, %1 offset:%2" : "=&v"(r) : "v"(vb), "i"(OFF) : "memory"); return r;
}
template <int D0> __device__ __forceinline__ void pv_one(f32x16& od, int vb, bf16x8 pa0, bf16x8 pa1, bf16x8 pa2, bf16x8 pa3) {
  const s16x4 l0 = tr_read<v_rd_off(D0, 0, 0)>(vb), h0 = tr_read<v_rd_off(D0, 0, 1)>(vb), l1 = tr_read<v_rd_off(D0, 1, 0)>(vb), h1 = tr_read<v_rd_off(D0, 1, 1)>(vb);
  const s16x4 l2 = tr_read<v_rd_off(D0, 2, 0)>(vb), h2 = tr_read<v_rd_off(D0, 2, 1)>(vb), l3 = tr_read<v_rd_off(D0, 3, 0)>(vb), h3 = tr_read<v_rd_off(D0, 3, 1)>(vb);
  asm volatile("s_waitcnt lgkmcnt(0)" ::: "memory"); SBAR();
#define PK(L, H) (bf16x8){L[0], L[1], L[2], L[3], H[0], H[1], H[2], H[3]}
  od = __builtin_amdgcn_mfma_f32_32x32x16_bf16(pa0, PK(l0, h0), od, 0, 0, 0);
  od = __builtin_amdgcn_mfma_f32_32x32x16_bf16(pa1, PK(l1, h1), od, 0, 0, 0);
  od = __builtin_amdgcn_mfma_f32_32x32x16_bf16(pa2, PK(l2, h2), od, 0, 0, 0);
  od = __builtin_amdgcn_mfma_f32_32x32x16_bf16(pa3, PK(l3, h3), od, 0, 0, 0);
#undef PK
}
template <int KS> __device__ __forceinline__ void pv_ks(f32x16* o, int vb, bf16x8 pa) {
  const s16x4 l0 = tr_read<v_rd_off(0, KS, 0)>(vb), h0 = tr_read<v_rd_off(0, KS, 1)>(vb), l1 = tr_read<v_rd_off(1, KS, 0)>(vb), h1 = tr_read<v_rd_off(1, KS, 1)>(vb);
  const s16x4 l2 = tr_read<v_rd_off(2, KS, 0)>(vb), h2 = tr_read<v_rd_off(2, KS, 1)>(vb), l3 = tr_read<v_rd_off(3, KS, 0)>(vb), h3 = tr_read<v_rd_off(3, KS, 1)>(vb);
  asm volatile("s_waitcnt lgkmcnt(0)" ::: "memory"); SBAR();
#define PK(L, H) (bf16x8){L[0], L[1], L[2], L[3], H[0], H[1], H[2], H[3]}
  o[0] = __builtin_amdgcn_mfma_f32_32x32x16_bf16(pa, PK(l0, h0), o[0], 0, 0, 0);
  o[1] = __builtin_amdgcn_mfma_f32_32x32x16_bf16(pa, PK(l1, h1), o[1], 0, 0, 0);
  o[2] = __builtin_amdgcn_mfma_f32_32x32x16_bf16(pa, PK(l2, h2), o[2], 0, 0, 0);
  o[3] = __builtin_amdgcn_mfma_f32_32x32x16_bf16(pa, PK(l3, h3), o[3], 0, 0, 0);
#undef PK
}
#define PVR(D0, l0, h0, l1, h1, l2, h2, l3, h3) const s16x4 l0 = tr_read<v_rd_off(D0, 0, 0)>(vb), h0 = tr_read<v_rd_off(D0, 0, 1)>(vb), l1 = tr_read<v_rd_off(D0, 1, 0)>(vb), h1 = tr_read<v_rd_off(D0, 1, 1)>(vb), \
    l2 = tr_read<v_rd_off(D0, 2, 0)>(vb), h2 = tr_read<v_rd_off(D0, 2, 1)>(vb), l3 = tr_read<v_rd_off(D0, 3, 0)>(vb), h3 = tr_read<v_rd_off(D0, 3, 1)>(vb)
#define PK(L, H) (bf16x8){L[0], L[1], L[2], L[3], H[0], H[1], H[2], H[3]}
#define PVM(od, l0, h0, l1, h1, l2, h2, l3, h3) do { od = __builtin_amdgcn_mfma_f32_32x32x16_bf16(pa0, PK(l0, h0), od, 0, 0, 0); od = __builtin_amdgcn_mfma_f32_32x32x16_bf16(pa1, PK(l1, h1), od, 0, 0, 0); \
    od = __builtin_amdgcn_mfma_f32_32x32x16_bf16(pa2, PK(l2, h2), od, 0, 0, 0); od = __builtin_amdgcn_mfma_f32_32x32x16_bf16(pa3, PK(l3, h3), od, 0, 0, 0); } while (0)
__device__ __forceinline__ void pv_d0(f32x16* o, int vb, bf16x8 pa0, bf16x8 pa1, bf16x8 pa2, bf16x8 pa3) {
#ifndef PV_PIPE
  pv_one<0>(o[0], vb, pa0, pa1, pa2, pa3); pv_one<1>(o[1], vb, pa0, pa1, pa2, pa3); pv_one<2>(o[2], vb, pa0, pa1, pa2, pa3); pv_one<3>(o[3], vb, pa0, pa1, pa2, pa3);
#else
  PVR(0, a0, a1, a2, a3, a4, a5, a6, a7);
  PVR(1, b0, b1, b2, b3, b4, b5, b6, b7);
  asm volatile("s_waitcnt lgkmcnt(8)" ::: "memory"); SBAR();
  PVM(o[0], a0, a1, a2, a3, a4, a5, a6, a7); SBAR();
  PVR(2, c0, c1, c2, c3, c4, c5, c6, c7);
  asm volatile("s_waitcnt lgkmcnt(8)" ::: "memory"); SBAR();
  PVM(o[1], b0, b1, b2, b3, b4, b5, b6, b7); SBAR();
  PVR(3, d0, d1, d2, d3, d4, d5, d6, d7);
  asm volatile("s_waitcnt lgkmcnt(8)" ::: "memory"); SBAR();
  PVM(o[2], c0, c1, c2, c3, c4, c5, c6, c7); SBAR();
  asm volatile("s_waitcnt lgkmcnt(0)" ::: "memory"); SBAR();
  PVM(o[3], d0, d1, d2, d3, d4, d5, d6, d7);
#endif
}
#undef PVR
#undef PVM
#undef PK
constexpr int STASH_OFF = 67584;
template <int DQK, int LDO, int MODE = 0>
__device__ __forceinline__ void attn_dense_body(const bf16* __restrict__ Qb, const bf16* __restrict__ Kh, const bf16* __restrict__ Vh,
                                                bf16* __restrict__ Ob, int seq, int kcol0, char* lds, float lam = 0.f, const float* __restrict__ gvec = nullptr, float gmul = 1.f) {
  constexpr int LDQ = PP, LDK = PP;
  constexpr float SCALE = (DQK == 64) ? 0.125f : 0.088388347648318440f;
  int tid = threadIdx.x; asm volatile("" : "+v"(tid)); const int wid = tid >> 6, lane = tid & 63, r32 = lane & 31, hi = lane >> 5;
  if (__builtin_amdgcn_readfirstlane(tid) >= 256) __builtin_amdgcn_s_setprio(1);
  bf16* V_lds = (bf16*)lds; bf16* K_lds = (bf16*)(lds + 2 * SHM_V);
  float* ws = (float*)(lds + 2 * SHM_V + 2 * SHM_K) + wid * 64; float* li_l = ws; float* al_l = ws + 32;
  constexpr bool ACCINIT = (DQK == 64) || ATT_ACCINIT128; float m_reg = ACCINIT ? 0.f : -1e30f, l_reg = 0; f32x16 o[4] = {}; bf16x8 qr[DQK / 16];
  f32x16 negm = {};
  const bf16* Qw = Qb + (long)(wid * QBLK + r32) * LDQ + hi * 8;
#pragma unroll
  for (int d0 = 0; d0 < DQK / 16; ++d0) qr[d0] = *reinterpret_cast<const bf16x8*>(Qw + d0 * 16);
  const int sr = tid >> 4, sc = (tid & 15) * 8, vst0 = v_st(sr, sc), vst1 = v_st(32 + sr, sc);
  const int vb0 = (int)(uintptr_t)V_lds + v_rd_base(lane);
  struct { bf16x8 vs0, vs1, ks0, ks1; } sr_[SDEPTH];
#define SLOAD(i, k0) do { sr_[i].vs0 = *reinterpret_cast<const bf16x8*>(&Vh[(long)((k0) + sr) * LDK + sc]); sr_[i].vs1 = *reinterpret_cast<const bf16x8*>(&Vh[(long)((k0) + 32 + sr) * LDK + sc]); \
    sr_[i].ks0 = *reinterpret_cast<const bf16x8*>(&Kh[(long)((k0) + sr) * LDK + sc]); sr_[i].ks1 = *reinterpret_cast<const bf16x8*>(&Kh[(long)((k0) + 32 + sr) * LDK + sc]); } while (0)
#define SWRITE(b, i) do { *(bf16x8*)((char*)V_lds + (b) * SHM_V + vst0) = sr_[i].vs0;          \
    *(bf16x8*)((char*)V_lds + (b) * SHM_V + vst1) = sr_[i].vs1; int kc = sc * 2;               \
    *(bf16x8*)((char*)K_lds + (b) * SHM_K + KSWZ(sr, kc)) = sr_[i].ks0;                       \
    *(bf16x8*)((char*)K_lds + (b) * SHM_K + KSWZ(32 + sr, kc)) = sr_[i].ks1; } while (0)
#define SWAIT() do { if constexpr (SDEPTH == 2) asm volatile("s_waitcnt vmcnt(4)" ::: "memory"); else asm volatile("s_waitcnt vmcnt(0)" ::: "memory"); } while (0)
#define RESC(a) do { if (__any((a) < 1.f)) { if (hi == 0) al_l[r32] = (a); asm volatile("s_waitcnt lgkmcnt(0)" ::: "memory"); \
    for (int d = 0; d < 4; ++d) for (int r = 0; r < 16; ++r) o[d][r] *= al_l[crow(r, hi)]; } } while (0)
  f32x16 pA0, pA1, pB0, pB1; float mnA, mnB, alA, alB; bf16x8 pa0, pa1, pa2, pa3; const int NT = seq / KVBLK;
  constexpr int SE = 0, SO = SDEPTH - 1;
  SLOAD(SE, 0); asm volatile("s_waitcnt vmcnt(0)" ::: "memory"); SWRITE(0, SE); __syncthreads();
  if constexpr (ACCINIT) { qktn<DQK>(pA0, pA1, K_lds, qr, r32, hi, kcol0, negm); partialSMn<true>(pA0, pA1, m_reg, negm, alA); }
  else { qkt<DQK>(pA0, pA1, K_lds, qr, r32, hi, kcol0); partialSM<DQK>(pA0, pA1, m_reg, mnA, alA); }
  SLOAD(SO, KVBLK); if constexpr (SDEPTH == 2) { if (2 < NT) SLOAD(SE, 2 * KVBLK); }
  SWAIT(); SWRITE(1, SO); __syncthreads();
  for (int j = 1; j + 1 < NT; j += 2) {
    SBAR(); if constexpr (ACCINIT) qktn<DQK>(pB0, pB1, (bf16*)((char*)K_lds + SHM_K), qr, r32, hi, kcol0, negm); else qkt<DQK>(pB0, pB1, (bf16*)((char*)K_lds + SHM_K), qr, r32, hi, kcol0);
    finishSM(pA0, pA1, alA, l_reg, pa0, pa1, pa2, pa3); SBAR();
    SLOAD(SO, (j + SDEPTH) * KVBLK); SBAR();
    pv_d0(o, vb0, pa0, pa1, pa2, pa3); if constexpr (ACCINIT) partialSMn<false>(pB0, pB1, m_reg, negm, alB); else partialSM<DQK>(pB0, pB1, m_reg, mnB, alB);
    __syncthreads(); SWAIT(); SWRITE(0, SE);
    RESC(alB); __syncthreads();
    SBAR(); if constexpr (ACCINIT) qktn<DQK>(pA0, pA1, K_lds, qr, r32, hi, kcol0, negm); else qkt<DQK>(pA0, pA1, K_lds, qr, r32, hi, kcol0);
    finishSM(pB0, pB1, alB, l_reg, pa0, pa1, pa2, pa3); SBAR();
    if (SDEPTH == 1 || j + 3 < NT) SLOAD(SE, (j + 1 + SDEPTH) * KVBLK); SBAR();
    pv_d0(o, vb0 + (int)SHM_V, pa0, pa1, pa2, pa3); if constexpr (ACCINIT) partialSMn<false>(pA0, pA1, m_reg, negm, alA); else partialSM<DQK>(pA0, pA1, m_reg, mnA, alA);
    __syncthreads(); SWAIT(); SWRITE(1, SO);
    RESC(alA); __syncthreads();
  }
  SBAR(); if constexpr (ACCINIT) qktn<DQK>(pB0, pB1, (bf16*)((char*)K_lds + SHM_K), qr, r32, hi, kcol0, negm); else qkt<DQK>(pB0, pB1, (bf16*)((char*)K_lds + SHM_K), qr, r32, hi, kcol0);
  finishSM(pA0, pA1, alA, l_reg, pa0, pa1, pa2, pa3); SBAR();
  pv_d0(o, vb0, pa0, pa1, pa2, pa3); if constexpr (ACCINIT) partialSMn<false>(pB0, pB1, m_reg, negm, alB); else partialSM<DQK>(pB0, pB1, m_reg, mnB, alB);
  __syncthreads(); RESC(alB);
  finishSM(pB0, pB1, alB, l_reg, pa0, pa1, pa2, pa3); SBAR();
  pv_d0(o, vb0 + (int)SHM_V, pa0, pa1, pa2, pa3);
  if (hi == 0) li_l[r32] = l_reg; asm volatile("s_waitcnt lgkmcnt(0)" ::: "memory");
  float rli[16];
#pragma unroll
  for (int r = 0; r < 16; ++r) rli[r] = __builtin_amdgcn_rcpf(li_l[crow(r, hi)]);
  if constexpr (MODE == 0) {
  bf16* Ow = Ob + (long)(wid * QBLK) * LDO;
#pragma unroll
  for (int r = 0; r < 16; ++r) { int orow = crow(r, hi);
    for (int d0 = 0; d0 < 4; ++d0) Ow[(long)orow * LDO + d0 * 32 + r32] = __float2bfloat16(o[d0][r] * rli[r]); }
  } else if constexpr (MODE == 1) {
  bf16* st = (bf16*)(lds + STASH_OFF) + (wid * QBLK) * 128;
#pragma unroll
  for (int r = 0; r < 16; ++r) { int orow = crow(r, hi);
    for (int d0 = 0; d0 < 4; ++d0) st[orow * 128 + d0 * 32 + r32] = __float2bfloat16(o[d0][r] * rli[r]); }
  } else {
  const bf16* st = (const bf16*)(lds + STASH_OFF) + (wid * QBLK) * 128;
  float ssq[16];
#pragma unroll
  for (int r = 0; r < 16; ++r) { int orow = crow(r, hi); float s = 0.f;
    for (int d0 = 0; d0 < 4; ++d0) { const float v = __bfloat162float(st[orow * 128 + d0 * 32 + r32]) - lam * (o[d0][r] * rli[r]); o[d0][r] = v; s += v * v; }
    s += __shfl_xor(s, 1); s += __shfl_xor(s, 2); s += __shfl_xor(s, 4); s += __shfl_xor(s, 8); s += __shfl_xor(s, 16);
    ssq[r] = 1.0f / sqrtf(s * (1.f / 128.f) + NORM_EPS); }
  bf16* Ow = Ob + (long)(wid * QBLK) * LDO;
#pragma unroll
  for (int d0 = 0; d0 < 4; ++d0) { const float gm = gvec[d0 * 32 + r32] * gmul;
#pragma unroll
    for (int r = 0; r < 16; ++r) Ow[(long)crow(r, hi) * LDO + d0 * 32 + r32] = __float2bfloat16(o[d0][r] * ssq[r] * gm); }
  }
  __builtin_amdgcn_s_setprio(0);
#undef SLOAD
#undef SWRITE
#undef SWAIT
#undef RESC
}

__device__ __forceinline__ void swa_unit(const bf16* __restrict__ P, bf16* __restrict__ Y, int bb, int kvh, int qblk, bool isctx, const float* __restrict__ sinkl, char* lds) {
  constexpr float SCALE = 0.125f;
  int tid = threadIdx.x; asm volatile("" : "+v"(tid)); const int wid = tid >> 6, lane = tid & 63, r32 = lane & 31, hi = lane >> 5;
  if (__builtin_amdgcn_readfirstlane(tid) >= 256) __builtin_amdgcn_s_setprio(1);
  const int head = kvh * 4 + (wid & 3), half = wid >> 2;
  bf16* V_lds = (bf16*)lds; bf16* K_lds = (bf16*)(lds + 2 * SHM_V);
  float* ws = (float*)(lds + 2 * SHM_V + 2 * SHM_K) + wid * 64; float* li_l = ws; float* al_l = ws + 32;
  const long rowq0 = (long)bb * TPB + (isctx ? 0 : CTX) + qblk * 64 + half * 32;
  const bf16* Qw = P + (rowq0 + r32) * PP + C_SQ + head * 64 + hi * 8;
  bf16x8 qr[4];
#pragma unroll
  for (int d0 = 0; d0 < 4; ++d0) qr[d0] = *reinterpret_cast<const bf16x8*>(Qw + d0 * 16);
  float m_reg = sinkl[head] * (1.f / SCALE), l_reg = 1.f; f32x16 o[2] = {};
  const int sr = tid >> 3, sc = (tid & 7) * 8, vst = v_st(sr, sc);
  const int vb0 = (int)(uintptr_t)V_lds + v_rd_base(lane);
  const int qpos = qblk * 64 + half * 32 + r32;
  int jlo = 0, nband = 0;
  if (!isctx) { const int q0 = qblk * 64; jlo = (q0 >= 128) ? 0 : (128 - q0) / 64; int jhi = (SEQ - 64 - q0 + 128) / 64; if (jhi > 4) jhi = 4; nband = jhi - jlo + 1; }
  const int ntile = 4 + nband;
  const long kbase = (long)bb * TPB;
#define SWA_KROW(tt) ((tt) < 4 ? kbase + (tt) * 64 : kbase + CTX + (qblk * 64 - 128 + ((tt) - 4 + jlo) * 64))
  bf16x8 kreg, vreg;
  { const long kr = SWA_KROW(0); kreg = *reinterpret_cast<const bf16x8*>(P + (kr + sr) * PP + C_SK + kvh * 64 + sc); vreg = *reinterpret_cast<const bf16x8*>(P + (kr + sr) * PP + C_SV + kvh * 64 + sc); }
  __syncthreads();
  for (int t = 0; t < ntile; ++t) {
    const int buf = t & 1; const bool band = (t >= 4); const int kpos0 = qblk * 64 - 128 + (t - 4 + jlo) * 64;
    *(bf16x8*)((char*)K_lds + buf * SHM_K + KSWZ(sr, sc * 2)) = kreg; *(bf16x8*)((char*)V_lds + buf * SHM_V + vst) = vreg;
    if (t + 1 < ntile) { const long kr = SWA_KROW(t + 1); kreg = *reinterpret_cast<const bf16x8*>(P + (kr + sr) * PP + C_SK + kvh * 64 + sc); vreg = *reinterpret_cast<const bf16x8*>(P + (kr + sr) * PP + C_SV + kvh * 64 + sc); }
    __syncthreads();
    f32x16 p0, p1; float mn, alpha; bf16x8 pa0, pa1, pa2, pa3;
    qkt<64>(p0, p1, (const bf16*)((const char*)K_lds + buf * SHM_K), qr, r32, hi, 0);
    if (band) {
#pragma unroll
      for (int r = 0; r < 16; ++r) { const int d0_ = qpos - (kpos0 + crow(r, hi)); if (d0_ > 128 || d0_ < -128) p0[r] = -1e30f; const int d1_ = d0_ - 32; if (d1_ > 128 || d1_ < -128) p1[r] = -1e30f; }
    }
    partialSM<64>(p0, p1, m_reg, mn, alpha);
    if (__any(alpha < 1.f)) { if (hi == 0) al_l[r32] = alpha; asm volatile("s_waitcnt lgkmcnt(0)" ::: "memory");
#pragma unroll
      for (int d = 0; d < 2; ++d)
#pragma unroll
        for (int r = 0; r < 16; ++r) o[d][r] *= al_l[crow(r, hi)]; }
    finishSM(p0, p1, alpha, l_reg, pa0, pa1, pa2, pa3); SBAR();
    pv_one<0>(o[0], vb0 + buf * (int)SHM_V, pa0, pa1, pa2, pa3); pv_one<1>(o[1], vb0 + buf * (int)SHM_V, pa0, pa1, pa2, pa3);
  }
#undef SWA_KROW
  if (hi == 0) li_l[r32] = l_reg; asm volatile("s_waitcnt lgkmcnt(0)" ::: "memory");
  float rli[16];
#pragma unroll
  for (int r = 0; r < 16; ++r) rli[r] = __builtin_amdgcn_rcpf(li_l[crow(r, hi)]);
  bf16* Ow = Y + rowq0 * DM + 1024 + head * 64;
#pragma unroll
  for (int r = 0; r < 16; ++r) { const int orow = crow(r, hi);
#pragma unroll
    for (int d0 = 0; d0 < 2; ++d0) Ow[(long)orow * DM + d0 * 32 + r32] = __float2bfloat16(o[d0][r] * rli[r]); }
  __builtin_amdgcn_s_setprio(0);
  __syncthreads();
}
#undef KSWZ
#undef SBAR
}

#define LAS __attribute__((address_space(3)))
#ifndef PH_MASK
#define PH_MASK 0xFFFFF
#endif
#ifndef MX_MASK
#define MX_MASK 15
#endif
#ifndef P_ALIGN
#define P_ALIGN true
#endif
#ifndef BR_ALIGN
#define BR_ALIGN true
#endif
#ifndef UP_ALIGN
#define UP_ALIGN true
#endif
#ifndef GATE_ALIGN
#define GATE_ALIGN false
#endif
#ifndef RESID_ALIGN
#define RESID_ALIGN false
#endif
#ifndef DBL_MASK
#define DBL_MASK 0
#endif
#ifndef DBL_MX
#define DBL_MX 0
#endif
#ifdef DBL_RESID
#define RESID_LOOP for (int rr_ = 0; rr_ < 2; ++rr_)
#else
#define RESID_LOOP for (int rr_ = 1; rr_ < 2; ++rr_)
#endif
#define REP(bit) for (int rep_ = 0; rep_ < ((DBL_MASK & (bit)) ? 2 : 1); ++rep_)
#define REPX(bit) for (int rep_ = 0; rep_ < ((DBL_MX & (bit)) ? 2 : 1); ++rep_)
typedef __hip_bfloat16 hbf16;
constexpr size_t WS_ZT = 7 * MiB + 256 * 1024;
struct Args { const float* in[21]; float* out; unsigned char* ws; int pad0, pad1; };
struct Frame { int tid, lane, wave, G, vcu, gw, NGW; unsigned char* ws; char* lds; };

#define XB_TMO      128
#define XB_XCNT(j)  (256  + 64 * (j))
#define XB_XSUB(j)  (1280 + 64 * (j))
#define XB_XGEN(j)  (2304 + 64 * (j))
#define XB_TOP      3328
#define XB_TOPGEN   3392
#define XCD_BAR_WORDS 3456
#define XB_SPIN_CAP (1u << 18)

__device__ __forceinline__ unsigned xb_ld(unsigned* p)              { return __hip_atomic_load(p, __ATOMIC_RELAXED, __HIP_MEMORY_SCOPE_AGENT); }
__device__ __forceinline__ unsigned xb_add(unsigned* p, unsigned v) { return __hip_atomic_fetch_add(p, v, __ATOMIC_RELAXED, __HIP_MEMORY_SCOPE_AGENT); }
__device__ __forceinline__ unsigned xb_xcc_id() { return (unsigned)__builtin_amdgcn_s_getreg((3 << 11) | 20) & 0xFu; }
#define XB_SPIN(cond, bar) do { unsigned _sp = 0; while (cond) { __builtin_amdgcn_s_sleep(1); \
    if ((++_sp & 255u) == 0u) { if (xb_ld(&(bar)[XB_TMO])) break; if (_sp > XB_SPIN_CAP) { atomicAdd(&(bar)[XB_TMO], 1u); break; } } } } while (0)

struct XcdBarrier {
    unsigned* bar; unsigned x;
    volatile LAS unsigned* st;
};

__device__ __forceinline__ XcdBarrier xcd_barrier_post(unsigned* bar, volatile LAS unsigned* st) {
    XcdBarrier b; b.bar = bar; b.x = xb_xcc_id(); b.st = st;
    if (threadIdx.x == 0) (void)xb_add(&bar[XB_XCNT(b.x)], 1u);
    return b;
}
__device__ __forceinline__ void xcd_barrier_complete(unsigned* bar, unsigned x, unsigned& nloc, unsigned& nx) {
    const unsigned G = gridDim.x * gridDim.y * gridDim.z;
    unsigned sum, cnt, mine, sp = 0u;
    for (;;) {
        sum = 0u; cnt = 0u; mine = 0u;
#pragma unroll
        for (unsigned j = 0; j < 16; ++j) { const unsigned c = xb_ld(&bar[XB_XCNT(j)]); sum += c; cnt += (c > 0u) ? 1u : 0u; mine = (j == x) ? c : mine; }
        if (sum == G) break;
        __builtin_amdgcn_s_sleep(1);
        if ((++sp & 255u) == 0u) { if (xb_ld(&bar[XB_TMO])) break; if (sp > XB_SPIN_CAP) { atomicAdd(&bar[XB_TMO], 1u); break; } }
    }
    nloc = mine > 0u ? mine : 1u; nx = cnt > 0u ? cnt : 1u;
}

__device__ __forceinline__ void xcd_barrier(const XcdBarrier& b) {
    asm volatile("s_waitcnt vmcnt(0)" ::: "memory");
    __syncthreads();
    if (threadIdx.x == 0) {
        unsigned* bar = b.bar;
        __builtin_amdgcn_s_waitcnt(0);
        unsigned nloc = b.st[0], nx = b.st[1];
        if (nloc == 0u) { xcd_barrier_complete(bar, b.x, nloc, nx); b.st[0] = nloc; b.st[1] = nx; }
        const unsigned old = xb_add(&bar[XB_XSUB(b.x)], 1u);
        const unsigned gen = old / nloc;
        if (old + 1u == (gen + 1u) * nloc) {
            __builtin_amdgcn_fence(__ATOMIC_RELEASE, "agent");
            asm volatile("s_waitcnt vmcnt(0)" ::: "memory");
            const unsigned og = xb_add(&bar[XB_TOP], 1u);
            const unsigned tg = og / nx;
            if (og + 1u == (tg + 1u) * nx) xb_add(&bar[XB_TOPGEN], 1u);
            else XB_SPIN(xb_ld(&bar[XB_TOPGEN]) == tg, bar);
            __builtin_amdgcn_fence(__ATOMIC_ACQUIRE, "agent");
            xb_add(&bar[XB_XGEN(b.x)], 1u);
            asm volatile("s_waitcnt vmcnt(0)" ::: "memory");
        } else {
            XB_SPIN(xb_ld(&bar[XB_XGEN(b.x)]) == gen, bar);
            __builtin_amdgcn_fence(__ATOMIC_ACQUIRE, "agent");
            asm volatile("s_waitcnt vmcnt(0)" ::: "memory");
        }
    }
    __syncthreads();
}

constexpr size_t WS_BAR = 7 * MiB + 512 * 1024;
constexpr int LDS_BARST = LDS_BYTES - 64;
__device__ __forceinline__ Frame make_frame(unsigned char* ws, char* lds) {
    Frame F; int t = threadIdx.x; asm volatile("" : "+v"(t)); F.tid = t; F.lane = t & 63; F.wave = __builtin_amdgcn_readfirstlane(t >> 6); F.G = gridDim.x;
    { const int bx = blockIdx.x; F.vcu = (F.G % 8 == 0) ? (bx % 8) * (F.G / 8) + bx / 8 : bx; }
    F.gw = F.vcu * 8 + F.wave; F.NGW = F.G * 8; F.ws = ws; F.lds = lds; return F;
}
typedef const __attribute__((address_space(4))) Args* CArgsP0;
__device__ __forceinline__ void s0_phase(const Frame& F, CArgsP0 a) {
    float* sv = (float*)F.lds;
    float* modp = (float*)(F.ws + WS_MODP);
    const float* c = a->in[1]; const float* cctx = a->in[3]; const float* adaw = a->in[4];
    for (int i = blockIdx.x * 512 + F.tid; i < 3 * 12288; i += F.G * 512) ((float*)(F.ws + WS_ZT))[i] = 0.f;
    for (int it = blockIdx.x; it < 793; it += F.G) {
        if (it < 768) {
            const int l = it / 384, r = it % 384, ks = r / 24, ch = r % 24;
            __syncthreads();
            if (F.tid < 384) { const int w = F.tid >> 7, dd = F.tid & 127, d = ks * 128 + dd; const float cv = (w < 2) ? c[w * DM + d] : cctx[d]; sv[F.tid] = cv / (1.f + expf(-cv)); }
            __syncthreads();
            const int j = ch * 512 + F.tid;
            const float* W = adaw + (size_t)l * DM * 12288 + (size_t)(ks * 128) * 12288 + j;
            float a0 = 0.f, a1 = 0.f, a2 = 0.f;
#pragma unroll 8
            for (int dd = 0; dd < 128; ++dd) { const float wv = W[(size_t)dd * 12288]; a0 += sv[dd] * wv; a1 += sv[128 + dd] * wv; a2 += sv[256 + dd] * wv; }
            float* o = modp + (size_t)((l * 16 + ks) * 3) * 12288 + j;
            o[0] = a0; o[12288] = a1; o[2 * 12288] = a2;
        } else if (it < 792) {
            const int idx = (it - 768) * 512 + F.tid;
            float* tab = (float*)(F.ws + WS_ROPE);
            int pos, f, nf; float* cdst; float* sdst;
            if (idx < 4096) { pos = idx >> 4; f = idx & 15; nf = 16; cdst = tab + idx; sdst = tab + 4096 + idx; }
            else { const int i2 = idx - 4096; pos = i2 >> 5; f = i2 & 31; nf = 32; cdst = tab + 8192 + i2; sdst = tab + 16384 + i2; }
            const float inv = exp2f(-(float)f / (float)nf * 13.287712379549449f);
            const float ang = (float)pos * inv;
            double rev = (double)ang * 0.15915494309189535; rev -= floor(rev);
            const float fr = (float)rev;
            *cdst = __builtin_amdgcn_cosf(fr); *sdst = __builtin_amdgcn_sinf(fr);
        } else {
            const int l = F.wave >> 2, h = F.wave & 3; const float* lp = a->in[10] + (size_t)l * 4 * 4 * 64;
            float pa = lp[(0 * 4 + h) * 64 + F.lane] * lp[(1 * 4 + h) * 64 + F.lane], pb = lp[(2 * 4 + h) * 64 + F.lane] * lp[(3 * 4 + h) * 64 + F.lane];
            pa = wave_sum(pa); pb = wave_sum(pb);
            const float lam_init = (l == 0) ? 0.2f : 0.35550906759f;
            if (F.lane == 0) ((float*)(F.ws + WS_LAM))[l * 4 + h] = expf(pa) - expf(pb) + lam_init;
        }
    }
}

__device__ __forceinline__ int map_win(int j) { return j < NMIX ? j : -1; }
__device__ __forceinline__ int map_gate(int R) { const int pn = R >> 8, c = R & 255; const int i = 2 * (c >> 7) + ((c & 31) >> 4), oc = 64 * pn + 16 * ((c & 127) >> 5) + (c & 15); return NMIX + i * DM + oc; }
__device__ __forceinline__ int map_up(int R) { const int pn = R >> 8, c = R & 255; return (c >> 7) * FF + 128 * pn + (c & 127); }
template <int MAP> __device__ __forceinline__ void transpose_item(const float* __restrict__ W, int Nsrc, int K, bf16raw* __restrict__ WT, int kb, int nb, float* scr, int lane) {
    const int k0 = 64 * kb, n0 = 32 * nb; const int jr = n0 + (lane & 31);
    const int col = (MAP == 0) ? jr : (MAP == 1) ? map_win(jr) : (MAP == 2) ? map_gate(jr) : map_up(jr);
#pragma unroll 8
    for (int i = 0; i < 32; ++i) { const int kk = 2 * i + (lane >> 5); scr[kk * 33 + (lane & 31)] = (col >= 0) ? W[(size_t)(k0 + kk) * Nsrc + col] : 0.f; }
    asm volatile("s_waitcnt lgkmcnt(0)" ::: "memory");
    const int cch = lane & 7;
#pragma unroll
    for (int j = 0; j < 4; ++j) { const int n = (lane >> 3) + 8 * j; const float* s = scr + (8 * cch) * 33 + n;
        u32x4_t o; o.x = pk2(s[0 * 33], s[1 * 33]); o.y = pk2(s[2 * 33], s[3 * 33]); o.z = pk2(s[4 * 33], s[5 * 33]); o.w = pk2(s[6 * 33], s[7 * 33]);
        *(u32x4_t*)(WT + (size_t)(n0 + n) * K + k0 + 8 * cch) = o; }
    asm volatile("s_waitcnt lgkmcnt(0)" ::: "memory");
}
__device__ __forceinline__ void s1_phase(const Frame& F, CArgsP0 a, int l) {
    if (l == 0) {
        const float* modp = (const float*)(F.ws + WS_MODP); float* mod = (float*)(F.ws + WS_MOD); const float* adab = a->in[5];
        for (int idx = blockIdx.x * 512 + F.tid; idx < 2 * 3 * 12288; idx += F.G * 512) {
            const int l2 = idx / (3 * 12288), rem = idx - l2 * 3 * 12288, w = rem / 12288, j = rem - w * 12288;
            float s = adab[l2 * 12288 + j];
#pragma unroll
            for (int ks = 0; ks < 16; ++ks) s += modp[(size_t)((l2 * 16 + ks) * 3 + w) * 12288 + j];
            mod[idx] = s;
        }
    }
    float* scr = (float*)F.lds + F.wave * (64 * 33);
    const float* w_in = a->in[7] + (size_t)l * DM * DIN; const float* w_br = a->in[15] + (size_t)l * 4 * 512 * DM; const float* w_out = a->in[16] + (size_t)l * DM * DM;
    const float* w_up = a->in[18] + (size_t)l * DM * 2 * FF; const float* w_dn = a->in[19] + (size_t)l * FF * DM;
    constexpr int I_IN = 32 * (PP / 32), I_G = 32 * (8192 / 32), I_B = 4 * 8 * 64, I_O = 32 * 64, I_U = 32 * (2 * FF / 32), I_D = (FF / 64) * 64;
    constexpr int NITEMS = I_IN + I_G + I_B + I_O + I_U + I_D;
    for (int it = F.gw; it < NITEMS; it += F.NGW) {
        int r = it;
        if (r < I_IN) { const int nblk = PP / 32; transpose_item<1>(w_in, DIN, DM, (bf16raw*)(F.ws + WS_WIN), r / nblk, r % nblk, scr, F.lane); continue; } r -= I_IN;
        if (r < I_G) { const int nblk = 8192 / 32; transpose_item<2>(w_in, DIN, DM, (bf16raw*)(F.ws + WS_WG), r / nblk, r % nblk, scr, F.lane); continue; } r -= I_G;
        if (r < I_B) { const int i = r / 512, rr = r % 512; transpose_item<0>(w_br + (size_t)i * 512 * DM, DM, 512, (bf16raw*)(F.ws + WS_WB) + (size_t)i * DM * 512, rr / 64, rr % 64, scr, F.lane); continue; } r -= I_B;
        if (r < I_O) { transpose_item<0>(w_out, DM, DM, (bf16raw*)(F.ws + WS_WOUT), r / 64, r % 64, scr, F.lane); continue; } r -= I_O;
        if (r < I_U) { const int nblk = 2 * FF / 32; transpose_item<3>(w_up, 2 * FF, DM, (bf16raw*)(F.ws + WS_WUP), r / nblk, r % nblk, scr, F.lane); continue; } r -= I_U;
        transpose_item<0>(w_dn, DM, FF, (bf16raw*)(F.ws + WS_WDN), r / 64, r % 64, scr, F.lane);
    }
}

__device__ __forceinline__ void norm_mod_phase(const Frame& F, const XPtr xin, const bf16raw* delta, const XOut xout, const float* __restrict__ gam, const float* __restrict__ modl, int shi, int sci, bf16raw* out) {
    constexpr int RPW = 17;
    int curw = -1; f32x4_t ca[8], cb[8];
    const int rbeg = F.gw * RPW, rend = (rbeg + RPW < MROWS) ? rbeg + RPW : MROWS;
    for (int r = rbeg; r < rend; ++r) {
        const int b = r / TPB, t = r - b * TPB, w = (t < CTX) ? 2 : b;
        if (w != curw) { curw = w;
#pragma unroll
            for (int j = 0; j < 8; ++j) { const int col = 4 * F.lane + 256 * j; const f32x4_t g = *(const f32x4_t*)(gam + col), sc = *(const f32x4_t*)(modl + (size_t)w * 12288 + sci * 2048 + col);
                ca[j] = g * (sc + 1.0f); cb[j] = *(const f32x4_t*)(modl + (size_t)w * 12288 + shi * 2048 + col); } }
        const f32x4_t* xr = (const f32x4_t*)xin.row(r) + F.lane;
        f32x4_t v[8]; float s = 0.f;
#pragma unroll
        for (int j = 0; j < 8; ++j) v[j] = xr[64 * j];
        if (delta) { const u32x2_t* dr = (const u32x2_t*)(delta + (size_t)r * DM) + F.lane; u32x2_t dv[8];
#pragma unroll
            for (int j = 0; j < 8; ++j) dv[j] = dr[64 * j];
            f32x4_t* xw = (f32x4_t*)xout.row(r) + F.lane;
#pragma unroll
            for (int j = 0; j < 8; ++j) { v[j].x += bflo(dv[j].x); v[j].y += bfhi(dv[j].x); v[j].z += bflo(dv[j].y); v[j].w += bfhi(dv[j].y); xw[64 * j] = v[j]; } }
#pragma unroll
        for (int j = 0; j < 8; ++j) s += (v[j].x * v[j].x + v[j].y * v[j].y) + (v[j].z * v[j].z + v[j].w * v[j].w);
        const float rstd = 1.0f / sqrtf(wave_sum(s) * (1.f / DM) + NORM_EPS);
        u32x2_t* o8 = (u32x2_t*)(out + (size_t)r * DM) + F.lane;
#pragma unroll
        for (int j = 0; j < 8; ++j) { const f32x4_t y = v[j] * rstd * ca[j] + cb[j]; u32x2_t w2; w2.x = pk2(y.x, y.y); w2.y = pk2(y.z, y.w); o8[64 * j] = w2; }
    }
}
__device__ __forceinline__ void final_norm_phase(const Frame& F, float* x, const bf16raw* __restrict__ delta, const float* __restrict__ gam) {
    for (int r = F.gw; r < NBATCH * SEQ; r += F.NGW) {
        f32x4_t* xr = (f32x4_t*)(x + (size_t)r * DM) + F.lane; f32x4_t v[8]; float s = 0.f;
        const int b = r / SEQ, ur = b * TPB + CTX + (r - b * SEQ);
        const u32x2_t* dr = (const u32x2_t*)(delta + (size_t)ur * DM) + F.lane;
#pragma unroll
        for (int j = 0; j < 8; ++j) { v[j] = xr[64 * j]; const u32x2_t d = dr[64 * j]; v[j].x += bflo(d.x); v[j].y += bfhi(d.x); v[j].z += bflo(d.y); v[j].w += bfhi(d.y);
            s += (v[j].x * v[j].x + v[j].y * v[j].y) + (v[j].z * v[j].z + v[j].w * v[j].w); }
        const float rstd = 1.0f / sqrtf(wave_sum(s) * (1.f / DM) + NORM_EPS);
#pragma unroll
        for (int j = 0; j < 8; ++j) xr[64 * j] = v[j] * rstd * *(const f32x4_t*)(gam + 4 * F.lane + 256 * j);
    }
}

__device__ __forceinline__ void rope_decode(int vp, int& x1c, int& x2c, int& f0, int& axis, int& hcol, bool& d128, bool& isq, bool& isdq) {
    x1c = 0; x2c = 0; f0 = 0; axis = 0; hcol = 0; d128 = false; isq = true; isdq = (vp >= 48 && vp < 80);
    if (vp < 48) { d128 = true; isq = vp < 32; const int v2 = isq ? vp : vp - 32; const int head = v2 >> 3, i = v2 & 7; axis = i >> 2; const int j = i & 3; f0 = 8 * j;
        const int base = (isq ? C_GQ : C_GK) + head * 128 + axis * 64; x1c = base + 8 * j; x2c = x1c + 32; hcol = axis * 64 + 8 * j; }
    else if (vp < 152) { const int v3 = vp - 48, seg = v3 >> 5, w = v3 & 31, head = w >> 2, i = w & 3; axis = i >> 1; const int j = i & 1; f0 = 8 * j;
        const int sb = (seg == 0) ? C_DQ : (seg == 1) ? C_DK : (seg == 2) ? C_SQ : C_SK; const int base = sb + head * 64 + axis * 32; x1c = base + 8 * j; x2c = x1c + 16; }
}
__device__ __forceinline__ void rope_phase(const Frame& F, bf16raw* P, const float* __restrict__ qg, const float* __restrict__ kg) {
    const float* tab = (const float*)(F.ws + WS_ROPE);
    int x1c[3], x2c[3], f0[3], axis[3], hcol[3]; bool d128[3], isq[3], act[3], isdq[3];
#pragma unroll
    for (int pass = 0; pass < 3; ++pass) { const int vp = pass * 64 + F.lane; act[pass] = vp < 152; rope_decode(vp, x1c[pass], x2c[pass], f0[pass], axis[pass], hcol[pass], d128[pass], isq[pass], isdq[pass]); }
    for (int r = F.gw; r < MROWS; r += F.NGW) {
        const int b = r / TPB, t = r - b * TPB; const bool latent = t >= CTX; const int pos = t - CTX, prow = pos >> 6, pcol = pos & 63;
        bf16raw* Pr = P + (size_t)r * PP;
        u32x4_t w1[3], w2[3];
#pragma unroll
        for (int pass = 0; pass < 3; ++pass) { const bool ld = act[pass] && (d128[pass] || latent || isdq[pass]);
            if (ld) { w1[pass] = *(const u32x4_t*)(Pr + x1c[pass]); w2[pass] = *(const u32x4_t*)(Pr + x2c[pass]); } else { w1[pass] = (u32x4_t){0u, 0u, 0u, 0u}; w2[pass] = w1[pass]; } }
#pragma unroll
        for (int pass = 0; pass < 3; ++pass) {
            float x1[8], x2[8]; unpack8(w1[pass], x1); unpack8(w2[pass], x2);
            if (pass == 0) {
                float ss = 0.f;
#pragma unroll
                for (int e = 0; e < 8; ++e) ss += x1[e] * x1[e] + x2[e] * x2[e];
                ss += __shfl_xor(ss, 1); ss += __shfl_xor(ss, 2); ss += __shfl_xor(ss, 4);
                if (d128[0]) { const float rstd = 1.0f / sqrtf(ss * (1.f / 128.f) + NORM_EPS); const float* gn = isq[0] ? qg : kg;
#pragma unroll
                    for (int e = 0; e < 8; ++e) { x1[e] = x1[e] * rstd * gn[hcol[0] + e]; x2[e] = x2[e] * rstd * gn[hcol[0] + 32 + e]; } }
            }
            if (act[pass] && latent) {
                const int p = axis[pass] ? pcol : prow;
                const float* ct = d128[pass] ? tab + 8192 + p * 32 + f0[pass] : tab + p * 16 + f0[pass]; const float* st = d128[pass] ? tab + 16384 + p * 32 + f0[pass] : tab + 4096 + p * 16 + f0[pass];
#pragma unroll
                for (int e = 0; e < 8; ++e) { const float cc = ct[e], sn = st[e], a1 = x1[e], a2 = x2[e]; x1[e] = a1 * cc - a2 * sn; x2[e] = a2 * cc + a1 * sn; }
            }
            if (ATT_ACCINIT128 && pass == 0 && d128[0] && isq[0]) {
#pragma unroll
                for (int e = 0; e < 8; ++e) { x1[e] *= 0.12751743074602467f; x2[e] *= 0.12751743074602467f; } }
            if (isdq[pass]) {
#pragma unroll
                for (int e = 0; e < 8; ++e) { x1[e] *= 0.18033688011112042f; x2[e] *= 0.18033688011112042f; } }
            if (act[pass] && (d128[pass] || latent || isdq[pass])) { *(u32x4_t*)(Pr + x1c[pass]) = pack8(x1); *(u32x4_t*)(Pr + x2c[pass]) = pack8(x2); }
        }
    }
}

__device__ __forceinline__ int tbmap(int dir, int j) { return dir == 0 ? j : (j == 0 ? 1 : (j == 1 ? 0 : 131 - j)); }
__device__ __forceinline__ float log_sigmoid_f(float x) { return fminf(x, 0.f) - log1pf(expf(-fabsf(x))); }
__device__ __forceinline__ void gate_scan(const bf16raw* __restrict__ P, const float* __restrict__ gb, int r0, int head, int dir, int lane, float (&ig)[2], float (&bc)[2], float& blast) {
    float lf[2];
#pragma unroll
    for (int k = 0; k < 2; ++k) { const int s = 2 * lane + k, tok = dir ? 127 - s : s; const bf16raw* pr = P + (size_t)(r0 + tok) * PP + C_MG;
        ig[k] = bf1(pr[(2 * dir) * 4 + head]) + gb[(2 * dir) * 4 + head]; lf[k] = log_sigmoid_f(bf1(pr[(2 * dir + 1) * 4 + head]) + gb[(2 * dir + 1) * 4 + head]); }
    const float c1 = lf[0] + lf[1]; float v = c1;
#pragma unroll
    for (int o = 1; o < 64; o <<= 1) { const float tt = __shfl_up(v, o); if (lane >= o) v += tt; }
    const float excl = v - c1; bc[0] = excl + lf[0]; bc[1] = excl + c1; blast = __shfl(v, 63);
}
__device__ __forceinline__ void mlstm_a_phase(const Frame& F, const bf16raw* __restrict__ P, const float* __restrict__ gb) {
    float* ks = (float*)F.lds;
    float* vs = ks + 128 * 64;
    float* wts = vs + 128 * 128;
    float* CST = (float*)(F.ws + WS_CST); float* NST = (float*)(F.ws + WS_NST); float* MSC = (float*)(F.ws + WS_MSC);
    for (int u = blockIdx.x; u < 16 * NCHUNK; u += F.G) {
        const int chain = u / NCHUNK, tb = u - chain * NCHUNK, bb = chain >> 3, head = (chain >> 1) & 3, dir = chain & 1;
        const int r0 = bb * TPB + tb * 128;
        __syncthreads();
        if (F.wave == 0) {
            float ig[2], bc[2], bl; gate_scan(P, gb, r0, head, dir, F.lane, ig, bc, bl);
            const float lw0 = bl - bc[0] + ig[0], lw1 = bl - bc[1] + ig[1]; const float ml = wave_max(fmaxf(lw0, lw1));
            const int s0 = 2 * F.lane; wts[dir ? 127 - s0 : s0] = expf(lw0 - ml); wts[dir ? 126 - s0 : s0 + 1] = expf(lw1 - ml);
            if (F.lane == 0) { MSC[chain * NCHUNK + tb] = bl; MSC[16 * NCHUNK + chain * NCHUNK + tb] = ml; }
        }
        __syncthreads();
#pragma unroll
        for (int i = 0; i < 2; ++i) { const int vi = F.tid + 512 * i, tok = vi >> 3, c8 = (vi & 7) * 8; float f[8]; unpack8(*(const u32x4_t*)(P + (size_t)(r0 + tok) * PP + C_MK + head * 64 + c8), f);
            const float w = wts[tok] * 0.125f;
#pragma unroll
            for (int e = 0; e < 8; ++e) ks[tok * 64 + c8 + e] = f[e] * w; }
#pragma unroll
        for (int i = 0; i < 4; ++i) { const int vi = F.tid + 512 * i, tok = vi >> 4, c8 = (vi & 15) * 8; float f[8]; unpack8(*(const u32x4_t*)(P + (size_t)(r0 + tok) * PP + C_MV + head * 128 + c8), f);
#pragma unroll
            for (int e = 0; e < 8; ++e) vs[tok * 128 + c8 + e] = f[e]; }
        __syncthreads();
        const int vg = F.tid & 31, dg = F.tid >> 5;
        f32x4_t acc[4];
#pragma unroll
        for (int i = 0; i < 4; ++i) acc[i] = (f32x4_t){0.f, 0.f, 0.f, 0.f};
#pragma unroll 4
        for (int tok = 0; tok < 128; ++tok) { const f32x4_t vv = *(const f32x4_t*)(vs + tok * 128 + 4 * vg), kv = *(const f32x4_t*)(ks + tok * 64 + 4 * dg);
            acc[0] += kv * vv.x; acc[1] += kv * vv.y; acc[2] += kv * vv.z; acc[3] += kv * vv.w; }
        float* Co = CST + (size_t)(chain * NCHUNK + tb) * 8192;
#pragma unroll
        for (int i = 0; i < 4; ++i) *(f32x4_t*)(Co + (4 * vg + i) * 64 + 4 * dg) = acc[i];
        if (F.tid < 64) { float s = 0.f;
#pragma unroll 8
            for (int tok = 0; tok < 128; ++tok) s += ks[tok * 64 + F.tid];
            NST[(size_t)(chain * NCHUNK + tb) * 64 + F.tid] = s; }
    }
}
__device__ __forceinline__ void mlstm_b_phase(const Frame& F) {
    float* CST = (float*)(F.ws + WS_CST); float* NST = (float*)(F.ws + WS_NST); float* MSC = (float*)(F.ws + WS_MSC);
    const float* BL = MSC; const float* ML = MSC + 16 * NCHUNK; float* MS = MSC + 32 * NCHUNK;
    for (int e = blockIdx.x * 512 + F.tid; e < 16 * 8192; e += F.G * 512) {
        const int chain = e >> 13, idx = e & 8191, dir = chain & 1; const bool hn = idx < 64;
        float C = 0.f, nv = 0.f, m = 0.f;
        for (int j0 = 0; j0 < NCHUNK; j0 += 10) {
            float cl[10], nl[10], bl[10], ml[10];
#pragma unroll
            for (int i = 0; i < 10; ++i) { const int tb = tbmap(dir, j0 + i), ci = chain * NCHUNK + tb; cl[i] = CST[(size_t)ci * 8192 + idx]; nl[i] = hn ? NST[(size_t)ci * 64 + idx] : 0.f; bl[i] = BL[ci]; ml[i] = ML[ci]; }
#pragma unroll
            for (int i = 0; i < 10; ++i) { const int tb = tbmap(dir, j0 + i), ci = chain * NCHUNK + tb;
                CST[(size_t)ci * 8192 + idx] = C; if (hn) NST[(size_t)ci * 64 + idx] = nv; if (idx == 0) MS[ci] = m;
                const float mnew = fmaxf(bl[i] + m, ml[i]); const float dec = expf(bl[i] + m - mnew), wg = expf(ml[i] - mnew);
                C = dec * C + wg * cl[i]; nv = dec * nv + wg * nl[i]; m = mnew; }
        }
    }
}
__device__ __forceinline__ void mlstm_c_unit(const Frame& F, const bf16raw* __restrict__ P, const float* __restrict__ gb, const float* __restrict__ ng, bf16raw* __restrict__ Y, int bb, int head, int tb) {
    constexpr int KP = 72, SP = 132;
    bf16raw* qs = (bf16raw*)F.lds;
    bf16raw* kc = qs + 128 * 64;
    bf16raw* vs = kc + 128 * KP;
    float* Ss = (float*)(vs + 128 * 128);
    float* sm = Ss + 128 * SP;
    float* a_tok = sm, *M_tok = sm + 128, *bc_tok = sm + 256, *nst = sm + 384, *misc = sm + 448;
    const float* CST = (const float*)(F.ws + WS_CST); const float* NST = (const float*)(F.ws + WS_NST); const float* MS = (const float*)(F.ws + WS_MSC) + 32 * NCHUNK;
    const int r0 = bb * TPB + tb * 128;
    int tidl = F.tid; asm volatile("" : "+v"(tidl));
    const int vg = tidl & 15, tg = tidl >> 4;
    float hsum[4][8];
#pragma unroll
    for (int a = 0; a < 4; ++a)
#pragma unroll
        for (int e = 0; e < 8; ++e) hsum[a][e] = 0.f;
    for (int dir = 0; dir < 2; ++dir) {
        const int chain = bb * 8 + head * 2 + dir, ci = chain * NCHUNK + tb;
        __syncthreads();
        int tA = F.tid; asm volatile("" : "+v"(tA));
#pragma unroll
        for (int i = 0; i < 2; ++i) { const int vi = tA + 512 * i, tok = vi >> 3, c8 = (vi & 7) * 8; const bf16raw* pr = P + (size_t)(r0 + tok) * PP + head * 64 + c8;
            *(u32x4_t*)(qs + tok * 64 + c8) = *(const u32x4_t*)(pr + C_MQ); *(u32x4_t*)(kc + tok * KP + c8) = *(const u32x4_t*)(pr + C_MK); }
#pragma unroll
        for (int i = 0; i < 4; ++i) { const int vi = tA + 512 * i, tok = vi >> 4, c8 = (vi & 15) * 8; *(u32x4_t*)(vs + tok * 128 + c8) = *(const u32x4_t*)(P + (size_t)(r0 + tok) * PP + C_MV + head * 128 + c8); }
        const float m_prev = MS[ci];
        if (F.wave == 0) {
            float ig[2], bc[2], bl; gate_scan(P, gb, r0, head, dir, F.lane, ig, bc, bl);
            const float a0 = ig[0] - bc[0], a1 = ig[1] - bc[1];
            const float pm = fmaxf(a0, a1); float v = pm;
#pragma unroll
            for (int o = 1; o < 64; o <<= 1) { const float tt = __shfl_up(v, o); if (F.lane >= o) v = fmaxf(v, tt); }
            float ex = __shfl_up(v, 1); if (F.lane == 0) ex = -3.0e38f;
            const float M0 = fmaxf(m_prev, fmaxf(ex, a0)), M1 = fmaxf(m_prev, fmaxf(ex, pm));
            const int s0 = 2 * F.lane, t0 = dir ? 127 - s0 : s0, t1 = dir ? 126 - s0 : s0 + 1;
            a_tok[t0] = a0; a_tok[t1] = a1; M_tok[t0] = M0; M_tok[t1] = M1; bc_tok[t0] = bc[0]; bc_tok[t1] = bc[1];
        } else if (F.wave == 1) { nst[F.lane] = NST[(size_t)ci * 64 + F.lane]; }
        __syncthreads();
        {
            float sacc[4][8];
#pragma unroll
            for (int a = 0; a < 4; ++a)
#pragma unroll
                for (int i = 0; i < 8; ++i) sacc[a][i] = 0.f;
#pragma unroll 1
            for (int d0 = 0; d0 < 64; d0 += 8) {
                float qf[4][8];
#pragma unroll
                for (int a = 0; a < 4; ++a) unpack8(*(const u32x4_t*)(qs + (4 * tg + a) * 64 + d0), qf[a]);
#pragma unroll
                for (int i = 0; i < 8; ++i) { float kf[8]; unpack8(*(const u32x4_t*)(kc + (vg + 16 * i) * KP + d0), kf);
#pragma unroll
                    for (int a = 0; a < 4; ++a)
#pragma unroll
                        for (int e = 0; e < 8; ++e) sacc[a][i] += qf[a][e] * kf[e]; }
            }
#pragma unroll
            for (int a = 0; a < 4; ++a) { const int t = 4 * tg + a; const float Mt = M_tok[t];
#pragma unroll
                for (int i = 0; i < 8; ++i) { const int s = vg + 16 * i; const bool ok = dir ? (s >= t) : (s <= t);
                    Ss[t * SP + s] = ok ? sacc[a][i] * 0.125f * expf(a_tok[s] - Mt) : 0.f; } }
        }
        __syncthreads();
        {
            const float* Cg = CST + (size_t)ci * 8192;
#pragma unroll
            for (int i = 0; i < 4; ++i) { const int vi = tA + 512 * i, vrow = vi >> 4, c4 = (vi & 15) * 4; const f32x4_t cv = *(const f32x4_t*)(Cg + vrow * 64 + c4);
                u32x2_t w; w.x = pk2(cv.x, cv.y); w.y = pk2(cv.z, cv.w); *(u32x2_t*)(kc + vrow * KP + c4) = w; }
        }
        float num[4][8], rs[4];
#pragma unroll
        for (int a = 0; a < 4; ++a) { rs[a] = 0.f;
#pragma unroll
            for (int e = 0; e < 8; ++e) num[a][e] = 0.f; }
        {
            const int wv16 = 16 * F.wave;
            const int sbeg = dir ? wv16 : 0, send = dir ? 128 : wv16 + 16;
#pragma unroll 1
            for (int s0 = sbeg; s0 < send; s0 += 4) {
                f32x4_t S4[4];
#pragma unroll
                for (int a = 0; a < 4; ++a) S4[a] = *(const f32x4_t*)(Ss + (4 * tg + a) * SP + s0);
#pragma unroll
                for (int ss = 0; ss < 4; ++ss) { float vf[8]; unpack8(*(const u32x4_t*)(vs + (s0 + ss) * 128 + 8 * vg), vf);
#pragma unroll
                    for (int a = 0; a < 4; ++a) { const float sv = S4[a][ss]; rs[a] += sv;
#pragma unroll
                        for (int e = 0; e < 8; ++e) num[a][e] += sv * vf[e]; } }
            }
        }
        __syncthreads();
        {
            float qc[4][8], nq[4];
#pragma unroll
            for (int a = 0; a < 4; ++a) { nq[a] = 0.f;
#pragma unroll
                for (int e = 0; e < 8; ++e) qc[a][e] = 0.f; }
#pragma unroll 1
            for (int d0 = 0; d0 < 64; d0 += 8) {
                float qf[4][8];
#pragma unroll
                for (int a = 0; a < 4; ++a) { unpack8(*(const u32x4_t*)(qs + (4 * tg + a) * 64 + d0), qf[a]);
#pragma unroll
                    for (int e = 0; e < 8; ++e) nq[a] += nst[d0 + e] * qf[a][e]; }
#pragma unroll
                for (int e = 0; e < 8; ++e) { float cf[8]; unpack8(*(const u32x4_t*)(kc + (8 * vg + e) * KP + d0), cf);
#pragma unroll
                    for (int a = 0; a < 4; ++a)
#pragma unroll
                        for (int k = 0; k < 8; ++k) qc[a][e] += cf[k] * qf[a][k]; }
            }
#pragma unroll
            for (int a = 0; a < 4; ++a) { const int t = 4 * tg + a; const float Mt = M_tok[t], winter = expf(m_prev - Mt);
                const float den = winter * nq[a] + rs[a]; const float dn = fmaxf(fabsf(den), expf(-(bc_tok[t] + Mt))); const float inv = 1.0f / dn;
#pragma unroll
                for (int e = 0; e < 8; ++e) hsum[a][e] += (winter * qc[a][e] + num[a][e]) * inv; }
        }
    }
    float gmm[8];
#pragma unroll
    for (int e = 0; e < 8; ++e) gmm[e] = ng[head * 128 + 8 * vg + e];
#pragma unroll
    for (int a = 0; a < 4; ++a) { float ss = 0.f;
#pragma unroll
        for (int e = 0; e < 8; ++e) ss += hsum[a][e] * hsum[a][e];
        ss += __shfl_xor(ss, 1); ss += __shfl_xor(ss, 2); ss += __shfl_xor(ss, 4); ss += __shfl_xor(ss, 8);
        const float rstd = 1.0f / sqrtf(ss * (1.f / 128.f) + NORM_EPS);
        const int row = r0 + 4 * tg + a; float of[8]; unpack8(*(const u32x4_t*)(P + (size_t)row * PP + C_MO + head * 128 + 8 * vg), of);
        float yv[8];
#pragma unroll
        for (int e = 0; e < 8; ++e) yv[e] = hsum[a][e] * rstd * gmm[e] * sigmoid_f(of[e]);
        *(u32x4_t*)(Y + (size_t)row * DM + head * 128 + 8 * vg) = pack8(yv); }
    (void)misc;
}

#define KSWZ64(row, colB) ((row) * 128 + ((colB) ^ (((row) & 7) << 4)))
__device__ __forceinline__ void mlstm_c_unit_mfma(const Frame& F, const bf16raw* __restrict__ P, const float* __restrict__ gb, const float* __restrict__ ng, bf16raw* __restrict__ Y, int bb, int head, int tb) {
    using att::bf16x8; using att::f32x16; using att::crow;
    constexpr int CP = 72;
    constexpr int L_K = 0, L_V = 16384, L_C = 49152, L_SM = 86016, L_WS = 90112, L_HB = 0, HP = 132;
    char* lds = F.lds;
    int tid = F.tid; asm volatile("" : "+v"(tid));
    const int wid = F.wave, lane = tid & 63, r32 = lane & 31, hi = lane >> 5, dir = wid >> 2, rg = wid & 3;
    if (wid >= 4) __builtin_amdgcn_s_setprio(1);
    const float* CST = (const float*)(F.ws + WS_CST); const float* NST = (const float*)(F.ws + WS_NST); const float* MS = (const float*)(F.ws + WS_MSC) + 32 * NCHUNK;
    const int r0 = bb * TPB + tb * 128;
    float* sm = (float*)(lds + L_SM);
    float* wsc = (float*)(lds + L_WS) + wid * 64;
    __syncthreads();
#pragma unroll
    for (int i = 0; i < 2; ++i) { const int vi = tid + 512 * i, key = vi >> 3, c8 = (vi & 7) * 8;
        *(u32x4_t*)(lds + L_K + (key >> 6) * 8192 + KSWZ64(key & 63, c8 * 2)) = *(const u32x4_t*)(P + (size_t)(r0 + key) * PP + C_MK + head * 64 + c8); }
#pragma unroll
    for (int i = 0; i < 4; ++i) { const int vi = tid + 512 * i, key = vi >> 4, c8 = (vi & 15) * 8;
        *(u32x4_t*)(lds + L_V + (key >> 6) * 16384 + att::v_st(key & 63, c8)) = *(const u32x4_t*)(P + (size_t)(r0 + key) * PP + C_MV + head * 128 + c8); }
#pragma unroll
    for (int i = 0; i < 8; ++i) { const int vi = tid + 512 * i, d2 = vi >> 11, rem = vi & 2047, vrow = rem >> 4, c4 = (rem & 15) * 4;
        const int ci2 = (bb * 8 + head * 2 + d2) * NCHUNK + tb; const f32x4_t cv = *(const f32x4_t*)(CST + (size_t)ci2 * 8192 + vrow * 64 + c4);
        u32x2_t w; w.x = pk2(cv.x, cv.y); w.y = pk2(cv.z, cv.w); *(u32x2_t*)(lds + L_C + d2 * 18432 + (vrow * CP + c4) * 2) = w; }
    const int chain = bb * 8 + head * 2 + dir, ci = chain * NCHUNK + tb;
    const float m_prev = MS[ci];
    float* smd = sm + dir * 448;
    if (rg == 0) {
        float ig[2], bc[2], bl; gate_scan(P, gb, r0, head, dir, lane, ig, bc, bl);
        const float a0 = ig[0] - bc[0], a1 = ig[1] - bc[1]; const float pm = fmaxf(a0, a1); float v = pm;
#pragma unroll
        for (int o = 1; o < 64; o <<= 1) { const float tt = __shfl_up(v, o); if (lane >= o) v = fmaxf(v, tt); }
        float ex = __shfl_up(v, 1); if (lane == 0) ex = -3.0e38f;
        const float M0 = fmaxf(m_prev, fmaxf(ex, a0)), M1 = fmaxf(m_prev, fmaxf(ex, pm));
        const int s0 = 2 * lane, t0 = dir ? 127 - s0 : s0, t1 = dir ? 126 - s0 : s0 + 1;
        smd[t0] = a0; smd[t1] = a1; smd[128 + t0] = M0; smd[128 + t1] = M1; smd[256 + t0] = bc[0]; smd[256 + t1] = bc[1];
    } else if (rg == 1) { smd[384 + lane] = NST[(size_t)ci * 64 + lane]; }
    const int tq = 32 * rg + r32;
    bf16x8 qr[4];
#pragma unroll
    for (int d0 = 0; d0 < 4; ++d0) qr[d0] = *reinterpret_cast<const bf16x8*>(P + (size_t)(r0 + tq) * PP + C_MQ + head * 64 + d0 * 16 + hi * 8);
    __syncthreads();
    const float Mt = smd[128 + tq], winter = __expf(m_prev - Mt);
    float nq = 0.f; bf16x8 qs[4];
#pragma unroll
    for (int d0 = 0; d0 < 4; ++d0) { float qf[8]; unpack8(__builtin_bit_cast(u32x4_t, qr[d0]), qf); float qw[8];
#pragma unroll
        for (int e = 0; e < 8; ++e) { nq += smd[384 + d0 * 16 + hi * 8 + e] * qf[e]; qw[e] = qf[e] * winter; }
        qs[d0] = __builtin_bit_cast(bf16x8, pack8(qw)); }
    { auto rr = __builtin_amdgcn_permlane32_swap(__float_as_uint(nq), __float_as_uint(nq), false, false); nq = __uint_as_float(rr[0]) + __uint_as_float(rr[1]); }
    f32x16 o[4] = {};
    { const char* cb = lds + L_C + dir * 18432;
#pragma unroll
      for (int blk = 0; blk < 4; ++blk)
#pragma unroll
        for (int ks = 0; ks < 4; ++ks) { const bf16x8 cf = *reinterpret_cast<const bf16x8*>(cb + ((32 * blk + r32) * CP + 16 * ks + 8 * hi) * 2);
            o[blk] = __builtin_amdgcn_mfma_f32_32x32x16_bf16(qs[ks], cf, o[blk], 0, 0, 0); } }
    float rs = 0.f;
    const int vb0 = (int)(uintptr_t)(lds + L_V) + att::v_rd_base(lane);
    const int kt_lo = dir ? (rg >= 2 ? 1 : 0) : 0, kt_hi = dir ? 1 : (rg >= 2 ? 1 : 0);
    for (int kt = kt_lo; kt <= kt_hi; ++kt) {
        f32x16 p0 = {}, p1 = {};
        const char* Ks = lds + L_K + kt * 8192;
#pragma unroll
        for (int d0 = 0; d0 < 4; ++d0) { const int cbb = (d0 * 16 + hi * 8) * 2;
            const bf16x8 b0 = *reinterpret_cast<const bf16x8*>(Ks + KSWZ64(r32, cbb)), b1 = *reinterpret_cast<const bf16x8*>(Ks + KSWZ64(32 + r32, cbb));
            p0 = __builtin_amdgcn_mfma_f32_32x32x16_bf16(b0, qr[d0], p0, 0, 0, 0); p1 = __builtin_amdgcn_mfma_f32_32x32x16_bf16(b1, qr[d0], p1, 0, 0, 0); }
#pragma unroll
        for (int r = 0; r < 16; ++r) { const int s0_ = 64 * kt + crow(r, hi), s1_ = s0_ + 32;
            const bool ok0 = dir ? (s0_ >= tq) : (s0_ <= tq), ok1 = dir ? (s1_ >= tq) : (s1_ <= tq);
            const float w0 = ok0 ? 0.125f * __expf(smd[s0_] - Mt) : 0.f, w1 = ok1 ? 0.125f * __expf(smd[s1_] - Mt) : 0.f;
            p0[r] *= w0; p1[r] *= w1; rs += p0[r] + p1[r]; }
        bf16x8 pa0, pa1, pa2, pa3;
#define PK4M(Pv, BASE, OUT) do { u32x4_t w_ = {att::cvtpk(Pv[BASE + 0], Pv[BASE + 1]), att::cvtpk(Pv[BASE + 2], Pv[BASE + 3]), att::cvtpk(Pv[BASE + 4], Pv[BASE + 5]), att::cvtpk(Pv[BASE + 6], Pv[BASE + 7])}; OUT = __builtin_bit_cast(bf16x8, w_); } while (0)
        PK4M(p0, 0, pa0); PK4M(p0, 8, pa1); PK4M(p1, 0, pa2); PK4M(p1, 8, pa3);
#undef PK4M
        __builtin_amdgcn_sched_barrier(0);
        const int vb = vb0 + kt * 16384;
        att::pv_one<0>(o[0], vb, pa0, pa1, pa2, pa3); att::pv_one<1>(o[1], vb, pa0, pa1, pa2, pa3); att::pv_one<2>(o[2], vb, pa0, pa1, pa2, pa3); att::pv_one<3>(o[3], vb, pa0, pa1, pa2, pa3);
    }
    { auto rr = __builtin_amdgcn_permlane32_swap(__float_as_uint(rs), __float_as_uint(rs), false, false); rs = __uint_as_float(rr[0]) + __uint_as_float(rr[1]); }
    const float den = winter * nq + rs; const float dn = fmaxf(fabsf(den), __expf(-(smd[256 + tq] + Mt)));
    if (hi == 0) wsc[r32] = 1.0f / dn;
    asm volatile("s_waitcnt lgkmcnt(0)" ::: "memory");
    float inv[16];
#pragma unroll
    for (int r = 0; r < 16; ++r) inv[r] = wsc[crow(r, hi)];
    __syncthreads();
    float* hb = (float*)(lds + L_HB);
    if (dir == 1) {
#pragma unroll
        for (int blk = 0; blk < 4; ++blk)
#pragma unroll
            for (int r = 0; r < 16; ++r) hb[(32 * rg + crow(r, hi)) * HP + 32 * blk + r32] = o[blk][r] * inv[r];
    }
    __syncthreads();
    __builtin_amdgcn_s_setprio(0);
    if (dir == 0) {
        float ss[16];
#pragma unroll
        for (int r = 0; r < 16; ++r) ss[r] = 0.f;
#pragma unroll
        for (int blk = 0; blk < 4; ++blk)
#pragma unroll
            for (int r = 0; r < 16; ++r) { const float h = o[blk][r] * inv[r] + hb[(32 * rg + crow(r, hi)) * HP + 32 * blk + r32]; o[blk][r] = h; ss[r] += h * h; }
#pragma unroll
        for (int r = 0; r < 16; ++r) { float s = ss[r]; s += __shfl_xor(s, 1); s += __shfl_xor(s, 2); s += __shfl_xor(s, 4); s += __shfl_xor(s, 8); s += __shfl_xor(s, 16); ss[r] = 1.0f / sqrtf(s * (1.f / 128.f) + NORM_EPS); }
#pragma unroll
        for (int blk = 0; blk < 4; ++blk) { const float gm = ng[head * 128 + 32 * blk + r32];
#pragma unroll
            for (int r = 0; r < 16; ++r) { const size_t row = (size_t)(r0 + 32 * rg + crow(r, hi));
                const float og = bf1(P[row * PP + C_MO + head * 128 + 32 * blk + r32]);
                const float yv = o[blk][r] * ss[r] * gm * sigmoid_f(og);
                Y[row * DM + head * 128 + 32 * blk + r32] = (bf16raw)(pk2(yv, 0.f) & 0xffffu); } }
    }
}

__device__ __forceinline__ void diff_post_phase(const Frame& F, const bf16raw* __restrict__ T, const float* __restrict__ lam, const float* __restrict__ g, float one_minus, bf16raw* __restrict__ Y) {
    const int h = F.lane >> 4, c8 = (F.lane & 15) * 8; const float lm = lam[h]; float gm[8];
#pragma unroll
    for (int e = 0; e < 8; ++e) gm[e] = g[h * 128 + c8 + e] * one_minus;
    for (int r = F.gw; r < MROWS; r += 2 * F.NGW) {
        const int r2 = r + F.NGW; const bool has2 = r2 < MROWS; const int rb = has2 ? r2 : r;
        const u32x4_t wa1 = *(const u32x4_t*)(T + (size_t)r * 1024 + (2 * h) * 128 + c8), wa2 = *(const u32x4_t*)(T + (size_t)r * 1024 + (2 * h + 1) * 128 + c8);
        const u32x4_t wb1 = *(const u32x4_t*)(T + (size_t)rb * 1024 + (2 * h) * 128 + c8), wb2 = *(const u32x4_t*)(T + (size_t)rb * 1024 + (2 * h + 1) * 128 + c8);
#pragma unroll
        for (int q = 0; q < 2; ++q) {
            float o1[8], o2[8]; unpack8(q ? wb1 : wa1, o1); unpack8(q ? wb2 : wa2, o2);
            float ss = 0.f;
#pragma unroll
            for (int e = 0; e < 8; ++e) { o1[e] -= lm * o2[e]; ss += o1[e] * o1[e]; }
            ss += __shfl_xor(ss, 1); ss += __shfl_xor(ss, 2); ss += __shfl_xor(ss, 4); ss += __shfl_xor(ss, 8);
            const float rstd = 1.0f / sqrtf(ss * (1.f / 128.f) + NORM_EPS);
#pragma unroll
            for (int e = 0; e < 8; ++e) o1[e] *= rstd * gm[e];
            if (q == 0 || has2) *(u32x4_t*)(Y + (size_t)(q ? r2 : r) * DM + 512 + h * 128 + c8) = pack8(o1);
        }
    }
}

__device__ __forceinline__ void mixer_phase(const Frame& F, CArgsP0 a, int l) {
    const hbf16* P = (const hbf16*)(F.ws + WS_P); hbf16* Yb = (hbf16*)(F.ws + WS_Y); hbf16* DT = (hbf16*)(F.ws + WS_DTMP);
    const bool lastl = (l == DEPTH - 1);
    const float* lamv = (const float*)(F.ws + WS_LAM) + l * 4; const float* dng = a->in[11] + l * 512; const float one_minus = (l == 0) ? 0.8f : 0.64449093241f;
    REPX(1) if (MX_MASK & 1) for (int k = F.vcu; k < 1024; k += F.G) {
        const int i = k >> 8, rem = k & 255;
        __syncthreads();
        if (i < 2) { const int id = i * 256 + rem, combo = id >> 6, qb = id & 63, bb = combo >> 2, h = combo & 3;
            const long rq = (long)bb * TPB + CTX + qb * 256, rk = (long)bb * TPB;
            att::attn_dense_body<64, DM, 1>(P + rq * PP + C_DQ + h * 128, P + rk * PP + C_DK + h * 128, P + rk * PP + C_DV + h * 128, Yb, TPB, 0, F.lds);
            __syncthreads();
            att::attn_dense_body<64, DM, 2>(P + rq * PP + C_DQ + h * 128 + 64, P + rk * PP + C_DK + h * 128, P + rk * PP + C_DV + h * 128, Yb + rq * DM + 512 + h * 128, TPB, 64, F.lds, lamv[h], dng + h * 128, one_minus);
        } else { const int id = (i - 2) * 256 + rem, combo = id >> 6, qb = id & 63, bb = combo >> 2, h = combo & 3;
            const long rq = (long)bb * TPB + CTX + qb * 256, rk = (long)bb * TPB;
            att::attn_dense_body<128, DM>(P + rq * PP + C_GQ + h * 128, P + rk * PP + C_GK + (h >> 1) * 128, P + rk * PP + C_GV + (h >> 1) * 128, Yb + rq * DM + 1536 + h * 128, TPB, 0, F.lds);
        }
    }
    if (!lastl && (MX_MASK & 1)) for (int k = F.vcu; k < 16; k += F.G) {
        __syncthreads();
        if (k < 8) { const int bb = k >> 2, h = k & 3; const long rq = (long)bb * TPB;
            att::attn_dense_body<64, DM, 1>(P + rq * PP + C_DQ + h * 128, P + rq * PP + C_DK + h * 128, P + rq * PP + C_DV + h * 128, Yb, CTX, 0, F.lds);
            __syncthreads();
            att::attn_dense_body<64, DM, 2>(P + rq * PP + C_DQ + h * 128 + 64, P + rq * PP + C_DK + h * 128, P + rq * PP + C_DV + h * 128, Yb + rq * DM + 512 + h * 128, CTX, 64, F.lds, lamv[h], dng + h * 128, one_minus);
        } else { const int k2 = k - 8, bb = k2 >> 2, h = k2 & 3; const long rq = (long)bb * TPB;
            att::attn_dense_body<128, DM>(P + rq * PP + C_GQ + h * 128, P + rq * PP + C_GK + (h >> 1) * 128, P + rq * PP + C_GV + (h >> 1) * 128, Yb + rq * DM + 1536 + h * 128, CTX, 0, F.lds);
        }
    }
    __syncthreads();
    const float* sinkl = a->in[12] + l * 8;
    REPX(2) if (MX_MASK & 2) for (int k = F.vcu; k < (lastl ? 1024 : 1040); k += F.G) {
        if (k < 1024) att::swa_unit(P, Yb, k >> 9, (k >> 8) & 1, k & 255, false, sinkl, F.lds);
        else { const int k2 = k - 1024; att::swa_unit(P, Yb, k2 >> 3, (k2 >> 2) & 1, k2 & 3, true, sinkl, F.lds); }
    }
    const float* gb = a->in[8] + l * 16; const float* ng = a->in[9] + l * 512;
    REPX(4) if (MX_MASK & 4) for (int k = F.vcu; k < (lastl ? 8 * (NCHUNK - 2) : 8 * NCHUNK); k += F.G) { int bb, head, tb;
        if (lastl) { bb = k / (4 * (NCHUNK - 2)); const int rem = k - bb * 4 * (NCHUNK - 2); head = rem / (NCHUNK - 2); tb = 2 + rem - head * (NCHUNK - 2); }
        else { bb = k / (4 * NCHUNK); const int rem = k - bb * 4 * NCHUNK; head = rem / NCHUNK; tb = rem - head * NCHUNK; }
#ifdef MLSTM_VALU
        mlstm_c_unit(F, (const bf16raw*)P, gb, ng, (bf16raw*)Yb, bb, head, tb);
#else
        mlstm_c_unit_mfma(F, (const bf16raw*)P, gb, ng, (bf16raw*)Yb, bb, head, tb);
#endif
    }
    __syncthreads();
}

__device__ __forceinline__ void stagger_start(int ticks) {
    const int grp = (blockIdx.x >> 3) & 3;
    if (grp) { const unsigned long long t0 = __builtin_amdgcn_s_memrealtime(); const unsigned long long d = (unsigned long long)(grp * ticks);
        while (__builtin_amdgcn_s_memrealtime() - t0 < d) __builtin_amdgcn_s_sleep(16); }
}
#ifndef STAG_GATE
#define STAG_GATE 0
#endif
#ifndef STAG_RESID
#define STAG_RESID 0
#endif
struct RowOrder { pg8::StaticOrder S; int skip;
    __device__ void init(int N, int G, int c, int skip_) { skip = skip_; S.init(skip_ ? NBATCH * SEQ : MROWS, N, G, c); }
    __device__ bool next(int i, pg8::Unit& u) const { if (!S.next(i, u)) return false; if (skip) u.pm += 1 + (u.pm >= 64 ? 1 : 0); return true; }
    __device__ __forceinline__ void a_ready(const pg8::Unit&) const {}
    __device__ __forceinline__ void done(const pg8::Unit&) const {}
};
typedef const __attribute__((address_space(4))) Args* CArgsP;
__device__ __forceinline__ CArgsP get_args() { CArgsP p = (CArgsP)__builtin_amdgcn_kernarg_segment_ptr(); asm volatile("" : "+s"(p)); return p; }
#define PHASE_BEGIN CArgsP ap = get_args(); unsigned char* ws = ap->ws; const Frame F = make_frame(ws, (char*)lds); (void)F;
__global__ void __launch_bounds__(512, 2) fwd_megakernel(Args a_unused) {
    extern __shared__ __attribute__((aligned(16))) unsigned char lds[];
    cg::grid_group grid = cg::this_grid();
    PG8_LAS unsigned char* glds = (PG8_LAS unsigned char*)lds;
    if (threadIdx.x < 16) ((LAS unsigned*)((LAS unsigned char*)lds + LDS_BARST))[threadIdx.x] = 0u;
    __syncthreads();
    { CArgsP ap0 = get_args(); (void)xcd_barrier_post((unsigned*)(ap0->ws + WS_BAR), (volatile LAS unsigned*)((LAS unsigned char*)lds + LDS_BARST)); }
#define GBAR() do { CArgsP apb = get_args(); XcdBarrier xb_; xb_.bar = (unsigned*)(apb->ws + WS_BAR); xb_.x = xb_xcc_id(); xb_.st = (volatile LAS unsigned*)((LAS unsigned char*)lds + LDS_BARST); xcd_barrier(xb_); } while (0)
    REP(1) if (PH_MASK & 1) { PHASE_BEGIN s0_phase(F, ap); }
    grid.sync();
#ifdef EXTRA_SYNCS
    for (int es = 0; es < EXTRA_SYNCS; ++es) GBAR();
#endif
#pragma unroll 1
    for (int l = 0; l < DEPTH; ++l) {
        REP(2) if (PH_MASK & 2) { PHASE_BEGIN s1_phase(F, ap, l); }
        GBAR();
        REP(4) if (PH_MASK & 4) { PHASE_BEGIN const float* modl = (const float*)(ws + WS_MOD) + (size_t)l * 3 * 12288;
            const XPtr xin = (l == 0) ? XPtr{ap->in[0], ap->in[2]} : XPtr{ap->out, (const float*)(ws + WS_XC)};
            norm_mod_phase(F, xin, (l == 0) ? (const bf16raw*)nullptr : (const bf16raw*)(ws + WS_H), XOut{ap->out, (float*)(ws + WS_XC)}, ap->in[6] + l * DM, modl, 0, 1, (bf16raw*)(ws + WS_H)); }
        GBAR();
        REP(8) if (PH_MASK & 8) { PHASE_BEGIN
            pg8::Gemm g{(const pg8::bf16_t*)(ws + WS_H), (const pg8::bf16_t*)(ws + WS_WIN), MROWS, PP, DM, DM, 0, 0}; pg8::StaticOrder S; S.init(MROWS, PP, F.G, (int)blockIdx.x);
            pg8::EpiBf16<0> E{(pg8::bf16_t*)(ws + WS_P), PP, nullptr, 0, 0, 1.f};
            pg8::gemm_phase<pg8::EpiBf16<0>, pg8::StaticOrder, P_ALIGN, true>(glds, g, S, E);
        }
        GBAR();
        if (PH_MASK & 16) { PHASE_BEGIN rope_phase(F, (bf16raw*)(ws + WS_P), ap->in[13] + l * 128, ap->in[14] + l * 128); }
#ifdef DBL_SCAN
        for (int rs_ = 0; rs_ < 2; ++rs_) {
#endif
        REP(32) if (PH_MASK & 32) { PHASE_BEGIN mlstm_a_phase(F, (const bf16raw*)(ws + WS_P), ap->in[8] + l * 16); }
        GBAR();
        if (PH_MASK & 64) { PHASE_BEGIN mlstm_b_phase(F); }
        GBAR();
#ifdef DBL_SCAN
        }
#endif
        if (PH_MASK & 128) { PHASE_BEGIN mixer_phase(F, ap, l); }
        GBAR();
        REP(512) if (PH_MASK & 512) { PHASE_BEGIN
            pg8::Gemm g{(const pg8::bf16_t*)(ws + WS_Y), (const pg8::bf16_t*)(ws + WS_WB), MROWS, 8192, 512, DM, 8, 512}; RowOrder S; S.init(8192, F.G, (int)blockIdx.x, l == DEPTH - 1);
            pg8::EpiBf16<0> E{(pg8::bf16_t*)(ws + WS_BIG), DM, nullptr, DM, (size_t)MROWS * DM, 1.f};
            pg8::gemm_phase<pg8::EpiBf16<0>, RowOrder, BR_ALIGN, true>(glds, g, S, E);
        }
        GBAR();
        REP(1024) if (PH_MASK & 1024) { PHASE_BEGIN
            pg8::Gemm g{(const pg8::bf16_t*)(ws + WS_H), (const pg8::bf16_t*)(ws + WS_WG), MROWS, 8192, DM, DM, 0, 0}; RowOrder S; S.init(8192, F.G, (int)blockIdx.x, l == DEPTH - 1);
            pg8::EpiGate E{(const pg8::bf16_t*)(ws + WS_BIG), (pg8::bf16_t*)(ws + WS_Y), (size_t)MROWS * DM};
            if (STAG_GATE) stagger_start(STAG_GATE);
#ifdef PROBE_GATE_KLOOP
            { pg8::EpiNone E0{(float*)(ws + WS_ZT)}; pg8::gemm_phase<pg8::EpiNone, RowOrder, GATE_ALIGN, true>(glds, g, S, E0); }
#endif
            pg8::gemm_phase<pg8::EpiGate, RowOrder, GATE_ALIGN, true>(glds, g, S, E);
        }
        GBAR();
        if (PH_MASK & 2048) { PHASE_BEGIN
            const float* modl = (const float*)(ws + WS_MOD) + (size_t)l * 3 * 12288;
            pg8::Gemm g{(const pg8::bf16_t*)(ws + WS_Y), (const pg8::bf16_t*)(ws + WS_WOUT), MROWS, DM, DM, DM, 0, 0}; RowOrder S; S.init(DM, F.G, (int)blockIdx.x, l == DEPTH - 1);
            pg8::EpiDelta E{(pg8::bf16_t*)(ws + WS_H), modl, 2};
            pg8::gemm_phase<pg8::EpiDelta, RowOrder, true, true>(glds, g, S, E);
        }
        GBAR();
        REP(4) if (PH_MASK & 4) { PHASE_BEGIN const float* modl = (const float*)(ws + WS_MOD) + (size_t)l * 3 * 12288;
            const XPtr xin2 = (l == 0) ? XPtr{ap->in[0], ap->in[2]} : XPtr{ap->out, (const float*)(ws + WS_XC)};
            norm_mod_phase(F, xin2, (const bf16raw*)(ws + WS_H), XOut{ap->out, (float*)(ws + WS_XC)}, ap->in[17] + l * DM, modl, 3, 4, (bf16raw*)(ws + WS_H)); }
        GBAR();
        REP(4096) if (PH_MASK & 4096) { PHASE_BEGIN
            pg8::Gemm g{(const pg8::bf16_t*)(ws + WS_H), (const pg8::bf16_t*)(ws + WS_WUP), MROWS, 2 * FF, DM, DM, 0, 0}; RowOrder S; S.init(2 * FF, F.G, (int)blockIdx.x, l == DEPTH - 1);
            pg8::EpiSwiGLU E{(pg8::bf16_t*)(ws + WS_BIG), FF};
            pg8::gemm_phase<pg8::EpiSwiGLU, RowOrder, UP_ALIGN, true>(glds, g, S, E);
        }
        GBAR();
        if (PH_MASK & 8192) { PHASE_BEGIN
            const float* modl = (const float*)(ws + WS_MOD) + (size_t)l * 3 * 12288;
            pg8::Gemm g{(const pg8::bf16_t*)(ws + WS_BIG), (const pg8::bf16_t*)(ws + WS_WDN), MROWS, DM, FF, FF, 0, 0}; RowOrder S; S.init(DM, F.G, (int)blockIdx.x, l == DEPTH - 1);
            pg8::EpiDelta E{(pg8::bf16_t*)(ws + WS_H), modl, 5};
            pg8::gemm_phase<pg8::EpiDelta, RowOrder, true, true>(glds, g, S, E);
        }
        GBAR();
    }
    if (PH_MASK & 16384) { PHASE_BEGIN final_norm_phase(F, ap->out, (const bf16raw*)(ws + WS_H), ap->in[20]); }
}

extern "C" void kernel_launch(void* const* d_in, const int* in_sizes, int n_in, void* d_out, int out_size, void* d_ws, size_t ws_size, hipStream_t stream) {
    static int grid = 0;
    if (grid == 0) {
        if (n_in != 21 || out_size != NBATCH * SEQ * DM || ws_size < WS_END) { fprintf(stderr, "kernel_launch: unexpected shapes: n_in %d out %d ws %zu (need %zu)\n", n_in, out_size, ws_size, (size_t)WS_END); grid = -1; return; }
        int dev = 0, cus = 0, per_cu = 0;
        if (hipGetDevice(&dev) != hipSuccess || hipDeviceGetAttribute(&cus, hipDeviceAttributeMultiprocessorCount, dev) != hipSuccess) { grid = -1; return; }
        if (hipFuncSetAttribute((const void*)fwd_megakernel, hipFuncAttributeMaxDynamicSharedMemorySize, LDS_BYTES) != hipSuccess) { fprintf(stderr, "kernel_launch: hipFuncSetAttribute failed\n"); grid = -1; return; }
        if (hipOccupancyMaxActiveBlocksPerMultiprocessor(&per_cu, (const void*)fwd_megakernel, 512, LDS_BYTES) != hipSuccess || per_cu < 1) per_cu = 1;
        (void)hipGetLastError();
        grid = cus;
        fprintf(stderr, "kernel_launch: cus %d per_cu %d grid %d ws %zu\n", cus, per_cu, grid, ws_size);
    }
    if (grid < 0) return;
    Args a{};
    for (int i = 0; i < 21; ++i) a.in[i] = (const float*)d_in[i];
    a.out = (float*)d_out; a.ws = (unsigned char*)d_ws;
    (void)hipMemsetAsync((char*)d_ws + WS_BAR, 0, XCD_BAR_WORDS * 4, stream);
    void* args[] = {&a};
    const hipError_t e = hipLaunchCooperativeKernel((const void*)fwd_megakernel, dim3(grid), dim3(512), args, LDS_BYTES, stream);
    if (e != hipSuccess) fprintf(stderr, "kernel_launch: cooperative launch failed: %s (grid %d)\n", hipGetErrorString(e), grid);
}
```

```cpp
#include <hip/hip_runtime.h>
#include <hip/hip_bf16.h>
#include <hip/hip_cooperative_groups.h>
#include <cstdio>
#include <cstdint>
namespace cg = cooperative_groups;

constexpr int DM = 2048, NBATCH = 2, SEQ = 16384, CTX = 256, DEPTH = 2;
constexpr int TPB = SEQ + CTX;
constexpr int MROWS = NBATCH * TPB;
constexpr int DIN = 13072, NMIX = 4880, PP = 5120;
constexpr int FF = 5632;
constexpr int C_MQ = 0, C_MK = 256, C_MV = 512, C_MO = 1024, C_MG = 1536, C_DQ = 1552, C_DK = 2064, C_DV = 2576, C_SQ = 3088, C_SK = 3600, C_SV = 3728,
              C_GQ = 3856, C_GK = 4368, C_GV = 4624;
constexpr int NCHUNK = TPB / 128;
constexpr float NORM_EPS = 1e-6f;

constexpr size_t MiB = 1u << 20;
constexpr size_t WS_MODP = 0;
constexpr size_t WS_MOD = 5 * MiB;
constexpr size_t WS_ROPE = 5 * MiB + 512 * 1024;
constexpr size_t WS_LAM = 5 * MiB + 768 * 1024;
constexpr size_t WS_MSC = 6 * MiB;
constexpr size_t WS_NST = 6 * MiB + 512 * 1024;
constexpr size_t WS_W = 8 * MiB;
constexpr size_t WS_WIN = WS_W, WS_WG = WS_WIN + 20 * MiB, WS_WB = WS_WG + 32 * MiB, WS_WOUT = WS_WB + 8 * MiB, WS_WUP = WS_WOUT + 8 * MiB, WS_WDN = WS_WUP + 44 * MiB;
constexpr size_t WS_H = WS_WDN + 22 * MiB;
constexpr size_t WS_Y = WS_H + 130 * MiB;
constexpr size_t WS_XC = WS_Y + 130 * MiB;
constexpr size_t WS_BIG = WS_XC + 4 * MiB;
constexpr size_t WS_P = WS_BIG, WS_DTMP = WS_BIG + 325 * MiB, WS_CST = WS_BIG + 390 * MiB;
constexpr size_t WS_END = WS_BIG + 520 * MiB;
static_assert(WS_H == 142 * MiB && WS_END == 926 * MiB, "ws map");
static_assert((size_t)MROWS * PP * 2 <= 325 * MiB && (size_t)MROWS * 1024 * 2 <= 65 * MiB && (size_t)16 * NCHUNK * 8192 * 4 <= 65 * MiB, "big map");
static_assert((size_t)4 * MROWS * DM * 2 <= 520 * MiB && (size_t)MROWS * FF * 2 <= 520 * MiB, "big map 2");

constexpr int LDS_BYTES = 147456;

typedef unsigned short bf16raw;
typedef float f32x4_t __attribute__((ext_vector_type(4)));
typedef float f32x2_t __attribute__((ext_vector_type(2)));
typedef unsigned u32x4_t __attribute__((ext_vector_type(4)));
typedef unsigned u32x2_t __attribute__((ext_vector_type(2)));
typedef __bf16 bf16x2_t __attribute__((ext_vector_type(2)));

__device__ __forceinline__ unsigned pk2(float lo, float hi) { f32x2_t v = {lo, hi}; bf16x2_t b = __builtin_convertvector(v, bf16x2_t); return __builtin_bit_cast(unsigned, b); }
__device__ __forceinline__ float bflo(unsigned u) { return __uint_as_float(u << 16); }
__device__ __forceinline__ float bfhi(unsigned u) { return __uint_as_float(u & 0xffff0000u); }
__device__ __forceinline__ float bf1(bf16raw u) { return __uint_as_float(((unsigned)u) << 16); }
__device__ __forceinline__ void unpack8(const u32x4_t w, float* f) { f[0] = bflo(w.x); f[1] = bfhi(w.x); f[2] = bflo(w.y); f[3] = bfhi(w.y); f[4] = bflo(w.z); f[5] = bfhi(w.z); f[6] = bflo(w.w); f[7] = bfhi(w.w); }
__device__ __forceinline__ u32x4_t pack8(const float* f) { u32x4_t w; w.x = pk2(f[0], f[1]); w.y = pk2(f[2], f[3]); w.z = pk2(f[4], f[5]); w.w = pk2(f[6], f[7]); return w; }
__device__ __forceinline__ float wave_sum(float v) {
#pragma unroll
    for (int o = 1; o < 64; o <<= 1) v += __shfl_xor(v, o);
    return v;
}
__device__ __forceinline__ float wave_max(float v) {
#pragma unroll
    for (int o = 1; o < 64; o <<= 1) v = fmaxf(v, __shfl_xor(v, o));
    return v;
}
__device__ __forceinline__ float sigmoid_f(float x) { return __builtin_amdgcn_rcpf(1.f + __expf(-x)); }

struct XPtr { const float* lat; const float* ctx;
    __device__ __forceinline__ const float* row(int r) const { const int b = r / TPB, t = r - b * TPB; return t < CTX ? ctx + ((size_t)b * CTX + t) * DM : lat + ((size_t)b * SEQ + (t - CTX)) * DM; } };
struct XOut { float* lat; float* ctx;
    __device__ __forceinline__ float* row(int r) const { const int b = r / TPB, t = r - b * TPB; return t < CTX ? ctx + ((size_t)b * CTX + t) * DM : lat + ((size_t)b * SEQ + (t - CTX)) * DM; } };

namespace pg8 {
#define PG8_LAS __attribute__((address_space(3)))
typedef unsigned short bf16_t;
typedef short bf16x8 __attribute__((ext_vector_type(8)));
typedef float f32x4 __attribute__((ext_vector_type(4)));
typedef unsigned u32x4 __attribute__((ext_vector_type(4)));
constexpr int BM = 256, BK = 64, HALF = 128, HTB = HALF * BK * 2  , STAGE_BYTES = 8 * HTB, NXCD = 8, WGM = 8;

__host__ __device__ __forceinline__ int lds_byte(int r, int c) { const int st = (r >> 4) * 2 + (c >> 5), rr = r & 15, cc = c & 31, ob = rr * 64 + cc * 2; return st * 1024 + (ob ^ (((ob >> 9) & 1) << 5)); }
__host__ __device__ __forceinline__ void stage_rc(int b, int& R, int& C) { const int st = b / 1024, sb = b % 1024, swz = sb ^ (((sb >> 9) & 1) << 5); R = (st >> 1) * 16 + swz / 64; C = (st & 1) * 32 + (swz % 64) / 2; }
__host__ __device__ __forceinline__ int perm32(int rho) { const int n = rho >> 4, i = rho & 15; return 8 * (i >> 2) + 4 * n + (i & 3); }

struct Unit { int pm, pn; };
struct Gemm { const bf16_t* A; const bf16_t* Bt; int M, N, K; int lda; int agrp; int agstride; };

struct StaticOrder {
    int nM, nN, nwg, G, c;
    __host__ __device__ void init(int M, int N, int G_, int c_) { nM = M / BM; nN = N / BM; nwg = nM * nN; G = G_; c = c_; }
    __host__ __device__ bool next(int i, Unit& u) const {
        const long L = (long)i * G + c; if (L >= nwg) return false;
        int wgid = (int)L; { const int q = nwg / NXCD, r = nwg % NXCD, xcd = wgid % NXCD, off = wgid / NXCD; wgid = (xcd < r ? xcd * (q + 1) : r * (q + 1) + (xcd - r) * q) + off; }
        const int nig = WGM * nN, gid = wgid / nig, fm = gid * WGM, gsz = (nM - fm) < WGM ? (nM - fm) : WGM;
        u.pm = fm + ((wgid % nig) % gsz); u.pn = (wgid % nig) / gsz; return true;
    }
    __device__ __forceinline__ void a_ready(const Unit&) const {}
    __device__ __forceinline__ void done(const Unit&) const {}
};

__device__ __forceinline__ unsigned cvt_pk_bf16(float lo, float hi) { unsigned r; asm volatile("v_cvt_pk_bf16_f32 %0, %1, %2" : "=v"(r) : "v"(lo), "v"(hi)); return r; }
typedef float f32x2 __attribute__((ext_vector_type(2)));
__device__ __forceinline__ f32x2 gelu_pk(f32x2 v) {
    const f32x2 av = __builtin_elementwise_abs(v), d = av * 0.2316418882f + 1.0f;
    f32x2 t; t.x = __builtin_amdgcn_rcpf(d.x); t.y = __builtin_amdgcn_rcpf(d.y);
    f32x2 q = t * 0.5307027145f + (-0.7265760135f); q = q * t + 0.7107068705f; q = q * t + (-0.142248368f); q = q * t + 0.127414796f; q = q * t;
    const f32x2 s = (v * v) * (-0.72134752044f);
    f32x2 e; e.x = __builtin_amdgcn_exp2f(s.x); e.y = __builtin_amdgcn_exp2f(s.y);
    const f32x2 m = v * (q * e), r = v - m;
    f32x2 o; o.x = v.x < 0.f ? m.x : r.x; o.y = v.y < 0.f ? m.y : r.y; return o;
}

template <int ACT  > struct EpiBf16 {
    static constexpr bool PERM = true, AFTER_DRAIN = false; static_assert(ACT == 0 || ACT == 1, "EpiBf16: ACT is 0 (none) or 1 (gelu_pk)");
    bf16_t* O; int ldc; const float* bias; int split_cols; size_t split_stride; float scale0;
    __device__ __forceinline__ void operator()(const f32x4 (&acc)[2][2][4][2], const Unit& u, int wr, int wc, int fr, int fq) const {
        asm volatile("" : "+v"(fr), "+v"(fq));
        const int row0 = u.pm * BM + wr * 64 + fr; int colt = u.pn * BM; bf16_t* base = O;
        float sc = 1.f; if (split_cols) { const int t = colt / split_cols; base += (size_t)t * split_stride; colt -= t * split_cols; if (t == 0) sc = scale0; }
        const int col0 = colt + wc * 32 + 8 * fq, bcol0 = u.pn * BM + wc * 32 + 8 * fq;
        f32x4 bv[2][2];
#pragma unroll
        for (int bj = 0; bj < 2; ++bj)
#pragma unroll
            for (int n = 0; n < 2; ++n) bv[bj][n] = bias ? *(const f32x4*)(bias + bcol0 + bj * HALF + 4 * n) : (f32x4){0.f, 0.f, 0.f, 0.f};
#pragma unroll
        for (int ai = 0; ai < 2; ++ai)
#pragma unroll
            for (int m = 0; m < 4; ++m) { bf16_t* rowp = base + (size_t)(row0 + ai * HALF + m * 16) * ldc + col0;
#pragma unroll
                for (int bj = 0; bj < 2; ++bj) { f32x4 v0 = acc[ai][bj][m][0] + bv[bj][0], v1 = acc[ai][bj][m][1] + bv[bj][1];
                    if (ACT == 1) { f32x2 a = gelu_pk((f32x2){v0[0], v0[1]}), b = gelu_pk((f32x2){v0[2], v0[3]}), c = gelu_pk((f32x2){v1[0], v1[1]}), d = gelu_pk((f32x2){v1[2], v1[3]});
                        v0 = (f32x4){a.x, a.y, b.x, b.y}; v1 = (f32x4){c.x, c.y, d.x, d.y}; }
                    v0 = v0 * sc; v1 = v1 * sc; u32x4 w; w.x = cvt_pk_bf16(v0[0], v0[1]); w.y = cvt_pk_bf16(v0[2], v0[3]); w.z = cvt_pk_bf16(v1[0], v1[1]); w.w = cvt_pk_bf16(v1[2], v1[3]);
                    *(u32x4*)(rowp + bj * HALF) = w; } }
    }
};

__device__ __forceinline__ float sigm(float x) { return __builtin_amdgcn_rcpf(1.f + __expf(-x)); }
struct EpiGate {
    static constexpr bool PERM = false, AFTER_DRAIN = false;
    const bf16_t* Bq; bf16_t* out; size_t bstride;
    __device__ __forceinline__ void operator()(const f32x4 (&acc)[2][2][4][2], const Unit& u, int wr, int wc, int fr, int fq) const {
        asm volatile("" : "+v"(fr), "+v"(fq));
        typedef unsigned u32x2 __attribute__((ext_vector_type(2)));
        const int oc = u.pn * 64 + wc * 16 + fq * 4;
        u32x2 bv[2][4][4];
#pragma unroll
        for (int ai = 0; ai < 2; ++ai)
#pragma unroll
            for (int m = 0; m < 4; ++m) { const size_t off = (size_t)(u.pm * BM + ai * HALF + wr * 64 + m * 16 + fr) * 2048 + oc;
#pragma unroll
                for (int i = 0; i < 4; ++i) bv[ai][m][i] = *(const u32x2*)(Bq + (size_t)i * bstride + off); }
#pragma unroll
        for (int ai = 0; ai < 2; ++ai)
#pragma unroll
            for (int m = 0; m < 4; ++m) {
                const size_t off = (size_t)(u.pm * BM + ai * HALF + wr * 64 + m * 16 + fr) * 2048 + oc;
                f32x4 s = (f32x4){0.f, 0.f, 0.f, 0.f};
#pragma unroll
                for (int bj = 0; bj < 2; ++bj)
#pragma unroll
                    for (int n = 0; n < 2; ++n) { const f32x4 g = acc[ai][bj][m][n]; const u32x2 b = bv[ai][m][2 * bj + n];
                        s[0] += sigm(g[0]) * __uint_as_float(b.x << 16); s[1] += sigm(g[1]) * __uint_as_float(b.x & 0xffff0000u);
                        s[2] += sigm(g[2]) * __uint_as_float(b.y << 16); s[3] += sigm(g[3]) * __uint_as_float(b.y & 0xffff0000u); }
                u32x2 w; w.x = cvt_pk_bf16(s[0], s[1]); w.y = cvt_pk_bf16(s[2], s[3]);
                *(u32x2*)(out + off) = w; }
    }
};
struct EpiBranchTiled {
    static constexpr bool PERM = true, AFTER_DRAIN = false;
    bf16_t* Bq;
    __device__ __forceinline__ void operator()(const f32x4 (&acc)[2][2][4][2], const Unit& u, int wr, int wc, int fr, int fq) const {
        asm volatile("" : "+v"(fr), "+v"(fq));
        const int t = u.pn >> 3, ct = u.pn & 7;
#pragma unroll
        for (int bj = 0; bj < 2; ++bj) { const int c0 = ct * 256 + bj * HALF + wc * 32 + 8 * fq, png = c0 >> 6, cc = c0 & 63;
            bf16_t* ub = Bq + (size_t)(u.pm * 32 + png) * 65536 + t * 64 + cc;
#pragma unroll
            for (int ai = 0; ai < 2; ++ai)
#pragma unroll
                for (int m = 0; m < 4; ++m) { const int rr = ai * HALF + wr * 64 + m * 16 + fr; const f32x4 v0 = acc[ai][bj][m][0], v1 = acc[ai][bj][m][1];
                    u32x4 w; w.x = cvt_pk_bf16(v0[0], v0[1]); w.y = cvt_pk_bf16(v0[2], v0[3]); w.z = cvt_pk_bf16(v1[0], v1[1]); w.w = cvt_pk_bf16(v1[2], v1[3]);
                    *(u32x4*)(ub + rr * 256) = w; } }
    }
};
struct EpiResid {
    static constexpr bool PERM = false, AFTER_DRAIN = false;
    const float* in_lat; const float* in_ctx; float* out_lat; float* out_ctx; const float* modl; int gidx;
    __device__ __forceinline__ void operator()(const f32x4 (&acc)[2][2][4][2], const Unit& u, int wr, int wc, int fr, int fq) const {
        asm volatile("" : "+v"(fr), "+v"(fq));
        const int b = u.pm / 65, tb = u.pm - b * 65; const bool isctx = (tb == 0);
        const float* gv = modl + (size_t)(isctx ? 2 : b) * 12288 + gidx * 2048;
        const float* xi = isctx ? in_ctx + (size_t)b * 256 * 2048 : in_lat + ((size_t)b * 16384 + (size_t)(tb - 1) * 256) * 2048;
        float* xo = isctx ? out_ctx + (size_t)b * 256 * 2048 : out_lat + ((size_t)b * 16384 + (size_t)(tb - 1) * 256) * 2048;
        const int col0 = u.pn * BM + wc * 32 + 4 * fq;
#pragma unroll
        for (int bj = 0; bj < 2; ++bj)
#pragma unroll
            for (int n = 0; n < 2; ++n) { const f32x4 gg = *(const f32x4*)(gv + col0 + bj * HALF + n * 16);
                f32x4 xv[2][4];
#pragma unroll
                for (int ai = 0; ai < 2; ++ai)
#pragma unroll
                    for (int m = 0; m < 4; ++m) xv[ai][m] = *(const f32x4*)(xi + (size_t)(ai * HALF + wr * 64 + m * 16 + fr) * 2048 + col0 + bj * HALF + n * 16);
#pragma unroll
                for (int ai = 0; ai < 2; ++ai)
#pragma unroll
                    for (int m = 0; m < 4; ++m) *(f32x4*)(xo + (size_t)(ai * HALF + wr * 64 + m * 16 + fr) * 2048 + col0 + bj * HALF + n * 16) = xv[ai][m] + gg * acc[ai][bj][m][n];
                asm volatile("" ::: "memory"); }
    }
};
struct EpiDelta {
    static constexpr bool PERM = true, AFTER_DRAIN = false;
    bf16_t* D; const float* modl; int gidx;
    __device__ __forceinline__ void operator()(const f32x4 (&acc)[2][2][4][2], const Unit& u, int wr, int wc, int fr, int fq) const {
        asm volatile("" : "+v"(fr), "+v"(fq));
        const int b = u.pm / 65, tb = u.pm - b * 65; const bool isctx = (tb == 0);
        const float* gv = modl + (size_t)(isctx ? 2 : b) * 12288 + gidx * 2048;
        const int col0 = u.pn * BM + wc * 32 + 8 * fq;
#pragma unroll
        for (int bj = 0; bj < 2; ++bj) { const f32x4 g0 = *(const f32x4*)(gv + col0 + bj * HALF), g1 = *(const f32x4*)(gv + col0 + bj * HALF + 4);
#pragma unroll
            for (int ai = 0; ai < 2; ++ai)
#pragma unroll
                for (int m = 0; m < 4; ++m) { const f32x4 v0 = acc[ai][bj][m][0] * g0, v1 = acc[ai][bj][m][1] * g1;
                    u32x4 w; w.x = cvt_pk_bf16(v0[0], v0[1]); w.y = cvt_pk_bf16(v0[2], v0[3]); w.z = cvt_pk_bf16(v1[0], v1[1]); w.w = cvt_pk_bf16(v1[2], v1[3]);
                    *(u32x4*)(D + (size_t)(u.pm * BM + ai * HALF + wr * 64 + m * 16 + fr) * 2048 + col0 + bj * HALF) = w; } }
    }
};
struct EpiSwiGLU {
    static constexpr bool PERM = true, AFTER_DRAIN = false;
    bf16_t* hid; int ldh;
    __device__ __forceinline__ void operator()(const f32x4 (&acc)[2][2][4][2], const Unit& u, int wr, int wc, int fr, int fq) const {
        asm volatile("" : "+v"(fr), "+v"(fq));
        const int hc = u.pn * 128 + wc * 32 + 8 * fq;
#pragma unroll
        for (int ai = 0; ai < 2; ++ai)
#pragma unroll
            for (int m = 0; m < 4; ++m) { bf16_t* p = hid + (size_t)(u.pm * BM + ai * HALF + wr * 64 + m * 16 + fr) * ldh + hc;
                f32x4 v[2];
#pragma unroll
                for (int n = 0; n < 2; ++n) { const f32x4 g = acc[ai][0][m][n], up = acc[ai][1][m][n];
#pragma unroll
                    for (int e = 0; e < 4; ++e) v[n][e] = g[e] * sigm(g[e]) * up[e]; }
                u32x4 w; w.x = cvt_pk_bf16(v[0][0], v[0][1]); w.y = cvt_pk_bf16(v[0][2], v[0][3]); w.z = cvt_pk_bf16(v[1][0], v[1][1]); w.w = cvt_pk_bf16(v[1][2], v[1][3]);
                *(u32x4*)p = w; }
    }
};


struct EpiNone {
    static constexpr bool PERM = false, AFTER_DRAIN = false;
    float* sink;
    __device__ __forceinline__ void operator()(const f32x4 (&acc)[2][2][4][2], const Unit& u, int wr, int wc, int fr, int fq) const {
        asm volatile("" : "+v"(fr), "+v"(fq));
        if (u.pm < 0) {
#pragma unroll
            for (int ai = 0; ai < 2; ++ai)
#pragma unroll
                for (int bj = 0; bj < 2; ++bj)
#pragma unroll
                    for (int m = 0; m < 4; ++m)
#pragma unroll
                        for (int n = 0; n < 2; ++n) *(f32x4*)(sink + ((((ai * 2 + bj) * 4 + m) * 2 + n) * 64 + fr + 16 * fq) * 4) = acc[ai][bj][m][n];
        }
    }
};
template <class Epi, class Sched, bool ALIGN_EPI = false, bool SP2 = false>
__device__ __forceinline__ void gemm_phase(PG8_LAS unsigned char* lds, const Gemm g, const Sched& S, const Epi& E) {
    int tid_ = threadIdx.x; asm volatile("" : "+v"(tid_)); const int tid = tid_, wid = __builtin_amdgcn_readfirstlane(tid >> 6), lane = tid & 63, wr = wid >> 2, wc = wid & 3, fr = lane & 15, fq = lane >> 4;
    const int K = g.K, nt = K / BK;
    unsigned voffA[2], voffB[2];
#pragma unroll
    for (int i = 0; i < 2; ++i) { int R, C; stage_rc(tid * 16 + i * 8192, R, C); const int Rb = Epi::PERM ? ((R & ~31) + perm32(R & 31)) : R;
        voffA[i] = (unsigned)(R * g.lda + C) * 2u; voffB[i] = (unsigned)(Rb * K + C) * 2u; }
    const size_t kstep = (size_t)(BK * 2);
    const size_t hstepB = (size_t)HALF * K * 2, hstepA = (size_t)HALF * g.lda * 2;
    const size_t tstepA = 2 * hstepA, tstepB = 2 * hstepB;
    const unsigned ldsw = (unsigned)wid * 1024u;
    const int aoff = lds_byte(wr * 64 + fr, fq * 8), boff = lds_byte(wc * 32 + fr, fq * 8);
#define PG8_SA(b, h) (((b) * 2 + (h)) * HTB)
#define PG8_SB(b, h) ((4 + (b) * 2 + (h)) * HTB)
#define PG8_STAGE(bufoff, gbase, voff) do { _Pragma("unroll") for (int _i = 0; _i < 2; ++_i) \
        __builtin_amdgcn_global_load_lds((const unsigned*)((const char*)(gbase) + (voff)[_i]), (PG8_LAS unsigned*)(lds + (bufoff) + ldsw + _i * 8192), 16, 0, 0); } while (0)
#define PG8_LDA(dst, b, h) do { _Pragma("unroll") for (int m = 0; m < 4; ++m) _Pragma("unroll") for (int k = 0; k < 2; ++k) dst[m][k] = *(const PG8_LAS bf16x8*)(lds + PG8_SA(b, h) + aoff + m * 2048 + k * 1024); } while (0)
#define PG8_LDB(dst, b, h) do { _Pragma("unroll") for (int n = 0; n < 2; ++n) _Pragma("unroll") for (int k = 0; k < 2; ++k) dst[n][k] = *(const PG8_LAS bf16x8*)(lds + PG8_SB(b, h) + boff + n * 2048 + k * 1024); } while (0)
#define PG8_MMA(ai, bj, At, Bt) do { __builtin_amdgcn_s_setprio(1); _Pragma("unroll") for (int m = 0; m < 4; ++m) _Pragma("unroll") for (int n = 0; n < 2; ++n) _Pragma("unroll") for (int k = 0; k < 2; ++k) \
        acc[ai][bj][m][n] = __builtin_amdgcn_mfma_f32_16x16x32_bf16(Bt[n][k], At[m][k], acc[ai][bj][m][n], 0, 0, 0); __builtin_amdgcn_s_setprio(0); } while (0)
#define PG8_WAIT_V(n) asm volatile("s_waitcnt vmcnt(" #n ")" ::: "memory")
#define PG8_WAIT_L(n) asm volatile("s_waitcnt lgkmcnt(" #n ")" ::: "memory")
#define PG8_BAR __builtin_amdgcn_s_barrier()
#define PG8_SCHED __builtin_amdgcn_sched_barrier(0)
    Unit cur, nxt; int ui = 0;
    if (!S.next(0, cur)) return;
    f32x4 acc[2][2][4][2];
#pragma unroll
    for (int a = 0; a < 2; ++a)
#pragma unroll
        for (int b = 0; b < 2; ++b)
#pragma unroll
            for (int m = 0; m < 4; ++m)
#pragma unroll
                for (int n = 0; n < 2; ++n) acc[a][b][m][n] = (f32x4){0.f, 0.f, 0.f, 0.f};
    bf16x8 At[4][2], B0[2][2], B1[2][2];
    const char* cA = (const char*)g.A + (size_t)cur.pm * tstepA + (g.agrp ? (size_t)(cur.pn / g.agrp) * g.agstride * 2 : 0); const char* cB = (const char*)g.Bt + (size_t)cur.pn * tstepB;
    S.a_ready(cur);
    if constexpr (SP2) {
        PG8_STAGE(PG8_SB(0, 0), cB, voffB); PG8_STAGE(PG8_SB(0, 1), cB + hstepB, voffB); PG8_STAGE(PG8_SA(0, 0), cA, voffA); PG8_STAGE(PG8_SA(0, 1), cA + hstepA, voffA);
        if (wr == 1) PG8_BAR;
        PG8_WAIT_V(2); PG8_BAR;
        PG8_STAGE(PG8_SB(1, 0), cB + kstep, voffB); PG8_STAGE(PG8_SA(1, 0), cA + kstep, voffA); PG8_STAGE(PG8_SB(1, 1), cB + hstepB + kstep, voffB);
        PG8_WAIT_V(6); PG8_BAR;
    } else {
        PG8_STAGE(PG8_SB(0, 0), cB, voffB); PG8_STAGE(PG8_SA(0, 0), cA, voffA); PG8_STAGE(PG8_SB(0, 1), cB + hstepB, voffB); PG8_STAGE(PG8_SA(0, 1), cA + hstepA, voffA);
        if (wr == 1) PG8_BAR;
        PG8_WAIT_V(4); PG8_BAR;
        PG8_STAGE(PG8_SB(1, 0), cB + kstep, voffB); PG8_STAGE(PG8_SA(1, 0), cA + kstep, voffA); PG8_STAGE(PG8_SB(1, 1), cB + hstepB + kstep, voffB);
        PG8_WAIT_V(6); PG8_BAR;
    }
    for (;;) {
        const bool has_next = S.next(ui + 1, nxt);
        const char* nA = has_next ? (const char*)g.A + (size_t)nxt.pm * tstepA + (g.agrp ? (size_t)(nxt.pn / g.agrp) * g.agstride * 2 : 0) : cA; const char* nB = has_next ? (const char*)g.Bt + (size_t)nxt.pn * tstepB : cB;
        for (int t = 0; t < nt; t += 2) {
            const bool last = (t == nt - 2);
            const char* a1 = cA + (size_t)(t + 1) * kstep;
            const char* a2 = last ? nA : cA + (size_t)(t + 2) * kstep; const char* b2 = last ? nB : cB + (size_t)(t + 2) * kstep;
            const char* a3 = a2 + kstep; const char* b3 = b2 + kstep;
            if (last && has_next) S.a_ready(nxt);
            if constexpr (SP2) {
            PG8_LDB(B0, 0, 0); PG8_LDB(B1, 0, 1); PG8_SCHED; PG8_LDA(At, 0, 0); PG8_STAGE(PG8_SA(1, 1), a1 + hstepA, voffA);
            PG8_WAIT_V(8); PG8_WAIT_L(0); PG8_BAR; PG8_MMA(0, 0, At, B0); PG8_MMA(0, 1, At, B1); PG8_BAR; PG8_SCHED;
            PG8_LDA(At, 0, 1); PG8_STAGE(PG8_SB(0, 0), b2, voffB); PG8_STAGE(PG8_SB(0, 1), b2 + hstepB, voffB); PG8_STAGE(PG8_SA(0, 0), a2, voffA);
            PG8_WAIT_V(8); PG8_WAIT_L(0); PG8_BAR; PG8_MMA(1, 0, At, B0); PG8_MMA(1, 1, At, B1); PG8_BAR; PG8_SCHED;
            PG8_LDB(B0, 1, 0); PG8_LDB(B1, 1, 1); PG8_SCHED; PG8_LDA(At, 1, 0); PG8_STAGE(PG8_SA(0, 1), a2 + hstepA, voffA);
            PG8_WAIT_V(8); PG8_WAIT_L(0); PG8_BAR; PG8_MMA(0, 0, At, B0); PG8_MMA(0, 1, At, B1); PG8_BAR; PG8_SCHED;
            PG8_LDA(At, 1, 1); PG8_STAGE(PG8_SB(1, 0), b3, voffB); PG8_STAGE(PG8_SB(1, 1), b3 + hstepB, voffB); PG8_STAGE(PG8_SA(1, 0), a3, voffA);
            PG8_WAIT_V(8); PG8_WAIT_L(0); PG8_BAR; PG8_MMA(1, 0, At, B0); PG8_MMA(1, 1, At, B1); PG8_BAR; PG8_SCHED;
            } else {
            PG8_LDB(B0, 0, 0); PG8_SCHED; PG8_LDA(At, 0, 0); PG8_STAGE(PG8_SA(1, 1), a1 + hstepA, voffA);
            PG8_WAIT_L(8); PG8_BAR; PG8_WAIT_L(0); PG8_MMA(0, 0, At, B0); PG8_BAR; PG8_SCHED;
            PG8_LDB(B1, 0, 1); PG8_STAGE(PG8_SB(0, 0), b2, voffB);
            PG8_BAR; PG8_WAIT_L(0); PG8_MMA(0, 1, At, B1); PG8_BAR;
            PG8_LDA(At, 0, 1); PG8_STAGE(PG8_SA(0, 0), a2, voffA);
            PG8_BAR; PG8_WAIT_L(0); PG8_MMA(1, 0, At, B0); PG8_BAR; PG8_SCHED;
            PG8_STAGE(PG8_SB(0, 1), b2 + hstepB, voffB);
            PG8_WAIT_V(6); PG8_BAR; PG8_MMA(1, 1, At, B1); PG8_BAR;
            PG8_LDB(B0, 1, 0); PG8_SCHED; PG8_LDA(At, 1, 0); PG8_STAGE(PG8_SA(0, 1), a2 + hstepA, voffA);
            PG8_WAIT_L(8); PG8_BAR; PG8_WAIT_L(0); PG8_MMA(0, 0, At, B0); PG8_BAR; PG8_SCHED;
            PG8_LDB(B1, 1, 1); PG8_STAGE(PG8_SB(1, 0), b3, voffB);
            PG8_BAR; PG8_WAIT_L(0); PG8_MMA(0, 1, At, B1); PG8_BAR;
            PG8_LDA(At, 1, 1); PG8_STAGE(PG8_SA(1, 0), a3, voffA);
            PG8_BAR; PG8_WAIT_L(0); PG8_MMA(1, 0, At, B0); PG8_BAR; PG8_SCHED;
            PG8_STAGE(PG8_SB(1, 1), b3 + hstepB, voffB);
            PG8_WAIT_V(6); PG8_BAR; PG8_MMA(1, 1, At, B1); PG8_BAR;
            }
        }
        if constexpr (ALIGN_EPI) { if (wr == 0) PG8_BAR; }
        if constexpr (!Epi::AFTER_DRAIN) { E(acc, cur, wr, wc, fr, fq); S.done(cur); }
        if (!has_next) break;
#pragma unroll
        for (int a = 0; a < 2; ++a)
#pragma unroll
            for (int b = 0; b < 2; ++b)
#pragma unroll
                for (int m = 0; m < 4; ++m)
#pragma unroll
                    for (int n = 0; n < 2; ++n) acc[a][b][m][n] = (f32x4){0.f, 0.f, 0.f, 0.f};
        cur = nxt; cA = nA; cB = nB; ++ui;
        if constexpr (ALIGN_EPI) { if (wr == 1) PG8_BAR; }
    }
    PG8_WAIT_V(0);
    if constexpr (!ALIGN_EPI) { if (wr == 0) PG8_BAR; }
    PG8_BAR;
    if constexpr (Epi::AFTER_DRAIN) { E.fused(acc, cur, wr, wc, fr, fq, lds, wid, lane); S.done(cur); }
#undef PG8_SA
#undef PG8_SB
#undef PG8_STAGE
#undef PG8_LDA
#undef PG8_LDB
#undef PG8_MMA
#undef PG8_WAIT_V
#undef PG8_WAIT_L
#undef PG8_BAR
#undef PG8_SCHED
}
}
#ifndef ATT_SDEPTH
#define ATT_SDEPTH 1
#endif
#ifndef ATT_ACCINIT128
#define ATT_ACCINIT128 1
#endif
namespace att {
using bf16 = __hip_bfloat16;
constexpr int NW = 8, QBLK = 32, KVBLK = 64, SDEPTH = ATT_SDEPTH;
constexpr float THR = 8.f;
constexpr size_t SHM_V = KVBLK * 128 * 2, SHM_K = KVBLK * 128 * 2, SHM_ATTN = 2 * SHM_V + 2 * SHM_K + NW * 64 * 4;
using bf16x8 = __attribute__((ext_vector_type(8))) short;
using s16x4  = __attribute__((ext_vector_type(4))) short;
using f32x16 = __attribute__((ext_vector_type(16))) float;
using f32x8  = __attribute__((ext_vector_type(8))) float;
using u32x4  = __attribute__((ext_vector_type(4))) unsigned;
#define KSWZ(row, colB) ((row) * 256 + ((colB) ^ (((row) & 7) << 4)))
#define SBAR() __builtin_amdgcn_sched_barrier(0)
__device__ __forceinline__ int crow(int r, int hi) { return (r & 3) + 8 * (r >> 2) + 4 * hi; }
__device__ __forceinline__ unsigned cvtpk(float lo, float hi) {
  unsigned r; asm volatile("v_cvt_pk_bf16_f32 %0, %1, %2" : "=v"(r) : "v"(lo), "v"(hi)); return r;
}
template <int DQK> __device__ __forceinline__ void partialSM(f32x16& p0, f32x16& p1, float& m_reg, float& mn, float& alpha) {
  constexpr float SCALE = (DQK == 64) ? 0.125f : 0.088388347648318440f; constexpr float C = SCALE * 1.4426950408889634f;
  float pmax = p0[0]; for (int r = 1; r < 16; ++r) pmax = fmaxf(pmax, p0[r]); for (int r = 0; r < 16; ++r) pmax = fmaxf(pmax, p1[r]);
  { auto rr = __builtin_amdgcn_permlane32_swap(__float_as_uint(pmax), __float_as_uint(pmax), false, false);
    pmax = fmaxf(__uint_as_float(rr[0]), __uint_as_float(rr[1])); }
  if (__builtin_expect(__all(pmax - m_reg <= THR / SCALE), 1)) { mn = m_reg; alpha = 1.f; }
  else { mn = fmaxf(m_reg, pmax); alpha = __builtin_amdgcn_exp2f((m_reg - mn) * C); m_reg = mn; }
  float mnC = -mn * C;
  for (int r = 0; r < 16; ++r) p0[r] = fmaf(p0[r], C, mnC); for (int r = 0; r < 16; ++r) p1[r] = fmaf(p1[r], C, mnC);
  for (int r = 0; r < 16; ++r) p0[r] = __builtin_amdgcn_exp2f(p0[r]);
}
__device__ __forceinline__ void finishSM(f32x16& p0, f32x16& p1, float alpha, float& l_reg, bf16x8& pa0, bf16x8& pa1, bf16x8& pa2, bf16x8& pa3) {
  for (int r = 0; r < 16; ++r) p1[r] = __builtin_amdgcn_exp2f(p1[r]);
  float ps = 0; for (int r = 0; r < 16; ++r) ps += p0[r]; for (int r = 0; r < 16; ++r) ps += p1[r];
  { auto rr = __builtin_amdgcn_permlane32_swap(__float_as_uint(ps), __float_as_uint(ps), false, false);
    ps = __uint_as_float(rr[0]) + __uint_as_float(rr[1]); }
  l_reg = l_reg * alpha + ps;
#define PK4(P, BASE, OUT) do { u32x4 w = {cvtpk(P[BASE + 0], P[BASE + 1]), cvtpk(P[BASE + 2], P[BASE + 3]), cvtpk(P[BASE + 4], P[BASE + 5]), cvtpk(P[BASE + 6], P[BASE + 7])}; OUT = *reinterpret_cast<bf16x8*>(&w); } while (0)
  PK4(p0, 0, pa0); PK4(p0, 8, pa1); PK4(p1, 0, pa2); PK4(p1, 8, pa3);
#undef PK4
}
template <int DQK> __device__ __forceinline__ void qkt(f32x16& p0, f32x16& p1, const bf16* Ks, const bf16x8* qr, int r32, int hi, int kcol0) {
  p0 = f32x16{}; p1 = f32x16{};
#pragma unroll
  for (int d0 = 0; d0 < DQK / 16; ++d0) { int cb = (kcol0 + d0 * 16 + hi * 8) * 2;
    bf16x8 b0 = *reinterpret_cast<const bf16x8*>((const char*)Ks + KSWZ(r32, cb));
    bf16x8 b1 = *reinterpret_cast<const bf16x8*>((const char*)Ks + KSWZ(32 + r32, cb));
    p0 = __builtin_amdgcn_mfma_f32_32x32x16_bf16(b0, qr[d0], p0, 0, 0, 0);
    p1 = __builtin_amdgcn_mfma_f32_32x32x16_bf16(b1, qr[d0], p1, 0, 0, 0); }
}
template <int DQK> __device__ __forceinline__ void qktn(f32x16& p0, f32x16& p1, const bf16* Ks, const bf16x8* qr, int r32, int hi, int kcol0, const f32x16& negm) {
#pragma unroll
  for (int d0 = 0; d0 < DQK / 16; ++d0) { int cb = (kcol0 + d0 * 16 + hi * 8) * 2;
    bf16x8 b0 = *reinterpret_cast<const bf16x8*>((const char*)Ks + KSWZ(r32, cb));
    bf16x8 b1 = *reinterpret_cast<const bf16x8*>((const char*)Ks + KSWZ(32 + r32, cb));
    if (d0 == 0) { p0 = __builtin_amdgcn_mfma_f32_32x32x16_bf16(b0, qr[0], negm, 0, 0, 0); p1 = __builtin_amdgcn_mfma_f32_32x32x16_bf16(b1, qr[0], negm, 0, 0, 0); }
    else { p0 = __builtin_amdgcn_mfma_f32_32x32x16_bf16(b0, qr[d0], p0, 0, 0, 0); p1 = __builtin_amdgcn_mfma_f32_32x32x16_bf16(b1, qr[d0], p1, 0, 0, 0); } }
}
template <bool FIRST> __device__ __forceinline__ void partialSMn(f32x16& p0, f32x16& p1, float& mref, f32x16& negm, float& alpha) {
  constexpr float THRL = THR * 1.4426950408889634f;
  float pmax = p0[0]; for (int r = 1; r < 16; ++r) pmax = fmaxf(pmax, p0[r]); for (int r = 0; r < 16; ++r) pmax = fmaxf(pmax, p1[r]);
  if (!FIRST && __builtin_expect(__all(pmax <= THRL), 1)) { alpha = 1.f; }
  else { { auto rr = __builtin_amdgcn_permlane32_swap(__float_as_uint(pmax), __float_as_uint(pmax), false, false); pmax = fmaxf(__uint_as_float(rr[0]), __uint_as_float(rr[1])); }
    const float dl = FIRST ? pmax : fmaxf(pmax, 0.f); mref += dl; alpha = FIRST ? 1.f : __builtin_amdgcn_exp2f(-dl);
    for (int r = 0; r < 16; ++r) { p0[r] -= dl; p1[r] -= dl; }
    const float nm = -mref; for (int r = 0; r < 16; ++r) negm[r] = nm; }
  for (int r = 0; r < 16; ++r) p0[r] = __builtin_amdgcn_exp2f(p0[r]);
}
__device__ __forceinline__ int v_st(int k, int c) { const int kk = k; return ((kk >> 3) * 4 + (c >> 5)) * 512 + ((kk & 7) * 32 + (c & 31)) * 2; }
__device__ __forceinline__ int v_rd_base(int lane) { return ((lane & 3) << 3) | (((lane >> 2) & 3) << 6) | (((lane >> 4) & 1) << 5) | (((lane >> 5) & 1) << 8); }
constexpr int v_rd_off(int d0, int ks, int half) { return d0 * 512 + ks * 4096 + half * 2048; }
template <int OFF> __device__ __forceinline__ s16x4 tr_read(int vb) {
  s16x4 r; asm volatile("ds_read_b64_tr_b16 %0, %1 offset:%2" : "=&v"(r) : "v"(vb), "i"(OFF) : "memory"); return r;
}
template <int D0> __device__ __forceinline__ void pv_one(f32x16& od, int vb, bf16x8 pa0, bf16x8 pa1, bf16x8 pa2, bf16x8 pa3) {
  const s16x4 l0 = tr_read<v_rd_off(D0, 0, 0)>(vb), h0 = tr_read<v_rd_off(D0, 0, 1)>(vb), l1 = tr_read<v_rd_off(D0, 1, 0)>(vb), h1 = tr_read<v_rd_off(D0, 1, 1)>(vb);
  const s16x4 l2 = tr_read<v_rd_off(D0, 2, 0)>(vb), h2 = tr_read<v_rd_off(D0, 2, 1)>(vb), l3 = tr_read<v_rd_off(D0, 3, 0)>(vb), h3 = tr_read<v_rd_off(D0, 3, 1)>(vb);
  asm volatile("s_waitcnt lgkmcnt(0)" ::: "memory"); SBAR();
#define PK(L, H) (bf16x8){L[0], L[1], L[2], L[3], H[0], H[1], H[2], H[3]}
  od = __builtin_amdgcn_mfma_f32_32x32x16_bf16(pa0, PK(l0, h0), od, 0, 0, 0);
  od = __builtin_amdgcn_mfma_f32_32x32x16_bf16(pa1, PK(l1, h1), od, 0, 0, 0);
  od = __builtin_amdgcn_mfma_f32_32x32x16_bf16(pa2, PK(l2, h2), od, 0, 0, 0);
  od = __builtin_amdgcn_mfma_f32_32x32x16_bf16(pa3, PK(l3, h3), od, 0, 0, 0);
#undef PK
}
template <int KS> __device__ __forceinline__ void pv_ks(f32x16* o, int vb, bf16x8 pa) {
  const s16x4 l0 = tr_read<v_rd_off(0, KS, 0)>(vb), h0 = tr_read<v_rd_off(0, KS, 1)>(vb), l1 = tr_read<v_rd_off(1, KS, 0)>(vb), h1 = tr_read<v_rd_off(1, KS, 1)>(vb);
  const s16x4 l2 = tr_read<v_rd_off(2, KS, 0)>(vb), h2 = tr_read<v_rd_off(2, KS, 1)>(vb), l3 = tr_read<v_rd_off(3, KS, 0)>(vb), h3 = tr_read<v_rd_off(3, KS, 1)>(vb);
  asm volatile("s_waitcnt lgkmcnt(0)" ::: "memory"); SBAR();
#define PK(L, H) (bf16x8){L[0], L[1], L[2], L[3], H[0], H[1], H[2], H[3]}
  o[0] = __builtin_amdgcn_mfma_f32_32x32x16_bf16(pa, PK(l0, h0), o[0], 0, 0, 0);
  o[1] = __builtin_amdgcn_mfma_f32_32x32x16_bf16(pa, PK(l1, h1), o[1], 0, 0, 0);
  o[2] = __builtin_amdgcn_mfma_f32_32x32x16_bf16(pa, PK(l2, h2), o[2], 0, 0, 0);
  o[3] = __builtin_amdgcn_mfma_f32_32x32x16_bf16(pa, PK(l3, h3), o[3], 0, 0, 0);
#undef PK
}
#define PVR(D0, l0, h0, l1, h1, l2, h2, l3, h3) const s16x4 l0 = tr_read<v_rd_off(D0, 0, 0)>(vb), h0 = tr_read<v_rd_off(D0, 0, 1)>(vb), l1 = tr_read<v_rd_off(D0, 1, 0)>(vb), h1 = tr_read<v_rd_off(D0, 1, 1)>(vb), \
    l2 = tr_read<v_rd_off(D0, 2, 0)>(vb), h2 = tr_read<v_rd_off(D0, 2, 1)>(vb), l3 = tr_read<v_rd_off(D0, 3, 0)>(vb), h3 = tr_read<v_rd_off(D0, 3, 1)>(vb)
#define PK(L, H) (bf16x8){L[0], L[1], L[2], L[3], H[0], H[1], H[2], H[3]}
#define PVM(od, l0, h0, l1, h1, l2, h2, l3, h3) do { od = __builtin_amdgcn_mfma_f32_32x32x16_bf16(pa0, PK(l0, h0), od, 0, 0, 0); od = __builtin_amdgcn_mfma_f32_32x32x16_bf16(pa1, PK(l1, h1), od, 0, 0, 0); \
    od = __builtin_amdgcn_mfma_f32_32x32x16_bf16(pa2, PK(l2, h2), od, 0, 0, 0); od = __builtin_amdgcn_mfma_f32_32x32x16_bf16(pa3, PK(l3, h3), od, 0, 0, 0); } while (0)
__device__ __forceinline__ void pv_d0(f32x16* o, int vb, bf16x8 pa0, bf16x8 pa1, bf16x8 pa2, bf16x8 pa3) {
#ifndef PV_PIPE
  pv_one<0>(o[0], vb, pa0, pa1, pa2, pa3); pv_one<1>(o[1], vb, pa0, pa1, pa2, pa3); pv_one<2>(o[2], vb, pa0, pa1, pa2, pa3); pv_one<3>(o[3], vb, pa0, pa1, pa2, pa3);
#else
  PVR(0, a0, a1, a2, a3, a4, a5, a6, a7);
  PVR(1, b0, b1, b2, b3, b4, b5, b6, b7);
  asm volatile("s_waitcnt lgkmcnt(8)" ::: "memory"); SBAR();
  PVM(o[0], a0, a1, a2, a3, a4, a5, a6, a7); SBAR();
  PVR(2, c0, c1, c2, c3, c4, c5, c6, c7);
  asm volatile("s_waitcnt lgkmcnt(8)" ::: "memory"); SBAR();
  PVM(o[1], b0, b1, b2, b3, b4, b5, b6, b7); SBAR();
  PVR(3, d0, d1, d2, d3, d4, d5, d6, d7);
  asm volatile("s_waitcnt lgkmcnt(8)" ::: "memory"); SBAR();
  PVM(o[2], c0, c1, c2, c3, c4, c5, c6, c7); SBAR();
  asm volatile("s_waitcnt lgkmcnt(0)" ::: "memory"); SBAR();
  PVM(o[3], d0, d1, d2, d3, d4, d5, d6, d7);
#endif
}
#undef PVR
#undef PVM
#undef PK
constexpr int STASH_OFF = 67584;
template <int DQK, int LDO, int MODE = 0>
__device__ __forceinline__ void attn_dense_body(const bf16* __restrict__ Qb, const bf16* __restrict__ Kh, const bf16* __restrict__ Vh,
                                                bf16* __restrict__ Ob, int seq, int kcol0, char* lds, float lam = 0.f, const float* __restrict__ gvec = nullptr, float gmul = 1.f) {
  constexpr int LDQ = PP, LDK = PP;
  constexpr float SCALE = (DQK == 64) ? 0.125f : 0.088388347648318440f;
  int tid = threadIdx.x; asm volatile("" : "+v"(tid)); const int wid = tid >> 6, lane = tid & 63, r32 = lane & 31, hi = lane >> 5;
  if (__builtin_amdgcn_readfirstlane(tid) >= 256) __builtin_amdgcn_s_setprio(1);
  bf16* V_lds = (bf16*)lds; bf16* K_lds = (bf16*)(lds + 2 * SHM_V);
  float* ws = (float*)(lds + 2 * SHM_V + 2 * SHM_K) + wid * 64; float* li_l = ws; float* al_l = ws + 32;
  constexpr bool ACCINIT = (DQK == 64) || ATT_ACCINIT128; float m_reg = ACCINIT ? 0.f : -1e30f, l_reg = 0; f32x16 o[4] = {}; bf16x8 qr[DQK / 16];
  f32x16 negm = {};
  const bf16* Qw = Qb + (long)(wid * QBLK + r32) * LDQ + hi * 8;
#pragma unroll
  for (int d0 = 0; d0 < DQK / 16; ++d0) qr[d0] = *reinterpret_cast<const bf16x8*>(Qw + d0 * 16);
  const int sr = tid >> 4, sc = (tid & 15) * 8, vst0 = v_st(sr, sc), vst1 = v_st(32 + sr, sc);
  const int vb0 = (int)(uintptr_t)V_lds + v_rd_base(lane);
  struct { bf16x8 vs0, vs1, ks0, ks1; } sr_[SDEPTH];
#define SLOAD(i, k0) do { sr_[i].vs0 = *reinterpret_cast<const bf16x8*>(&Vh[(long)((k0) + sr) * LDK + sc]); sr_[i].vs1 = *reinterpret_cast<const bf16x8*>(&Vh[(long)((k0) + 32 + sr) * LDK + sc]); \
    sr_[i].ks0 = *reinterpret_cast<const bf16x8*>(&Kh[(long)((k0) + sr) * LDK + sc]); sr_[i].ks1 = *reinterpret_cast<const bf16x8*>(&Kh[(long)((k0) + 32 + sr) * LDK + sc]); } while (0)
#define SWRITE(b, i) do { *(bf16x8*)((char*)V_lds + (b) * SHM_V + vst0) = sr_[i].vs0;          \
    *(bf16x8*)((char*)V_lds + (b) * SHM_V + vst1) = sr_[i].vs1; int kc = sc * 2;               \
    *(bf16x8*)((char*)K_lds + (b) * SHM_K + KSWZ(sr, kc)) = sr_[i].ks0;                       \
    *(bf16x8*)((char*)K_lds + (b) * SHM_K + KSWZ(32 + sr, kc)) = sr_[i].ks1; } while (0)
#define SWAIT() do { if constexpr (SDEPTH == 2) asm volatile("s_waitcnt vmcnt(4)" ::: "memory"); else asm volatile("s_waitcnt vmcnt(0)" ::: "memory"); } while (0)
#define RESC(a) do { if (__any((a) < 1.f)) { if (hi == 0) al_l[r32] = (a); asm volatile("s_waitcnt lgkmcnt(0)" ::: "memory"); \
    for (int d = 0; d < 4; ++d) for (int r = 0; r < 16; ++r) o[d][r] *= al_l[crow(r, hi)]; } } while (0)
  f32x16 pA0, pA1, pB0, pB1; float mnA, mnB, alA, alB; bf16x8 pa0, pa1, pa2, pa3; const int NT = seq / KVBLK;
  constexpr int SE = 0, SO = SDEPTH - 1;
  SLOAD(SE, 0); asm volatile("s_waitcnt vmcnt(0)" ::: "memory"); SWRITE(0, SE); __syncthreads();
  if constexpr (ACCINIT) { qktn<DQK>(pA0, pA1, K_lds, qr, r32, hi, kcol0, negm); partialSMn<true>(pA0, pA1, m_reg, negm, alA); }
  else { qkt<DQK>(pA0, pA1, K_lds, qr, r32, hi, kcol0); partialSM<DQK>(pA0, pA1, m_reg, mnA, alA); }
  SLOAD(SO, KVBLK); if constexpr (SDEPTH == 2) { if (2 < NT) SLOAD(SE, 2 * KVBLK); }
  SWAIT(); SWRITE(1, SO); __syncthreads();
  for (int j = 1; j + 1 < NT; j += 2) {
    SBAR(); if constexpr (ACCINIT) qktn<DQK>(pB0, pB1, (bf16*)((char*)K_lds + SHM_K), qr, r32, hi, kcol0, negm); else qkt<DQK>(pB0, pB1, (bf16*)((char*)K_lds + SHM_K), qr, r32, hi, kcol0);
    finishSM(pA0, pA1, alA, l_reg, pa0, pa1, pa2, pa3); SBAR();
    SLOAD(SO, (j + SDEPTH) * KVBLK); SBAR();
    pv_d0(o, vb0, pa0, pa1, pa2, pa3); if constexpr (ACCINIT) partialSMn<false>(pB0, pB1, m_reg, negm, alB); else partialSM<DQK>(pB0, pB1, m_reg, mnB, alB);
    __syncthreads(); SWAIT(); SWRITE(0, SE);
    RESC(alB); __syncthreads();
    SBAR(); if constexpr (ACCINIT) qktn<DQK>(pA0, pA1, K_lds, qr, r32, hi, kcol0, negm); else qkt<DQK>(pA0, pA1, K_lds, qr, r32, hi, kcol0);
    finishSM(pB0, pB1, alB, l_reg, pa0, pa1, pa2, pa3); SBAR();
    if (SDEPTH == 1 || j + 3 < NT) SLOAD(SE, (j + 1 + SDEPTH) * KVBLK); SBAR();
    pv_d0(o, vb0 + (int)SHM_V, pa0, pa1, pa2, pa3); if constexpr (ACCINIT) partialSMn<false>(pA0, pA1, m_reg, negm, alA); else partialSM<DQK>(pA0, pA1, m_reg, mnA, alA);
    __syncthreads(); SWAIT(); SWRITE(1, SO);
    RESC(alA); __syncthreads();
  }
  SBAR(); if constexpr (ACCINIT) qktn<DQK>(pB0, pB1, (bf16*)((char*)K_lds + SHM_K), qr, r32, hi, kcol0, negm); else qkt<DQK>(pB0, pB1, (bf16*)((char*)K_lds + SHM_K), qr, r32, hi, kcol0);
  finishSM(pA0, pA1, alA, l_reg, pa0, pa1, pa2, pa3); SBAR();
  pv_d0(o, vb0, pa0, pa1, pa2, pa3); if constexpr (ACCINIT) partialSMn<false>(pB0, pB1, m_reg, negm, alB); else partialSM<DQK>(pB0, pB1, m_reg, mnB, alB);
  __syncthreads(); RESC(alB);
  finishSM(pB0, pB1, alB, l_reg, pa0, pa1, pa2, pa3); SBAR();
  pv_d0(o, vb0 + (int)SHM_V, pa0, pa1, pa2, pa3);
  if (hi == 0) li_l[r32] = l_reg; asm volatile("s_waitcnt lgkmcnt(0)" ::: "memory");
  float rli[16];
#pragma unroll
  for (int r = 0; r < 16; ++r) rli[r] = __builtin_amdgcn_rcpf(li_l[crow(r, hi)]);
  if constexpr (MODE == 0) {
  bf16* Ow = Ob + (long)(wid * QBLK) * LDO;
#pragma unroll
  for (int r = 0; r < 16; ++r) { int orow = crow(r, hi);
    for (int d0 = 0; d0 < 4; ++d0) Ow[(long)orow * LDO + d0 * 32 + r32] = __float2bfloat16(o[d0][r] * rli[r]); }
  } else if constexpr (MODE == 1) {
  bf16* st = (bf16*)(lds + STASH_OFF) + (wid * QBLK) * 128;
#pragma unroll
  for (int r = 0; r < 16; ++r) { int orow = crow(r, hi);
    for (int d0 = 0; d0 < 4; ++d0) st[orow * 128 + d0 * 32 + r32] = __float2bfloat16(o[d0][r] * rli[r]); }
  } else {
  const bf16* st = (const bf16*)(lds + STASH_OFF) + (wid * QBLK) * 128;
  float ssq[16];
#pragma unroll
  for (int r = 0; r < 16; ++r) { int orow = crow(r, hi); float s = 0.f;
    for (int d0 = 0; d0 < 4; ++d0) { const float v = __bfloat162float(st[orow * 128 + d0 * 32 + r32]) - lam * (o[d0][r] * rli[r]); o[d0][r] = v; s += v * v; }
    s += __shfl_xor(s, 1); s += __shfl_xor(s, 2); s += __shfl_xor(s, 4); s += __shfl_xor(s, 8); s += __shfl_xor(s, 16);
    ssq[r] = 1.0f / sqrtf(s * (1.f / 128.f) + NORM_EPS); }
  bf16* Ow = Ob + (long)(wid * QBLK) * LDO;
#pragma unroll
  for (int d0 = 0; d0 < 4; ++d0) { const float gm = gvec[d0 * 32 + r32] * gmul;
#pragma unroll
    for (int r = 0; r < 16; ++r) Ow[(long)crow(r, hi) * LDO + d0 * 32 + r32] = __float2bfloat16(o[d0][r] * ssq[r] * gm); }
  }
  __builtin_amdgcn_s_setprio(0);
#undef SLOAD
#undef SWRITE
#undef SWAIT
#undef RESC
}

__device__ __forceinline__ void swa_unit(const bf16* __restrict__ P, bf16* __restrict__ Y, int bb, int kvh, int qblk, bool isctx, const float* __restrict__ sinkl, char* lds) {
  constexpr float SCALE = 0.125f;
  int tid = threadIdx.x; asm volatile("" : "+v"(tid)); const int wid = tid >> 6, lane = tid & 63, r32 = lane & 31, hi = lane >> 5;
  if (__builtin_amdgcn_readfirstlane(tid) >= 256) __builtin_amdgcn_s_setprio(1);
  const int head = kvh * 4 + (wid & 3), half = wid >> 2;
  bf16* V_lds = (bf16*)lds; bf16* K_lds = (bf16*)(lds + 2 * SHM_V);
  float* ws = (float*)(lds + 2 * SHM_V + 2 * SHM_K) + wid * 64; float* li_l = ws; float* al_l = ws + 32;
  const long rowq0 = (long)bb * TPB + (isctx ? 0 : CTX) + qblk * 64 + half * 32;
  const bf16* Qw = P + (rowq0 + r32) * PP + C_SQ + head * 64 + hi * 8;
  bf16x8 qr[4];
#pragma unroll
  for (int d0 = 0; d0 < 4; ++d0) qr[d0] = *reinterpret_cast<const bf16x8*>(Qw + d0 * 16);
  float m_reg = sinkl[head] * (1.f / SCALE), l_reg = 1.f; f32x16 o[2] = {};
  const int sr = tid >> 3, sc = (tid & 7) * 8, vst = v_st(sr, sc);
  const int vb0 = (int)(uintptr_t)V_lds + v_rd_base(lane);
  const int qpos = qblk * 64 + half * 32 + r32;
  int jlo = 0, nband = 0;
  if (!isctx) { const int q0 = qblk * 64; jlo = (q0 >= 128) ? 0 : (128 - q0) / 64; int jhi = (SEQ - 64 - q0 + 128) / 64; if (jhi > 4) jhi = 4; nband = jhi - jlo + 1; }
  const int ntile = 4 + nband;
  const long kbase = (long)bb * TPB;
#define SWA_KROW(tt) ((tt) < 4 ? kbase + (tt) * 64 : kbase + CTX + (qblk * 64 - 128 + ((tt) - 4 + jlo) * 64))
  bf16x8 kreg, vreg;
  { const long kr = SWA_KROW(0); kreg = *reinterpret_cast<const bf16x8*>(P + (kr + sr) * PP + C_SK + kvh * 64 + sc); vreg = *reinterpret_cast<const bf16x8*>(P + (kr + sr) * PP + C_SV + kvh * 64 + sc); }
  __syncthreads();
  for (int t = 0; t < ntile; ++t) {
    const int buf = t & 1; const bool band = (t >= 4); const int kpos0 = qblk * 64 - 128 + (t - 4 + jlo) * 64;
    *(bf16x8*)((char*)K_lds + buf * SHM_K + KSWZ(sr, sc * 2)) = kreg; *(bf16x8*)((char*)V_lds + buf * SHM_V + vst) = vreg;
    if (t + 1 < ntile) { const long kr = SWA_KROW(t + 1); kreg = *reinterpret_cast<const bf16x8*>(P + (kr + sr) * PP + C_SK + kvh * 64 + sc); vreg = *reinterpret_cast<const bf16x8*>(P + (kr + sr) * PP + C_SV + kvh * 64 + sc); }
    __syncthreads();
    f32x16 p0, p1; float mn, alpha; bf16x8 pa0, pa1, pa2, pa3;
    qkt<64>(p0, p1, (const bf16*)((const char*)K_lds + buf * SHM_K), qr, r32, hi, 0);
    if (band) {
#pragma unroll
      for (int r = 0; r < 16; ++r) { const int d0_ = qpos - (kpos0 + crow(r, hi)); if (d0_ > 128 || d0_ < -128) p0[r] = -1e30f; const int d1_ = d0_ - 32; if (d1_ > 128 || d1_ < -128) p1[r] = -1e30f; }
    }
    partialSM<64>(p0, p1, m_reg, mn, alpha);
    if (__any(alpha < 1.f)) { if (hi == 0) al_l[r32] = alpha; asm volatile("s_waitcnt lgkmcnt(0)" ::: "memory");
#pragma unroll
      for (int d = 0; d < 2; ++d)
#pragma unroll
        for (int r = 0; r < 16; ++r) o[d][r] *= al_l[crow(r, hi)]; }
    finishSM(p0, p1, alpha, l_reg, pa0, pa1, pa2, pa3); SBAR();
    pv_one<0>(o[0], vb0 + buf * (int)SHM_V, pa0, pa1, pa2, pa3); pv_one<1>(o[1], vb0 + buf * (int)SHM_V, pa0, pa1, pa2, pa3);
  }
#undef SWA_KROW
  if (hi == 0) li_l[r32] = l_reg; asm volatile("s_waitcnt lgkmcnt(0)" ::: "memory");
  float rli[16];
#pragma unroll
  for (int r = 0; r < 16; ++r) rli[r] = __builtin_amdgcn_rcpf(li_l[crow(r, hi)]);
  bf16* Ow = Y + rowq0 * DM + 1024 + head * 64;
#pragma unroll
  for (int r = 0; r < 16; ++r) { const int orow = crow(r, hi);
#pragma unroll
    for (int d0 = 0; d0 < 2; ++d0) Ow[(long)orow * DM + d0 * 32 + r32] = __float2bfloat16(o[d0][r] * rli[r]); }
  __builtin_amdgcn_s_setprio(0);
  __syncthreads();
}
#undef KSWZ
#undef SBAR
}

#define LAS __attribute__((address_space(3)))
#ifndef PH_MASK
#define PH_MASK 0xFFFFF
#endif
#ifndef MX_MASK
#define MX_MASK 15
#endif
#ifndef P_ALIGN
#define P_ALIGN true
#endif
#ifndef BR_ALIGN
#define BR_ALIGN true
#endif
#ifndef UP_ALIGN
#define UP_ALIGN true
#endif
#ifndef GATE_ALIGN
#define GATE_ALIGN false
#endif
#ifndef RESID_ALIGN
#define RESID_ALIGN false
#endif
#ifndef DBL_MASK
#define DBL_MASK 0
#endif
#ifndef DBL_MX
#define DBL_MX 0
#endif
#ifdef DBL_RESID
#define RESID_LOOP for (int rr_ = 0; rr_ < 2; ++rr_)
#else
#define RESID_LOOP for (int rr_ = 1; rr_ < 2; ++rr_)
#endif
#define REP(bit) for (int rep_ = 0; rep_ < ((DBL_MASK & (bit)) ? 2 : 1); ++rep_)
#define REPX(bit) for (int rep_ = 0; rep_ < ((DBL_MX & (bit)) ? 2 : 1); ++rep_)
typedef __hip_bfloat16 hbf16;
constexpr size_t WS_ZT = 7 * MiB + 256 * 1024;
struct Args { const float* in[21]; float* out; unsigned char* ws; int pad0, pad1; };
struct Frame { int tid, lane, wave, G, vcu, gw, NGW; unsigned char* ws; char* lds; };

#define XB_TMO      128
#define XB_XCNT(j)  (256  + 64 * (j))
#define XB_XSUB(j)  (1280 + 64 * (j))
#define XB_XGEN(j)  (2304 + 64 * (j))
#define XB_TOP      3328
#define XB_TOPGEN   3392
#define XCD_BAR_WORDS 3456
#define XB_SPIN_CAP (1u << 18)

__device__ __forceinline__ unsigned xb_ld(unsigned* p)              { return __hip_atomic_load(p, __ATOMIC_RELAXED, __HIP_MEMORY_SCOPE_AGENT); }
__device__ __forceinline__ unsigned xb_add(unsigned* p, unsigned v) { return __hip_atomic_fetch_add(p, v, __ATOMIC_RELAXED, __HIP_MEMORY_SCOPE_AGENT); }
__device__ __forceinline__ unsigned xb_xcc_id() { return (unsigned)__builtin_amdgcn_s_getreg((3 << 11) | 20) & 0xFu; }
#define XB_SPIN(cond, bar) do { unsigned _sp = 0; while (cond) { __builtin_amdgcn_s_sleep(1); \
    if ((++_sp & 255u) == 0u) { if (xb_ld(&(bar)[XB_TMO])) break; if (_sp > XB_SPIN_CAP) { atomicAdd(&(bar)[XB_TMO], 1u); break; } } } } while (0)

struct XcdBarrier {
    unsigned* bar; unsigned x;
    volatile LAS unsigned* st;
};

__device__ __forceinline__ XcdBarrier xcd_barrier_post(unsigned* bar, volatile LAS unsigned* st) {
    XcdBarrier b; b.bar = bar; b.x = xb_xcc_id(); b.st = st;
    if (threadIdx.x == 0) (void)xb_add(&bar[XB_XCNT(b.x)], 1u);
    return b;
}
__device__ __forceinline__ void xcd_barrier_complete(unsigned* bar, unsigned x, unsigned& nloc, unsigned& nx) {
    const unsigned G = gridDim.x * gridDim.y * gridDim.z;
    unsigned sum, cnt, mine, sp = 0u;
    for (;;) {
        sum = 0u; cnt = 0u; mine = 0u;
#pragma unroll
        for (unsigned j = 0; j < 16; ++j) { const unsigned c = xb_ld(&bar[XB_XCNT(j)]); sum += c; cnt += (c > 0u) ? 1u : 0u; mine = (j == x) ? c : mine; }
        if (sum == G) break;
        __builtin_amdgcn_s_sleep(1);
        if ((++sp & 255u) == 0u) { if (xb_ld(&bar[XB_TMO])) break; if (sp > XB_SPIN_CAP) { atomicAdd(&bar[XB_TMO], 1u); break; } }
    }
    nloc = mine > 0u ? mine : 1u; nx = cnt > 0u ? cnt : 1u;
}

__device__ __forceinline__ void xcd_barrier(const XcdBarrier& b) {
    asm volatile("s_waitcnt vmcnt(0)" ::: "memory");
    __syncthreads();
    if (threadIdx.x == 0) {
        unsigned* bar = b.bar;
        __builtin_amdgcn_s_waitcnt(0);
        unsigned nloc = b.st[0], nx = b.st[1];
        if (nloc == 0u) { xcd_barrier_complete(bar, b.x, nloc, nx); b.st[0] = nloc; b.st[1] = nx; }
        const unsigned old = xb_add(&bar[XB_XSUB(b.x)], 1u);
        const unsigned gen = old / nloc;
        if (old + 1u == (gen + 1u) * nloc) {
            __builtin_amdgcn_fence(__ATOMIC_RELEASE, "agent");
            asm volatile("s_waitcnt vmcnt(0)" ::: "memory");
            const unsigned og = xb_add(&bar[XB_TOP], 1u);
            const unsigned tg = og / nx;
            if (og + 1u == (tg + 1u) * nx) xb_add(&bar[XB_TOPGEN], 1u);
            else XB_SPIN(xb_ld(&bar[XB_TOPGEN]) == tg, bar);
            __builtin_amdgcn_fence(__ATOMIC_ACQUIRE, "agent");
            xb_add(&bar[XB_XGEN(b.x)], 1u);
            asm volatile("s_waitcnt vmcnt(0)" ::: "memory");
        } else {
            XB_SPIN(xb_ld(&bar[XB_XGEN(b.x)]) == gen, bar);
            __builtin_amdgcn_fence(__ATOMIC_ACQUIRE, "agent");
            asm volatile("s_waitcnt vmcnt(0)" ::: "memory");
        }
    }
    __syncthreads();
}

constexpr size_t WS_BAR = 7 * MiB + 512 * 1024;
constexpr int LDS_BARST = LDS_BYTES - 64;
__device__ __forceinline__ Frame make_frame(unsigned char* ws, char* lds) {
    Frame F; int t = threadIdx.x; asm volatile("" : "+v"(t)); F.tid = t; F.lane = t & 63; F.wave = __builtin_amdgcn_readfirstlane(t >> 6); F.G = gridDim.x;
    { const int bx = blockIdx.x; F.vcu = (F.G % 8 == 0) ? (bx % 8) * (F.G / 8) + bx / 8 : bx; }
    F.gw = F.vcu * 8 + F.wave; F.NGW = F.G * 8; F.ws = ws; F.lds = lds; return F;
}
typedef const __attribute__((address_space(4))) Args* CArgsP0;
__device__ __forceinline__ void s0_phase(const Frame& F, CArgsP0 a) {
    float* sv = (float*)F.lds;
    float* modp = (float*)(F.ws + WS_MODP);
    const float* c = a->in[1]; const float* cctx = a->in[3]; const float* adaw = a->in[4];
    for (int i = blockIdx.x * 512 + F.tid; i < 3 * 12288; i += F.G * 512) ((float*)(F.ws + WS_ZT))[i] = 0.f;
    for (int it = blockIdx.x; it < 793; it += F.G) {
        if (it < 768) {
            const int l = it / 384, r = it % 384, ks = r / 24, ch = r % 24;
            __syncthreads();
            if (F.tid < 384) { const int w = F.tid >> 7, dd = F.tid & 127, d = ks * 128 + dd; const float cv = (w < 2) ? c[w * DM + d] : cctx[d]; sv[F.tid] = cv / (1.f + expf(-cv)); }
            __syncthreads();
            const int j = ch * 512 + F.tid;
            const float* W = adaw + (size_t)l * DM * 12288 + (size_t)(ks * 128) * 12288 + j;
            float a0 = 0.f, a1 = 0.f, a2 = 0.f;
#pragma unroll 8
            for (int dd = 0; dd < 128; ++dd) { const float wv = W[(size_t)dd * 12288]; a0 += sv[dd] * wv; a1 += sv[128 + dd] * wv; a2 += sv[256 + dd] * wv; }
            float* o = modp + (size_t)((l * 16 + ks) * 3) * 12288 + j;
            o[0] = a0; o[12288] = a1; o[2 * 12288] = a2;
        } else if (it < 792) {
            const int idx = (it - 768) * 512 + F.tid;
            float* tab = (float*)(F.ws + WS_ROPE);
            int pos, f, nf; float* cdst; float* sdst;
            if (idx < 4096) { pos = idx >> 4; f = idx & 15; nf = 16; cdst = tab + idx; sdst = tab + 4096 + idx; }
            else { const int i2 = idx - 4096; pos = i2 >> 5; f = i2 & 31; nf = 32; cdst = tab + 8192 + i2; sdst = tab + 16384 + i2; }
            const float inv = exp2f(-(float)f / (float)nf * 13.287712379549449f);
            const float ang = (float)pos * inv;
            double rev = (double)ang * 0.15915494309189535; rev -= floor(rev);
            const float fr = (float)rev;
            *cdst = __builtin_amdgcn_cosf(fr); *sdst = __builtin_amdgcn_sinf(fr);
        } else {
            const int l = F.wave >> 2, h = F.wave & 3; const float* lp = a->in[10] + (size_t)l * 4 * 4 * 64;
            float pa = lp[(0 * 4 + h) * 64 + F.lane] * lp[(1 * 4 + h) * 64 + F.lane], pb = lp[(2 * 4 + h) * 64 + F.lane] * lp[(3 * 4 + h) * 64 + F.lane];
            pa = wave_sum(pa); pb = wave_sum(pb);
            const float lam_init = (l == 0) ? 0.2f : 0.35550906759f;
            if (F.lane == 0) ((float*)(F.ws + WS_LAM))[l * 4 + h] = expf(pa) - expf(pb) + lam_init;
        }
    }
}

__device__ __forceinline__ int map_win(int j) { return j < NMIX ? j : -1; }
__device__ __forceinline__ int map_gate(int R) { const int pn = R >> 8, c = R & 255; const int i = 2 * (c >> 7) + ((c & 31) >> 4), oc = 64 * pn + 16 * ((c & 127) >> 5) + (c & 15); return NMIX + i * DM + oc; }
__device__ __forceinline__ int map_up(int R) { const int pn = R >> 8, c = R & 255; return (c >> 7) * FF + 128 * pn + (c & 127); }
template <int MAP> __device__ __forceinline__ void transpose_item(const float* __restrict__ W, int Nsrc, int K, bf16raw* __restrict__ WT, int kb, int nb, float* scr, int lane) {
    const int k0 = 64 * kb, n0 = 32 * nb; const int jr = n0 + (lane & 31);
    const int col = (MAP == 0) ? jr : (MAP == 1) ? map_win(jr) : (MAP == 2) ? map_gate(jr) : map_up(jr);
#pragma unroll 8
    for (int i = 0; i < 32; ++i) { const int kk = 2 * i + (lane >> 5); scr[kk * 33 + (lane & 31)] = (col >= 0) ? W[(size_t)(k0 + kk) * Nsrc + col] : 0.f; }
    asm volatile("s_waitcnt lgkmcnt(0)" ::: "memory");
    const int cch = lane & 7;
#pragma unroll
    for (int j = 0; j < 4; ++j) { const int n = (lane >> 3) + 8 * j; const float* s = scr + (8 * cch) * 33 + n;
        u32x4_t o; o.x = pk2(s[0 * 33], s[1 * 33]); o.y = pk2(s[2 * 33], s[3 * 33]); o.z = pk2(s[4 * 33], s[5 * 33]); o.w = pk2(s[6 * 33], s[7 * 33]);
        *(u32x4_t*)(WT + (size_t)(n0 + n) * K + k0 + 8 * cch) = o; }
    asm volatile("s_waitcnt lgkmcnt(0)" ::: "memory");
}
__device__ __forceinline__ void s1_phase(const Frame& F, CArgsP0 a, int l) {
    if (l == 0) {
        const float* modp = (const float*)(F.ws + WS_MODP); float* mod = (float*)(F.ws + WS_MOD); const float* adab = a->in[5];
        for (int idx = blockIdx.x * 512 + F.tid; idx < 2 * 3 * 12288; idx += F.G * 512) {
            const int l2 = idx / (3 * 12288), rem = idx - l2 * 3 * 12288, w = rem / 12288, j = rem - w * 12288;
            float s = adab[l2 * 12288 + j];
#pragma unroll
            for (int ks = 0; ks < 16; ++ks) s += modp[(size_t)((l2 * 16 + ks) * 3 + w) * 12288 + j];
            mod[idx] = s;
        }
    }
    float* scr = (float*)F.lds + F.wave * (64 * 33);
    const float* w_in = a->in[7] + (size_t)l * DM * DIN; const float* w_br = a->in[15] + (size_t)l * 4 * 512 * DM; const float* w_out = a->in[16] + (size_t)l * DM * DM;
    const float* w_up = a->in[18] + (size_t)l * DM * 2 * FF; const float* w_dn = a->in[19] + (size_t)l * FF * DM;
    constexpr int I_IN = 32 * (PP / 32), I_G = 32 * (8192 / 32), I_B = 4 * 8 * 64, I_O = 32 * 64, I_U = 32 * (2 * FF / 32), I_D = (FF / 64) * 64;
    constexpr int NITEMS = I_IN + I_G + I_B + I_O + I_U + I_D;
    for (int it = F.gw; it < NITEMS; it += F.NGW) {
        int r = it;
        if (r < I_IN) { const int nblk = PP / 32; transpose_item<1>(w_in, DIN, DM, (bf16raw*)(F.ws + WS_WIN), r / nblk, r % nblk, scr, F.lane); continue; } r -= I_IN;
        if (r < I_G) { const int nblk = 8192 / 32; transpose_item<2>(w_in, DIN, DM, (bf16raw*)(F.ws + WS_WG), r / nblk, r % nblk, scr, F.lane); continue; } r -= I_G;
        if (r < I_B) { const int i = r / 512, rr = r % 512; transpose_item<0>(w_br + (size_t)i * 512 * DM, DM, 512, (bf16raw*)(F.ws + WS_WB) + (size_t)i * DM * 512, rr / 64, rr % 64, scr, F.lane); continue; } r -= I_B;
        if (r < I_O) { transpose_item<0>(w_out, DM, DM, (bf16raw*)(F.ws + WS_WOUT), r / 64, r % 64, scr, F.lane); continue; } r -= I_O;
        if (r < I_U) { const int nblk = 2 * FF / 32; transpose_item<3>(w_up, 2 * FF, DM, (bf16raw*)(F.ws + WS_WUP), r / nblk, r % nblk, scr, F.lane); continue; } r -= I_U;
        transpose_item<0>(w_dn, DM, FF, (bf16raw*)(F.ws + WS_WDN), r / 64, r % 64, scr, F.lane);
    }
}

__device__ __forceinline__ void norm_mod_phase(const Frame& F, const XPtr xin, const bf16raw* delta, const XOut xout, const float* __restrict__ gam, const float* __restrict__ modl, int shi, int sci, bf16raw* out) {
    constexpr int RPW = 17;
    int curw = -1; f32x4_t ca[8], cb[8];
    const int rbeg = F.gw * RPW, rend = (rbeg + RPW < MROWS) ? rbeg + RPW : MROWS;
    for (int r = rbeg; r < rend; ++r) {
        const int b = r / TPB, t = r - b * TPB, w = (t < CTX) ? 2 : b;
        if (w != curw) { curw = w;
#pragma unroll
            for (int j = 0; j < 8; ++j) { const int col = 4 * F.lane + 256 * j; const f32x4_t g = *(const f32x4_t*)(gam + col), sc = *(const f32x4_t*)(modl + (size_t)w * 12288 + sci * 2048 + col);
                ca[j] = g * (sc + 1.0f); cb[j] = *(const f32x4_t*)(modl + (size_t)w * 12288 + shi * 2048 + col); } }
        const f32x4_t* xr = (const f32x4_t*)xin.row(r) + F.lane;
        f32x4_t v[8]; float s = 0.f;
#pragma unroll
        for (int j = 0; j < 8; ++j) v[j] = xr[64 * j];
        if (delta) { const u32x2_t* dr = (const u32x2_t*)(delta + (size_t)r * DM) + F.lane; u32x2_t dv[8];
#pragma unroll
            for (int j = 0; j < 8; ++j) dv[j] = dr[64 * j];
            f32x4_t* xw = (f32x4_t*)xout.row(r) + F.lane;
#pragma unroll
            for (int j = 0; j < 8; ++j) { v[j].x += bflo(dv[j].x); v[j].y += bfhi(dv[j].x); v[j].z += bflo(dv[j].y); v[j].w += bfhi(dv[j].y); xw[64 * j] = v[j]; } }
#pragma unroll
        for (int j = 0; j < 8; ++j) s += (v[j].x * v[j].x + v[j].y * v[j].y) + (v[j].z * v[j].z + v[j].w * v[j].w);
        const float rstd = 1.0f / sqrtf(wave_sum(s) * (1.f / DM) + NORM_EPS);
        u32x2_t* o8 = (u32x2_t*)(out + (size_t)r * DM) + F.lane;
#pragma unroll
        for (int j = 0; j < 8; ++j) { const f32x4_t y = v[j] * rstd * ca[j] + cb[j]; u32x2_t w2; w2.x = pk2(y.x, y.y); w2.y = pk2(y.z, y.w); o8[64 * j] = w2; }
    }
}
__device__ __forceinline__ void final_norm_phase(const Frame& F, float* x, const bf16raw* __restrict__ delta, const float* __restrict__ gam) {
    for (int r = F.gw; r < NBATCH * SEQ; r += F.NGW) {
        f32x4_t* xr = (f32x4_t*)(x + (size_t)r * DM) + F.lane; f32x4_t v[8]; float s = 0.f;
        const int b = r / SEQ, ur = b * TPB + CTX + (r - b * SEQ);
        const u32x2_t* dr = (const u32x2_t*)(delta + (size_t)ur * DM) + F.lane;
#pragma unroll
        for (int j = 0; j < 8; ++j) { v[j] = xr[64 * j]; const u32x2_t d = dr[64 * j]; v[j].x += bflo(d.x); v[j].y += bfhi(d.x); v[j].z += bflo(d.y); v[j].w += bfhi(d.y);
            s += (v[j].x * v[j].x + v[j].y * v[j].y) + (v[j].z * v[j].z + v[j].w * v[j].w); }
        const float rstd = 1.0f / sqrtf(wave_sum(s) * (1.f / DM) + NORM_EPS);
#pragma unroll
        for (int j = 0; j < 8; ++j) xr[64 * j] = v[j] * rstd * *(const f32x4_t*)(gam + 4 * F.lane + 256 * j);
    }
}

__device__ __forceinline__ void rope_decode(int vp, int& x1c, int& x2c, int& f0, int& axis, int& hcol, bool& d128, bool& isq, bool& isdq) {
    x1c = 0; x2c = 0; f0 = 0; axis = 0; hcol = 0; d128 = false; isq = true; isdq = (vp >= 48 && vp < 80);
    if (vp < 48) { d128 = true; isq = vp < 32; const int v2 = isq ? vp : vp - 32; const int head = v2 >> 3, i = v2 & 7; axis = i >> 2; const int j = i & 3; f0 = 8 * j;
        const int base = (isq ? C_GQ : C_GK) + head * 128 + axis * 64; x1c = base + 8 * j; x2c = x1c + 32; hcol = axis * 64 + 8 * j; }
    else if (vp < 152) { const int v3 = vp - 48, seg = v3 >> 5, w = v3 & 31, head = w >> 2, i = w & 3; axis = i >> 1; const int j = i & 1; f0 = 8 * j;
        const int sb = (seg == 0) ? C_DQ : (seg == 1) ? C_DK : (seg == 2) ? C_SQ : C_SK; const int base = sb + head * 64 + axis * 32; x1c = base + 8 * j; x2c = x1c + 16; }
}
__device__ __forceinline__ void rope_phase(const Frame& F, bf16raw* P, const float* __restrict__ qg, const float* __restrict__ kg) {
    const float* tab = (const float*)(F.ws + WS_ROPE);
    int x1c[3], x2c[3], f0[3], axis[3], hcol[3]; bool d128[3], isq[3], act[3], isdq[3];
#pragma unroll
    for (int pass = 0; pass < 3; ++pass) { const int vp = pass * 64 + F.lane; act[pass] = vp < 152; rope_decode(vp, x1c[pass], x2c[pass], f0[pass], axis[pass], hcol[pass], d128[pass], isq[pass], isdq[pass]); }
    for (int r = F.gw; r < MROWS; r += F.NGW) {
        const int b = r / TPB, t = r - b * TPB; const bool latent = t >= CTX; const int pos = t - CTX, prow = pos >> 6, pcol = pos & 63;
        bf16raw* Pr = P + (size_t)r * PP;
        u32x4_t w1[3], w2[3];
#pragma unroll
        for (int pass = 0; pass < 3; ++pass) { const bool ld = act[pass] && (d128[pass] || latent || isdq[pass]);
            if (ld) { w1[pass] = *(const u32x4_t*)(Pr + x1c[pass]); w2[pass] = *(const u32x4_t*)(Pr + x2c[pass]); } else { w1[pass] = (u32x4_t){0u, 0u, 0u, 0u}; w2[pass] = w1[pass]; } }
#pragma unroll
        for (int pass = 0; pass < 3; ++pass) {
            float x1[8], x2[8]; unpack8(w1[pass], x1); unpack8(w2[pass], x2);
            if (pass == 0) {
                float ss = 0.f;
#pragma unroll
                for (int e = 0; e < 8; ++e) ss += x1[e] * x1[e] + x2[e] * x2[e];
                ss += __shfl_xor(ss, 1); ss += __shfl_xor(ss, 2); ss += __shfl_xor(ss, 4);
                if (d128[0]) { const float rstd = 1.0f / sqrtf(ss * (1.f / 128.f) + NORM_EPS); const float* gn = isq[0] ? qg : kg;
#pragma unroll
                    for (int e = 0; e < 8; ++e) { x1[e] = x1[e] * rstd * gn[hcol[0] + e]; x2[e] = x2[e] * rstd * gn[hcol[0] + 32 + e]; } }
            }
            if (act[pass] && latent) {
                const int p = axis[pass] ? pcol : prow;
                const float* ct = d128[pass] ? tab + 8192 + p * 32 + f0[pass] : tab + p * 16 + f0[pass]; const float* st = d128[pass] ? tab + 16384 + p * 32 + f0[pass] : tab + 4096 + p * 16 + f0[pass];
#pragma unroll
                for (int e = 0; e < 8; ++e) { const float cc = ct[e], sn = st[e], a1 = x1[e], a2 = x2[e]; x1[e] = a1 * cc - a2 * sn; x2[e] = a2 * cc + a1 * sn; }
            }
            if (ATT_ACCINIT128 && pass == 0 && d128[0] && isq[0]) {
#pragma unroll
                for (int e = 0; e < 8; ++e) { x1[e] *= 0.12751743074602467f; x2[e] *= 0.12751743074602467f; } }
            if (isdq[pass]) {
#pragma unroll
                for (int e = 0; e < 8; ++e) { x1[e] *= 0.18033688011112042f; x2[e] *= 0.18033688011112042f; } }
            if (act[pass] && (d128[pass] || latent || isdq[pass])) { *(u32x4_t*)(Pr + x1c[pass]) = pack8(x1); *(u32x4_t*)(Pr + x2c[pass]) = pack8(x2); }
        }
    }
}

__device__ __forceinline__ int tbmap(int dir, int j) { return dir == 0 ? j : (j == 0 ? 1 : (j == 1 ? 0 : 131 - j)); }
__device__ __forceinline__ float log_sigmoid_f(float x) { return fminf(x, 0.f) - log1pf(expf(-fabsf(x))); }
__device__ __forceinline__ void gate_scan(const bf16raw* __restrict__ P, const float* __restrict__ gb, int r0, int head, int dir, int lane, float (&ig)[2], float (&bc)[2], float& blast) {
    float lf[2];
#pragma unroll
    for (int k = 0; k < 2; ++k) { const int s = 2 * lane + k, tok = dir ? 127 - s : s; const bf16raw* pr = P + (size_t)(r0 + tok) * PP + C_MG;
        ig[k] = bf1(pr[(2 * dir) * 4 + head]) + gb[(2 * dir) * 4 + head]; lf[k] = log_sigmoid_f(bf1(pr[(2 * dir + 1) * 4 + head]) + gb[(2 * dir + 1) * 4 + head]); }
    const float c1 = lf[0] + lf[1]; float v = c1;
#pragma unroll
    for (int o = 1; o < 64; o <<= 1) { const float tt = __shfl_up(v, o); if (lane >= o) v += tt; }
    const float excl = v - c1; bc[0] = excl + lf[0]; bc[1] = excl + c1; blast = __shfl(v, 63);
}
__device__ __forceinline__ void mlstm_a_phase(const Frame& F, const bf16raw* __restrict__ P, const float* __restrict__ gb) {
    float* ks = (float*)F.lds;
    float* vs = ks + 128 * 64;
    float* wts = vs + 128 * 128;
    float* CST = (float*)(F.ws + WS_CST); float* NST = (float*)(F.ws + WS_NST); float* MSC = (float*)(F.ws + WS_MSC);
    for (int u = blockIdx.x; u < 16 * NCHUNK; u += F.G) {
        const int chain = u / NCHUNK, tb = u - chain * NCHUNK, bb = chain >> 3, head = (chain >> 1) & 3, dir = chain & 1;
        const int r0 = bb * TPB + tb * 128;
        __syncthreads();
        if (F.wave == 0) {
            float ig[2], bc[2], bl; gate_scan(P, gb, r0, head, dir, F.lane, ig, bc, bl);
            const float lw0 = bl - bc[0] + ig[0], lw1 = bl - bc[1] + ig[1]; const float ml = wave_max(fmaxf(lw0, lw1));
            const int s0 = 2 * F.lane; wts[dir ? 127 - s0 : s0] = expf(lw0 - ml); wts[dir ? 126 - s0 : s0 + 1] = expf(lw1 - ml);
            if (F.lane == 0) { MSC[chain * NCHUNK + tb] = bl; MSC[16 * NCHUNK + chain * NCHUNK + tb] = ml; }
        }
        __syncthreads();
#pragma unroll
        for (int i = 0; i < 2; ++i) { const int vi = F.tid + 512 * i, tok = vi >> 3, c8 = (vi & 7) * 8; float f[8]; unpack8(*(const u32x4_t*)(P + (size_t)(r0 + tok) * PP + C_MK + head * 64 + c8), f);
            const float w = wts[tok] * 0.125f;
#pragma unroll
            for (int e = 0; e < 8; ++e) ks[tok * 64 + c8 + e] = f[e] * w; }
#pragma unroll
        for (int i = 0; i < 4; ++i) { const int vi = F.tid + 512 * i, tok = vi >> 4, c8 = (vi & 15) * 8; float f[8]; unpack8(*(const u32x4_t*)(P + (size_t)(r0 + tok) * PP + C_MV + head * 128 + c8), f);
#pragma unroll
            for (int e = 0; e < 8; ++e) vs[tok * 128 + c8 + e] = f[e]; }
        __syncthreads();
        const int vg = F.tid & 31, dg = F.tid >> 5;
        f32x4_t acc[4];
#pragma unroll
        for (int i = 0; i < 4; ++i) acc[i] = (f32x4_t){0.f, 0.f, 0.f, 0.f};
#pragma unroll 4
        for (int tok = 0; tok < 128; ++tok) { const f32x4_t vv = *(const f32x4_t*)(vs + tok * 128 + 4 * vg), kv = *(const f32x4_t*)(ks + tok * 64 + 4 * dg);
            acc[0] += kv * vv.x; acc[1] += kv * vv.y; acc[2] += kv * vv.z; acc[3] += kv * vv.w; }
        float* Co = CST + (size_t)(chain * NCHUNK + tb) * 8192;
#pragma unroll
        for (int i = 0; i < 4; ++i) *(f32x4_t*)(Co + (4 * vg + i) * 64 + 4 * dg) = acc[i];
        if (F.tid < 64) { float s = 0.f;
#pragma unroll 8
            for (int tok = 0; tok < 128; ++tok) s += ks[tok * 64 + F.tid];
            NST[(size_t)(chain * NCHUNK + tb) * 64 + F.tid] = s; }
    }
}
__device__ __forceinline__ void mlstm_b_phase(const Frame& F) {
    float* CST = (float*)(F.ws + WS_CST); float* NST = (float*)(F.ws + WS_NST); float* MSC = (float*)(F.ws + WS_MSC);
    const float* BL = MSC; const float* ML = MSC + 16 * NCHUNK; float* MS = MSC + 32 * NCHUNK;
    for (int e = blockIdx.x * 512 + F.tid; e < 16 * 8192; e += F.G * 512) {
        const int chain = e >> 13, idx = e & 8191, dir = chain & 1; const bool hn = idx < 64;
        float C = 0.f, nv = 0.f, m = 0.f;
        for (int j0 = 0; j0 < NCHUNK; j0 += 10) {
            float cl[10], nl[10], bl[10], ml[10];
#pragma unroll
            for (int i = 0; i < 10; ++i) { const int tb = tbmap(dir, j0 + i), ci = chain * NCHUNK + tb; cl[i] = CST[(size_t)ci * 8192 + idx]; nl[i] = hn ? NST[(size_t)ci * 64 + idx] : 0.f; bl[i] = BL[ci]; ml[i] = ML[ci]; }
#pragma unroll
            for (int i = 0; i < 10; ++i) { const int tb = tbmap(dir, j0 + i), ci = chain * NCHUNK + tb;
                CST[(size_t)ci * 8192 + idx] = C; if (hn) NST[(size_t)ci * 64 + idx] = nv; if (idx == 0) MS[ci] = m;
                const float mnew = fmaxf(bl[i] + m, ml[i]); const float dec = expf(bl[i] + m - mnew), wg = expf(ml[i] - mnew);
                C = dec * C + wg * cl[i]; nv = dec * nv + wg * nl[i]; m = mnew; }
        }
    }
}
__device__ __forceinline__ void mlstm_c_unit(const Frame& F, const bf16raw* __restrict__ P, const float* __restrict__ gb, const float* __restrict__ ng, bf16raw* __restrict__ Y, int bb, int head, int tb) {
    constexpr int KP = 72, SP = 132;
    bf16raw* qs = (bf16raw*)F.lds;
    bf16raw* kc = qs + 128 * 64;
    bf16raw* vs = kc + 128 * KP;
    float* Ss = (float*)(vs + 128 * 128);
    float* sm = Ss + 128 * SP;
    float* a_tok = sm, *M_tok = sm + 128, *bc_tok = sm + 256, *nst = sm + 384, *misc = sm + 448;
    const float* CST = (const float*)(F.ws + WS_CST); const float* NST = (const float*)(F.ws + WS_NST); const float* MS = (const float*)(F.ws + WS_MSC) + 32 * NCHUNK;
    const int r0 = bb * TPB + tb * 128;
    int tidl = F.tid; asm volatile("" : "+v"(tidl));
    const int vg = tidl & 15, tg = tidl >> 4;
    float hsum[4][8];
#pragma unroll
    for (int a = 0; a < 4; ++a)
#pragma unroll
        for (int e = 0; e < 8; ++e) hsum[a][e] = 0.f;
    for (int dir = 0; dir < 2; ++dir) {
        const int chain = bb * 8 + head * 2 + dir, ci = chain * NCHUNK + tb;
        __syncthreads();
        int tA = F.tid; asm volatile("" : "+v"(tA));
#pragma unroll
        for (int i = 0; i < 2; ++i) { const int vi = tA + 512 * i, tok = vi >> 3, c8 = (vi & 7) * 8; const bf16raw* pr = P + (size_t)(r0 + tok) * PP + head * 64 + c8;
            *(u32x4_t*)(qs + tok * 64 + c8) = *(const u32x4_t*)(pr + C_MQ); *(u32x4_t*)(kc + tok * KP + c8) = *(const u32x4_t*)(pr + C_MK); }
#pragma unroll
        for (int i = 0; i < 4; ++i) { const int vi = tA + 512 * i, tok = vi >> 4, c8 = (vi & 15) * 8; *(u32x4_t*)(vs + tok * 128 + c8) = *(const u32x4_t*)(P + (size_t)(r0 + tok) * PP + C_MV + head * 128 + c8); }
        const float m_prev = MS[ci];
        if (F.wave == 0) {
            float ig[2], bc[2], bl; gate_scan(P, gb, r0, head, dir, F.lane, ig, bc, bl);
            const float a0 = ig[0] - bc[0], a1 = ig[1] - bc[1];
            const float pm = fmaxf(a0, a1); float v = pm;
#pragma unroll
            for (int o = 1; o < 64; o <<= 1) { const float tt = __shfl_up(v, o); if (F.lane >= o) v = fmaxf(v, tt); }
            float ex = __shfl_up(v, 1); if (F.lane == 0) ex = -3.0e38f;
            const float M0 = fmaxf(m_prev, fmaxf(ex, a0)), M1 = fmaxf(m_prev, fmaxf(ex, pm));
            const int s0 = 2 * F.lane, t0 = dir ? 127 - s0 : s0, t1 = dir ? 126 - s0 : s0 + 1;
            a_tok[t0] = a0; a_tok[t1] = a1; M_tok[t0] = M0; M_tok[t1] = M1; bc_tok[t0] = bc[0]; bc_tok[t1] = bc[1];
        } else if (F.wave == 1) { nst[F.lane] = NST[(size_t)ci * 64 + F.lane]; }
        __syncthreads();
        {
            float sacc[4][8];
#pragma unroll
            for (int a = 0; a < 4; ++a)
#pragma unroll
                for (int i = 0; i < 8; ++i) sacc[a][i] = 0.f;
#pragma unroll 1
            for (int d0 = 0; d0 < 64; d0 += 8) {
                float qf[4][8];
#pragma unroll
                for (int a = 0; a < 4; ++a) unpack8(*(const u32x4_t*)(qs + (4 * tg + a) * 64 + d0), qf[a]);
#pragma unroll
                for (int i = 0; i < 8; ++i) { float kf[8]; unpack8(*(const u32x4_t*)(kc + (vg + 16 * i) * KP + d0), kf);
#pragma unroll
                    for (int a = 0; a < 4; ++a)
#pragma unroll
                        for (int e = 0; e < 8; ++e) sacc[a][i] += qf[a][e] * kf[e]; }
            }
#pragma unroll
            for (int a = 0; a < 4; ++a) { const int t = 4 * tg + a; const float Mt = M_tok[t];
#pragma unroll
                for (int i = 0; i < 8; ++i) { const int s = vg + 16 * i; const bool ok = dir ? (s >= t) : (s <= t);
                    Ss[t * SP + s] = ok ? sacc[a][i] * 0.125f * expf(a_tok[s] - Mt) : 0.f; } }
        }
        __syncthreads();
        {
            const float* Cg = CST + (size_t)ci * 8192;
#pragma unroll
            for (int i = 0; i < 4; ++i) { const int vi = tA + 512 * i, vrow = vi >> 4, c4 = (vi & 15) * 4; const f32x4_t cv = *(const f32x4_t*)(Cg + vrow * 64 + c4);
                u32x2_t w; w.x = pk2(cv.x, cv.y); w.y = pk2(cv.z, cv.w); *(u32x2_t*)(kc + vrow * KP + c4) = w; }
        }
        float num[4][8], rs[4];
#pragma unroll
        for (int a = 0; a < 4; ++a) { rs[a] = 0.f;
#pragma unroll
            for (int e = 0; e < 8; ++e) num[a][e] = 0.f; }
        {
            const int wv16 = 16 * F.wave;
            const int sbeg = dir ? wv16 : 0, send = dir ? 128 : wv16 + 16;
#pragma unroll 1
            for (int s0 = sbeg; s0 < send; s0 += 4) {
                f32x4_t S4[4];
#pragma unroll
                for (int a = 0; a < 4; ++a) S4[a] = *(const f32x4_t*)(Ss + (4 * tg + a) * SP + s0);
#pragma unroll
                for (int ss = 0; ss < 4; ++ss) { float vf[8]; unpack8(*(const u32x4_t*)(vs + (s0 + ss) * 128 + 8 * vg), vf);
#pragma unroll
                    for (int a = 0; a < 4; ++a) { const float sv = S4[a][ss]; rs[a] += sv;
#pragma unroll
                        for (int e = 0; e < 8; ++e) num[a][e] += sv * vf[e]; } }
            }
        }
        __syncthreads();
        {
            float qc[4][8], nq[4];
#pragma unroll
            for (int a = 0; a < 4; ++a) { nq[a] = 0.f;
#pragma unroll
                for (int e = 0; e < 8; ++e) qc[a][e] = 0.f; }
#pragma unroll 1
            for (int d0 = 0; d0 < 64; d0 += 8) {
                float qf[4][8];
#pragma unroll
                for (int a = 0; a < 4; ++a) { unpack8(*(const u32x4_t*)(qs + (4 * tg + a) * 64 + d0), qf[a]);
#pragma unroll
                    for (int e = 0; e < 8; ++e) nq[a] += nst[d0 + e] * qf[a][e]; }
#pragma unroll
                for (int e = 0; e < 8; ++e) { float cf[8]; unpack8(*(const u32x4_t*)(kc + (8 * vg + e) * KP + d0), cf);
#pragma unroll
                    for (int a = 0; a < 4; ++a)
#pragma unroll
                        for (int k = 0; k < 8; ++k) qc[a][e] += cf[k] * qf[a][k]; }
            }
#pragma unroll
            for (int a = 0; a < 4; ++a) { const int t = 4 * tg + a; const float Mt = M_tok[t], winter = expf(m_prev - Mt);
                const float den = winter * nq[a] + rs[a]; const float dn = fmaxf(fabsf(den), expf(-(bc_tok[t] + Mt))); const float inv = 1.0f / dn;
#pragma unroll
                for (int e = 0; e < 8; ++e) hsum[a][e] += (winter * qc[a][e] + num[a][e]) * inv; }
        }
    }
    float gmm[8];
#pragma unroll
    for (int e = 0; e < 8; ++e) gmm[e] = ng[head * 128 + 8 * vg + e];
#pragma unroll
    for (int a = 0; a < 4; ++a) { float ss = 0.f;
#pragma unroll
        for (int e = 0; e < 8; ++e) ss += hsum[a][e] * hsum[a][e];
        ss += __shfl_xor(ss, 1); ss += __shfl_xor(ss, 2); ss += __shfl_xor(ss, 4); ss += __shfl_xor(ss, 8);
        const float rstd = 1.0f / sqrtf(ss * (1.f / 128.f) + NORM_EPS);
        const int row = r0 + 4 * tg + a; float of[8]; unpack8(*(const u32x4_t*)(P + (size_t)row * PP + C_MO + head * 128 + 8 * vg), of);
        float yv[8];
#pragma unroll
        for (int e = 0; e < 8; ++e) yv[e] = hsum[a][e] * rstd * gmm[e] * sigmoid_f(of[e]);
        *(u32x4_t*)(Y + (size_t)row * DM + head * 128 + 8 * vg) = pack8(yv); }
    (void)misc;
}

#define KSWZ64(row, colB) ((row) * 128 + ((colB) ^ (((row) & 7) << 4)))
__device__ __forceinline__ void mlstm_c_unit_mfma(const Frame& F, const bf16raw* __restrict__ P, const float* __restrict__ gb, const float* __restrict__ ng, bf16raw* __restrict__ Y, int bb, int head, int tb) {
    using att::bf16x8; using att::f32x16; using att::crow;
    constexpr int CP = 72;
    constexpr int L_K = 0, L_V = 16384, L_C = 49152, L_SM = 86016, L_WS = 90112, L_HB = 0, HP = 132;
    char* lds = F.lds;
    int tid = F.tid; asm volatile("" : "+v"(tid));
    const int wid = F.wave, lane = tid & 63, r32 = lane & 31, hi = lane >> 5, dir = wid >> 2, rg = wid & 3;
    if (wid >= 4) __builtin_amdgcn_s_setprio(1);
    const float* CST = (const float*)(F.ws + WS_CST); const float* NST = (const float*)(F.ws + WS_NST); const float* MS = (const float*)(F.ws + WS_MSC) + 32 * NCHUNK;
    const int r0 = bb * TPB + tb * 128;
    float* sm = (float*)(lds + L_SM);
    float* wsc = (float*)(lds + L_WS) + wid * 64;
    __syncthreads();
#pragma unroll
    for (int i = 0; i < 2; ++i) { const int vi = tid + 512 * i, key = vi >> 3, c8 = (vi & 7) * 8;
        *(u32x4_t*)(lds + L_K + (key >> 6) * 8192 + KSWZ64(key & 63, c8 * 2)) = *(const u32x4_t*)(P + (size_t)(r0 + key) * PP + C_MK + head * 64 + c8); }
#pragma unroll
    for (int i = 0; i < 4; ++i) { const int vi = tid + 512 * i, key = vi >> 4, c8 = (vi & 15) * 8;
        *(u32x4_t*)(lds + L_V + (key >> 6) * 16384 + att::v_st(key & 63, c8)) = *(const u32x4_t*)(P + (size_t)(r0 + key) * PP + C_MV + head * 128 + c8); }
#pragma unroll
    for (int i = 0; i < 8; ++i) { const int vi = tid + 512 * i, d2 = vi >> 11, rem = vi & 2047, vrow = rem >> 4, c4 = (rem & 15) * 4;
        const int ci2 = (bb * 8 + head * 2 + d2) * NCHUNK + tb; const f32x4_t cv = *(const f32x4_t*)(CST + (size_t)ci2 * 8192 + vrow * 64 + c4);
        u32x2_t w; w.x = pk2(cv.x, cv.y); w.y = pk2(cv.z, cv.w); *(u32x2_t*)(lds + L_C + d2 * 18432 + (vrow * CP + c4) * 2) = w; }
    const int chain = bb * 8 + head * 2 + dir, ci = chain * NCHUNK + tb;
    const float m_prev = MS[ci];
    float* smd = sm + dir * 448;
    if (rg == 0) {
        float ig[2], bc[2], bl; gate_scan(P, gb, r0, head, dir, lane, ig, bc, bl);
        const float a0 = ig[0] - bc[0], a1 = ig[1] - bc[1]; const float pm = fmaxf(a0, a1); float v = pm;
#pragma unroll
        for (int o = 1; o < 64; o <<= 1) { const float tt = __shfl_up(v, o); if (lane >= o) v = fmaxf(v, tt); }
        float ex = __shfl_up(v, 1); if (lane == 0) ex = -3.0e38f;
        const float M0 = fmaxf(m_prev, fmaxf(ex, a0)), M1 = fmaxf(m_prev, fmaxf(ex, pm));
        const int s0 = 2 * lane, t0 = dir ? 127 - s0 : s0, t1 = dir ? 126 - s0 : s0 + 1;
        smd[t0] = a0; smd[t1] = a1; smd[128 + t0] = M0; smd[128 + t1] = M1; smd[256 + t0] = bc[0]; smd[256 + t1] = bc[1];
    } else if (rg == 1) { smd[384 + lane] = NST[(size_t)ci * 64 + lane]; }
    const int tq = 32 * rg + r32;
    bf16x8 qr[4];
#pragma unroll
    for (int d0 = 0; d0 < 4; ++d0) qr[d0] = *reinterpret_cast<const bf16x8*>(P + (size_t)(r0 + tq) * PP + C_MQ + head * 64 + d0 * 16 + hi * 8);
    __syncthreads();
    const float Mt = smd[128 + tq], winter = __expf(m_prev - Mt);
    float nq = 0.f; bf16x8 qs[4];
#pragma unroll
    for (int d0 = 0; d0 < 4; ++d0) { float qf[8]; unpack8(__builtin_bit_cast(u32x4_t, qr[d0]), qf); float qw[8];
#pragma unroll
        for (int e = 0; e < 8; ++e) { nq += smd[384 + d0 * 16 + hi * 8 + e] * qf[e]; qw[e] = qf[e] * winter; }
        qs[d0] = __builtin_bit_cast(bf16x8, pack8(qw)); }
    { auto rr = __builtin_amdgcn_permlane32_swap(__float_as_uint(nq), __float_as_uint(nq), false, false); nq = __uint_as_float(rr[0]) + __uint_as_float(rr[1]); }
    f32x16 o[4] = {};
    { const char* cb = lds + L_C + dir * 18432;
#pragma unroll
      for (int blk = 0; blk < 4; ++blk)
#pragma unroll
        for (int ks = 0; ks < 4; ++ks) { const bf16x8 cf = *reinterpret_cast<const bf16x8*>(cb + ((32 * blk + r32) * CP + 16 * ks + 8 * hi) * 2);
            o[blk] = __builtin_amdgcn_mfma_f32_32x32x16_bf16(qs[ks], cf, o[blk], 0, 0, 0); } }
    float rs = 0.f;
    const int vb0 = (int)(uintptr_t)(lds + L_V) + att::v_rd_base(lane);
    const int kt_lo = dir ? (rg >= 2 ? 1 : 0) : 0, kt_hi = dir ? 1 : (rg >= 2 ? 1 : 0);
    for (int kt = kt_lo; kt <= kt_hi; ++kt) {
        f32x16 p0 = {}, p1 = {};
        const char* Ks = lds + L_K + kt * 8192;
#pragma unroll
        for (int d0 = 0; d0 < 4; ++d0) { const int cbb = (d0 * 16 + hi * 8) * 2;
            const bf16x8 b0 = *reinterpret_cast<const bf16x8*>(Ks + KSWZ64(r32, cbb)), b1 = *reinterpret_cast<const bf16x8*>(Ks + KSWZ64(32 + r32, cbb));
            p0 = __builtin_amdgcn_mfma_f32_32x32x16_bf16(b0, qr[d0], p0, 0, 0, 0); p1 = __builtin_amdgcn_mfma_f32_32x32x16_bf16(b1, qr[d0], p1, 0, 0, 0); }
#pragma unroll
        for (int r = 0; r < 16; ++r) { const int s0_ = 64 * kt + crow(r, hi), s1_ = s0_ + 32;
            const bool ok0 = dir ? (s0_ >= tq) : (s0_ <= tq), ok1 = dir ? (s1_ >= tq) : (s1_ <= tq);
            const float w0 = ok0 ? 0.125f * __expf(smd[s0_] - Mt) : 0.f, w1 = ok1 ? 0.125f * __expf(smd[s1_] - Mt) : 0.f;
            p0[r] *= w0; p1[r] *= w1; rs += p0[r] + p1[r]; }
        bf16x8 pa0, pa1, pa2, pa3;
#define PK4M(Pv, BASE, OUT) do { u32x4_t w_ = {att::cvtpk(Pv[BASE + 0], Pv[BASE + 1]), att::cvtpk(Pv[BASE + 2], Pv[BASE + 3]), att::cvtpk(Pv[BASE + 4], Pv[BASE + 5]), att::cvtpk(Pv[BASE + 6], Pv[BASE + 7])}; OUT = __builtin_bit_cast(bf16x8, w_); } while (0)
        PK4M(p0, 0, pa0); PK4M(p0, 8, pa1); PK4M(p1, 0, pa2); PK4M(p1, 8, pa3);
#undef PK4M
        __builtin_amdgcn_sched_barrier(0);
        const int vb = vb0 + kt * 16384;
        att::pv_one<0>(o[0], vb, pa0, pa1, pa2, pa3); att::pv_one<1>(o[1], vb, pa0, pa1, pa2, pa3); att::pv_one<2>(o[2], vb, pa0, pa1, pa2, pa3); att::pv_one<3>(o[3], vb, pa0, pa1, pa2, pa3);
    }
    { auto rr = __builtin_amdgcn_permlane32_swap(__float_as_uint(rs), __float_as_uint(rs), false, false); rs = __uint_as_float(rr[0]) + __uint_as_float(rr[1]); }
    const float den = winter * nq + rs; const float dn = fmaxf(fabsf(den), __expf(-(smd[256 + tq] + Mt)));
    if (hi == 0) wsc[r32] = 1.0f / dn;
    asm volatile("s_waitcnt lgkmcnt(0)" ::: "memory");
    float inv[16];
#pragma unroll
    for (int r = 0; r < 16; ++r) inv[r] = wsc[crow(r, hi)];
    __syncthreads();
    float* hb = (float*)(lds + L_HB);
    if (dir == 1) {
#pragma unroll
        for (int blk = 0; blk < 4; ++blk)
#pragma unroll
            for (int r = 0; r < 16; ++r) hb[(32 * rg + crow(r, hi)) * HP + 32 * blk + r32] = o[blk][r] * inv[r];
    }
    __syncthreads();
    __builtin_amdgcn_s_setprio(0);
    if (dir == 0) {
        float ss[16];
#pragma unroll
        for (int r = 0; r < 16; ++r) ss[r] = 0.f;
#pragma unroll
        for (int blk = 0; blk < 4; ++blk)
#pragma unroll
            for (int r = 0; r < 16; ++r) { const float h = o[blk][r] * inv[r] + hb[(32 * rg + crow(r, hi)) * HP + 32 * blk + r32]; o[blk][r] = h; ss[r] += h * h; }
#pragma unroll
        for (int r = 0; r < 16; ++r) { float s = ss[r]; s += __shfl_xor(s, 1); s += __shfl_xor(s, 2); s += __shfl_xor(s, 4); s += __shfl_xor(s, 8); s += __shfl_xor(s, 16); ss[r] = 1.0f / sqrtf(s * (1.f / 128.f) + NORM_EPS); }
#pragma unroll
        for (int blk = 0; blk < 4; ++blk) { const float gm = ng[head * 128 + 32 * blk + r32];
#pragma unroll
            for (int r = 0; r < 16; ++r) { const size_t row = (size_t)(r0 + 32 * rg + crow(r, hi));
                const float og = bf1(P[row * PP + C_MO + head * 128 + 32 * blk + r32]);
                const float yv = o[blk][r] * ss[r] * gm * sigmoid_f(og);
                Y[row * DM + head * 128 + 32 * blk + r32] = (bf16raw)(pk2(yv, 0.f) & 0xffffu); } }
    }
}

__device__ __forceinline__ void diff_post_phase(const Frame& F, const bf16raw* __restrict__ T, const float* __restrict__ lam, const float* __restrict__ g, float one_minus, bf16raw* __restrict__ Y) {
    const int h = F.lane >> 4, c8 = (F.lane & 15) * 8; const float lm = lam[h]; float gm[8];
#pragma unroll
    for (int e = 0; e < 8; ++e) gm[e] = g[h * 128 + c8 + e] * one_minus;
    for (int r = F.gw; r < MROWS; r += 2 * F.NGW) {
        const int r2 = r + F.NGW; const bool has2 = r2 < MROWS; const int rb = has2 ? r2 : r;
        const u32x4_t wa1 = *(const u32x4_t*)(T + (size_t)r * 1024 + (2 * h) * 128 + c8), wa2 = *(const u32x4_t*)(T + (size_t)r * 1024 + (2 * h + 1) * 128 + c8);
        const u32x4_t wb1 = *(const u32x4_t*)(T + (size_t)rb * 1024 + (2 * h) * 128 + c8), wb2 = *(const u32x4_t*)(T + (size_t)rb * 1024 + (2 * h + 1) * 128 + c8);
#pragma unroll
        for (int q = 0; q < 2; ++q) {
            float o1[8], o2[8]; unpack8(q ? wb1 : wa1, o1); unpack8(q ? wb2 : wa2, o2);
            float ss = 0.f;
#pragma unroll
            for (int e = 0; e < 8; ++e) { o1[e] -= lm * o2[e]; ss += o1[e] * o1[e]; }
            ss += __shfl_xor(ss, 1); ss += __shfl_xor(ss, 2); ss += __shfl_xor(ss, 4); ss += __shfl_xor(ss, 8);
            const float rstd = 1.0f / sqrtf(ss * (1.f / 128.f) + NORM_EPS);
#pragma unroll
            for (int e = 0; e < 8; ++e) o1[e] *= rstd * gm[e];
            if (q == 0 || has2) *(u32x4_t*)(Y + (size_t)(q ? r2 : r) * DM + 512 + h * 128 + c8) = pack8(o1);
        }
    }
}

__device__ __forceinline__ void mixer_phase(const Frame& F, CArgsP0 a, int l) {
    const hbf16* P = (const hbf16*)(F.ws + WS_P); hbf16* Yb = (hbf16*)(F.ws + WS_Y); hbf16* DT = (hbf16*)(F.ws + WS_DTMP);
    const bool lastl = (l == DEPTH - 1);
    const float* lamv = (const float*)(F.ws + WS_LAM) + l * 4; const float* dng = a->in[11] + l * 512; const float one_minus = (l == 0) ? 0.8f : 0.64449093241f;
    REPX(1) if (MX_MASK & 1) for (int k = F.vcu; k < 1024; k += F.G) {
        const int i = k >> 8, rem = k & 255;
        __syncthreads();
        if (i < 2) { const int id = i * 256 + rem, combo = id >> 6, qb = id & 63, bb = combo >> 2, h = combo & 3;
            const long rq = (long)bb * TPB + CTX + qb * 256, rk = (long)bb * TPB;
            att::attn_dense_body<64, DM, 1>(P + rq * PP + C_DQ + h * 128, P + rk * PP + C_DK + h * 128, P + rk * PP + C_DV + h * 128, Yb, TPB, 0, F.lds);
            __syncthreads();
            att::attn_dense_body<64, DM, 2>(P + rq * PP + C_DQ + h * 128 + 64, P + rk * PP + C_DK + h * 128, P + rk * PP + C_DV + h * 128, Yb + rq * DM + 512 + h * 128, TPB, 64, F.lds, lamv[h], dng + h * 128, one_minus);
        } else { const int id = (i - 2) * 256 + rem, combo = id >> 6, qb = id & 63, bb = combo >> 2, h = combo & 3;
            const long rq = (long)bb * TPB + CTX + qb * 256, rk = (long)bb * TPB;
            att::attn_dense_body<128, DM>(P + rq * PP + C_GQ + h * 128, P + rk * PP + C_GK + (h >> 1) * 128, P + rk * PP + C_GV + (h >> 1) * 128, Yb + rq * DM + 1536 + h * 128, TPB, 0, F.lds);
        }
    }
    if (!lastl && (MX_MASK & 1)) for (int k = F.vcu; k < 16; k += F.G) {
        __syncthreads();
        if (k < 8) { const int bb = k >> 2, h = k & 3; const long rq = (long)bb * TPB;
            att::attn_dense_body<64, DM, 1>(P + rq * PP + C_DQ + h * 128, P + rq * PP + C_DK + h * 128, P + rq * PP + C_DV + h * 128, Yb, CTX, 0, F.lds);
            __syncthreads();
            att::attn_dense_body<64, DM, 2>(P + rq * PP + C_DQ + h * 128 + 64, P + rq * PP + C_DK + h * 128, P + rq * PP + C_DV + h * 128, Yb + rq * DM + 512 + h * 128, CTX, 64, F.lds, lamv[h], dng + h * 128, one_minus);
        } else { const int k2 = k - 8, bb = k2 >> 2, h = k2 & 3; const long rq = (long)bb * TPB;
            att::attn_dense_body<128, DM>(P + rq * PP + C_GQ + h * 128, P + rq * PP + C_GK + (h >> 1) * 128, P + rq * PP + C_GV + (h >> 1) * 128, Yb + rq * DM + 1536 + h * 128, CTX, 0, F.lds);
        }
    }
    __syncthreads();
    const float* sinkl = a->in[12] + l * 8;
    REPX(2) if (MX_MASK & 2) for (int k = F.vcu; k < (lastl ? 1024 : 1040); k += F.G) {
        if (k < 1024) att::swa_unit(P, Yb, k >> 9, (k >> 8) & 1, k & 255, false, sinkl, F.lds);
        else { const int k2 = k - 1024; att::swa_unit(P, Yb, k2 >> 3, (k2 >> 2) & 1, k2 & 3, true, sinkl, F.lds); }
    }
    const float* gb = a->in[8] + l * 16; const float* ng = a->in[9] + l * 512;
    REPX(4) if (MX_MASK & 4) for (int k = F.vcu; k < (lastl ? 8 * (NCHUNK - 2) : 8 * NCHUNK); k += F.G) { int bb, head, tb;
        if (lastl) { bb = k / (4 * (NCHUNK - 2)); const int rem = k - bb * 4 * (NCHUNK - 2); head = rem / (NCHUNK - 2); tb = 2 + rem - head * (NCHUNK - 2); }
        else { bb = k / (4 * NCHUNK); const int rem = k - bb * 4 * NCHUNK; head = rem / NCHUNK; tb = rem - head * NCHUNK; }
#ifdef MLSTM_VALU
        mlstm_c_unit(F, (const bf16raw*)P, gb, ng, (bf16raw*)Yb, bb, head, tb);
#else
        mlstm_c_unit_mfma(F, (const bf16raw*)P, gb, ng, (bf16raw*)Yb, bb, head, tb);
#endif
    }
    __syncthreads();
}

__device__ __forceinline__ void stagger_start(int ticks) {
    const int grp = (blockIdx.x >> 3) & 3;
    if (grp) { const unsigned long long t0 = __builtin_amdgcn_s_memrealtime(); const unsigned long long d = (unsigned long long)(grp * ticks);
        while (__builtin_amdgcn_s_memrealtime() - t0 < d) __builtin_amdgcn_s_sleep(16); }
}
#ifndef STAG_GATE
#define STAG_GATE 0
#endif
#ifndef STAG_RESID
#define STAG_RESID 0
#endif
struct RowOrder { pg8::StaticOrder S; int skip;
    __device__ void init(int N, int G, int c, int skip_) { skip = skip_; S.init(skip_ ? NBATCH * SEQ : MROWS, N, G, c); }
    __device__ bool next(int i, pg8::Unit& u) const { if (!S.next(i, u)) return false; if (skip) u.pm += 1 + (u.pm >= 64 ? 1 : 0); return true; }
    __device__ __forceinline__ void a_ready(const pg8::Unit&) const {}
    __device__ __forceinline__ void done(const pg8::Unit&) const {}
};
typedef const __attribute__((address_space(4))) Args* CArgsP;
__device__ __forceinline__ CArgsP get_args() { CArgsP p = (CArgsP)__builtin_amdgcn_kernarg_segment_ptr(); asm volatile("" : "+s"(p)); return p; }
#define PHASE_BEGIN CArgsP ap = get_args(); unsigned char* ws = ap->ws; const Frame F = make_frame(ws, (char*)lds); (void)F;
__global__ void __launch_bounds__(512, 2) fwd_megakernel(Args a_unused) {
    extern __shared__ __attribute__((aligned(16))) unsigned char lds[];
    cg::grid_group grid = cg::this_grid();
    PG8_LAS unsigned char* glds = (PG8_LAS unsigned char*)lds;
    if (threadIdx.x < 16) ((LAS unsigned*)((LAS unsigned char*)lds + LDS_BARST))[threadIdx.x] = 0u;
    __syncthreads();
    { CArgsP ap0 = get_args(); (void)xcd_barrier_post((unsigned*)(ap0->ws + WS_BAR), (volatile LAS unsigned*)((LAS unsigned char*)lds + LDS_BARST)); }
#define GBAR() do { CArgsP apb = get_args(); XcdBarrier xb_; xb_.bar = (unsigned*)(apb->ws + WS_BAR); xb_.x = xb_xcc_id(); xb_.st = (volatile LAS unsigned*)((LAS unsigned char*)lds + LDS_BARST); xcd_barrier(xb_); } while (0)
    REP(1) if (PH_MASK & 1) { PHASE_BEGIN s0_phase(F, ap); }
    grid.sync();
#ifdef EXTRA_SYNCS
    for (int es = 0; es < EXTRA_SYNCS; ++es) GBAR();
#endif
#pragma unroll 1
    for (int l = 0; l < DEPTH; ++l) {
        REP(2) if (PH_MASK & 2) { PHASE_BEGIN s1_phase(F, ap, l); }
        GBAR();
        REP(4) if (PH_MASK & 4) { PHASE_BEGIN const float* modl = (const float*)(ws + WS_MOD) + (size_t)l * 3 * 12288;
            const XPtr xin = (l == 0) ? XPtr{ap->in[0], ap->in[2]} : XPtr{ap->out, (const float*)(ws + WS_XC)};
            norm_mod_phase(F, xin, (l == 0) ? (const bf16raw*)nullptr : (const bf16raw*)(ws + WS_H), XOut{ap->out, (float*)(ws + WS_XC)}, ap->in[6] + l * DM, modl, 0, 1, (bf16raw*)(ws + WS_H)); }
        GBAR();
        REP(8) if (PH_MASK & 8) { PHASE_BEGIN
            pg8::Gemm g{(const pg8::bf16_t*)(ws + WS_H), (const pg8::bf16_t*)(ws + WS_WIN), MROWS, PP, DM, DM, 0, 0}; pg8::StaticOrder S; S.init(MROWS, PP, F.G, (int)blockIdx.x);
            pg8::EpiBf16<0> E{(pg8::bf16_t*)(ws + WS_P), PP, nullptr, 0, 0, 1.f};
            pg8::gemm_phase<pg8::EpiBf16<0>, pg8::StaticOrder, P_ALIGN, true>(glds, g, S, E);
        }
        GBAR();
        if (PH_MASK & 16) { PHASE_BEGIN rope_phase(F, (bf16raw*)(ws + WS_P), ap->in[13] + l * 128, ap->in[14] + l * 128); }
#ifdef DBL_SCAN
        for (int rs_ = 0; rs_ < 2; ++rs_) {
#endif
        REP(32) if (PH_MASK & 32) { PHASE_BEGIN mlstm_a_phase(F, (const bf16raw*)(ws + WS_P), ap->in[8] + l * 16); }
        GBAR();
        if (PH_MASK & 64) { PHASE_BEGIN mlstm_b_phase(F); }
        GBAR();
#ifdef DBL_SCAN
        }
#endif
        if (PH_MASK & 128) { PHASE_BEGIN mixer_phase(F, ap, l); }
        GBAR();
        REP(512) if (PH_MASK & 512) { PHASE_BEGIN
            pg8::Gemm g{(const pg8::bf16_t*)(ws + WS_Y), (const pg8::bf16_t*)(ws + WS_WB), MROWS, 8192, 512, DM, 8, 512}; RowOrder S; S.init(8192, F.G, (int)blockIdx.x, l == DEPTH - 1);
            pg8::EpiBf16<0> E{(pg8::bf16_t*)(ws + WS_BIG), DM, nullptr, DM, (size_t)MROWS * DM, 1.f};
            pg8::gemm_phase<pg8::EpiBf16<0>, RowOrder, BR_ALIGN, true>(glds, g, S, E);
        }
        GBAR();
        REP(1024) if (PH_MASK & 1024) { PHASE_BEGIN
            pg8::Gemm g{(const pg8::bf16_t*)(ws + WS_H), (const pg8::bf16_t*)(ws + WS_WG), MROWS, 8192, DM, DM, 0, 0}; RowOrder S; S.init(8192, F.G, (int)blockIdx.x, l == DEPTH - 1);
            pg8::EpiGate E{(const pg8::bf16_t*)(ws + WS_BIG), (pg8::bf16_t*)(ws + WS_Y), (size_t)MROWS * DM};
            if (STAG_GATE) stagger_start(STAG_GATE);
#ifdef PROBE_GATE_KLOOP
            { pg8::EpiNone E0{(float*)(ws + WS_ZT)}; pg8::gemm_phase<pg8::EpiNone, RowOrder, GATE_ALIGN, true>(glds, g, S, E0); }
#endif
            pg8::gemm_phase<pg8::EpiGate, RowOrder, GATE_ALIGN, true>(glds, g, S, E);
        }
        GBAR();
        if (PH_MASK & 2048) { PHASE_BEGIN
            const float* modl = (const float*)(ws + WS_MOD) + (size_t)l * 3 * 12288;
            pg8::Gemm g{(const pg8::bf16_t*)(ws + WS_Y), (const pg8::bf16_t*)(ws + WS_WOUT), MROWS, DM, DM, DM, 0, 0}; RowOrder S; S.init(DM, F.G, (int)blockIdx.x, l == DEPTH - 1);
            pg8::EpiDelta E{(pg8::bf16_t*)(ws + WS_H), modl, 2};
            pg8::gemm_phase<pg8::EpiDelta, RowOrder, true, true>(glds, g, S, E);
        }
        GBAR();
        REP(4) if (PH_MASK & 4) { PHASE_BEGIN const float* modl = (const float*)(ws + WS_MOD) + (size_t)l * 3 * 12288;
            const XPtr xin2 = (l == 0) ? XPtr{ap->in[0], ap->in[2]} : XPtr{ap->out, (const float*)(ws + WS_XC)};
            norm_mod_phase(F, xin2, (const bf16raw*)(ws + WS_H), XOut{ap->out, (float*)(ws + WS_XC)}, ap->in[17] + l * DM, modl, 3, 4, (bf16raw*)(ws + WS_H)); }
        GBAR();
        REP(4096) if (PH_MASK & 4096) { PHASE_BEGIN
            pg8::Gemm g{(const pg8::bf16_t*)(ws + WS_H), (const pg8::bf16_t*)(ws + WS_WUP), MROWS, 2 * FF, DM, DM, 0, 0}; RowOrder S; S.init(2 * FF, F.G, (int)blockIdx.x, l == DEPTH - 1);
            pg8::EpiSwiGLU E{(pg8::bf16_t*)(ws + WS_BIG), FF};
            pg8::gemm_phase<pg8::EpiSwiGLU, RowOrder, UP_ALIGN, true>(glds, g, S, E);
        }
        GBAR();
        if (PH_MASK & 8192) { PHASE_BEGIN
            const float* modl = (const float*)(ws + WS_MOD) + (size_t)l * 3 * 12288;
            pg8::Gemm g{(const pg8::bf16_t*)(ws + WS_BIG), (const pg8::bf16_t*)(ws + WS_WDN), MROWS, DM, FF, FF, 0, 0}; RowOrder S; S.init(DM, F.G, (int)blockIdx.x, l == DEPTH - 1);
            pg8::EpiDelta E{(pg8::bf16_t*)(ws + WS_H), modl, 5};
            pg8::gemm_phase<pg8::EpiDelta, RowOrder, true, true>(glds, g, S, E);
        }
        GBAR();
    }
    if (PH_MASK & 16384) { PHASE_BEGIN final_norm_phase(F, ap->out, (const bf16raw*)(ws + WS_H), ap->in[20]); }
}

extern "C" void kernel_launch(void* const* d_in, const int* in_sizes, int n_in, void* d_out, int out_size, void* d_ws, size_t ws_size, hipStream_t stream) {
    static int grid = 0;
    if (grid == 0) {
        if (n_in != 21 || out_size != NBATCH * SEQ * DM || ws_size < WS_END) { fprintf(stderr, "kernel_launch: unexpected shapes: n_in %d out %d ws %zu (need %zu)\n", n_in, out_size, ws_size, (size_t)WS_END); grid = -1; return; }
        int dev = 0, cus = 0, per_cu = 0;
        if (hipGetDevice(&dev) != hipSuccess || hipDeviceGetAttribute(&cus, hipDeviceAttributeMultiprocessorCount, dev) != hipSuccess) { grid = -1; return; }
        if (hipFuncSetAttribute((const void*)fwd_megakernel, hipFuncAttributeMaxDynamicSharedMemorySize, LDS_BYTES) != hipSuccess) { fprintf(stderr, "kernel_launch: hipFuncSetAttribute failed\n"); grid = -1; return; }
        if (hipOccupancyMaxActiveBlocksPerMultiprocessor(&per_cu, (const void*)fwd_megakernel, 512, LDS_BYTES) != hipSuccess || per_cu < 1) per_cu = 1;
        (void)hipGetLastError();
        grid = cus;
        fprintf(stderr, "kernel_launch: cus %d per_cu %d grid %d ws %zu\n", cus, per_cu, grid, ws_size);
    }
    if (grid < 0) return;
    Args a{};
    for (int i = 0; i < 21; ++i) a.in[i] = (const float*)d_in[i];
    a.out = (float*)d_out; a.ws = (unsigned char*)d_ws;
    (void)hipMemsetAsync((char*)d_ws + WS_BAR, 0, XCD_BAR_WORDS * 4, stream);
    void* args[] = {&a};
    const hipError_t e = hipLaunchCooperativeKernel((const void*)fwd_megakernel, dim3(grid), dim3(512), args, LDS_BYTES, stream);
    if (e != hipSuccess) fprintf(stderr, "kernel_launch: cooperative launch failed: %s (grid %d)\n", hipGetErrorString(e), grid);
}
```
